# Optimizing an MI355X kernel written in HIP

```python
import math
import jax
import jax.numpy as jnp
from jax import lax
import numpy as np

D_MODEL = 1024
BATCH = 4
SEQ = 8192
DEPTH = 2

GRID_W = 64
CTX_LEN = 256
EPS = 1e-6

CONV_DIM = 512
CONV_W = 3
GDN_HEADS = 4
GDN_DK = 128
GDN_DV = 128
GDN_CHUNK = 64
GDN_QK = GDN_HEADS * GDN_DK
GDN_V = GDN_HEADS * GDN_DV
MIX_DIM = CONV_DIM + GDN_V
IN_SIZES = (CONV_DIM, CONV_DIM, CONV_DIM, 2 * GDN_QK + GDN_V, GDN_V, GDN_HEADS, GDN_HEADS, GDN_HEADS, GDN_HEADS)
IN_COLS = sum(IN_SIZES)
DIFF_HEADS = 8
DIFF_DH = 64
DIFF_QK = DIFF_HEADS * 2 * DIFF_DH
DIFF_V = DIFF_HEADS * 2 * DIFF_DH
Q_BLOCK = 128
ROPE_BASE = 10000.0
N_EXPERTS = 16
EXPERT_FF = 2048
CAPACITY_FACTOR = 2

kernel_name = 'hybrid_dit_conv_gdn_diffattn_ecmoe'


def _rmsnorm(x, w):
    xf = x.astype(jnp.float32)
    y = xf * lax.rsqrt(jnp.mean(xf * xf, axis=-1, keepdims=True) + EPS)
    return y.astype(x.dtype) * w


def _l2norm(x):
    xf = x.astype(jnp.float32)
    return (xf * lax.rsqrt(jnp.sum(xf * xf, axis=-1, keepdims=True) + EPS)).astype(x.dtype)


def _adaln(cond, w, b):
    m = jax.nn.silu(cond) @ w + b
    return jnp.split(m[:, None, :], 6, axis=-1)


def _modulate(x, w, shift, scale):
    return _rmsnorm(x, w) * (1.0 + scale) + shift


def _dwconv_centred(x, w):
    pad = CONV_W // 2
    return lax.conv_general_dilated(x, w[:, None, :], window_strides=(1,), padding=[(pad, pad)],
                                    dimension_numbers=('NWC', 'WIO', 'NWC'),
                                    feature_group_count=x.shape[-1])


def _gated_delta_chunked(q, k, v, g, beta, s0):
    f32 = jnp.float32
    bn, seq_len, nh, dk = q.shape
    dv = v.shape[-1]
    n = seq_len // GDN_CHUNK

    def chunks(t):
        t = t.astype(f32).reshape((bn, n, GDN_CHUNK, nh) + t.shape[3:])
        return jnp.moveaxis(t, 3, 1)

    q, k, v, g, beta = (chunks(t) for t in (q, k, v, g, beta))
    gc = jnp.cumsum(g, axis=-1)
    incl = jnp.tril(jnp.ones((GDN_CHUNK, GDN_CHUNK), bool))
    strict = jnp.tril(jnp.ones((GDN_CHUNK, GDN_CHUNK), bool), k=-1)
    diff = gc[..., :, None] - gc[..., None, :]
    decay = jnp.where(incl, jnp.exp(jnp.where(incl, diff, 0.0)), 0.0)
    k_beta = k * beta[..., None]
    lower = jnp.where(strict, jnp.einsum('bhncd,bhnmd->bhncm', k_beta, k) * decay, 0.0)
    eye = jnp.eye(GDN_CHUNK, dtype=f32)
    t_mat = lax.linalg.triangular_solve(eye + lower, jnp.broadcast_to(eye, lower.shape),
                                        left_side=True, lower=True, unit_diagonal=True)
    u = jnp.einsum('bhncm,bhnme->bhnce', t_mat, v * beta[..., None])
    w = jnp.einsum('bhncm,bhnmd->bhncd', t_mat, k_beta * jnp.exp(gc)[..., None])
    intra = jnp.where(incl, jnp.einsum('bhncd,bhnmd->bhncm', q, k) * decay, 0.0)
    q_dec = q * jnp.exp(gc)[..., None]
    k_dec = k * jnp.exp(gc[..., -1:] - gc)[..., None]
    g_last = jnp.exp(gc[..., -1])

    def step(state, xs):
        q_i, k_i, u_i, w_i, a_i, gl_i = xs
        v_new = u_i - jnp.einsum('bhcd,bhde->bhce', w_i, state)
        o = jnp.einsum('bhcd,bhde->bhce', q_i, state) + jnp.einsum('bhcm,bhme->bhce', a_i, v_new)
        state = state * gl_i[..., None, None] + jnp.einsum('bhcd,bhce->bhde', k_i, v_new)
        return state, o

    xs = tuple(jnp.moveaxis(t, 2, 0) for t in (q_dec, k_dec, u, w, intra, g_last))
    state, o = lax.scan(step, s0.astype(f32), xs)
    o = jnp.transpose(o, (1, 0, 3, 2, 4)).reshape(bn, seq_len, nh, dv)
    return o, state


def _conv_gdn_mixer(h, p, s0_f, s0_b):
    bn, seq_len, _ = h.shape
    splits = [int(s) for s in np.cumsum(IN_SIZES)[:-1]]
    xa, gate_b, gate_c, qkv, z, a_f, a_b, b_f, b_b = jnp.split(h @ p['w_in'], splits, axis=-1)
    y_conv = gate_b * _dwconv_centred(gate_c * xa, p['conv_a'])
    qkv = jax.nn.silu(_dwconv_centred(qkv, p['conv_qkv']))
    q, k, v = jnp.split(qkv, [GDN_QK, 2 * GDN_QK], axis=-1)
    q = _l2norm(q.reshape(bn, seq_len, GDN_HEADS, GDN_DK)) * GDN_DK ** -0.5
    k = _l2norm(k.reshape(bn, seq_len, GDN_HEADS, GDN_DK))
    v = v.reshape(bn, seq_len, GDN_HEADS, GDN_DV)

    def log_decay(a, d):
        return -jnp.exp(p['a_log'][d].astype(jnp.float32)) * jax.nn.softplus(a.astype(jnp.float32) + p['dt_bias'][d])

    def flip(t):
        return jnp.flip(t, axis=1)

    o_f, s_f = _gated_delta_chunked(q, k, v, log_decay(a_f, 0), jax.nn.sigmoid(b_f), s0_f)
    o_b, s_b = _gated_delta_chunked(flip(q), flip(k), flip(v), flip(log_decay(a_b, 1)),
                                    flip(jax.nn.sigmoid(b_b)), s0_b)
    o = o_f + flip(o_b)
    y_gdn = _rmsnorm(o, p['gdn_norm']) * jax.nn.silu(z.reshape(bn, seq_len, GDN_HEADS, GDN_DV).astype(jnp.float32))
    y = jnp.concatenate([y_conv, y_gdn.reshape(bn, seq_len, GDN_V).astype(h.dtype)], axis=-1) @ p['w_out']
    return y, s_f, s_b


def _axial_angles(seq_len):
    rows = seq_len // GRID_W
    row = jnp.repeat(jnp.arange(rows), GRID_W).astype(jnp.float32)
    col = jnp.tile(jnp.arange(GRID_W), rows).astype(jnp.float32)
    n_freq = DIFF_DH // 4
    inv_freq = ROPE_BASE ** (-jnp.arange(n_freq, dtype=jnp.float32) / n_freq)
    return row[:, None] * inv_freq, col[:, None] * inv_freq


def _rope_1d(x, ang):
    cos = jnp.cos(ang)[None, :, None, None, :].astype(x.dtype)
    sin = jnp.sin(ang)[None, :, None, None, :].astype(x.dtype)
    x1, x2 = jnp.split(x, 2, axis=-1)
    return jnp.concatenate([x1 * cos - x2 * sin, x2 * cos + x1 * sin], axis=-1)


def _axial_rope(x, ang_row, ang_col):
    half = DIFF_DH // 2
    return jnp.concatenate([_rope_1d(x[..., :half], ang_row), _rope_1d(x[..., half:], ang_col)], axis=-1)


def _diff_attention(q, k, v, lam):
    bn, lq = q.shape[:2]
    nb = lq // Q_BLOCK
    qb = jnp.moveaxis(q.reshape((bn, nb, Q_BLOCK) + q.shape[2:]), 1, 0)
    scale = DIFF_DH ** -0.5

    def block(qi):
        s = jnp.einsum('bqhid,bkhid->bihqk', qi, k).astype(jnp.float32) * scale
        pr = jax.nn.softmax(s, axis=-1)
        a = pr[:, 0] - lam * pr[:, 1]
        return jnp.einsum('bhqk,bkhe->bqhe', a, v)

    o = lax.map(block, qb)
    return jnp.moveaxis(o, 0, 1).reshape(bn, lq, q.shape[2], v.shape[-1])


def _diff_attn_mixer(h_lat, h_ctx, p, lam_init, need_ctx):
    bn, seq_len, _ = h_lat.shape

    def qk_heads(t):
        return t.reshape(t.shape[:2] + (DIFF_HEADS, 2, DIFF_DH))

    def v_heads(t):
        return t.reshape(t.shape[:2] + (DIFF_HEADS, 2 * DIFF_DH))

    q_lat, k_lat, v_lat = jnp.split(h_lat @ p['w_qkv'], [DIFF_QK, 2 * DIFF_QK], axis=-1)
    ang_row, ang_col = _axial_angles(seq_len)
    q_lat = _axial_rope(qk_heads(q_lat), ang_row, ang_col)
    k_lat = _axial_rope(qk_heads(k_lat), ang_row, ang_col)
    k_ctx, v_ctx = jnp.split(h_ctx @ p['w_qkv'][:, DIFF_QK:], [DIFF_QK], axis=-1)
    k_ctx, v_ctx = qk_heads(k_ctx), v_heads(v_ctx)
    lam = (jnp.exp(jnp.sum(p['lambda_q1'] * p['lambda_k1']).astype(jnp.float32))
           - jnp.exp(jnp.sum(p['lambda_q2'] * p['lambda_k2']).astype(jnp.float32)) + lam_init)
    k_all = jnp.concatenate([k_ctx, k_lat], axis=1)
    v_all = jnp.concatenate([v_ctx, v_heads(v_lat)], axis=1).astype(jnp.float32)

    def out(o):
        o = _rmsnorm(o, p['subln']) * (1.0 - lam_init)
        return o.reshape(o.shape[:2] + (DIFF_V,)).astype(h_lat.dtype) @ p['w_o']

    y_lat = out(_diff_attention(q_lat, k_all, v_all, lam))
    y_ctx = None
    if need_ctx:
        q_ctx = qk_heads(h_ctx @ p['w_qkv'][:, :DIFF_QK])
        y_ctx = out(_diff_attention(q_ctx, k_ctx, v_ctx.astype(jnp.float32), lam))
    return y_lat, y_ctx


def _expert_choice_moe(h, p):
    bn, n, _ = h.shape
    cap = CAPACITY_FACTOR * n // N_EXPERTS
    aff = jax.nn.softmax((h @ p['router']).astype(jnp.float32), axis=-1)
    gate, idx = lax.top_k(jnp.swapaxes(aff, 1, 2), cap)
    bidx = jnp.arange(bn)[:, None, None]
    xe = h[bidx, idx]
    hid = jax.nn.silu(jnp.einsum('becd,edf->becf', xe, p['exp_gate'])) * jnp.einsum('becd,edf->becf', xe, p['exp_up'])
    ye = jnp.einsum('becf,efd->becd', hid, p['exp_down']) * gate[..., None].astype(h.dtype)
    return jnp.zeros_like(h).at[bidx, idx].add(ye)


def setup_inputs(seed: int = 0) -> dict:
    key = jax.random.key(seed)
    keys = iter(jax.random.split(key, 48))
    D = D_MODEL

    def nrm(shape, scale):
        return scale * jax.random.normal(next(keys), shape, jnp.float32)

    def gain(n):
        return 1.0 + nrm((n,), 0.05)

    def experts():
        return (nrm((N_EXPERTS, D, EXPERT_FF), D ** -0.5), nrm((N_EXPERTS, D, EXPERT_FF), D ** -0.5),
                nrm((N_EXPERTS, EXPERT_FF, D), EXPERT_FF ** -0.5))

    a_log = jnp.log(jax.random.uniform(next(keys), (2, GDN_HEADS), jnp.float32, 1.0, 16.0))
    dt = jnp.exp(jax.random.uniform(next(keys), (2, GDN_HEADS), jnp.float32, math.log(1e-3), math.log(1e-1)))
    dt_bias = dt + jnp.log(-jnp.expm1(-dt))
    g0, u0, d0 = experts()
    g1, u1, d1 = experts()
    return {
        'x': nrm((BATCH, SEQ, D), 1.0),
        'c': nrm((BATCH, D), 1.0),
        'ctx': nrm((BATCH, CTX_LEN, D), 1.0),
        'c_ctx': nrm((D,), 1.0),
        'l0_mod_w': nrm((D, 6 * D), 0.5 * D ** -0.5),
        'l0_mod_b': nrm((6 * D,), 0.02),
        'l0_norm1': gain(D),
        'l0_w_in': nrm((D, IN_COLS), D ** -0.5),
        'l0_conv_a': nrm((CONV_W, CONV_DIM), CONV_W ** -0.5),
        'l0_conv_qkv': nrm((CONV_W, 2 * GDN_QK + GDN_V), CONV_W ** -0.5),
        'l0_a_log': a_log,
        'l0_dt_bias': dt_bias,
        'l0_gdn_norm': gain(GDN_DV),
        'l0_w_out': nrm((MIX_DIM, D), MIX_DIM ** -0.5),
        'l0_norm2': gain(D),
        'l0_router': nrm((D, N_EXPERTS), D ** -0.5),
        'l0_exp_gate': g0,
        'l0_exp_up': u0,
        'l0_exp_down': d0,
        'l1_mod_w': nrm((D, 6 * D), 0.5 * D ** -0.5),
        'l1_mod_b': nrm((6 * D,), 0.02),
        'l1_norm1': gain(D),
        'l1_w_qkv': nrm((D, 2 * DIFF_QK + DIFF_V), D ** -0.5),
        'l1_lambda_q1': nrm((DIFF_DH,), 0.1),
        'l1_lambda_k1': nrm((DIFF_DH,), 0.1),
        'l1_lambda_q2': nrm((DIFF_DH,), 0.1),
        'l1_lambda_k2': nrm((DIFF_DH,), 0.1),
        'l1_subln': gain(2 * DIFF_DH),
        'l1_w_o': nrm((DIFF_V, D), DIFF_V ** -0.5),
        'l1_norm2': gain(D),
        'l1_router': nrm((D, N_EXPERTS), D ** -0.5),
        'l1_exp_gate': g1,
        'l1_exp_up': u1,
        'l1_exp_down': d1,
        'final_norm': gain(D),
    }


def reference(x, c, ctx, c_ctx,
              l0_mod_w, l0_mod_b, l0_norm1, l0_w_in, l0_conv_a, l0_conv_qkv, l0_a_log, l0_dt_bias,
              l0_gdn_norm, l0_w_out, l0_norm2, l0_router, l0_exp_gate, l0_exp_up, l0_exp_down,
              l1_mod_w, l1_mod_b, l1_norm1, l1_w_qkv, l1_lambda_q1, l1_lambda_k1, l1_lambda_q2,
              l1_lambda_k2, l1_subln, l1_w_o, l1_norm2, l1_router, l1_exp_gate, l1_exp_up, l1_exp_down,
              final_norm):
    layers = (
        dict(mod_w=l0_mod_w, mod_b=l0_mod_b, norm1=l0_norm1, w_in=l0_w_in, conv_a=l0_conv_a,
             conv_qkv=l0_conv_qkv, a_log=l0_a_log, dt_bias=l0_dt_bias, gdn_norm=l0_gdn_norm,
             w_out=l0_w_out, norm2=l0_norm2, router=l0_router, exp_gate=l0_exp_gate,
             exp_up=l0_exp_up, exp_down=l0_exp_down),
        dict(mod_w=l1_mod_w, mod_b=l1_mod_b, norm1=l1_norm1, w_qkv=l1_w_qkv, lambda_q1=l1_lambda_q1,
             lambda_k1=l1_lambda_k1, lambda_q2=l1_lambda_q2, lambda_k2=l1_lambda_k2, subln=l1_subln,
             w_o=l1_w_o, norm2=l1_norm2, router=l1_router, exp_gate=l1_exp_gate,
             exp_up=l1_exp_up, exp_down=l1_exp_down),
    )
    for i in range(DEPTH):
        p = layers[i]
        last = i == DEPTH - 1
        m = _adaln(c, p['mod_w'], p['mod_b'])
        mc = _adaln(c_ctx[None], p['mod_w'], p['mod_b'])
        h = _modulate(x, p['norm1'], m[0], m[1])
        hc = _modulate(ctx, p['norm1'], mc[0], mc[1])
        if i % 2 == 0:
            s0 = jnp.zeros((x.shape[0], GDN_HEADS, GDN_DK, GDN_DV), jnp.float32)
            y_ctx, s_f, s_b = _conv_gdn_mixer(hc, p, s0, s0)
            y, _, _ = _conv_gdn_mixer(h, p, s_f, s_b)
        else:
            y, y_ctx = _diff_attn_mixer(h, hc, p, 0.8 - 0.6 * math.exp(-0.3 * i), not last)
        x = x + m[2] * y
        x = x + m[5] * _expert_choice_moe(_modulate(x, p['norm2'], m[3], m[4]), p)
        if not last:
            ctx = ctx + mc[2] * y_ctx
            ctx = ctx + mc[5] * _expert_choice_moe(_modulate(ctx, p['norm2'], mc[3], mc[4]), p)
    return _rmsnorm(x, final_norm)
```

```cpp
#include <hip/hip_runtime.h>
#include <cstdio>
#include <cstdint>
#ifndef MK_SPLIT
#define MK_SPLIT 0
#endif
namespace pg8 {
#define PG8_LAS __attribute__((address_space(3)))
typedef unsigned short bf16_t;
typedef short bf16x8 __attribute__((ext_vector_type(8)));
typedef float f32x4 __attribute__((ext_vector_type(4)));
typedef unsigned u32x4 __attribute__((ext_vector_type(4)));
constexpr int BM = 256, BK = 64, HALF = 128, HTB = HALF * BK * 2  , STAGE_BYTES = 8 * HTB, NXCD = 8, WGM = 8;

__host__ __device__ __forceinline__ int lds_byte(int r, int c) { const int st = (r >> 4) * 2 + (c >> 5), rr = r & 15, cc = c & 31, ob = rr * 64 + cc * 2; return st * 1024 + (ob ^ (((ob >> 9) & 1) << 5)); }
__host__ __device__ __forceinline__ void stage_rc(int b, int& R, int& C) { const int st = b / 1024, sb = b % 1024, swz = sb ^ (((sb >> 9) & 1) << 5); R = (st >> 1) * 16 + swz / 64; C = (st & 1) * 32 + (swz % 64) / 2; }
__host__ __device__ __forceinline__ int perm32(int rho) { const int n = rho >> 4, i = rho & 15; return 8 * (i >> 2) + 4 * n + (i & 3); }

struct Unit { int pm, pn; };
struct Gemm { const bf16_t* A; const bf16_t* Bt; int M, N, K; };

struct StaticOrder {
    int nM, nN, nwg, G, c;
    __host__ __device__ void init(int M, int N, int G_, int c_) { nM = M / BM; nN = N / BM; nwg = nM * nN; G = G_; c = c_; }
    __host__ __device__ bool next(int i, Unit& u) const {
        const long L = (long)i * G + c; if (L >= nwg) return false;
        int wgid = (int)L; { const int q = nwg / NXCD, r = nwg % NXCD, xcd = wgid % NXCD, off = wgid / NXCD; wgid = (xcd < r ? xcd * (q + 1) : r * (q + 1) + (xcd - r) * q) + off; }
        const int nig = WGM * nN, gid = wgid / nig, fm = gid * WGM, gsz = (nM - fm) < WGM ? (nM - fm) : WGM;
        u.pm = fm + ((wgid % nig) % gsz); u.pn = (wgid % nig) / gsz; return true;
    }
    __device__ __forceinline__ void a_ready(const Unit&) const {}
    __device__ __forceinline__ void done(const Unit&) const {}
};

__device__ __forceinline__ unsigned cvt_pk_bf16(float lo, float hi) { unsigned r; asm volatile("v_cvt_pk_bf16_f32 %0, %1, %2" : "=v"(r) : "v"(lo), "v"(hi)); return r; }
typedef float f32x2 __attribute__((ext_vector_type(2)));
__device__ __forceinline__ f32x2 gelu_pk(f32x2 v) {
    const f32x2 av = __builtin_elementwise_abs(v), d = av * 0.2316418882f + 1.0f;
    f32x2 t; t.x = __builtin_amdgcn_rcpf(d.x); t.y = __builtin_amdgcn_rcpf(d.y);
    f32x2 q = t * 0.5307027145f + (-0.7265760135f); q = q * t + 0.7107068705f; q = q * t + (-0.142248368f); q = q * t + 0.127414796f; q = q * t;
    const f32x2 s = (v * v) * (-0.72134752044f);
    f32x2 e; e.x = __builtin_amdgcn_exp2f(s.x); e.y = __builtin_amdgcn_exp2f(s.y);
    const f32x2 m = v * (q * e), r = v - m;
    f32x2 o; o.x = v.x < 0.f ? m.x : r.x; o.y = v.y < 0.f ? m.y : r.y; return o;
}

template <int ACT  > struct EpiBf16 {
    static constexpr bool PERM = true, AFTER_DRAIN = false; static_assert(ACT == 0 || ACT == 1, "EpiBf16: ACT is 0 (none) or 1 (gelu_pk)");
    bf16_t* O; int ldc; const float* bias; int split_cols; size_t split_stride; float scale0;
    __device__ __forceinline__ void operator()(const f32x4 (&acc)[2][2][4][2], const Unit& u, int wr, int wc, int fr, int fq) const {
        const int row0 = u.pm * BM + wr * 64 + fr; int colt = u.pn * BM; bf16_t* base = O;
        float sc = 1.f; if (split_cols) { const int t = colt / split_cols; base += (size_t)t * split_stride; colt -= t * split_cols; if (t == 0) sc = scale0; }
        const int col0 = colt + wc * 32 + 8 * fq, bcol0 = u.pn * BM + wc * 32 + 8 * fq;
        f32x4 bv[2][2];
#pragma unroll
        for (int bj = 0; bj < 2; ++bj)
#pragma unroll
            for (int n = 0; n < 2; ++n) bv[bj][n] = bias ? *(const f32x4*)(bias + bcol0 + bj * HALF + 4 * n) : (f32x4){0.f, 0.f, 0.f, 0.f};
#pragma unroll
        for (int ai = 0; ai < 2; ++ai)
#pragma unroll
            for (int m = 0; m < 4; ++m) { bf16_t* rowp = base + (size_t)(row0 + ai * HALF + m * 16) * ldc + col0;
#pragma unroll
                for (int bj = 0; bj < 2; ++bj) { f32x4 v0 = acc[ai][bj][m][0] + bv[bj][0], v1 = acc[ai][bj][m][1] + bv[bj][1];
                    if (ACT == 1) { f32x2 a = gelu_pk((f32x2){v0[0], v0[1]}), b = gelu_pk((f32x2){v0[2], v0[3]}), c = gelu_pk((f32x2){v1[0], v1[1]}), d = gelu_pk((f32x2){v1[2], v1[3]});
                        v0 = (f32x4){a.x, a.y, b.x, b.y}; v1 = (f32x4){c.x, c.y, d.x, d.y}; }
                    v0 = v0 * sc; v1 = v1 * sc; u32x4 w; w.x = cvt_pk_bf16(v0[0], v0[1]); w.y = cvt_pk_bf16(v0[2], v0[3]); w.z = cvt_pk_bf16(v1[0], v1[1]); w.w = cvt_pk_bf16(v1[2], v1[3]);
                    *(u32x4*)(rowp + bj * HALF) = w; } }
    }
};

__device__ __forceinline__ float silu_fast(float x) { return x * __builtin_amdgcn_rcpf(1.0f + __builtin_amdgcn_exp2f(-1.4426950408889634f * x)); }
struct EpiResidual {
    static constexpr bool PERM = false, AFTER_DRAIN = false;
    const float* base_lat; const float* base_ctx; float* out_lat; float* out_ctx; const float* gate; int RL;
    __device__ __forceinline__ void operator()(const f32x4 (&acc)[2][2][4][2], const Unit& u, int wr, int wc, int fr, int fq) const {
        const int col0 = u.pn * BM + wc * 32 + 4 * fq;
#pragma unroll
        for (int ai = 0; ai < 2; ++ai)
#pragma unroll
            for (int m = 0; m < 4; ++m) {
                const int row = u.pm * BM + ai * HALF + wr * 64 + m * 16 + fr;
                const bool lat = row < RL; const int rr = lat ? row : row - RL; const int bb = lat ? (row >> 13) : 4;
                const float* bp = (lat ? base_lat : base_ctx) + (size_t)rr * 1024 + col0; float* op = (lat ? out_lat : out_ctx) + (size_t)rr * 1024 + col0;
                const float* gp = gate + bb * 6144 + col0;
#pragma unroll
                for (int bj = 0; bj < 2; ++bj)
#pragma unroll
                    for (int n = 0; n < 2; ++n) { const int c = bj * HALF + n * 16; const f32x4 g = *(const f32x4*)(gp + c), b = *(const f32x4*)(bp + c); *(f32x4*)(op + c) = b + g * acc[ai][bj][m][n]; }
            }
    }
};
struct EpiMoe1 {
    static constexpr bool PERM = true, AFTER_DRAIN = false;
    bf16_t* O;
    __device__ __forceinline__ void operator()(const f32x4 (&acc)[2][2][4][2], const Unit& u, int wr, int wc, int fr, int fq) const {
        const int row0 = u.pm * BM + wr * 64 + fr; const int hcol0 = (u.pn & 15) * 128 + wc * 32 + 8 * fq;
#pragma unroll
        for (int ai = 0; ai < 2; ++ai)
#pragma unroll
            for (int m = 0; m < 4; ++m) { bf16_t* rowp = O + (size_t)(row0 + ai * HALF + m * 16) * 2048 + hcol0;
                const f32x4 g0 = acc[ai][0][m][0], g1 = acc[ai][0][m][1], u0 = acc[ai][1][m][0], u1 = acc[ai][1][m][1];
                u32x4 w; w.x = cvt_pk_bf16(silu_fast(g0[0]) * u0[0], silu_fast(g0[1]) * u0[1]); w.y = cvt_pk_bf16(silu_fast(g0[2]) * u0[2], silu_fast(g0[3]) * u0[3]);
                w.z = cvt_pk_bf16(silu_fast(g1[0]) * u1[0], silu_fast(g1[1]) * u1[1]); w.w = cvt_pk_bf16(silu_fast(g1[2]) * u1[2], silu_fast(g1[3]) * u1[3]);
                *(u32x4*)rowp = w; }
    }
};
struct EpiMoe2 {
    static constexpr bool PERM = true, AFTER_DRAIN = false;
    bf16_t* O; const float* gatev;
    __device__ __forceinline__ void operator()(const f32x4 (&acc)[2][2][4][2], const Unit& u, int wr, int wc, int fr, int fq) const {
        const int row0 = u.pm * BM + wr * 64 + fr; const int col0 = (u.pn & 3) * BM + wc * 32 + 8 * fq;
#pragma unroll
        for (int ai = 0; ai < 2; ++ai)
#pragma unroll
            for (int m = 0; m < 4; ++m) { const int row = row0 + ai * HALF + m * 16; const float gv = gatev[row]; bf16_t* rowp = O + (size_t)row * 1024 + col0;
#pragma unroll
                for (int bj = 0; bj < 2; ++bj) { const f32x4 v0 = acc[ai][bj][m][0] * gv, v1 = acc[ai][bj][m][1] * gv;
                    u32x4 w; w.x = cvt_pk_bf16(v0[0], v0[1]); w.y = cvt_pk_bf16(v0[2], v0[3]); w.z = cvt_pk_bf16(v1[0], v1[1]); w.w = cvt_pk_bf16(v1[2], v1[3]);
                    *(u32x4*)(rowp + bj * HALF) = w; } }
    }
};
struct EpiQK {
    static constexpr bool PERM = true, AFTER_DRAIN = false;
    bf16_t* O; const float* rope; float qscale; int RL;
    __device__ __forceinline__ void operator()(const f32x4 (&acc)[2][2][4][2], const Unit& u, int wr, int wc, int fr, int fq) const {
        const int row0 = u.pm * BM + wr * 64 + fr; const int colb = u.pn * BM + wc * 32 + 8 * fq;
#pragma unroll
        for (int ai = 0; ai < 2; ++ai)
#pragma unroll
            for (int m = 0; m < 4; ++m) { const int row = row0 + ai * HALF + m * 16; const bool lat = row < RL; const int t = row & 8191; const int pr = t >> 6, pc = t & 63;
#pragma unroll
                for (int bj = 0; bj < 2; ++bj) { const int col = colb + bj * HALF; f32x4 v0 = acc[ai][bj][m][0], v1 = acc[ai][bj][m][1];
                    if (lat) { const int half = (col >> 5) & 1, j0 = (col & 31) >> 1;
                        const float* cp = rope + (half ? 4096 + pc * 16 : pr * 16) + j0; const float* sp = cp + (half ? 1024 : 2048);
                        const f32x4 c = *(const f32x4*)cp, s = *(const f32x4*)sp;
                        f32x4 a, b;
                        a[0] = v0[0] * c[0] - v0[1] * s[0]; a[1] = v0[1] * c[0] + v0[0] * s[0]; a[2] = v0[2] * c[1] - v0[3] * s[1]; a[3] = v0[3] * c[1] + v0[2] * s[1];
                        b[0] = v1[0] * c[2] - v1[1] * s[2]; b[1] = v1[1] * c[2] + v1[0] * s[2]; b[2] = v1[2] * c[3] - v1[3] * s[3]; b[3] = v1[3] * c[3] + v1[2] * s[3];
                        v0 = a; v1 = b; }
                    const float sc = (col < 1024) ? qscale : 1.0f; v0 = v0 * sc; v1 = v1 * sc;
                    u32x4 w; w.x = cvt_pk_bf16(v0[0], v0[1]); w.y = cvt_pk_bf16(v0[2], v0[3]); w.z = cvt_pk_bf16(v1[0], v1[1]); w.w = cvt_pk_bf16(v1[2], v1[3]);
                    *(u32x4*)(O + (size_t)row * 2048 + col) = w; } }
    }
};
struct MoeOrder {
    int total, G, c, tiles_pe, ncol;
    __device__ __forceinline__ bool next(int i, Unit& u) const {
        const long L = (long)i * G + c; if (L >= total) return false;
        const int per = tiles_pe * ncol; const int e = (int)L / per, rem = (int)L % per; const int pml = rem % tiles_pe, pnl = rem / tiles_pe;
        u.pm = e * tiles_pe + pml; u.pn = e * ncol + pnl; return true; }
    __device__ __forceinline__ void a_ready(const Unit&) const {}
    __device__ __forceinline__ void done(const Unit&) const {}
};
template <class Epi, class Sched, bool ALIGN_EPI = false, bool SP2 = false>
__device__ __forceinline__ void gemm_phase(PG8_LAS unsigned char* lds, const Gemm g, const Sched& S, const Epi& E) {
    const int tid = threadIdx.x, wid = __builtin_amdgcn_readfirstlane(tid >> 6), lane = tid & 63, wr = wid >> 2, wc = wid & 3, fr = lane & 15, fq = lane >> 4;
    const int K = g.K, nt = K / BK;
    unsigned voffA[2], voffB[2];
#pragma unroll
    for (int i = 0; i < 2; ++i) { int R, C; stage_rc(tid * 16 + i * 8192, R, C); const int Rb = Epi::PERM ? ((R & ~31) + perm32(R & 31)) : R;
        voffA[i] = (unsigned)(R * K + C) * 2u; voffB[i] = (unsigned)(Rb * K + C) * 2u; }
    const size_t kstep = (size_t)(BK * 2);
    const size_t hstep = (size_t)HALF * K * 2;
    const size_t tstep = 2 * hstep;
    const unsigned ldsw = (unsigned)wid * 1024u;
    const int aoff = lds_byte(wr * 64 + fr, fq * 8), boff = lds_byte(wc * 32 + fr, fq * 8);
#define PG8_SA(b, h) (((b) * 2 + (h)) * HTB)
#define PG8_SB(b, h) ((4 + (b) * 2 + (h)) * HTB)
#define PG8_STAGE(bufoff, gbase, voff) do { _Pragma("unroll") for (int _i = 0; _i < 2; ++_i) \
        __builtin_amdgcn_global_load_lds((const unsigned*)((const char*)(gbase) + (voff)[_i]), (PG8_LAS unsigned*)(lds + (bufoff) + ldsw + _i * 8192), 16, 0, 0); } while (0)
#define PG8_LDA(dst, b, h) do { _Pragma("unroll") for (int m = 0; m < 4; ++m) _Pragma("unroll") for (int k = 0; k < 2; ++k) dst[m][k] = *(const PG8_LAS bf16x8*)(lds + PG8_SA(b, h) + aoff + m * 2048 + k * 1024); } while (0)
#define PG8_LDB(dst, b, h) do { _Pragma("unroll") for (int n = 0; n < 2; ++n) _Pragma("unroll") for (int k = 0; k < 2; ++k) dst[n][k] = *(const PG8_LAS bf16x8*)(lds + PG8_SB(b, h) + boff + n * 2048 + k * 1024); } while (0)
#define PG8_MMA(ai, bj, At, Bt) do { __builtin_amdgcn_s_setprio(1); _Pragma("unroll") for (int m = 0; m < 4; ++m) _Pragma("unroll") for (int n = 0; n < 2; ++n) _Pragma("unroll") for (int k = 0; k < 2; ++k) \
        acc[ai][bj][m][n] = __builtin_amdgcn_mfma_f32_16x16x32_bf16(Bt[n][k], At[m][k], acc[ai][bj][m][n], 0, 0, 0); __builtin_amdgcn_s_setprio(0); } while (0)
#define PG8_WAIT_V(n) asm volatile("s_waitcnt vmcnt(" #n ")" ::: "memory")
#define PG8_WAIT_L(n) asm volatile("s_waitcnt lgkmcnt(" #n ")" ::: "memory")
#define PG8_BAR __builtin_amdgcn_s_barrier()
#define PG8_SCHED __builtin_amdgcn_sched_barrier(0)
    Unit cur, nxt; int ui = 0;
    if (!S.next(0, cur)) return;
    f32x4 acc[2][2][4][2];
#pragma unroll
    for (int a = 0; a < 2; ++a)
#pragma unroll
        for (int b = 0; b < 2; ++b)
#pragma unroll
            for (int m = 0; m < 4; ++m)
#pragma unroll
                for (int n = 0; n < 2; ++n) acc[a][b][m][n] = (f32x4){0.f, 0.f, 0.f, 0.f};
    bf16x8 At[4][2], B0[2][2], B1[2][2];
    const char* cA = (const char*)g.A + (size_t)cur.pm * tstep; const char* cB = (const char*)g.Bt + (size_t)cur.pn * tstep;
    S.a_ready(cur);
    if constexpr (SP2) {
        PG8_STAGE(PG8_SB(0, 0), cB, voffB); PG8_STAGE(PG8_SB(0, 1), cB + hstep, voffB); PG8_STAGE(PG8_SA(0, 0), cA, voffA); PG8_STAGE(PG8_SA(0, 1), cA + hstep, voffA);
        if (wr == 1) PG8_BAR;
        PG8_WAIT_V(2); PG8_BAR;
        PG8_STAGE(PG8_SB(1, 0), cB + kstep, voffB); PG8_STAGE(PG8_SA(1, 0), cA + kstep, voffA); PG8_STAGE(PG8_SB(1, 1), cB + hstep + kstep, voffB);
        PG8_WAIT_V(6); PG8_BAR;
    } else {
        PG8_STAGE(PG8_SB(0, 0), cB, voffB); PG8_STAGE(PG8_SA(0, 0), cA, voffA); PG8_STAGE(PG8_SB(0, 1), cB + hstep, voffB); PG8_STAGE(PG8_SA(0, 1), cA + hstep, voffA);
        if (wr == 1) PG8_BAR;
        PG8_WAIT_V(4); PG8_BAR;
        PG8_STAGE(PG8_SB(1, 0), cB + kstep, voffB); PG8_STAGE(PG8_SA(1, 0), cA + kstep, voffA); PG8_STAGE(PG8_SB(1, 1), cB + hstep + kstep, voffB);
        PG8_WAIT_V(6); PG8_BAR;
    }
    for (;;) {
        const bool has_next = S.next(ui + 1, nxt);
        const char* nA = has_next ? (const char*)g.A + (size_t)nxt.pm * tstep : cA; const char* nB = has_next ? (const char*)g.Bt + (size_t)nxt.pn * tstep : cB;
        for (int t = 0; t < nt; t += 2) {
            const bool last = (t == nt - 2);
            const char* a1 = cA + (size_t)(t + 1) * kstep;
            const char* a2 = last ? nA : cA + (size_t)(t + 2) * kstep; const char* b2 = last ? nB : cB + (size_t)(t + 2) * kstep;
            const char* a3 = a2 + kstep; const char* b3 = b2 + kstep;
            if (last && has_next) S.a_ready(nxt);
            if constexpr (SP2) {
            PG8_LDB(B0, 0, 0); PG8_LDB(B1, 0, 1); PG8_SCHED; PG8_LDA(At, 0, 0); PG8_STAGE(PG8_SA(1, 1), a1 + hstep, voffA);
            PG8_WAIT_V(8); PG8_WAIT_L(0); PG8_BAR; PG8_MMA(0, 0, At, B0); PG8_MMA(0, 1, At, B1); PG8_BAR; PG8_SCHED;
            PG8_LDA(At, 0, 1); PG8_STAGE(PG8_SB(0, 0), b2, voffB); PG8_STAGE(PG8_SB(0, 1), b2 + hstep, voffB); PG8_STAGE(PG8_SA(0, 0), a2, voffA);
            PG8_WAIT_V(8); PG8_WAIT_L(0); PG8_BAR; PG8_MMA(1, 0, At, B0); PG8_MMA(1, 1, At, B1); PG8_BAR; PG8_SCHED;
            PG8_LDB(B0, 1, 0); PG8_LDB(B1, 1, 1); PG8_SCHED; PG8_LDA(At, 1, 0); PG8_STAGE(PG8_SA(0, 1), a2 + hstep, voffA);
            PG8_WAIT_V(8); PG8_WAIT_L(0); PG8_BAR; PG8_MMA(0, 0, At, B0); PG8_MMA(0, 1, At, B1); PG8_BAR; PG8_SCHED;
            PG8_LDA(At, 1, 1); PG8_STAGE(PG8_SB(1, 0), b3, voffB); PG8_STAGE(PG8_SB(1, 1), b3 + hstep, voffB); PG8_STAGE(PG8_SA(1, 0), a3, voffA);
            PG8_WAIT_V(8); PG8_WAIT_L(0); PG8_BAR; PG8_MMA(1, 0, At, B0); PG8_MMA(1, 1, At, B1); PG8_BAR; PG8_SCHED;
            } else {
            PG8_LDB(B0, 0, 0); PG8_SCHED; PG8_LDA(At, 0, 0); PG8_STAGE(PG8_SA(1, 1), a1 + hstep, voffA);
            PG8_WAIT_L(8); PG8_BAR; PG8_WAIT_L(0); PG8_MMA(0, 0, At, B0); PG8_BAR; PG8_SCHED;
            PG8_LDB(B1, 0, 1); PG8_STAGE(PG8_SB(0, 0), b2, voffB);
            PG8_BAR; PG8_WAIT_L(0); PG8_MMA(0, 1, At, B1); PG8_BAR;
            PG8_LDA(At, 0, 1); PG8_STAGE(PG8_SA(0, 0), a2, voffA);
            PG8_BAR; PG8_WAIT_L(0); PG8_MMA(1, 0, At, B0); PG8_BAR; PG8_SCHED;
            PG8_STAGE(PG8_SB(0, 1), b2 + hstep, voffB);
            PG8_WAIT_V(6); PG8_BAR; PG8_MMA(1, 1, At, B1); PG8_BAR;
            PG8_LDB(B0, 1, 0); PG8_SCHED; PG8_LDA(At, 1, 0); PG8_STAGE(PG8_SA(0, 1), a2 + hstep, voffA);
            PG8_WAIT_L(8); PG8_BAR; PG8_WAIT_L(0); PG8_MMA(0, 0, At, B0); PG8_BAR; PG8_SCHED;
            PG8_LDB(B1, 1, 1); PG8_STAGE(PG8_SB(1, 0), b3, voffB);
            PG8_BAR; PG8_WAIT_L(0); PG8_MMA(0, 1, At, B1); PG8_BAR;
            PG8_LDA(At, 1, 1); PG8_STAGE(PG8_SA(1, 0), a3, voffA);
            PG8_BAR; PG8_WAIT_L(0); PG8_MMA(1, 0, At, B0); PG8_BAR; PG8_SCHED;
            PG8_STAGE(PG8_SB(1, 1), b3 + hstep, voffB);
            PG8_WAIT_V(6); PG8_BAR; PG8_MMA(1, 1, At, B1); PG8_BAR;
            }
        }
        if constexpr (ALIGN_EPI) { if (wr == 0) PG8_BAR; }
        if constexpr (!Epi::AFTER_DRAIN) { E(acc, cur, wr, wc, fr, fq); S.done(cur); }
        if (!has_next) break;
#pragma unroll
        for (int a = 0; a < 2; ++a)
#pragma unroll
            for (int b = 0; b < 2; ++b)
#pragma unroll
                for (int m = 0; m < 4; ++m)
#pragma unroll
                    for (int n = 0; n < 2; ++n) acc[a][b][m][n] = (f32x4){0.f, 0.f, 0.f, 0.f};
        cur = nxt; cA = nA; cB = nB; ++ui;
        if constexpr (ALIGN_EPI) { if (wr == 1) PG8_BAR; }
    }
    PG8_WAIT_V(0);
    if constexpr (!ALIGN_EPI) { if (wr == 0) PG8_BAR; }
    PG8_BAR;
    if constexpr (Epi::AFTER_DRAIN) { E.fused(acc, cur, wr, wc, fr, fq, lds, wid, lane); S.done(cur); }
#undef PG8_SA
#undef PG8_SB
#undef PG8_STAGE
#undef PG8_LDA
#undef PG8_LDB
#undef PG8_MMA
#undef PG8_WAIT_V
#undef PG8_WAIT_L
#undef PG8_BAR
#undef PG8_SCHED
}
}

#define GAS __attribute__((address_space(1)))
#define LAS __attribute__((address_space(3)))
#define DI __device__ __forceinline__
typedef unsigned short bf16;
typedef float f32x4 __attribute__((ext_vector_type(4)));
typedef float f32x2 __attribute__((ext_vector_type(2)));
typedef float f32x16 __attribute__((ext_vector_type(16)));
typedef short bf16x8 __attribute__((ext_vector_type(8)));
typedef unsigned u32x4 __attribute__((ext_vector_type(4)));
typedef unsigned u32x2 __attribute__((ext_vector_type(2)));
typedef __bf16 bf16x2_t __attribute__((ext_vector_type(2)));
#define LDS_WAIT() asm volatile("s_waitcnt lgkmcnt(0)" ::: "memory")
#define MFMA32(a, b, c) __builtin_amdgcn_mfma_f32_32x32x16_bf16((a), (b), (c), 0, 0, 0)
DI unsigned pk2(float lo, float hi) { f32x2 v = {lo, hi}; bf16x2_t b = __builtin_convertvector(v, bf16x2_t); return __builtin_bit_cast(unsigned, b); }
DI float bflo(unsigned w) { return __uint_as_float(w << 16); }
DI float bfhi(unsigned w) { return __uint_as_float(w & 0xffff0000u); }
DI int crow(int r, int hi) { return (r & 3) + 8 * (r >> 2) + 4 * hi; }
DI float wave_sum(float v) {
#pragma unroll
    for (int o = 1; o < 64; o <<= 1) v += __shfl_xor(v, o);
    return v;
}
DI float wave_max(float v) {
#pragma unroll
    for (int o = 1; o < 64; o <<= 1) v = fmaxf(v, __shfl_xor(v, o));
    return v;
}
DI float silu_f(float x) { return x / (1.0f + __expf(-x)); }
template <int S> DI bf16x8 pack8(const f32x16& x) {
    u32x4 p; p.x = pk2(x[8 * S], x[8 * S + 1]); p.y = pk2(x[8 * S + 2], x[8 * S + 3]); p.z = pk2(x[8 * S + 4], x[8 * S + 5]); p.w = pk2(x[8 * S + 6], x[8 * S + 7]);
    return __builtin_bit_cast(bf16x8, p);
}
DI int sw64(int row, int c8) { return row * 128 + ((c8 ^ ((row >> 1) & 7)) << 4); }
DI int sw128(int row, int c16) { return row * 256 + ((c16 ^ (row & 15)) << 4); }

#define XB_TMO      128
#define XB_XCNT(j)  (256  + 64 * (j))
#define XB_XSUB(j)  (1280 + 64 * (j))
#define XB_XGEN(j)  (2304 + 64 * (j))
#define XB_TOP      3328
#define XB_TOPGEN   3392
#define XCD_BAR_WORDS 3456
#define XB_SPIN_CAP (1u << 18)

__device__ __forceinline__ unsigned xb_ld(unsigned* p)              { return __hip_atomic_load(p, __ATOMIC_RELAXED, __HIP_MEMORY_SCOPE_AGENT); }
__device__ __forceinline__ unsigned xb_add(unsigned* p, unsigned v) { return __hip_atomic_fetch_add(p, v, __ATOMIC_RELAXED, __HIP_MEMORY_SCOPE_AGENT); }
__device__ __forceinline__ unsigned xb_xcc_id() { return (unsigned)__builtin_amdgcn_s_getreg((3 << 11) | 20) & 0xFu; }
#define XB_SPIN(cond, bar) do { unsigned _sp = 0; while (cond) { __builtin_amdgcn_s_sleep(1); \
    if ((++_sp & 255u) == 0u) { if (xb_ld(&(bar)[XB_TMO])) break; if (_sp > XB_SPIN_CAP) { atomicAdd(&(bar)[XB_TMO], 1u); break; } } } } while (0)

struct XcdBarrier {
    unsigned* bar; unsigned x;
    volatile LAS unsigned* st;
};

__device__ __forceinline__ XcdBarrier xcd_barrier_post(unsigned* bar, volatile LAS unsigned* st) {
    XcdBarrier b; b.bar = bar; b.x = xb_xcc_id(); b.st = st;
    if (threadIdx.x == 0) (void)xb_add(&bar[XB_XCNT(b.x)], 1u);
    return b;
}
__device__ __forceinline__ void xcd_barrier_complete(unsigned* bar, unsigned x, unsigned& nloc, unsigned& nx) {
    const unsigned G = gridDim.x * gridDim.y * gridDim.z;
    unsigned sum, cnt, mine, sp = 0u;
    for (;;) {
        sum = 0u; cnt = 0u; mine = 0u;
#pragma unroll
        for (unsigned j = 0; j < 16; ++j) { const unsigned c = xb_ld(&bar[XB_XCNT(j)]); sum += c; cnt += (c > 0u) ? 1u : 0u; mine = (j == x) ? c : mine; }
        if (sum == G) break;
        __builtin_amdgcn_s_sleep(1);
        if ((++sp & 255u) == 0u) { if (xb_ld(&bar[XB_TMO])) break; if (sp > XB_SPIN_CAP) { atomicAdd(&bar[XB_TMO], 1u); break; } }
    }
    nloc = mine > 0u ? mine : 1u; nx = cnt > 0u ? cnt : 1u;
}

__device__ __forceinline__ void xcd_barrier(const XcdBarrier& b) {
    asm volatile("s_waitcnt vmcnt(0)" ::: "memory");
    __syncthreads();
    if (threadIdx.x == 0) {
        unsigned* bar = b.bar;
        __builtin_amdgcn_s_waitcnt(0);
        unsigned nloc = b.st[0], nx = b.st[1];
        if (nloc == 0u) { xcd_barrier_complete(bar, b.x, nloc, nx); b.st[0] = nloc; b.st[1] = nx; }
        const unsigned old = xb_add(&bar[XB_XSUB(b.x)], 1u);
        const unsigned gen = old / nloc;
        if (old + 1u == (gen + 1u) * nloc) {
            __builtin_amdgcn_fence(__ATOMIC_RELEASE, "agent");
            asm volatile("s_waitcnt vmcnt(0)" ::: "memory");
            const unsigned og = xb_add(&bar[XB_TOP], 1u);
            const unsigned tg = og / nx;
            if (og + 1u == (tg + 1u) * nx) xb_add(&bar[XB_TOPGEN], 1u);
            else XB_SPIN(xb_ld(&bar[XB_TOPGEN]) == tg, bar);
            __builtin_amdgcn_fence(__ATOMIC_ACQUIRE, "agent");
            xb_add(&bar[XB_XGEN(b.x)], 1u);
            asm volatile("s_waitcnt vmcnt(0)" ::: "memory");
        } else {
            XB_SPIN(xb_ld(&bar[XB_XGEN(b.x)]) == gen, bar);
            __builtin_amdgcn_fence(__ATOMIC_ACQUIRE, "agent");
            asm volatile("s_waitcnt vmcnt(0)" ::: "memory");
        }
    }
    __syncthreads();
}

constexpr int NWAVES = 8, NTHR = 512;
constexpr int DM = 1024, NBATCH = 4, SEQL = 8192, CTXL = 256, RL = NBATCH * SEQL, RC = NBATCH * CTXL, RT = RL + RC;
constexpr int NPROJ = 3584, INCOLS = 3600, NEXP = 16, FFN = 2048;
constexpr int SPE0 = 17 * 256, SPE1 = 16 * 256;
constexpr int M1_0 = NEXP * SPE0, M1_1 = NEXP * SPE1;
constexpr float EPSN = 1e-6f;
constexpr float LAM_INIT = 0.35550907f;
constexpr int NCHUNK = 132;
constexpr int GBLK = 73728;

constexpr size_t MiB = 1u << 20;
constexpr size_t WS_CTL = 0, CTL_ZERO_BYTES = 1 * MiB;
constexpr size_t WS_MODV = 1 * MiB;
constexpr size_t WS_ROPE = 1 * MiB + 256 * 1024;
constexpr size_t WS_ZROW = 1 * MiB + 512 * 1024;
constexpr size_t WS_GATES = 2 * MiB;
constexpr size_t WS_AFFT = 5 * MiB;
constexpr size_t WS_INV = 8 * MiB;
constexpr size_t WS_GATEV = 11 * MiB;
constexpr size_t WS_GLAST = 12 * MiB;
constexpr size_t WS_WIN = 17 * MiB, WS_WOUT = 24 * MiB, WS_WQK = 26 * MiB, WS_WV = 30 * MiB, WS_WO = 32 * MiB;
constexpr size_t WS_E0 = 36 * MiB;
constexpr size_t WS_XC = 228 * MiB;
constexpr size_t WS_H = 232 * MiB;
constexpr size_t WS_BIG = 298 * MiB;
constexpr size_t WS_G = 570 * MiB;
constexpr size_t WS_END = 898 * MiB;
constexpr int CW_BAR = 4096;

constexpr int RING_BYTES = 131072;
constexpr int LDSX = RING_BYTES;
constexpr int LDS_BYTES = 147456;

struct Args { const float* in[35]; float* out; unsigned char* ws; int ph_lo, ph_hi; };

template <class F> DI void tr_item(const float* W, int ldw, bf16* WT, int ldk, int k0, F rowmap, LAS float* scr, int lane) {
#pragma unroll 8
    for (int i = 0; i < 32; ++i) { const int kk = 2 * i + (lane >> 5); scr[kk * 33 + (lane & 31)] = W[(size_t)kk * ldw + (lane & 31)]; }
    LDS_WAIT(); asm volatile("" ::: "memory");
    const int c = lane & 7;
#pragma unroll
    for (int j = 0; j < 4; ++j) { const int n = (lane >> 3) + 8 * j; const LAS float* s = scr + (8 * c) * 33 + n;
        u32x4 o; o.x = pk2(s[0 * 33], s[1 * 33]); o.y = pk2(s[2 * 33], s[3 * 33]); o.z = pk2(s[4 * 33], s[5 * 33]); o.w = pk2(s[6 * 33], s[7 * 33]);
        *(u32x4*)(WT + (size_t)rowmap(n) * ldk + k0 + 8 * c) = o; }
    LDS_WAIT(); asm volatile("" ::: "memory");
}
struct AddMap { int base; DI int operator()(int n) const { return base + n; } };
struct PairMap { int base; DI int operator()(int n) const { return base + (n < 16 ? 2 * n : 2 * (n - 16) + 1); } };
DI void expert_item(int r, const float* Wg, const float* Wu, const float* Wd, bf16* W1, bf16* W2, LAS float* scr, int lane) {
    if (r < 32768) { const int up = r >> 14, q = r & 16383, e = q >> 10, it = q & 1023, kb = it >> 6, nb = it & 63;
        const float* src = (up ? Wu : Wg) + (size_t)e * 1024 * 2048 + (size_t)(kb * 64) * 2048 + nb * 32;
        const int rbase = e * 4096 + (nb >> 2) * 256 + up * 128 + (nb & 3) * 32;
        tr_item(src, 2048, W1, 1024, kb * 64, AddMap{rbase}, scr, lane);
    } else { const int q = r - 32768, e = q >> 10, it = q & 1023, kb = it >> 5, nb = it & 31;
        const float* src = Wd + (size_t)e * 2048 * 1024 + (size_t)(kb * 64) * 1024 + nb * 32;
        const int rbase = e * 1024 + nb * 32;
        tr_item(src, 1024, W2, 2048, kb * 64, AddMap{rbase}, scr, lane);
    }
}
DI void stage_tab16(const float* W, int ldw, LAS float* tab, int tid) {
    for (int idx = tid; idx < 16384; idx += NTHR) { const int d = idx >> 4, e = idx & 15; const int j = d >> 8, l = (d >> 2) & 63, c = d & 3;
        tab[((((j * 4 + c) * 4 + (e >> 2)) * 64 + l) << 2) + (e & 3)] = W[(size_t)d * ldw + e]; }
}
DI void row_gemv16(const f32x4 (&h)[4], const LAS float* tab, int lane, float (&sums)[16]) {
#pragma unroll
    for (int e = 0; e < 16; ++e) sums[e] = 0.f;
#pragma unroll
    for (int j = 0; j < 4; ++j)
#pragma unroll
        for (int c = 0; c < 4; ++c) { const float hv = h[j][c];
#pragma unroll
            for (int q = 0; q < 4; ++q) { const f32x4 w = *(const LAS f32x4*)(tab + ((((j * 4 + c) * 4 + q) * 64 + lane) << 2));
                sums[4 * q + 0] += hv * w[0]; sums[4 * q + 1] += hv * w[1]; sums[4 * q + 2] += hv * w[2]; sums[4 * q + 3] += hv * w[3]; }
            asm volatile("" ::: "memory"); }
}
DI int eidx16(int lane) { return ((lane >> 5) & 1) * 8 + ((lane >> 4) & 1) * 4 + ((lane >> 3) & 1) * 2 + ((lane >> 2) & 1); }
DI float reduce16(const float (&s)[16], int lane) {
    float a8[8], a4[4], a2[2];
    const bool u5 = (lane & 32) != 0, u4 = (lane & 16) != 0, u3 = (lane & 8) != 0, u2 = (lane & 4) != 0;
#pragma unroll
    for (int k = 0; k < 8; ++k) { const float keep = u5 ? s[k + 8] : s[k], send = u5 ? s[k] : s[k + 8]; a8[k] = keep + __shfl_xor(send, 32); }
#pragma unroll
    for (int k = 0; k < 4; ++k) { const float keep = u4 ? a8[k + 4] : a8[k], send = u4 ? a8[k] : a8[k + 4]; a4[k] = keep + __shfl_xor(send, 16); }
#pragma unroll
    for (int k = 0; k < 2; ++k) { const float keep = u3 ? a4[k + 2] : a4[k], send = u3 ? a4[k] : a4[k + 2]; a2[k] = keep + __shfl_xor(send, 8); }
    float r; { const float keep = u2 ? a2[1] : a2[0], send = u2 ? a2[0] : a2[1]; r = keep + __shfl_xor(send, 4); }
    r += __shfl_xor(r, 2); r += __shfl_xor(r, 1);
    return r;
}
DI float* resid_ptr(float* lat, float* ctx, int r) { return r < RL ? lat + (size_t)r * DM : ctx + (size_t)(r - RL) * DM; }
DI int row_bb(int r) { return r < RL ? (r >> 13) : 4; }
DI void modulate_row(f32x4 (&v)[4], const float* nw, const float* shift, const float* scale, int lane) {
    float ss = 0.f;
#pragma unroll
    for (int j = 0; j < 4; ++j) ss += (v[j][0] * v[j][0] + v[j][1] * v[j][1]) + (v[j][2] * v[j][2] + v[j][3] * v[j][3]);
    const float rstd = 1.0f / sqrtf(wave_sum(ss) * (1.0f / DM) + EPSN);
#pragma unroll
    for (int j = 0; j < 4; ++j) { const int d = 256 * j + 4 * lane; const f32x4 w = *(const f32x4*)(nw + d), sc = *(const f32x4*)(scale + d), sh = *(const f32x4*)(shift + d);
        v[j] = v[j] * rstd * w * (sc + 1.0f) + sh; }
}
DI void store_row_bf16(bf16* dst, const f32x4 (&v)[4], int lane) {
#pragma unroll
    for (int j = 0; j < 4; ++j) { u32x2 o; o.x = pk2(v[j][0], v[j][1]); o.y = pk2(v[j][2], v[j][3]); *(u32x2*)(dst + 256 * j + 4 * lane) = o; }
}
DI void load_row_f32(const float* src, f32x4 (&v)[4], int lane) {
#pragma unroll
    for (int j = 0; j < 4; ++j) v[j] = *(const f32x4*)(src + 256 * j + 4 * lane);
}
DI void moe_combine_row(f32x4 (&v)[4], const int* invrow, const bf16* YE, const float* gvec, int lane) {
    const int mine = invrow[lane & 15];
    f32x4 a[4];
#pragma unroll
    for (int j = 0; j < 4; ++j) a[j] = (f32x4){0.f, 0.f, 0.f, 0.f};
#pragma unroll
    for (int e = 0; e < 16; ++e) { const int s = __builtin_amdgcn_readlane(mine, e);
        if (s >= 0) { const bf16* yr = YE + (size_t)s * DM;
#pragma unroll
            for (int j = 0; j < 4; ++j) { const u32x2 w = *(const u32x2*)(yr + 256 * j + 4 * lane); a[j][0] += bflo(w.x); a[j][1] += bfhi(w.x); a[j][2] += bflo(w.y); a[j][3] += bfhi(w.y); } } }
#pragma unroll
    for (int j = 0; j < 4; ++j) { const f32x4 g = *(const f32x4*)(gvec + 256 * j + 4 * lane); v[j] = v[j] + g * a[j]; }
}

#define PH_ARGS const Args& A, LAS unsigned char* lds, int tid, int lane, int wave, int G, int bx
DI void sincos_d(double a, float& sn, float& cs) {
    const double TWO_OVER_PI = 0.63661977236758134308, PIO2 = 1.57079632679489661923;
    const double kq = (double)(long long)(a * TWO_OVER_PI + 0.5); const double y = a - kq * PIO2; const double y2 = y * y;
    const double s = y * (1.0 + y2 * (-1.0 / 6 + y2 * (1.0 / 120 + y2 * (-1.0 / 5040 + y2 * (1.0 / 362880 + y2 * (-1.0 / 39916800 + y2 * (1.0 / 6227020800.0)))))));
    const double c = 1.0 + y2 * (-0.5 + y2 * (1.0 / 24 + y2 * (-1.0 / 720 + y2 * (1.0 / 40320 + y2 * (-1.0 / 3628800 + y2 * (1.0 / 479001600.0))))));
    const int k = (int)((long long)kq & 3);
    const double ss = (k == 0) ? s : (k == 1) ? c : (k == 2) ? -s : -c;
    const double cc = (k == 0) ? c : (k == 1) ? -s : (k == 2) ? -c : s;
    sn = (float)ss; cs = (float)cc;
}

DI void phase0(PH_ARGS) {
    unsigned char* ws = A.ws;
    LAS float* sil = (LAS float*)(lds + 73728);
    for (int i = tid; i < 5120; i += NTHR) { const int bb = i >> 10, k = i & 1023; const float cv = bb < 4 ? A.in[1][bb * 1024 + k] : A.in[3][k]; sil[i] = silu_f(cv); }
    __syncthreads();
    {
        const int t = wave * G + bx;
        if (t < 192) { const int layer = t / 96, n = (t % 96) * 64 + lane; const float* W = A.in[layer ? 19 : 4] + n; const float* Bv = A.in[layer ? 20 : 5];
            float a0 = 0.f, a1 = 0.f, a2 = 0.f, a3 = 0.f, a4 = 0.f;
#pragma unroll 8
            for (int k = 0; k < 1024; ++k) { const float w = W[(size_t)k * 6144]; a0 += sil[k] * w; a1 += sil[1024 + k] * w; a2 += sil[2048 + k] * w; a3 += sil[3072 + k] * w; a4 += sil[4096 + k] * w; }
            float* mv = (float*)(ws + WS_MODV) + layer * 5 * 6144 + n; const float bv = Bv[n];
            mv[0] = a0 + bv; mv[6144] = a1 + bv; mv[2 * 6144] = a2 + bv; mv[3 * 6144] = a3 + bv; mv[4 * 6144] = a4 + bv; }
    }
    if (bx == G - 1) {
        float* rope = (float*)(ws + WS_ROPE);
        for (int i = tid; i < 3072; i += NTHR) { const int isc = i >= 2048, ii = isc ? i - 2048 : i; const int pos = ii >> 4, j = ii & 15;
            double f = 1.0; for (int q = 0; q < j; ++q) f *= 0.56234132519034908;
            float sn, cs; sincos_d((double)pos * f, sn, cs);
            if (isc) { rope[4096 + ii] = cs; rope[5120 + ii] = sn; } else { rope[ii] = cs; rope[2048 + ii] = sn; } }
        unsigned* z = (unsigned*)(ws + WS_ZROW); for (int i = tid; i < 512; i += NTHR) z[i] = 0u;
    }
    LAS float* scr = (LAS float*)(lds + wave * 8704);
    const int gw = bx * NWAVES + wave, NGW = G * NWAVES;
    constexpr int I_IN = 16 * 112, I_OUT = 16 * 32, I_QK = 16 * 64, I_V = 16 * 32, I_O = 16 * 32, I_EXP = 49152;
    constexpr int NITEMS = I_IN + I_OUT + I_QK + I_V + I_O + I_EXP;
    for (int it = gw; it < NITEMS; it += NGW) {
        int r = it;
        if (r < I_EXP) { expert_item(r, A.in[16], A.in[17], A.in[18], (bf16*)(ws + WS_E0), (bf16*)(ws + WS_E0 + 128 * MiB), scr, lane); continue; } r -= I_EXP;
        if (r < I_IN) { const int kb = r / 112, nb = r % 112; tr_item(A.in[7] + (size_t)(kb * 64) * INCOLS + nb * 32, INCOLS, (bf16*)(ws + WS_WIN), 1024, kb * 64, AddMap{nb * 32}, scr, lane); continue; } r -= I_IN;
        if (r < I_OUT) { const int kb = r >> 5, nb = r & 31; tr_item(A.in[13] + (size_t)(kb * 64) * 1024 + nb * 32, 1024, (bf16*)(ws + WS_WOUT), 1024, kb * 64, AddMap{nb * 32}, scr, lane); continue; } r -= I_OUT;
        if (r < I_QK) { const int kb = r >> 6, nb = r & 63; tr_item(A.in[22] + (size_t)(kb * 64) * 3072 + nb * 32, 3072, (bf16*)(ws + WS_WQK), 1024, kb * 64, PairMap{nb * 32}, scr, lane); continue; } r -= I_QK;
        if (r < I_V) { const int kb = r >> 5, nb = r & 31; tr_item(A.in[22] + (size_t)(kb * 64) * 3072 + 2048 + nb * 32, 3072, (bf16*)(ws + WS_WV), 1024, kb * 64, AddMap{nb * 32}, scr, lane); continue; } r -= I_V;
        { const int kb = r >> 5, nb = r & 31; tr_item(A.in[28] + (size_t)(kb * 64) * 1024 + nb * 32, 1024, (bf16*)(ws + WS_WO), 1024, kb * 64, AddMap{nb * 32}, scr, lane); }
    }
}

template <int MODE, int LAYER> DI void phase_modulate(PH_ARGS) {
    unsigned char* ws = A.ws;
    LAS float* tab = (LAS float*)lds;
    if (MODE == 0) stage_tab16(A.in[7] + NPROJ, INCOLS, tab, tid); else stage_tab16(A.in[LAYER ? 30 : 15], 16, tab, tid);
    __syncthreads();
    const float* nw = A.in[MODE == 0 ? 6 : (LAYER ? 29 : 14)];
    const float* mv = (const float*)(ws + WS_MODV) + LAYER * 5 * 6144 + (MODE == 0 ? 0 : 3 * 1024);
    bf16* H = (bf16*)(ws + WS_H);
    const int NR = (MODE == 1 && LAYER == 1) ? RL : RT;
    for (int r = bx * NWAVES + wave; r < NR; r += G * NWAVES) {
        const float* src = (MODE == 0) ? (r < RL ? A.in[0] + (size_t)r * DM : A.in[2] + (size_t)(r - RL) * DM) : resid_ptr(A.out, (float*)(ws + WS_XC), r);
        const int bb = row_bb(r);
        f32x4 v[4]; load_row_f32(src, v, lane);
        modulate_row(v, nw, mv + bb * 6144, mv + bb * 6144 + 1024, lane);
        store_row_bf16(H + (size_t)r * DM, v, lane);
        float sums[16]; row_gemv16(v, tab, lane, sums);
        const float red = reduce16(sums, lane); const int ee = eidx16(lane);
        if (MODE == 0) { if ((lane & 3) == 0) ((float*)(ws + WS_GATES))[(size_t)r * 16 + ee] = red; }
        else { const float mx = wave_max(red); const float ex = __expf(red - mx); const float den = wave_sum(ex) * 0.25f; const float mine = ex / den;
            if ((lane & 3) == 0) { float* af = (float*)(ws + WS_AFFT);
                if (r < RL) af[(size_t)(((r >> 13) * 16 + ee)) * 8192 + (r & 8191)] = mine;
                else { const int rr = r - RL; af[524288 + (size_t)(((rr >> 8) * 16 + ee)) * 256 + (rr & 255)] = mine; } } }
    }
}

DI void fnma_asm(float& acc, float a, float b) { asm("v_fma_f32 %0, -%1, %2, %0" : "+v"(acc) : "v"(a), "v"(b)); }
template <int J> DI void backsub_row(float (&t)[64], const LAS float* LT, int lane) {
    float acc0 = (lane == J) ? 1.0f : 0.0f, acc1 = 0.f;
    constexpr int K0 = (J + 1) >> 2;
#pragma unroll
    for (int k4 = K0; k4 < 16; ++k4) { const f32x4 l4 = *(const LAS f32x4*)(LT + J * 64 + 4 * k4);
#pragma unroll
        for (int q = 0; q < 4; ++q) { const int k = 4 * k4 + q; if (k > J) { if (q & 1) fnma_asm(acc1, t[k], l4[q]); else fnma_asm(acc0, t[k], l4[q]); } } }
    t[J] = acc0 + acc1;
    __builtin_amdgcn_sched_barrier(0);
}
template <int J> DI void backsub_all(float (&t)[64], const LAS float* LT, int lane) {
    backsub_row<J>(t, LT, lane);
    if constexpr (J > 0) backsub_all<J - 1>(t, LT, lane);
}
DI void gdn_dir(const Args& A, LAS unsigned char* lds, int lane, int dir, int b, int h, int seqsel, int cidx, int rowbase, int t0) {
    unsigned char* ws = A.ws;
    const int r32 = lane & 31, hi = lane >> 5;
    LAS unsigned char* Qn = lds; LAS unsigned char* Kn = lds + 16384;
    LAS unsigned char* DB = lds + 32768 + 49152 * dir;
    LAS float* LT = (LAS float*)DB; LAS unsigned char* TBG = DB; LAS unsigned char* TB = DB + 8192;
    LAS unsigned char* KT = DB + 16384; LAS unsigned char* VT = DB + 32768;
    LAS float* SM = (LAS float*)(lds + LDSX + 1024 + dir * 1280);
    LAS float* GC = SM; LAS float* EGC = SM + 64; LAS float* BETA = SM + 128; LAS float* BG = SM + 192; LAS float* KDEC = SM + 256;
    const int ch = (b * 4 + h) * 2 + dir;
    const int p = seqsel ? (dir ? 3 - cidx : cidx) : 4 + (dir ? 127 - cidx : cidx);
    unsigned char* blk = ws + WS_G + (size_t)(ch * NCHUNK + p) * GBLK;
    {
        const int tk = dir ? 63 - lane : lane; const float* gr = (const float*)(ws + WS_GATES) + (size_t)(rowbase + t0 + tk) * 16;
        const float av = gr[dir * 4 + h], bv = gr[8 + dir * 4 + h];
        const float xs = av + A.in[11][dir * 4 + h]; const float sp = xs > 20.f ? xs : log1pf(__expf(xs));
        const float g = -__expf(A.in[10][dir * 4 + h]) * sp; const float beta = 1.0f / (1.0f + __expf(-bv));
        float gc = g;
#pragma unroll
        for (int o = 1; o < 64; o <<= 1) { const float tv = __shfl_up(gc, o); if (lane >= o) gc += tv; }
        const float gl = __shfl(gc, 63); const float eg = __expf(gc);
        GC[lane] = gc; EGC[lane] = eg; BETA[lane] = beta; BG[lane] = beta * eg; KDEC[lane] = __expf(gl - gc);
        if (lane == 0) ((float*)(ws + WS_GLAST))[ch * NCHUNK + p] = __expf(gl);
    }
    LDS_WAIT(); asm volatile("" ::: "memory");
#pragma unroll
    for (int ib = 0; ib < 2; ++ib) {
        const int i = 32 * ib + r32; const int ti = dir ? 63 - i : i; const float gi = GC[i], bi = BETA[i];
#pragma unroll
        for (int jb = 0; jb < 2; ++jb) {
            f32x16 aK, aQ;
#pragma unroll
            for (int r = 0; r < 16; ++r) { aK[r] = 0.f; aQ[r] = 0.f; }
            if (jb <= ib) {
                const int j = 32 * jb + r32; const int tj = dir ? 63 - j : j;
#pragma unroll
                for (int kk = 0; kk < 8; ++kk) {
                    const bf16x8 a = *(const LAS bf16x8*)(Kn + sw128(tj, 2 * kk + hi));
                    const bf16x8 bK = *(const LAS bf16x8*)(Kn + sw128(ti, 2 * kk + hi));
                    const bf16x8 bQ = *(const LAS bf16x8*)(Qn + sw128(ti, 2 * kk + hi));
                    aK = MFMA32(a, bK, aK); aQ = MFMA32(a, bQ, aQ);
                }
            }
#pragma unroll
            for (int g4 = 0; g4 < 4; ++g4) { const f32x4 gj = *(const LAS f32x4*)(GC + 32 * jb + 8 * g4 + 4 * hi);
#pragma unroll
                for (int q = 0; q < 4; ++q) { const int r = 4 * g4 + q; const int j = 32 * jb + 8 * g4 + 4 * hi + q;
                    const float dec = __expf(fminf(gi - gj[q], 0.f));
                    const float lv = (j < i) ? bi * aK[r] * dec : 0.f;
                    LT[j * 64 + i] = lv;
                    aQ[r] = (j <= i) ? aQ[r] * dec : 0.f; } }
            *(bf16x8*)(blk + 32768 + ((ib * 4 + 2 * jb + 0) * 1024) + lane * 16) = pack8<0>(aQ);
            *(bf16x8*)(blk + 32768 + ((ib * 4 + 2 * jb + 1) * 1024) + lane * 16) = pack8<1>(aQ);
        }
    }
    LDS_WAIT(); asm volatile("" ::: "memory");
    float t[64];
    backsub_all<63>(t, LT, lane);
    LDS_WAIT(); asm volatile("" ::: "memory");
#pragma unroll
    for (int c = 0; c < 8; ++c) {
        const f32x4 b0 = *(const LAS f32x4*)(BETA + 8 * c), b1 = *(const LAS f32x4*)(BETA + 8 * c + 4), g0 = *(const LAS f32x4*)(BG + 8 * c), g1 = *(const LAS f32x4*)(BG + 8 * c + 4);
        u32x4 wb, wg;
        wb.x = pk2(t[8 * c] * b0[0], t[8 * c + 1] * b0[1]); wb.y = pk2(t[8 * c + 2] * b0[2], t[8 * c + 3] * b0[3]); wb.z = pk2(t[8 * c + 4] * b1[0], t[8 * c + 5] * b1[1]); wb.w = pk2(t[8 * c + 6] * b1[2], t[8 * c + 7] * b1[3]);
        wg.x = pk2(t[8 * c] * g0[0], t[8 * c + 1] * g0[1]); wg.y = pk2(t[8 * c + 2] * g0[2], t[8 * c + 3] * g0[3]); wg.z = pk2(t[8 * c + 4] * g1[0], t[8 * c + 5] * g1[1]); wg.w = pk2(t[8 * c + 6] * g1[2], t[8 * c + 7] * g1[3]);
        *(LAS u32x4*)(TB + sw64(lane, c)) = wb; *(LAS u32x4*)(TBG + sw64(lane, c)) = wg;
    }
    LDS_WAIT(); asm volatile("" ::: "memory");
#pragma unroll
    for (int ib = 0; ib < 2; ++ib) {
        bf16x8 tg[4], tb[4];
#pragma unroll
        for (int js = 0; js < 4; ++js) { tg[js] = *(const LAS bf16x8*)(TBG + sw64(32 * ib + r32, 2 * js + hi)); tb[js] = *(const LAS bf16x8*)(TB + sw64(32 * ib + r32, 2 * js + hi)); }
#pragma unroll
        for (int kb = 0; kb < 4; ++kb) {
            f32x16 acc;
#pragma unroll
            for (int r = 0; r < 16; ++r) acc[r] = 0.f;
#pragma unroll
            for (int js = 0; js < 4; ++js) { const bf16x8 a = *(const LAS bf16x8*)(KT + sw64(32 * kb + r32, 2 * js + hi)); acc = MFMA32(a, tg[js], acc); }
            *(bf16x8*)(blk + ((ib * 8 + 2 * kb + 0) * 1024) + lane * 16) = pack8<0>(acc);
            *(bf16x8*)(blk + ((ib * 8 + 2 * kb + 1) * 1024) + lane * 16) = pack8<1>(acc);
        }
#pragma unroll
        for (int dvb = 0; dvb < 4; ++dvb) {
            f32x16 acc;
#pragma unroll
            for (int r = 0; r < 16; ++r) acc[r] = 0.f;
#pragma unroll
            for (int js = 0; js < 4; ++js) { const bf16x8 bv = *(const LAS bf16x8*)(VT + sw64(32 * dvb + r32, 2 * js + hi)); acc = MFMA32(tb[js], bv, acc); }
            unsigned char* up = blk + 57344 + (dvb * 2 + ib) * 2048 + lane * 32;
            *(bf16x8*)(up) = pack8<0>(acc); *(bf16x8*)(up + 16) = pack8<1>(acc);
        }
    }
#pragma unroll
    for (int ib = 0; ib < 2; ++ib) { const int i = 32 * ib + r32; const int ti = dir ? 63 - i : i; const float eg = EGC[i];
#pragma unroll
        for (int ks = 0; ks < 8; ++ks) {
            const u32x2 lo = *(const LAS u32x2*)(Qn + sw128(ti, 2 * ks) + 8 * hi), hh = *(const LAS u32x2*)(Qn + sw128(ti, 2 * ks + 1) + 8 * hi);
            u32x4 o; o.x = pk2(bflo(lo.x) * eg, bfhi(lo.x) * eg); o.y = pk2(bflo(lo.y) * eg, bfhi(lo.y) * eg); o.z = pk2(bflo(hh.x) * eg, bfhi(hh.x) * eg); o.w = pk2(bflo(hh.y) * eg, bfhi(hh.y) * eg);
            *(u32x4*)(blk + 16384 + ((ib * 8 + ks) * 1024) + lane * 16) = o; } }
#pragma unroll
    for (int kb = 0; kb < 4; ++kb) { const int dk = 32 * kb + r32;
#pragma unroll
        for (int ks = 0; ks < 4; ++ks) {
            const u32x2 lo = *(const LAS u32x2*)(KT + sw64(dk, 2 * ks) + 8 * hi), hh = *(const LAS u32x2*)(KT + sw64(dk, 2 * ks + 1) + 8 * hi);
            const f32x4 d0 = *(const LAS f32x4*)(KDEC + 16 * ks + 4 * hi), d1 = *(const LAS f32x4*)(KDEC + 16 * ks + 8 + 4 * hi);
            u32x4 o; o.x = pk2(bflo(lo.x) * d0[0], bfhi(lo.x) * d0[1]); o.y = pk2(bflo(lo.y) * d0[2], bfhi(lo.y) * d0[3]); o.z = pk2(bflo(hh.x) * d1[0], bfhi(hh.x) * d1[1]); o.w = pk2(bflo(hh.y) * d1[2], bfhi(hh.y) * d1[3]);
            *(u32x4*)(blk + 40960 + ((kb * 4 + ks) * 1024) + lane * 16) = o; } }
}

DI void phase_gdn_prep(PH_ARGS) {
    unsigned char* ws = A.ws;
    const bf16* PROJ = (const bf16*)(ws + WS_BIG);
    LAS unsigned char* Qn = lds; LAS unsigned char* Kn = lds + 16384;
    const int lane_in = lane;
    for (int u = bx; u < 2112; u += G) {
        int lane = lane_in; asm volatile("" : "+v"(lane));
        int seqsel, b, cidx, h;
        if (u < 2048) { seqsel = 0; b = u >> 9; cidx = (u >> 2) & 127; h = u & 3; } else { const int q = u - 2048; seqsel = 1; b = q >> 4; cidx = (q >> 2) & 3; h = q & 3; }
        const int rowbase = seqsel ? RL + b * CTXL : b * SEQL; const int L = seqsel ? CTXL : SEQL; const int t0 = cidx * 64;
        {
            const int d = 2 * lane; float w[3][3][2];
#pragma unroll
            for (int s = 0; s < 3; ++s)
#pragma unroll
                for (int j = 0; j < 3; ++j) { const f32x2 wv = *(const f32x2*)(A.in[9] + j * 1536 + s * 512 + h * 128 + d); w[s][j][0] = wv[0]; w[s][j][1] = wv[1]; }
            unsigned raw[10][3];
#pragma unroll
            for (int rr = 0; rr < 10; ++rr) { const int t = t0 + 8 * wave - 1 + rr; const bool ok = (t >= 0) && (t < L);
#pragma unroll
                for (int s = 0; s < 3; ++s) raw[rr][s] = ok ? *(const unsigned*)(PROJ + (size_t)(rowbase + t) * NPROJ + 1536 + s * 512 + h * 128 + d) : 0u; }
#pragma unroll
            for (int ii = 0; ii < 8; ++ii) { const int i = 8 * wave + ii;
                float val[3][2];
#pragma unroll
                for (int s = 0; s < 3; ++s) {
                    const float x0 = w[s][0][0] * bflo(raw[ii][s]) + w[s][1][0] * bflo(raw[ii + 1][s]) + w[s][2][0] * bflo(raw[ii + 2][s]);
                    const float x1 = w[s][0][1] * bfhi(raw[ii][s]) + w[s][1][1] * bfhi(raw[ii + 1][s]) + w[s][2][1] * bfhi(raw[ii + 2][s]);
                    val[s][0] = silu_f(x0); val[s][1] = silu_f(x1); }
                const float qs = wave_sum(val[0][0] * val[0][0] + val[0][1] * val[0][1]), ksq = wave_sum(val[1][0] * val[1][0] + val[1][1] * val[1][1]);
                const float rq = 0.08838834764831845f / sqrtf(qs + EPSN), rk = 1.0f / sqrtf(ksq + EPSN);
                const unsigned qp = pk2(val[0][0] * rq, val[0][1] * rq), kp = pk2(val[1][0] * rk, val[1][1] * rk), vp = pk2(val[2][0], val[2][1]);
                *(LAS unsigned*)(Qn + sw128(i, lane >> 2) + (lane & 3) * 4) = qp;
                *(LAS unsigned*)(Kn + sw128(i, lane >> 2) + (lane & 3) * 4) = kp;
#pragma unroll
                for (int dir = 0; dir < 2; ++dir) { const int pi = dir ? 63 - i : i; LAS unsigned char* KT = lds + 32768 + 49152 * dir + 16384; LAS unsigned char* VT = KT + 16384;
                    *(LAS unsigned short*)(KT + sw64(d, pi >> 3) + (pi & 7) * 2) = (unsigned short)(kp & 0xffffu);
                    *(LAS unsigned short*)(KT + sw64(d + 1, pi >> 3) + (pi & 7) * 2) = (unsigned short)(kp >> 16);
                    *(LAS unsigned short*)(VT + sw64(d, pi >> 3) + (pi & 7) * 2) = (unsigned short)(vp & 0xffffu);
                    *(LAS unsigned short*)(VT + sw64(d + 1, pi >> 3) + (pi & 7) * 2) = (unsigned short)(vp >> 16); }
            }
        }
        __syncthreads();
        if (wave < 2) gdn_dir(A, lds, lane, wave, b, h, seqsel, cidx, rowbase, t0);
        __syncthreads();
    }
}

DI void phase_gdn_scan(PH_ARGS) {
    unsigned char* ws = A.ws;
    if (wave != 0 || bx >= 128) return;
    const int xcd = bx & 7, idx = bx >> 3; const int ch = xcd + 8 * (idx >> 2), v = idx & 3;
    const int dir = ch & 1, bh = ch >> 1, b = bh >> 2, h = bh & 3;
    const int r32 = lane & 31, hi = lane >> 5;
    bf16* PROJ = (bf16*)(ws + WS_BIG);
    const float* GL = (const float*)(ws + WS_GLAST) + ch * NCHUNK;
    f32x16 S[4];
#pragma unroll
    for (int kb = 0; kb < 4; ++kb)
#pragma unroll
        for (int r = 0; r < 16; ++r) S[kb][r] = 0.f;
    for (int p = 0; p < NCHUNK; ++p) {
        const unsigned char* blk = ws + WS_G + (size_t)(ch * NCHUNK + p) * GBLK + lane * 16;
        const float gl = GL[p];
        bf16x8 Sb[8];
        Sb[0] = pack8<0>(S[0]); Sb[1] = pack8<1>(S[0]); Sb[2] = pack8<0>(S[1]); Sb[3] = pack8<1>(S[1]);
        Sb[4] = pack8<0>(S[2]); Sb[5] = pack8<1>(S[2]); Sb[6] = pack8<0>(S[3]); Sb[7] = pack8<1>(S[3]);
        f32x16 P[2], O[2];
#pragma unroll
        for (int ib = 0; ib < 2; ++ib) {
#pragma unroll
            for (int r = 0; r < 16; ++r) { P[ib][r] = 0.f; O[ib][r] = 0.f; }
#pragma unroll
            for (int ks = 0; ks < 8; ++ks) { const bf16x8 wf = *(const bf16x8*)(blk + (ib * 8 + ks) * 1024); P[ib] = MFMA32(wf, Sb[ks], P[ib]); }
#pragma unroll
            for (int ks = 0; ks < 8; ++ks) { const bf16x8 qf = *(const bf16x8*)(blk + 16384 + (ib * 8 + ks) * 1024); O[ib] = MFMA32(qf, Sb[ks], O[ib]); }
        }
        bf16x8 Vb[4];
#pragma unroll
        for (int ib = 0; ib < 2; ++ib) {
            const unsigned char* up = ws + WS_G + (size_t)(ch * NCHUNK + p) * GBLK + 57344 + (v * 2 + ib) * 2048 + lane * 32;
            const u32x4 u0 = *(const u32x4*)up, u1 = *(const u32x4*)(up + 16);
            f32x16 vn;
            vn[0] = bflo(u0.x) - P[ib][0]; vn[1] = bfhi(u0.x) - P[ib][1]; vn[2] = bflo(u0.y) - P[ib][2]; vn[3] = bfhi(u0.y) - P[ib][3];
            vn[4] = bflo(u0.z) - P[ib][4]; vn[5] = bfhi(u0.z) - P[ib][5]; vn[6] = bflo(u0.w) - P[ib][6]; vn[7] = bfhi(u0.w) - P[ib][7];
            vn[8] = bflo(u1.x) - P[ib][8]; vn[9] = bfhi(u1.x) - P[ib][9]; vn[10] = bflo(u1.y) - P[ib][10]; vn[11] = bfhi(u1.y) - P[ib][11];
            vn[12] = bflo(u1.z) - P[ib][12]; vn[13] = bfhi(u1.z) - P[ib][13]; vn[14] = bflo(u1.w) - P[ib][14]; vn[15] = bfhi(u1.w) - P[ib][15];
            Vb[2 * ib] = pack8<0>(vn); Vb[2 * ib + 1] = pack8<1>(vn);
        }
#pragma unroll
        for (int ib = 0; ib < 2; ++ib)
#pragma unroll
            for (int kt = 0; kt < 4; ++kt) { const bf16x8 af = *(const bf16x8*)(blk + 32768 + (ib * 4 + kt) * 1024); O[ib] = MFMA32(af, Vb[kt], O[ib]); }
#pragma unroll
        for (int kb = 0; kb < 4; ++kb) {
#pragma unroll
            for (int r = 0; r < 16; ++r) S[kb][r] *= gl;
#pragma unroll
            for (int kt = 0; kt < 4; ++kt) { const bf16x8 kf = *(const bf16x8*)(blk + 40960 + (kb * 4 + kt) * 1024); S[kb] = MFMA32(kf, Vb[kt], S[kb]); }
        }
        int rowbase, cidx;
        if (p < 4) { cidx = dir ? 3 - p : p; rowbase = RL + b * CTXL; } else { cidx = dir ? 131 - p : p - 4; rowbase = b * SEQL; }
        bf16* ob = PROJ + (size_t)(rowbase + cidx * 64) * NPROJ + 1536 + dir * 512 + h * 128 + 32 * v + r32;
#pragma unroll
        for (int ib = 0; ib < 2; ++ib)
#pragma unroll
            for (int r = 0; r < 16; ++r) { const int i = 32 * ib + crow(r, hi); const int tk = dir ? 63 - i : i;
                ob[(size_t)tk * NPROJ] = (bf16)(pk2(O[ib][r], 0.f) & 0xffffu); }
    }
}

DI void unpack8(const u32x4 w, float (&f)[8]) { f[0] = bflo(w.x); f[1] = bfhi(w.x); f[2] = bflo(w.y); f[3] = bfhi(w.y); f[4] = bflo(w.z); f[5] = bfhi(w.z); f[6] = bflo(w.w); f[7] = bfhi(w.w); }
DI void phase_ycat(PH_ARGS) {
    unsigned char* ws = A.ws;
    const bf16* PROJ = (const bf16*)(ws + WS_BIG); bf16* Y = (bf16*)(ws + WS_H);
    const int c0 = 8 * lane;
    float cw[3][8], gn[8];
#pragma unroll
    for (int j = 0; j < 3; ++j) { const f32x4 a = *(const f32x4*)(A.in[8] + j * 512 + c0), b2 = *(const f32x4*)(A.in[8] + j * 512 + c0 + 4);
        cw[j][0] = a[0]; cw[j][1] = a[1]; cw[j][2] = a[2]; cw[j][3] = a[3]; cw[j][4] = b2[0]; cw[j][5] = b2[1]; cw[j][6] = b2[2]; cw[j][7] = b2[3]; }
    { const f32x4 a = *(const f32x4*)(A.in[12] + (c0 & 127)), b2 = *(const f32x4*)(A.in[12] + (c0 & 127) + 4);
        gn[0] = a[0]; gn[1] = a[1]; gn[2] = a[2]; gn[3] = a[3]; gn[4] = b2[0]; gn[5] = b2[1]; gn[6] = b2[2]; gn[7] = b2[3]; }
    for (int r = bx * NWAVES + wave; r < RT; r += G * NWAVES) {
        const int t = r < RL ? (r & 8191) : ((r - RL) & 255); const int L = r < RL ? SEQL : CTXL;
        const bf16* pr = PROJ + (size_t)r * NPROJ;
        float pm[8], pc[8], pn[8], xa[8], gc_[8], gb[8];
        unpack8(*(const u32x4*)(pr + c0), xa); unpack8(*(const u32x4*)(pr + 1024 + c0), gc_); unpack8(*(const u32x4*)(pr + 512 + c0), gb);
#pragma unroll
        for (int q = 0; q < 8; ++q) pc[q] = gc_[q] * xa[q];
        if (t > 0) { unpack8(*(const u32x4*)(pr - NPROJ + c0), xa); unpack8(*(const u32x4*)(pr - NPROJ + 1024 + c0), gc_);
#pragma unroll
            for (int q = 0; q < 8; ++q) pm[q] = gc_[q] * xa[q]; }
        else {
#pragma unroll
            for (int q = 0; q < 8; ++q) pm[q] = 0.f; }
        if (t < L - 1) { unpack8(*(const u32x4*)(pr + NPROJ + c0), xa); unpack8(*(const u32x4*)(pr + NPROJ + 1024 + c0), gc_);
#pragma unroll
            for (int q = 0; q < 8; ++q) pn[q] = gc_[q] * xa[q]; }
        else {
#pragma unroll
            for (int q = 0; q < 8; ++q) pn[q] = 0.f; }
        u32x4 o;
        { float y[8];
#pragma unroll
            for (int q = 0; q < 8; ++q) y[q] = gb[q] * (cw[0][q] * pm[q] + cw[1][q] * pc[q] + cw[2][q] * pn[q]);
            o.x = pk2(y[0], y[1]); o.y = pk2(y[2], y[3]); o.z = pk2(y[4], y[5]); o.w = pk2(y[6], y[7]); }
        *(u32x4*)(Y + (size_t)r * DM + c0) = o;
        float of[8], ob[8], z[8];
        unpack8(*(const u32x4*)(pr + 1536 + c0), of); unpack8(*(const u32x4*)(pr + 2048 + c0), ob); unpack8(*(const u32x4*)(pr + 3072 + c0), z);
        float ss = 0.f;
#pragma unroll
        for (int q = 0; q < 8; ++q) { of[q] += ob[q]; ss += of[q] * of[q]; }
        ss += __shfl_xor(ss, 1); ss += __shfl_xor(ss, 2); ss += __shfl_xor(ss, 4); ss += __shfl_xor(ss, 8);
        const float rn = 1.0f / sqrtf(ss * (1.0f / 128.0f) + EPSN);
        { float y[8];
#pragma unroll
            for (int q = 0; q < 8; ++q) y[q] = of[q] * rn * gn[q] * silu_f(z[q]);
            o.x = pk2(y[0], y[1]); o.y = pk2(y[2], y[3]); o.z = pk2(y[4], y[5]); o.w = pk2(y[6], y[7]); }
        *(u32x4*)(Y + (size_t)r * DM + 512 + c0) = o;
    }
}

template <int LAYER> DI void phase_topk(PH_ARGS) {
    unsigned char* ws = A.ws;
    LAS unsigned* vals = (LAS unsigned*)lds; LAS unsigned* hist = (LAS unsigned*)(lds + 32768); LAS unsigned* misc = (LAS unsigned*)(lds + 34816);
    LAS unsigned* wsum = (LAS unsigned*)(lds + 35840); LAS int* slist = (LAS int*)(lds + 36864);
    const int SPE = LAYER ? SPE1 : SPE0; const int NTASK = LAYER ? 64 : 128;
    const bf16* H = (const bf16*)(ws + WS_H); bf16* XE = (bf16*)(ws + WS_G + (LAYER ? 192 * MiB : 0));
    float* gatev = (float*)(ws + WS_GATEV); int* INV = (int*)(ws + WS_INV);
    for (int task = bx; task < NTASK; task += G) {
        const int seqsel = task >> 6, b = (task >> 4) & 3, e = task & 15;
        const int n = seqsel ? CTXL : SEQL, cap = seqsel ? 32 : 1024;
        const float* af = (const float*)(ws + WS_AFFT) + (seqsel ? 524288 + (size_t)((b * 16 + e)) * 256 : (size_t)((b * 16 + e)) * 8192);
        const int rowbase = seqsel ? RL + b * CTXL : b * SEQL;
        const int slotbase = e * SPE + (seqsel ? 4096 + b * 32 : b * 1024);
        for (int i = tid; i < n; i += NTHR) vals[i] = __float_as_uint(af[i]);
        __syncthreads();
        unsigned prefix = 0u; int remaining = cap;
#pragma unroll 1
        for (int pass = 3; pass >= 0; --pass) { const int shift = pass * 8;
            if (tid < 256) hist[tid] = 0u;
            __syncthreads();
            for (int i = tid; i < n; i += NTHR) { const unsigned vv = vals[i]; const bool match = (pass == 3) || (((vv ^ prefix) >> (shift + 8)) == 0u); if (match) __hip_atomic_fetch_add(&hist[(vv >> shift) & 255u], 1u, __ATOMIC_RELAXED, __HIP_MEMORY_SCOPE_WORKGROUP); }
            __syncthreads();
            if (tid == 0) { int cum = 0, dsel = 0, rem = remaining;
                for (int d = 255; d >= 0; --d) { const int hc = (int)hist[d]; if (cum + hc >= remaining) { dsel = d; rem = remaining - cum; break; } cum += hc; }
                misc[0] = (unsigned)dsel; misc[1] = (unsigned)rem; }
            __syncthreads();
            prefix |= misc[0] << shift; remaining = (int)misc[1];
            __syncthreads();
        }
        const int per = seqsel ? 1 : 16; const int i0 = tid * per; const bool act = i0 < n;
        int cgt = 0, ceq = 0;
        if (act) for (int q = 0; q < per; ++q) { const unsigned vv = vals[i0 + q]; cgt += (vv > prefix); ceq += (vv == prefix); }
        unsigned pk = (unsigned)cgt | ((unsigned)ceq << 16), inc = pk;
#pragma unroll
        for (int o = 1; o < 64; o <<= 1) { const unsigned tv = __shfl_up(inc, o); if (lane >= o) inc += tv; }
        if (lane == 63) wsum[wave] = inc;
        __syncthreads();
        unsigned woff = 0u;
#pragma unroll
        for (int w = 0; w < NWAVES; ++w) { const unsigned s = wsum[w]; if (w < wave) woff += s; }
        const unsigned exc = woff + inc - pk; int gt_before = (int)(exc & 0xffffu), eq_before = (int)(exc >> 16);
        if (act) for (int q = 0; q < per; ++q) { const int i = i0 + q; const unsigned vv = vals[i]; int slot = -1;
            if (vv > prefix) { slot = gt_before + (eq_before < remaining ? eq_before : remaining); ++gt_before; }
            else if (vv == prefix) { if (eq_before < remaining) slot = gt_before + eq_before; ++eq_before; }
            INV[(size_t)(rowbase + i) * 16 + e] = slot >= 0 ? slotbase + slot : -1;
            if (slot >= 0) { slist[slot] = i; gatev[slotbase + slot] = __uint_as_float(vv); } }
        __syncthreads();
        for (int s = wave; s < cap; s += NWAVES) { const int tk = slist[s]; const u32x4* src = (const u32x4*)(H + (size_t)(rowbase + tk) * DM); u32x4* dst = (u32x4*)(XE + (size_t)(slotbase + s) * DM);
            dst[lane] = src[lane]; dst[64 + lane] = src[64 + lane]; }
        if (LAYER == 0 && seqsel == 1 && b == 0) {
            for (int s = wave; s < 128; s += NWAVES) { u32x4* dst = (u32x4*)(XE + (size_t)(e * SPE + 4224 + s) * DM); dst[lane] = (u32x4){0u, 0u, 0u, 0u}; dst[64 + lane] = (u32x4){0u, 0u, 0u, 0u}; }
            if (tid < 128) gatev[e * SPE + 4224 + tid] = 0.f; }
        __syncthreads();
    }
}

template <int LAYER> DI void phase_combine(PH_ARGS) {
    unsigned char* ws = A.ws;
    const bf16* YE = (const bf16*)(LAYER ? ws + WS_E0 : ws + WS_G + 192 * MiB);
    const int* INV = (const int*)(ws + WS_INV);
    const float* mv = (const float*)(ws + WS_MODV) + LAYER * 5 * 6144;
    const int NR = LAYER ? RL : RT;
    for (int r = bx * NWAVES + wave; r < NR; r += G * NWAVES) {
        float* xr = resid_ptr(A.out, (float*)(ws + WS_XC), r); const int bb = row_bb(r);
        f32x4 v[4]; load_row_f32(xr, v, lane);
        moe_combine_row(v, INV + (size_t)r * 16, YE, mv + bb * 6144 + 5 * 1024, lane);
        if (LAYER == 0) {
#pragma unroll
            for (int j = 0; j < 4; ++j) *(f32x4*)(xr + 256 * j + 4 * lane) = v[j];
            const float* m1 = (const float*)(ws + WS_MODV) + 5 * 6144 + bb * 6144;
            modulate_row(v, A.in[21], m1, m1 + 1024, lane);
            store_row_bf16((bf16*)(ws + WS_H) + (size_t)r * DM, v, lane);
        } else {
            float ss = 0.f;
#pragma unroll
            for (int j = 0; j < 4; ++j) ss += (v[j][0] * v[j][0] + v[j][1] * v[j][1]) + (v[j][2] * v[j][2] + v[j][3] * v[j][3]);
            const float rstd = 1.0f / sqrtf(wave_sum(ss) * (1.0f / DM) + EPSN);
#pragma unroll
            for (int j = 0; j < 4; ++j) { const f32x4 w = *(const f32x4*)(A.in[34] + 256 * j + 4 * lane); *(f32x4*)(xr + 256 * j + 4 * lane) = v[j] * rstd * w; }
        }
    }
    if (LAYER == 0) {
        LAS float* scr = (LAS float*)(lds + wave * 8704);
        for (int it = bx * NWAVES + wave; it < 49152; it += G * NWAVES)
            expert_item(it, A.in[31], A.in[32], A.in[33], (bf16*)(ws + WS_G), (bf16*)(ws + WS_G + 128 * MiB), scr, lane);
    }
}

DI int swv(int dv, int c8, int half) { return dv * 128 + ((c8 ^ ((dv >> 1) & 7)) << 4) + ((half ^ ((dv >> 4) & 1)) << 3); }
DI void phase_attn(PH_ARGS) {
    unsigned char* ws = A.ws;
    const bf16* QK = (const bf16*)(ws + WS_BIG); const bf16* VTg = (const bf16*)(ws + WS_BIG + 132 * MiB); bf16* ATT = (bf16*)(ws + WS_H);
    const int r32 = lane & 31, hi = lane >> 5; const int isub = wave >> 2, rg = wave & 3;
    float lam;
    { const float s1 = wave_sum(A.in[23][lane] * A.in[24][lane]), s2 = wave_sum(A.in[25][lane] * A.in[26][lane]); lam = __expf(s1) - __expf(s2) + LAM_INIT; }
    const int vcu = (G % 8 == 0) ? (bx % 8) * (G / 8) + bx / 8 : bx;
    for (int u = vcu; u < 2048; u += G) {
        const int bh = u >> 6, b = bh >> 3, h = bh & 7, q0 = (u & 63) * 128;
        const int qrow = b * SEQL + q0 + 32 * rg + r32;
        bf16x8 qf[4];
#pragma unroll
        for (int kk = 0; kk < 4; ++kk) qf[kk] = *(const bf16x8*)(QK + (size_t)qrow * 2048 + h * 128 + isub * 64 + 16 * kk + 8 * hi);
        const int kkey0 = tid >> 4, kcc = tid & 15; const int vdv0 = tid >> 3, vc8 = tid & 7;
        const bf16* kg = QK + 1024 + h * 128 + kcc * 8; const bf16* vg = VTg + (size_t)(h * 128 + vdv0) * RT + vc8 * 8;
        const int kl0 = (kcc >> 3) * 8192 + sw64(kkey0, kcc & 7), kl1 = (kcc >> 3) * 8192 + sw64(kkey0 + 32, kcc & 7);
        const int vl0 = 16384 + sw64(vdv0, vc8), vl1 = 16384 + sw64(vdv0 + 64, vc8);
        const bool vswap0 = (vdv0 >> 4) & 1, vswap1 = ((vdv0 + 64) >> 4) & 1;
        u32x4 kr0, kr1, vr0, vr1;
#define ATT_LOAD(j) do { const int keyrow = ((j) < 4) ? (RL + b * CTXL + (j) * 64) : (b * SEQL + ((j) - 4) * 64); \
            kr0 = *(const u32x4*)(kg + (size_t)(keyrow + kkey0) * 2048); kr1 = *(const u32x4*)(kg + (size_t)(keyrow + kkey0 + 32) * 2048); \
            vr0 = *(const u32x4*)(vg + keyrow); vr1 = *(const u32x4*)(vg + (size_t)64 * RT + keyrow); } while (0)
#define ATT_STORE(buf) do { LAS unsigned char* bp = lds + (buf) * 32768; \
            *(LAS u32x4*)(bp + kl0) = kr0; *(LAS u32x4*)(bp + kl1) = kr1; \
            *(LAS u32x4*)(bp + vl0) = vswap0 ? (u32x4){vr0.z, vr0.w, vr0.x, vr0.y} : vr0; *(LAS u32x4*)(bp + vl1) = vswap1 ? (u32x4){vr1.z, vr1.w, vr1.x, vr1.y} : vr1; } while (0)
        float m_run = -1e30f, l_run = 0.f;
        f32x16 OT[4];
#pragma unroll
        for (int d = 0; d < 4; ++d)
#pragma unroll
            for (int r = 0; r < 16; ++r) OT[d][r] = 0.f;
        ATT_LOAD(0); ATT_STORE(0);
        __syncthreads();
        for (int j = 0; j < 132; ++j) {
            if (j + 1 < 132) ATT_LOAD(j + 1);
            const LAS unsigned char* bp = lds + (j & 1) * 32768; const LAS unsigned char* Kb = bp + isub * 8192; const LAS unsigned char* Vb = bp + 16384;
            f32x16 s0, s1;
#pragma unroll
            for (int r = 0; r < 16; ++r) { s0[r] = 0.f; s1[r] = 0.f; }
#pragma unroll
            for (int kk = 0; kk < 4; ++kk) { const bf16x8 a0 = *(const LAS bf16x8*)(Kb + sw64(r32, 2 * kk + hi)), a1 = *(const LAS bf16x8*)(Kb + sw64(32 + r32, 2 * kk + hi));
                s0 = MFMA32(a0, qf[kk], s0); s1 = MFMA32(a1, qf[kk], s1); }
            float mx = fmaxf(s0[0], s1[0]);
#pragma unroll
            for (int r = 1; r < 16; ++r) mx = fmaxf(mx, fmaxf(s0[r], s1[r]));
            mx = fmaxf(mx, __shfl_xor(mx, 32));
            const float mnew = fmaxf(m_run, mx);
            if (__any(mnew > m_run)) { const float al = __builtin_amdgcn_exp2f(m_run - mnew); l_run *= al;
#pragma unroll
                for (int d = 0; d < 4; ++d)
#pragma unroll
                    for (int r = 0; r < 16; ++r) OT[d][r] *= al;
                m_run = mnew; }
            float ls = 0.f;
#pragma unroll
            for (int r = 0; r < 16; ++r) { s0[r] = __builtin_amdgcn_exp2f(s0[r] - m_run); s1[r] = __builtin_amdgcn_exp2f(s1[r] - m_run); ls += s0[r] + s1[r]; }
            l_run += ls;
            bf16x8 Pb[4]; Pb[0] = pack8<0>(s0); Pb[1] = pack8<1>(s0); Pb[2] = pack8<0>(s1); Pb[3] = pack8<1>(s1);
#pragma unroll
            for (int dvb = 0; dvb < 4; ++dvb) { const int dv = 32 * dvb + r32;
#pragma unroll
                for (int js = 0; js < 4; ++js) { const u32x2 lo = *(const LAS u32x2*)(Vb + swv(dv, 2 * js, hi)), hh = *(const LAS u32x2*)(Vb + swv(dv, 2 * js + 1, hi));
                    const u32x4 av = {lo.x, lo.y, hh.x, hh.y};
                    OT[dvb] = MFMA32(__builtin_bit_cast(bf16x8, av), Pb[js], OT[dvb]); } }
            if (j + 1 < 132) ATT_STORE((j + 1) & 1);
            __syncthreads();
        }
        { const float lt = l_run + __shfl_xor(l_run, 32); const float il = 1.0f / lt;
#pragma unroll
            for (int d = 0; d < 4; ++d)
#pragma unroll
                for (int r = 0; r < 16; ++r) OT[d][r] *= il; }
        LAS float* ex = (LAS float*)lds;
        if (isub == 1) {
#pragma unroll
            for (int d = 0; d < 4; ++d)
#pragma unroll
                for (int r = 0; r < 16; ++r) ex[((rg * 4 + d) * 16 + r) * 64 + lane] = OT[d][r]; }
        __syncthreads();
        if (isub == 0) {
            float ss = 0.f;
#pragma unroll
            for (int d = 0; d < 4; ++d)
#pragma unroll
                for (int r = 0; r < 16; ++r) { const float o = OT[d][r] - lam * ex[((rg * 4 + d) * 16 + r) * 64 + lane]; OT[d][r] = o; ss += o * o; }
            ss += __shfl_xor(ss, 32);
            const float rn = (1.0f - LAM_INIT) / sqrtf(ss * (1.0f / 128.0f) + EPSN);
            bf16* orow = ATT + (size_t)qrow * DM + h * 128;
#pragma unroll
            for (int d = 0; d < 4; ++d)
#pragma unroll
                for (int g4 = 0; g4 < 4; ++g4) { const int dv = 32 * d + 8 * g4 + 4 * hi; const f32x4 w = *(const f32x4*)(A.in[27] + dv);
                    u32x2 o; o.x = pk2(OT[d][4 * g4] * rn * w[0], OT[d][4 * g4 + 1] * rn * w[1]); o.y = pk2(OT[d][4 * g4 + 2] * rn * w[2], OT[d][4 * g4 + 3] * rn * w[3]);
                    *(u32x2*)(orow + dv) = o; }
        }
        __syncthreads();
#undef ATT_LOAD
#undef ATT_STORE
    }
}

constexpr int NPHASE = 20;
__global__ void __launch_bounds__(NTHR, 2) mega_fwd(Args A) {
    extern __shared__ __attribute__((aligned(16))) unsigned char lds_raw[];
    LAS unsigned char* lds = (LAS unsigned char*)lds_raw;
    const int tid = threadIdx.x, lane = tid & 63, wave = __builtin_amdgcn_readfirstlane(tid >> 6);
    const int G = gridDim.x, bx = blockIdx.x;
    unsigned char* ws = A.ws;
    if (tid < 64) ((LAS unsigned*)(lds + LDSX))[tid] = 0u;
    __syncthreads();
    XcdBarrier bar; bar.bar = (unsigned*)(ws + WS_CTL) + CW_BAR; bar.x = 0; bar.st = nullptr;
    if (!MK_SPLIT) bar = xcd_barrier_post((unsigned*)(ws + WS_CTL) + CW_BAR, (volatile LAS unsigned*)(lds + LDSX));
    const int lo = A.ph_lo, hi_ = A.ph_hi;
#ifdef ONLY_PHASE
#define IN(k) ((k) == ONLY_PHASE && lo <= (k) && (k) < hi_)
#else
#define IN(k) (lo <= (k) && (k) < hi_)
#endif
#define SEAM(k) do { if (IN(k) && IN((k) + 1)) xcd_barrier(bar); } while (0)
    if (IN(0)) { phase0(A, lds, tid, lane, wave, G, bx); } SEAM(0);
    if (IN(1)) { phase_modulate<0, 0>(A, lds, tid, lane, wave, G, bx); } SEAM(1);
    if (IN(2)) {
        pg8::Gemm g{(const pg8::bf16_t*)(ws + WS_H), (const pg8::bf16_t*)(ws + WS_WIN), RT, NPROJ, DM}; pg8::StaticOrder S; S.init(RT, NPROJ, G, bx);
        pg8::EpiBf16<0> E{(pg8::bf16_t*)(ws + WS_BIG), NPROJ, nullptr, 0, 0, 1.f};
        pg8::gemm_phase<pg8::EpiBf16<0>, pg8::StaticOrder, true, true>(lds, g, S, E);
    } SEAM(2);
    if (IN(3)) { phase_gdn_prep(A, lds, tid, lane, wave, G, bx); } SEAM(3);
    if (IN(4)) { phase_gdn_scan(A, lds, tid, lane, wave, G, bx); } SEAM(4);
    if (IN(5)) { phase_ycat(A, lds, tid, lane, wave, G, bx); } SEAM(5);
    if (IN(6)) {
        pg8::Gemm g{(const pg8::bf16_t*)(ws + WS_H), (const pg8::bf16_t*)(ws + WS_WOUT), RT, DM, DM}; pg8::StaticOrder S; S.init(RT, DM, G, bx);
        pg8::EpiResidual E{A.in[0], A.in[2], A.out, (float*)(ws + WS_XC), (const float*)(ws + WS_MODV) + 2 * 1024, RL};
        pg8::gemm_phase<pg8::EpiResidual, pg8::StaticOrder, true, true>(lds, g, S, E);
    } SEAM(6);
    if (IN(7)) { phase_modulate<1, 0>(A, lds, tid, lane, wave, G, bx); } SEAM(7);
    if (IN(8)) { phase_topk<0>(A, lds, tid, lane, wave, G, bx); } SEAM(8);
    if (IN(9)) {
        pg8::Gemm g{(const pg8::bf16_t*)(ws + WS_G), (const pg8::bf16_t*)(ws + WS_E0), M1_0, 4096, DM}; pg8::MoeOrder S{17 * 16 * 16, G, bx, 17, 16};
        pg8::EpiMoe1 E{(pg8::bf16_t*)(ws + WS_BIG)};
        pg8::gemm_phase<pg8::EpiMoe1, pg8::MoeOrder, true, true>(lds, g, S, E);
    } SEAM(9);
    if (IN(10)) {
        pg8::Gemm g{(const pg8::bf16_t*)(ws + WS_BIG), (const pg8::bf16_t*)(ws + WS_E0 + 128 * MiB), M1_0, DM, FFN}; pg8::MoeOrder S{17 * 16 * 4, G, bx, 17, 4};
        pg8::EpiMoe2 E{(pg8::bf16_t*)(ws + WS_G + 192 * MiB), (const float*)(ws + WS_GATEV)};
        pg8::gemm_phase<pg8::EpiMoe2, pg8::MoeOrder, true, true>(lds, g, S, E);
    } SEAM(10);
    if (IN(11)) { phase_combine<0>(A, lds, tid, lane, wave, G, bx); } SEAM(11);
    if (IN(12)) {
        { pg8::Gemm g{(const pg8::bf16_t*)(ws + WS_H), (const pg8::bf16_t*)(ws + WS_WQK), RT, 2048, DM}; pg8::StaticOrder S; S.init(RT, 2048, G, bx);
          pg8::EpiQK E{(pg8::bf16_t*)(ws + WS_BIG), (const float*)(ws + WS_ROPE), 0.125f * 1.4426950408889634f, RL};
          pg8::gemm_phase<pg8::EpiQK, pg8::StaticOrder, true, true>(lds, g, S, E); }
        { pg8::Gemm g{(const pg8::bf16_t*)(ws + WS_WV), (const pg8::bf16_t*)(ws + WS_H), DM, RT, DM}; pg8::StaticOrder S; S.init(DM, RT, G, bx);
          pg8::EpiBf16<0> E{(pg8::bf16_t*)(ws + WS_BIG + 132 * MiB), RT, nullptr, 0, 0, 1.f};
          pg8::gemm_phase<pg8::EpiBf16<0>, pg8::StaticOrder, true, true>(lds, g, S, E); }
    } SEAM(12);
    if (IN(13)) { phase_attn(A, lds, tid, lane, wave, G, bx); } SEAM(13);
    if (IN(14)) {
        pg8::Gemm g{(const pg8::bf16_t*)(ws + WS_H), (const pg8::bf16_t*)(ws + WS_WO), RL, DM, DM}; pg8::StaticOrder S; S.init(RL, DM, G, bx);
        pg8::EpiResidual E{A.out, A.out, A.out, A.out, (const float*)(ws + WS_MODV) + 5 * 6144 + 2 * 1024, RL};
        pg8::gemm_phase<pg8::EpiResidual, pg8::StaticOrder, true, true>(lds, g, S, E);
    } SEAM(14);
    if (IN(15)) { phase_modulate<1, 1>(A, lds, tid, lane, wave, G, bx); } SEAM(15);
    if (IN(16)) { phase_topk<1>(A, lds, tid, lane, wave, G, bx); } SEAM(16);
    if (IN(17)) {
        pg8::Gemm g{(const pg8::bf16_t*)(ws + WS_G + 192 * MiB), (const pg8::bf16_t*)(ws + WS_G), M1_1, 4096, DM}; pg8::MoeOrder S{16 * 16 * 16, G, bx, 16, 16};
        pg8::EpiMoe1 E{(pg8::bf16_t*)(ws + WS_BIG)};
        pg8::gemm_phase<pg8::EpiMoe1, pg8::MoeOrder, true, true>(lds, g, S, E);
    } SEAM(17);
    if (IN(18)) {
        pg8::Gemm g{(const pg8::bf16_t*)(ws + WS_BIG), (const pg8::bf16_t*)(ws + WS_G + 128 * MiB), M1_1, DM, FFN}; pg8::MoeOrder S{16 * 16 * 4, G, bx, 16, 4};
        pg8::EpiMoe2 E{(pg8::bf16_t*)(ws + WS_E0), (const float*)(ws + WS_GATEV)};
        pg8::gemm_phase<pg8::EpiMoe2, pg8::MoeOrder, true, true>(lds, g, S, E);
    } SEAM(18);
    if (IN(19)) { phase_combine<1>(A, lds, tid, lane, wave, G, bx); }
#undef IN
#undef SEAM
}

extern "C" void kernel_launch(void* const* d_in, const int* in_sizes, int n_in, void* d_out, int out_size, void* d_ws, size_t ws_size, hipStream_t stream) {
    static int grid = 0;
    if (grid == 0) {
        if (n_in != 35 || out_size != RL * DM || ws_size < WS_END) { fprintf(stderr, "kernel_launch: unexpected problem (n_in %d, out %d, ws %zu < %zu)\n", n_in, out_size, ws_size, (size_t)WS_END); grid = -1; return; }
        int dev = 0, cus = 0, per_cu = 0;
        if (hipGetDevice(&dev) != hipSuccess || hipDeviceGetAttribute(&cus, hipDeviceAttributeMultiprocessorCount, dev) != hipSuccess) { grid = -1; return; }
        if (hipFuncSetAttribute((const void*)mega_fwd, hipFuncAttributeMaxDynamicSharedMemorySize, LDS_BYTES) != hipSuccess) { fprintf(stderr, "kernel_launch: hipFuncSetAttribute failed\n"); grid = -1; return; }
        if (hipOccupancyMaxActiveBlocksPerMultiprocessor(&per_cu, (const void*)mega_fwd, NTHR, LDS_BYTES) != hipSuccess || per_cu < 1) { fprintf(stderr, "kernel_launch: occupancy query reports %d\n", per_cu); }
        (void)hipGetLastError();
        grid = cus;
    }
    if (grid < 0) return;
    if (hipMemsetAsync((char*)d_ws + WS_CTL, 0, CTL_ZERO_BYTES, stream) != hipSuccess) return;
    Args a{};
    for (int i = 0; i < 35; ++i) a.in[i] = (const float*)d_in[i];
    a.out = (float*)d_out; a.ws = (unsigned char*)d_ws;
#if MK_SPLIT
    for (int p = 0; p < NPHASE; ++p) { a.ph_lo = p; a.ph_hi = p + 1; hipLaunchKernelGGL(mega_fwd, dim3(grid), dim3(NTHR), LDS_BYTES, stream, a); }
#else
    a.ph_lo = 0; a.ph_hi = NPHASE;
    hipLaunchKernelGGL(mega_fwd, dim3(grid), dim3(NTHR), LDS_BYTES, stream, a);
#endif
}
```

```cpp
#include <hip/hip_runtime.h>
#include <cstdio>
#include <cstdint>
#ifndef MK_SPLIT
#define MK_SPLIT 0
#endif

namespace pg8 {
#define PG8_LAS __attribute__((address_space(3)))
typedef unsigned short bf16_t;
typedef short bf16x8 __attribute__((ext_vector_type(8)));
typedef float f32x4 __attribute__((ext_vector_type(4)));
typedef unsigned u32x4 __attribute__((ext_vector_type(4)));
constexpr int BM = 256, BK = 64, HALF = 128, HTB = HALF * BK * 2  , STAGE_BYTES = 8 * HTB, NXCD = 8, WGM = 8;

__host__ __device__ __forceinline__ int lds_byte(int r, int c) { const int st = (r >> 4) * 2 + (c >> 5), rr = r & 15, cc = c & 31, ob = rr * 64 + cc * 2; return st * 1024 + (ob ^ (((ob >> 9) & 1) << 5)); }
__host__ __device__ __forceinline__ void stage_rc(int b, int& R, int& C) { const int st = b / 1024, sb = b % 1024, swz = sb ^ (((sb >> 9) & 1) << 5); R = (st >> 1) * 16 + swz / 64; C = (st & 1) * 32 + (swz % 64) / 2; }
__host__ __device__ __forceinline__ int perm32(int rho) { const int n = rho >> 4, i = rho & 15; return 8 * (i >> 2) + 4 * n + (i & 3); }

struct Unit { int pm, pn; };
struct Gemm { const bf16_t* A; const bf16_t* Bt; int M, N, K; };

struct StaticOrder {
    int nM, nN, nwg, G, c;
    __host__ __device__ void init(int M, int N, int G_, int c_) { nM = M / BM; nN = N / BM; nwg = nM * nN; G = G_; c = c_; }
    __host__ __device__ bool next(int i, Unit& u) const {
        const long L = (long)i * G + c; if (L >= nwg) return false;
        int wgid = (int)L; { const int q = nwg / NXCD, r = nwg % NXCD, xcd = wgid % NXCD, off = wgid / NXCD; wgid = (xcd < r ? xcd * (q + 1) : r * (q + 1) + (xcd - r) * q) + off; }
        const int nig = WGM * nN, gid = wgid / nig, fm = gid * WGM, gsz = (nM - fm) < WGM ? (nM - fm) : WGM;
        u.pm = fm + ((wgid % nig) % gsz); u.pn = (wgid % nig) / gsz; return true;
    }
    __device__ __forceinline__ void a_ready(const Unit&) const {}
    __device__ __forceinline__ void done(const Unit&) const {}
};

__device__ __forceinline__ unsigned cvt_pk_bf16(float lo, float hi) { unsigned r; asm volatile("v_cvt_pk_bf16_f32 %0, %1, %2" : "=v"(r) : "v"(lo), "v"(hi)); return r; }
typedef float f32x2 __attribute__((ext_vector_type(2)));
__device__ __forceinline__ f32x2 gelu_pk(f32x2 v) {
    const f32x2 av = __builtin_elementwise_abs(v), d = av * 0.2316418882f + 1.0f;
    f32x2 t; t.x = __builtin_amdgcn_rcpf(d.x); t.y = __builtin_amdgcn_rcpf(d.y);
    f32x2 q = t * 0.5307027145f + (-0.7265760135f); q = q * t + 0.7107068705f; q = q * t + (-0.142248368f); q = q * t + 0.127414796f; q = q * t;
    const f32x2 s = (v * v) * (-0.72134752044f);
    f32x2 e; e.x = __builtin_amdgcn_exp2f(s.x); e.y = __builtin_amdgcn_exp2f(s.y);
    const f32x2 m = v * (q * e), r = v - m;
    f32x2 o; o.x = v.x < 0.f ? m.x : r.x; o.y = v.y < 0.f ? m.y : r.y; return o;
}

template <int ACT  > struct EpiBf16 {
    static constexpr bool PERM = true, AFTER_DRAIN = false; static_assert(ACT == 0 || ACT == 1, "EpiBf16: ACT is 0 (none) or 1 (gelu_pk)");
    bf16_t* O; int ldc; const float* bias; int split_cols; size_t split_stride; float scale0;
    __device__ __forceinline__ void operator()(const f32x4 (&acc)[2][2][4][2], const Unit& u, int wr, int wc, int fr, int fq) const {
        const int row0 = u.pm * BM + wr * 64 + fr; int colt = u.pn * BM; bf16_t* base = O;
        float sc = 1.f; if (split_cols) { const int t = colt / split_cols; base += (size_t)t * split_stride; colt -= t * split_cols; if (t == 0) sc = scale0; }
        const int col0 = colt + wc * 32 + 8 * fq, bcol0 = u.pn * BM + wc * 32 + 8 * fq;
        f32x4 bv[2][2];
#pragma unroll
        for (int bj = 0; bj < 2; ++bj)
#pragma unroll
            for (int n = 0; n < 2; ++n) bv[bj][n] = bias ? *(const f32x4*)(bias + bcol0 + bj * HALF + 4 * n) : (f32x4){0.f, 0.f, 0.f, 0.f};
#pragma unroll
        for (int ai = 0; ai < 2; ++ai)
#pragma unroll
            for (int m = 0; m < 4; ++m) { bf16_t* rowp = base + (size_t)(row0 + ai * HALF + m * 16) * ldc + col0;
#pragma unroll
                for (int bj = 0; bj < 2; ++bj) { f32x4 v0 = acc[ai][bj][m][0] + bv[bj][0], v1 = acc[ai][bj][m][1] + bv[bj][1];
                    if (ACT == 1) { f32x2 a = gelu_pk((f32x2){v0[0], v0[1]}), b = gelu_pk((f32x2){v0[2], v0[3]}), c = gelu_pk((f32x2){v1[0], v1[1]}), d = gelu_pk((f32x2){v1[2], v1[3]});
                        v0 = (f32x4){a.x, a.y, b.x, b.y}; v1 = (f32x4){c.x, c.y, d.x, d.y}; }
                    v0 = v0 * sc; v1 = v1 * sc; u32x4 w; w.x = cvt_pk_bf16(v0[0], v0[1]); w.y = cvt_pk_bf16(v0[2], v0[3]); w.z = cvt_pk_bf16(v1[0], v1[1]); w.w = cvt_pk_bf16(v1[2], v1[3]);
                    *(u32x4*)(rowp + bj * HALF) = w; } }
    }
};

__device__ __forceinline__ float silu_fast(float x) { return x * __builtin_amdgcn_rcpf(1.0f + __builtin_amdgcn_exp2f(-1.4426950408889634f * x)); }
struct EpiResidual {
    static constexpr bool PERM = false, AFTER_DRAIN = false;
    const float* base_lat; const float* base_ctx; float* out_lat; float* out_ctx; const float* gate; int RL;
    __device__ __forceinline__ void operator()(const f32x4 (&acc)[2][2][4][2], const Unit& u, int wr, int wc, int fr, int fq) const {
        const int col0 = u.pn * BM + wc * 32 + 4 * fq;
#pragma unroll
        for (int ai = 0; ai < 2; ++ai)
#pragma unroll
            for (int m = 0; m < 4; ++m) {
                const int row = u.pm * BM + ai * HALF + wr * 64 + m * 16 + fr;
                const bool lat = row < RL; const int rr = lat ? row : row - RL; const int bb = lat ? (row >> 13) : 4;
                const float* bp = (lat ? base_lat : base_ctx) + (size_t)rr * 1024 + col0; float* op = (lat ? out_lat : out_ctx) + (size_t)rr * 1024 + col0;
                const float* gp = gate + bb * 6144 + col0;
#pragma unroll
                for (int bj = 0; bj < 2; ++bj)
#pragma unroll
                    for (int n = 0; n < 2; ++n) { const int c = bj * HALF + n * 16; const f32x4 g = *(const f32x4*)(gp + c), b = *(const f32x4*)(bp + c); *(f32x4*)(op + c) = b + g * acc[ai][bj][m][n]; }
            }
    }
};
struct EpiMoe1 {
    static constexpr bool PERM = true, AFTER_DRAIN = false;
    bf16_t* O;
    __device__ __forceinline__ void operator()(const f32x4 (&acc)[2][2][4][2], const Unit& u, int wr, int wc, int fr, int fq) const {
        const int row0 = u.pm * BM + wr * 64 + fr; const int hcol0 = (u.pn & 15) * 128 + wc * 32 + 8 * fq;
#pragma unroll
        for (int ai = 0; ai < 2; ++ai)
#pragma unroll
            for (int m = 0; m < 4; ++m) { bf16_t* rowp = O + (size_t)(row0 + ai * HALF + m * 16) * 2048 + hcol0;
                const f32x4 g0 = acc[ai][0][m][0], g1 = acc[ai][0][m][1], u0 = acc[ai][1][m][0], u1 = acc[ai][1][m][1];
                u32x4 w; w.x = cvt_pk_bf16(silu_fast(g0[0]) * u0[0], silu_fast(g0[1]) * u0[1]); w.y = cvt_pk_bf16(silu_fast(g0[2]) * u0[2], silu_fast(g0[3]) * u0[3]);
                w.z = cvt_pk_bf16(silu_fast(g1[0]) * u1[0], silu_fast(g1[1]) * u1[1]); w.w = cvt_pk_bf16(silu_fast(g1[2]) * u1[2], silu_fast(g1[3]) * u1[3]);
                *(u32x4*)rowp = w; }
    }
};
struct EpiMoe2 {
    static constexpr bool PERM = true, AFTER_DRAIN = false;
    bf16_t* O; const float* gatev;
    __device__ __forceinline__ void operator()(const f32x4 (&acc)[2][2][4][2], const Unit& u, int wr, int wc, int fr, int fq) const {
        const int row0 = u.pm * BM + wr * 64 + fr; const int col0 = (u.pn & 3) * BM + wc * 32 + 8 * fq;
#pragma unroll
        for (int ai = 0; ai < 2; ++ai)
#pragma unroll
            for (int m = 0; m < 4; ++m) { const int row = row0 + ai * HALF + m * 16; const float gv = gatev[row]; bf16_t* rowp = O + (size_t)row * 1024 + col0;
#pragma unroll
                for (int bj = 0; bj < 2; ++bj) { const f32x4 v0 = acc[ai][bj][m][0] * gv, v1 = acc[ai][bj][m][1] * gv;
                    u32x4 w; w.x = cvt_pk_bf16(v0[0], v0[1]); w.y = cvt_pk_bf16(v0[2], v0[3]); w.z = cvt_pk_bf16(v1[0], v1[1]); w.w = cvt_pk_bf16(v1[2], v1[3]);
                    *(u32x4*)(rowp + bj * HALF) = w; } }
    }
};
struct EpiQK {
    static constexpr bool PERM = true, AFTER_DRAIN = false;
    bf16_t* O; const float* rope; float qscale; int RL;
    __device__ __forceinline__ void operator()(const f32x4 (&acc)[2][2][4][2], const Unit& u, int wr, int wc, int fr, int fq) const {
        const int row0 = u.pm * BM + wr * 64 + fr; const int colb = u.pn * BM + wc * 32 + 8 * fq;
#pragma unroll
        for (int ai = 0; ai < 2; ++ai)
#pragma unroll
            for (int m = 0; m < 4; ++m) { const int row = row0 + ai * HALF + m * 16; const bool lat = row < RL; const int t = row & 8191; const int pr = t >> 6, pc = t & 63;
#pragma unroll
                for (int bj = 0; bj < 2; ++bj) { const int col = colb + bj * HALF; f32x4 v0 = acc[ai][bj][m][0], v1 = acc[ai][bj][m][1];
                    if (lat) { const int half = (col >> 5) & 1, j0 = (col & 31) >> 1;
                        const float* cp = rope + (half ? 4096 + pc * 16 : pr * 16) + j0; const float* sp = cp + (half ? 1024 : 2048);
                        const f32x4 c = *(const f32x4*)cp, s = *(const f32x4*)sp;
                        f32x4 a, b;
                        a[0] = v0[0] * c[0] - v0[1] * s[0]; a[1] = v0[1] * c[0] + v0[0] * s[0]; a[2] = v0[2] * c[1] - v0[3] * s[1]; a[3] = v0[3] * c[1] + v0[2] * s[1];
                        b[0] = v1[0] * c[2] - v1[1] * s[2]; b[1] = v1[1] * c[2] + v1[0] * s[2]; b[2] = v1[2] * c[3] - v1[3] * s[3]; b[3] = v1[3] * c[3] + v1[2] * s[3];
                        v0 = a; v1 = b; }
                    const float sc = (col < 1024) ? qscale : 1.0f; v0 = v0 * sc; v1 = v1 * sc;
                    u32x4 w; w.x = cvt_pk_bf16(v0[0], v0[1]); w.y = cvt_pk_bf16(v0[2], v0[3]); w.z = cvt_pk_bf16(v1[0], v1[1]); w.w = cvt_pk_bf16(v1[2], v1[3]);
                    *(u32x4*)(O + (size_t)row * 2048 + col) = w; } }
    }
};
struct MoeOrder {
    int total, G, c, tiles_pe, ncol;
    __device__ __forceinline__ bool next(int i, Unit& u) const {
        const long L = (long)i * G + c; if (L >= total) return false;
        const int per = tiles_pe * ncol; const int e = (int)L / per, rem = (int)L % per; const int pml = rem % tiles_pe, pnl = rem / tiles_pe;
        u.pm = e * tiles_pe + pml; u.pn = e * ncol + pnl; return true; }
    __device__ __forceinline__ void a_ready(const Unit&) const {}
    __device__ __forceinline__ void done(const Unit&) const {}
};
template <class Epi, class Sched, bool ALIGN_EPI = false, bool SP2 = false>
__device__ __forceinline__ void gemm_phase(PG8_LAS unsigned char* lds, const Gemm g, const Sched& S, const Epi& E) {
    const int tid = threadIdx.x, wid = __builtin_amdgcn_readfirstlane(tid >> 6), lane = tid & 63, wr = wid >> 2, wc = wid & 3, fr = lane & 15, fq = lane >> 4;
    const int K = g.K, nt = K / BK;
    unsigned voffA[2], voffB[2];
#pragma unroll
    for (int i = 0; i < 2; ++i) { int R, C; stage_rc(tid * 16 + i * 8192, R, C); const int Rb = Epi::PERM ? ((R & ~31) + perm32(R & 31)) : R;
        voffA[i] = (unsigned)(R * K + C) * 2u; voffB[i] = (unsigned)(Rb * K + C) * 2u; }
    const size_t kstep = (size_t)(BK * 2);
    const size_t hstep = (size_t)HALF * K * 2;
    const size_t tstep = 2 * hstep;
    const unsigned ldsw = (unsigned)wid * 1024u;
    const int aoff = lds_byte(wr * 64 + fr, fq * 8), boff = lds_byte(wc * 32 + fr, fq * 8);
#define PG8_SA(b, h) (((b) * 2 + (h)) * HTB)
#define PG8_SB(b, h) ((4 + (b) * 2 + (h)) * HTB)
#define PG8_STAGE(bufoff, gbase, voff) do { _Pragma("unroll") for (int _i = 0; _i < 2; ++_i) \
        __builtin_amdgcn_global_load_lds((const unsigned*)((const char*)(gbase) + (voff)[_i]), (PG8_LAS unsigned*)(lds + (bufoff) + ldsw + _i * 8192), 16, 0, 0); } while (0)
#define PG8_LDA(dst, b, h) do { _Pragma("unroll") for (int m = 0; m < 4; ++m) _Pragma("unroll") for (int k = 0; k < 2; ++k) dst[m][k] = *(const PG8_LAS bf16x8*)(lds + PG8_SA(b, h) + aoff + m * 2048 + k * 1024); } while (0)
#define PG8_LDB(dst, b, h) do { _Pragma("unroll") for (int n = 0; n < 2; ++n) _Pragma("unroll") for (int k = 0; k < 2; ++k) dst[n][k] = *(const PG8_LAS bf16x8*)(lds + PG8_SB(b, h) + boff + n * 2048 + k * 1024); } while (0)
#define PG8_MMA(ai, bj, At, Bt) do { __builtin_amdgcn_s_setprio(1); _Pragma("unroll") for (int m = 0; m < 4; ++m) _Pragma("unroll") for (int n = 0; n < 2; ++n) _Pragma("unroll") for (int k = 0; k < 2; ++k) \
        acc[ai][bj][m][n] = __builtin_amdgcn_mfma_f32_16x16x32_bf16(Bt[n][k], At[m][k], acc[ai][bj][m][n], 0, 0, 0); __builtin_amdgcn_s_setprio(0); } while (0)
#define PG8_WAIT_V(n) asm volatile("s_waitcnt vmcnt(" #n ")" ::: "memory")
#define PG8_WAIT_L(n) asm volatile("s_waitcnt lgkmcnt(" #n ")" ::: "memory")
#define PG8_BAR __builtin_amdgcn_s_barrier()
#define PG8_SCHED __builtin_amdgcn_sched_barrier(0)
    Unit cur, nxt; int ui = 0;
    if (!S.next(0, cur)) return;
    f32x4 acc[2][2][4][2];
#pragma unroll
    for (int a = 0; a < 2; ++a)
#pragma unroll
        for (int b = 0; b < 2; ++b)
#pragma unroll
            for (int m = 0; m < 4; ++m)
#pragma unroll
                for (int n = 0; n < 2; ++n) acc[a][b][m][n] = (f32x4){0.f, 0.f, 0.f, 0.f};
    bf16x8 At[4][2], B0[2][2], B1[2][2];
    const char* cA = (const char*)g.A + (size_t)cur.pm * tstep; const char* cB = (const char*)g.Bt + (size_t)cur.pn * tstep;
    S.a_ready(cur);
    if constexpr (SP2) {
        PG8_STAGE(PG8_SB(0, 0), cB, voffB); PG8_STAGE(PG8_SB(0, 1), cB + hstep, voffB); PG8_STAGE(PG8_SA(0, 0), cA, voffA); PG8_STAGE(PG8_SA(0, 1), cA + hstep, voffA);
        if (wr == 1) PG8_BAR;
        PG8_WAIT_V(2); PG8_BAR;
        PG8_STAGE(PG8_SB(1, 0), cB + kstep, voffB); PG8_STAGE(PG8_SA(1, 0), cA + kstep, voffA); PG8_STAGE(PG8_SB(1, 1), cB + hstep + kstep, voffB);
        PG8_WAIT_V(6); PG8_BAR;
    } else {
        PG8_STAGE(PG8_SB(0, 0), cB, voffB); PG8_STAGE(PG8_SA(0, 0), cA, voffA); PG8_STAGE(PG8_SB(0, 1), cB + hstep, voffB); PG8_STAGE(PG8_SA(0, 1), cA + hstep, voffA);
        if (wr == 1) PG8_BAR;
        PG8_WAIT_V(4); PG8_BAR;
        PG8_STAGE(PG8_SB(1, 0), cB + kstep, voffB); PG8_STAGE(PG8_SA(1, 0), cA + kstep, voffA); PG8_STAGE(PG8_SB(1, 1), cB + hstep + kstep, voffB);
        PG8_WAIT_V(6); PG8_BAR;
    }
    for (;;) {
        const bool has_next = S.next(ui + 1, nxt);
        const char* nA = has_next ? (const char*)g.A + (size_t)nxt.pm * tstep : cA; const char* nB = has_next ? (const char*)g.Bt + (size_t)nxt.pn * tstep : cB;
        for (int t = 0; t < nt; t += 2) {
            const bool last = (t == nt - 2);
            const char* a1 = cA + (size_t)(t + 1) * kstep;
            const char* a2 = last ? nA : cA + (size_t)(t + 2) * kstep; const char* b2 = last ? nB : cB + (size_t)(t + 2) * kstep;
            const char* a3 = a2 + kstep; const char* b3 = b2 + kstep;
            if (last && has_next) S.a_ready(nxt);
            if constexpr (SP2) {
            PG8_LDB(B0, 0, 0); PG8_LDB(B1, 0, 1); PG8_SCHED; PG8_LDA(At, 0, 0); PG8_STAGE(PG8_SA(1, 1), a1 + hstep, voffA);
            PG8_WAIT_V(8); PG8_WAIT_L(0); PG8_BAR; PG8_MMA(0, 0, At, B0); PG8_MMA(0, 1, At, B1); PG8_BAR; PG8_SCHED;
            PG8_LDA(At, 0, 1); PG8_STAGE(PG8_SB(0, 0), b2, voffB); PG8_STAGE(PG8_SB(0, 1), b2 + hstep, voffB); PG8_STAGE(PG8_SA(0, 0), a2, voffA);
            PG8_WAIT_V(8); PG8_WAIT_L(0); PG8_BAR; PG8_MMA(1, 0, At, B0); PG8_MMA(1, 1, At, B1); PG8_BAR; PG8_SCHED;
            PG8_LDB(B0, 1, 0); PG8_LDB(B1, 1, 1); PG8_SCHED; PG8_LDA(At, 1, 0); PG8_STAGE(PG8_SA(0, 1), a2 + hstep, voffA);
            PG8_WAIT_V(8); PG8_WAIT_L(0); PG8_BAR; PG8_MMA(0, 0, At, B0); PG8_MMA(0, 1, At, B1); PG8_BAR; PG8_SCHED;
            PG8_LDA(At, 1, 1); PG8_STAGE(PG8_SB(1, 0), b3, voffB); PG8_STAGE(PG8_SB(1, 1), b3 + hstep, voffB); PG8_STAGE(PG8_SA(1, 0), a3, voffA);
            PG8_WAIT_V(8); PG8_WAIT_L(0); PG8_BAR; PG8_MMA(1, 0, At, B0); PG8_MMA(1, 1, At, B1); PG8_BAR; PG8_SCHED;
            } else {
            PG8_LDB(B0, 0, 0); PG8_SCHED; PG8_LDA(At, 0, 0); PG8_STAGE(PG8_SA(1, 1), a1 + hstep, voffA);
            PG8_WAIT_L(8); PG8_BAR; PG8_WAIT_L(0); PG8_MMA(0, 0, At, B0); PG8_BAR; PG8_SCHED;
            PG8_LDB(B1, 0, 1); PG8_STAGE(PG8_SB(0, 0), b2, voffB);
            PG8_BAR; PG8_WAIT_L(0); PG8_MMA(0, 1, At, B1); PG8_BAR;
            PG8_LDA(At, 0, 1); PG8_STAGE(PG8_SA(0, 0), a2, voffA);
            PG8_BAR; PG8_WAIT_L(0); PG8_MMA(1, 0, At, B0); PG8_BAR; PG8_SCHED;
            PG8_STAGE(PG8_SB(0, 1), b2 + hstep, voffB);
            PG8_WAIT_V(6); PG8_BAR; PG8_MMA(1, 1, At, B1); PG8_BAR;
            PG8_LDB(B0, 1, 0); PG8_SCHED; PG8_LDA(At, 1, 0); PG8_STAGE(PG8_SA(0, 1), a2 + hstep, voffA);
            PG8_WAIT_L(8); PG8_BAR; PG8_WAIT_L(0); PG8_MMA(0, 0, At, B0); PG8_BAR; PG8_SCHED;
            PG8_LDB(B1, 1, 1); PG8_STAGE(PG8_SB(1, 0), b3, voffB);
            PG8_BAR; PG8_WAIT_L(0); PG8_MMA(0, 1, At, B1); PG8_BAR;
            PG8_LDA(At, 1, 1); PG8_STAGE(PG8_SA(1, 0), a3, voffA);
            PG8_BAR; PG8_WAIT_L(0); PG8_MMA(1, 0, At, B0); PG8_BAR; PG8_SCHED;
            PG8_STAGE(PG8_SB(1, 1), b3 + hstep, voffB);
            PG8_WAIT_V(6); PG8_BAR; PG8_MMA(1, 1, At, B1); PG8_BAR;
            }
        }
        if constexpr (ALIGN_EPI) { if (wr == 0) PG8_BAR; }
        if constexpr (!Epi::AFTER_DRAIN) { E(acc, cur, wr, wc, fr, fq); S.done(cur); }
        if (!has_next) break;
#pragma unroll
        for (int a = 0; a < 2; ++a)
#pragma unroll
            for (int b = 0; b < 2; ++b)
#pragma unroll
                for (int m = 0; m < 4; ++m)
#pragma unroll
                    for (int n = 0; n < 2; ++n) acc[a][b][m][n] = (f32x4){0.f, 0.f, 0.f, 0.f};
        cur = nxt; cA = nA; cB = nB; ++ui;
        if constexpr (ALIGN_EPI) { if (wr == 1) PG8_BAR; }
    }
    PG8_WAIT_V(0);
    if constexpr (!ALIGN_EPI) { if (wr == 0) PG8_BAR; }
    PG8_BAR;
    if constexpr (Epi::AFTER_DRAIN) { E.fused(acc, cur, wr, wc, fr, fq, lds, wid, lane); S.done(cur); }
#undef PG8_SA
#undef PG8_SB
#undef PG8_STAGE
#undef PG8_LDA
#undef PG8_LDB
#undef PG8_MMA
#undef PG8_WAIT_V
#undef PG8_WAIT_L
#undef PG8_BAR
#undef PG8_SCHED
}
}

#define GAS __attribute__((address_space(1)))
#define LAS __attribute__((address_space(3)))
#define DI __device__ __forceinline__
typedef unsigned short bf16;
typedef float f32x4 __attribute__((ext_vector_type(4)));
typedef float f32x2 __attribute__((ext_vector_type(2)));
typedef float f32x16 __attribute__((ext_vector_type(16)));
typedef short bf16x8 __attribute__((ext_vector_type(8)));
typedef unsigned u32x4 __attribute__((ext_vector_type(4)));
typedef unsigned u32x2 __attribute__((ext_vector_type(2)));
typedef __bf16 bf16x2_t __attribute__((ext_vector_type(2)));
#define LDS_WAIT() asm volatile("s_waitcnt lgkmcnt(0)" ::: "memory")
#define MFMA32(a, b, c) __builtin_amdgcn_mfma_f32_32x32x16_bf16((a), (b), (c), 0, 0, 0)
DI unsigned pk2(float lo, float hi) { f32x2 v = {lo, hi}; bf16x2_t b = __builtin_convertvector(v, bf16x2_t); return __builtin_bit_cast(unsigned, b); }
DI float bflo(unsigned w) { return __uint_as_float(w << 16); }
DI float bfhi(unsigned w) { return __uint_as_float(w & 0xffff0000u); }
DI int crow(int r, int hi) { return (r & 3) + 8 * (r >> 2) + 4 * hi; }
DI float wave_sum(float v) {
#pragma unroll
    for (int o = 1; o < 64; o <<= 1) v += __shfl_xor(v, o);
    return v;
}
DI float wave_max(float v) {
#pragma unroll
    for (int o = 1; o < 64; o <<= 1) v = fmaxf(v, __shfl_xor(v, o));
    return v;
}
DI float silu_f(float x) { return x / (1.0f + __expf(-x)); }
template <int S> DI bf16x8 pack8(const f32x16& x) {
    u32x4 p; p.x = pk2(x[8 * S], x[8 * S + 1]); p.y = pk2(x[8 * S + 2], x[8 * S + 3]); p.z = pk2(x[8 * S + 4], x[8 * S + 5]); p.w = pk2(x[8 * S + 6], x[8 * S + 7]);
    return __builtin_bit_cast(bf16x8, p);
}
DI int sw64(int row, int c8) { return row * 128 + ((c8 ^ ((row >> 1) & 7)) << 4); }
DI int sw128(int row, int c16) { return row * 256 + ((c16 ^ (row & 15)) << 4); }

#define XB_TMO      128
#define XB_XCNT(j)  (256  + 64 * (j))
#define XB_XSUB(j)  (1280 + 64 * (j))
#define XB_XGEN(j)  (2304 + 64 * (j))
#define XB_TOP      3328
#define XB_TOPGEN   3392
#define XCD_BAR_WORDS 3456
#define XB_SPIN_CAP (1u << 18)

__device__ __forceinline__ unsigned xb_ld(unsigned* p)              { return __hip_atomic_load(p, __ATOMIC_RELAXED, __HIP_MEMORY_SCOPE_AGENT); }
__device__ __forceinline__ unsigned xb_add(unsigned* p, unsigned v) { return __hip_atomic_fetch_add(p, v, __ATOMIC_RELAXED, __HIP_MEMORY_SCOPE_AGENT); }
__device__ __forceinline__ unsigned xb_xcc_id() { return (unsigned)__builtin_amdgcn_s_getreg((3 << 11) | 20) & 0xFu; }
#define XB_SPIN(cond, bar) do { unsigned _sp = 0; while (cond) { __builtin_amdgcn_s_sleep(1); \
    if ((++_sp & 255u) == 0u) { if (xb_ld(&(bar)[XB_TMO])) break; if (_sp > XB_SPIN_CAP) { atomicAdd(&(bar)[XB_TMO], 1u); break; } } } } while (0)

struct XcdBarrier {
    unsigned* bar; unsigned x;
    volatile LAS unsigned* st;
};

__device__ __forceinline__ XcdBarrier xcd_barrier_post(unsigned* bar, volatile LAS unsigned* st) {
    XcdBarrier b; b.bar = bar; b.x = xb_xcc_id(); b.st = st;
    if (threadIdx.x == 0) (void)xb_add(&bar[XB_XCNT(b.x)], 1u);
    return b;
}
__device__ __forceinline__ void xcd_barrier_complete(unsigned* bar, unsigned x, unsigned& nloc, unsigned& nx) {
    const unsigned G = gridDim.x * gridDim.y * gridDim.z;
    unsigned sum, cnt, mine, sp = 0u;
    for (;;) {
        sum = 0u; cnt = 0u; mine = 0u;
#pragma unroll
        for (unsigned j = 0; j < 16; ++j) { const unsigned c = xb_ld(&bar[XB_XCNT(j)]); sum += c; cnt += (c > 0u) ? 1u : 0u; mine = (j == x) ? c : mine; }
        if (sum == G) break;
        __builtin_amdgcn_s_sleep(1);
        if ((++sp & 255u) == 0u) { if (xb_ld(&bar[XB_TMO])) break; if (sp > XB_SPIN_CAP) { atomicAdd(&bar[XB_TMO], 1u); break; } }
    }
    nloc = mine > 0u ? mine : 1u; nx = cnt > 0u ? cnt : 1u;
}

__device__ __forceinline__ void xcd_barrier(const XcdBarrier& b) {
    asm volatile("s_waitcnt vmcnt(0)" ::: "memory");
    __syncthreads();
    if (threadIdx.x == 0) {
        unsigned* bar = b.bar;
        __builtin_amdgcn_s_waitcnt(0);
        unsigned nloc = b.st[0], nx = b.st[1];
        if (nloc == 0u) { xcd_barrier_complete(bar, b.x, nloc, nx); b.st[0] = nloc; b.st[1] = nx; }
        const unsigned old = xb_add(&bar[XB_XSUB(b.x)], 1u);
        const unsigned gen = old / nloc;
        if (old + 1u == (gen + 1u) * nloc) {
            __builtin_amdgcn_fence(__ATOMIC_RELEASE, "agent");
            asm volatile("s_waitcnt vmcnt(0)" ::: "memory");
            const unsigned og = xb_add(&bar[XB_TOP], 1u);
            const unsigned tg = og / nx;
            if (og + 1u == (tg + 1u) * nx) xb_add(&bar[XB_TOPGEN], 1u);
            else XB_SPIN(xb_ld(&bar[XB_TOPGEN]) == tg, bar);
            __builtin_amdgcn_fence(__ATOMIC_ACQUIRE, "agent");
            xb_add(&bar[XB_XGEN(b.x)], 1u);
            asm volatile("s_waitcnt vmcnt(0)" ::: "memory");
        } else {
            XB_SPIN(xb_ld(&bar[XB_XGEN(b.x)]) == gen, bar);
            __builtin_amdgcn_fence(__ATOMIC_ACQUIRE, "agent");
            asm volatile("s_waitcnt vmcnt(0)" ::: "memory");
        }
    }
    __syncthreads();
}

constexpr int NWAVES = 8, NTHR = 512;
constexpr int DM = 1024, NBATCH = 4, SEQL = 8192, CTXL = 256, RL = NBATCH * SEQL, RC = NBATCH * CTXL, RT = RL + RC;
constexpr int NPROJ = 3584, INCOLS = 3600, NEXP = 16, FFN = 2048;
constexpr int SPE0 = 17 * 256, SPE1 = 16 * 256;
constexpr int M1_0 = NEXP * SPE0, M1_1 = NEXP * SPE1;
constexpr float EPSN = 1e-6f;
constexpr float LAM_INIT = 0.35550907f;
constexpr int NCHUNK = 132;
constexpr int GBLK = 73728;

constexpr size_t MiB = 1u << 20;
constexpr size_t WS_CTL = 0, CTL_ZERO_BYTES = 1 * MiB;
constexpr size_t WS_MODV = 1 * MiB;
constexpr size_t WS_ROPE = 1 * MiB + 256 * 1024;
constexpr size_t WS_ZROW = 1 * MiB + 512 * 1024;
constexpr size_t WS_GATES = 2 * MiB;
constexpr size_t WS_AFFT = 5 * MiB;
constexpr size_t WS_INV = 8 * MiB;
constexpr size_t WS_GATEV = 11 * MiB;
constexpr size_t WS_GLAST = 12 * MiB;
constexpr size_t WS_WIN = 17 * MiB, WS_WOUT = 24 * MiB, WS_WQK = 26 * MiB, WS_WV = 30 * MiB, WS_WO = 32 * MiB;
constexpr size_t WS_E0 = 36 * MiB;
constexpr size_t WS_XC = 228 * MiB;
constexpr size_t WS_H = 232 * MiB;
constexpr size_t WS_BIG = 298 * MiB;
constexpr size_t WS_G = 570 * MiB;
constexpr size_t WS_END = 898 * MiB;
constexpr int CW_BAR = 4096, CW_Q0 = 8192, CW_Q1 = 8256;

constexpr int RING_BYTES = 131072;
constexpr int LDSX = RING_BYTES;
constexpr int LDS_BYTES = 147456;

struct Args { const float* in[35]; float* out; unsigned char* ws; int ph_lo, ph_hi, ph_rep, pad; };

template <class F> DI void tr_item(const float* W, int ldw, bf16* WT, int ldk, int k0, F rowmap, LAS float* scr, int lane) {
#pragma unroll 8
    for (int i = 0; i < 32; ++i) { const int kk = 2 * i + (lane >> 5); scr[kk * 33 + (lane & 31)] = W[(size_t)kk * ldw + (lane & 31)]; }
    LDS_WAIT(); asm volatile("" ::: "memory");
    const int c = lane & 7;
#pragma unroll
    for (int j = 0; j < 4; ++j) { const int n = (lane >> 3) + 8 * j; const LAS float* s = scr + (8 * c) * 33 + n;
        u32x4 o; o.x = pk2(s[0 * 33], s[1 * 33]); o.y = pk2(s[2 * 33], s[3 * 33]); o.z = pk2(s[4 * 33], s[5 * 33]); o.w = pk2(s[6 * 33], s[7 * 33]);
        *(u32x4*)(WT + (size_t)rowmap(n) * ldk + k0 + 8 * c) = o; }
    LDS_WAIT(); asm volatile("" ::: "memory");
}
struct AddMap { int base; DI int operator()(int n) const { return base + n; } };
struct PairMap { int base; DI int operator()(int n) const { return base + (n < 16 ? 2 * n : 2 * (n - 16) + 1); } };
DI void expert_item(int r, const float* Wg, const float* Wu, const float* Wd, bf16* W1, bf16* W2, LAS float* scr, int lane) {
    if (r < 32768) { const int up = r >> 14, q = r & 16383, e = q >> 10, it = q & 1023, kb = it >> 6, nb = it & 63;
        const float* src = (up ? Wu : Wg) + (size_t)e * 1024 * 2048 + (size_t)(kb * 64) * 2048 + nb * 32;
        const int rbase = e * 4096 + (nb >> 2) * 256 + up * 128 + (nb & 3) * 32;
        tr_item(src, 2048, W1, 1024, kb * 64, AddMap{rbase}, scr, lane);
    } else { const int q = r - 32768, e = q >> 10, it = q & 1023, kb = it >> 5, nb = it & 31;
        const float* src = Wd + (size_t)e * 2048 * 1024 + (size_t)(kb * 64) * 1024 + nb * 32;
        const int rbase = e * 1024 + nb * 32;
        tr_item(src, 1024, W2, 2048, kb * 64, AddMap{rbase}, scr, lane);
    }
}
DI void stage_tab16(const float* W, int ldw, LAS float* tab, int tid) {
    for (int idx = tid; idx < 16384; idx += NTHR) { const int d = idx >> 4, e = idx & 15; const int j = d >> 8, l = (d >> 2) & 63, c = d & 3;
        tab[((((j * 4 + c) * 4 + (e >> 2)) * 64 + l) << 2) + (e & 3)] = W[(size_t)d * ldw + e]; }
}
DI void row_gemv16(const f32x4 (&h)[4], const LAS float* tab, int lane, float (&sums)[16]) {
#pragma unroll
    for (int e = 0; e < 16; ++e) sums[e] = 0.f;
#pragma unroll
    for (int j = 0; j < 4; ++j)
#pragma unroll
        for (int c = 0; c < 4; ++c) { const float hv = h[j][c];
#pragma unroll
            for (int q = 0; q < 4; ++q) { const f32x4 w = *(const LAS f32x4*)(tab + ((((j * 4 + c) * 4 + q) * 64 + lane) << 2));
                sums[4 * q + 0] += hv * w[0]; sums[4 * q + 1] += hv * w[1]; sums[4 * q + 2] += hv * w[2]; sums[4 * q + 3] += hv * w[3]; }
            asm volatile("" ::: "memory"); }
}
DI int eidx16(int lane) { return ((lane >> 5) & 1) * 8 + ((lane >> 4) & 1) * 4 + ((lane >> 3) & 1) * 2 + ((lane >> 2) & 1); }
DI float reduce16(const float (&s)[16], int lane) {
    float a8[8], a4[4], a2[2];
    const bool u5 = (lane & 32) != 0, u4 = (lane & 16) != 0, u3 = (lane & 8) != 0, u2 = (lane & 4) != 0;
#pragma unroll
    for (int k = 0; k < 8; ++k) { const float keep = u5 ? s[k + 8] : s[k], send = u5 ? s[k] : s[k + 8]; a8[k] = keep + __shfl_xor(send, 32); }
#pragma unroll
    for (int k = 0; k < 4; ++k) { const float keep = u4 ? a8[k + 4] : a8[k], send = u4 ? a8[k] : a8[k + 4]; a4[k] = keep + __shfl_xor(send, 16); }
#pragma unroll
    for (int k = 0; k < 2; ++k) { const float keep = u3 ? a4[k + 2] : a4[k], send = u3 ? a4[k] : a4[k + 2]; a2[k] = keep + __shfl_xor(send, 8); }
    float r; { const float keep = u2 ? a2[1] : a2[0], send = u2 ? a2[0] : a2[1]; r = keep + __shfl_xor(send, 4); }
    r += __shfl_xor(r, 2); r += __shfl_xor(r, 1);
    return r;
}
DI float* resid_ptr(float* lat, float* ctx, int r) { return r < RL ? lat + (size_t)r * DM : ctx + (size_t)(r - RL) * DM; }
DI int row_bb(int r) { return r < RL ? (r >> 13) : 4; }
DI void modulate_row(f32x4 (&v)[4], const float* nw, const float* shift, const float* scale, int lane) {
    float ss = 0.f;
#pragma unroll
    for (int j = 0; j < 4; ++j) ss += (v[j][0] * v[j][0] + v[j][1] * v[j][1]) + (v[j][2] * v[j][2] + v[j][3] * v[j][3]);
    const float rstd = 1.0f / sqrtf(wave_sum(ss) * (1.0f / DM) + EPSN);
#pragma unroll
    for (int j = 0; j < 4; ++j) { const int d = 256 * j + 4 * lane; const f32x4 w = *(const f32x4*)(nw + d), sc = *(const f32x4*)(scale + d), sh = *(const f32x4*)(shift + d);
        v[j] = v[j] * rstd * w * (sc + 1.0f) + sh; }
}
DI void store_row_bf16(bf16* dst, const f32x4 (&v)[4], int lane) {
#pragma unroll
    for (int j = 0; j < 4; ++j) { u32x2 o; o.x = pk2(v[j][0], v[j][1]); o.y = pk2(v[j][2], v[j][3]); *(u32x2*)(dst + 256 * j + 4 * lane) = o; }
}
DI void load_row_f32(const float* src, f32x4 (&v)[4], int lane) {
#pragma unroll
    for (int j = 0; j < 4; ++j) v[j] = *(const f32x4*)(src + 256 * j + 4 * lane);
}
DI void moe_combine_row(f32x4 (&v)[4], const int* invrow, const bf16* YE, const float* gvec, int lane) {
    const int mine = invrow[lane & 15];
    f32x4 a[4];
#pragma unroll
    for (int j = 0; j < 4; ++j) a[j] = (f32x4){0.f, 0.f, 0.f, 0.f};
#pragma unroll
    for (int e = 0; e < 16; ++e) { const int s = __builtin_amdgcn_readlane(mine, e);
        if (s >= 0) { const bf16* yr = YE + (size_t)s * DM;
#pragma unroll
            for (int j = 0; j < 4; ++j) { const u32x2 w = *(const u32x2*)(yr + 256 * j + 4 * lane); a[j][0] += bflo(w.x); a[j][1] += bfhi(w.x); a[j][2] += bflo(w.y); a[j][3] += bfhi(w.y); } } }
#pragma unroll
    for (int j = 0; j < 4; ++j) { const f32x4 g = *(const f32x4*)(gvec + 256 * j + 4 * lane); v[j] = v[j] + g * a[j]; }
}

#define PH_ARGS const Args& A, LAS unsigned char* lds, int tid, int lane, int wave, int G, int bx
DI void sincos_d(double a, float& sn, float& cs) {
    const double TWO_OVER_PI = 0.63661977236758134308, PIO2 = 1.57079632679489661923;
    const double kq = (double)(long long)(a * TWO_OVER_PI + 0.5); const double y = a - kq * PIO2; const double y2 = y * y;
    const double s = y * (1.0 + y2 * (-1.0 / 6 + y2 * (1.0 / 120 + y2 * (-1.0 / 5040 + y2 * (1.0 / 362880 + y2 * (-1.0 / 39916800 + y2 * (1.0 / 6227020800.0)))))));
    const double c = 1.0 + y2 * (-0.5 + y2 * (1.0 / 24 + y2 * (-1.0 / 720 + y2 * (1.0 / 40320 + y2 * (-1.0 / 3628800 + y2 * (1.0 / 479001600.0))))));
    const int k = (int)((long long)kq & 3);
    const double ss = (k == 0) ? s : (k == 1) ? c : (k == 2) ? -s : -c;
    const double cc = (k == 0) ? c : (k == 1) ? -s : (k == 2) ? -c : s;
    sn = (float)ss; cs = (float)cc;
}

DI void phase0(PH_ARGS) {
    unsigned char* ws = A.ws;
    LAS float* sil = (LAS float*)(lds + 73728);
    for (int i = tid; i < 5120; i += NTHR) { const int bb = i >> 10, k = i & 1023; const float cv = bb < 4 ? A.in[1][bb * 1024 + k] : A.in[3][k]; sil[i] = silu_f(cv); }
    __syncthreads();
    {
        const int t = wave * G + bx;
        if (t < 192) { const int layer = t / 96, n = (t % 96) * 64 + lane; const float* W = A.in[layer ? 19 : 4] + n; const float* Bv = A.in[layer ? 20 : 5];
            float a0 = 0.f, a1 = 0.f, a2 = 0.f, a3 = 0.f, a4 = 0.f;
#pragma unroll 8
            for (int k = 0; k < 1024; ++k) { const float w = W[(size_t)k * 6144]; a0 += sil[k] * w; a1 += sil[1024 + k] * w; a2 += sil[2048 + k] * w; a3 += sil[3072 + k] * w; a4 += sil[4096 + k] * w; }
            float* mv = (float*)(ws + WS_MODV) + layer * 5 * 6144 + n; const float bv = Bv[n];
            mv[0] = a0 + bv; mv[6144] = a1 + bv; mv[2 * 6144] = a2 + bv; mv[3 * 6144] = a3 + bv; mv[4 * 6144] = a4 + bv; }
    }
    if (bx == G - 1) {
        float* rope = (float*)(ws + WS_ROPE);
        for (int i = tid; i < 3072; i += NTHR) { const int isc = i >= 2048, ii = isc ? i - 2048 : i; const int pos = ii >> 4, j = ii & 15;
            double f = 1.0; for (int q = 0; q < j; ++q) f *= 0.56234132519034908;
            float sn, cs; sincos_d((double)pos * f, sn, cs);
            if (isc) { rope[4096 + ii] = cs; rope[5120 + ii] = sn; } else { rope[ii] = cs; rope[2048 + ii] = sn; } }
        unsigned* z = (unsigned*)(ws + WS_ZROW); for (int i = tid; i < 512; i += NTHR) z[i] = 0u;
    }
    LAS float* scr = (LAS float*)(lds + wave * 8704);
    const int gw = bx * NWAVES + wave, NGW = G * NWAVES;
    constexpr int I_IN = 16 * 112, I_OUT = 16 * 32, I_QK = 16 * 64, I_V = 16 * 32, I_O = 16 * 32;
    constexpr int NITEMS = I_IN + I_OUT + I_QK + I_V + I_O;
    for (int it = gw; it < NITEMS; it += NGW) {
        int r = it;
        if (r < I_IN) { const int kb = r / 112, nb = r % 112; tr_item(A.in[7] + (size_t)(kb * 64) * INCOLS + nb * 32, INCOLS, (bf16*)(ws + WS_WIN), 1024, kb * 64, AddMap{nb * 32}, scr, lane); continue; } r -= I_IN;
        if (r < I_OUT) { const int kb = r >> 5, nb = r & 31; tr_item(A.in[13] + (size_t)(kb * 64) * 1024 + nb * 32, 1024, (bf16*)(ws + WS_WOUT), 1024, kb * 64, AddMap{nb * 32}, scr, lane); continue; } r -= I_OUT;
        if (r < I_QK) { const int kb = r >> 6, nb = r & 63; tr_item(A.in[22] + (size_t)(kb * 64) * 3072 + nb * 32, 3072, (bf16*)(ws + WS_WQK), 1024, kb * 64, PairMap{nb * 32}, scr, lane); continue; } r -= I_QK;
        if (r < I_V) { const int kb = r >> 5, nb = r & 31; tr_item(A.in[22] + (size_t)(kb * 64) * 3072 + 2048 + nb * 32, 3072, (bf16*)(ws + WS_WV), 1024, kb * 64, AddMap{nb * 32}, scr, lane); continue; } r -= I_V;
        { const int kb = r >> 5, nb = r & 31; tr_item(A.in[28] + (size_t)(kb * 64) * 1024 + nb * 32, 1024, (bf16*)(ws + WS_WO), 1024, kb * 64, AddMap{nb * 32}, scr, lane); }
    }
}

template <int MODE, int LAYER> DI void phase_modulate(PH_ARGS) {
    unsigned char* ws = A.ws;
    LAS float* tab = (LAS float*)lds;
    if (MODE == 0) stage_tab16(A.in[7] + NPROJ, INCOLS, tab, tid); else stage_tab16(A.in[LAYER ? 30 : 15], 16, tab, tid);
    __syncthreads();
    const float* nw = A.in[MODE == 0 ? 6 : (LAYER ? 29 : 14)];
    const float* mv = (const float*)(ws + WS_MODV) + LAYER * 5 * 6144 + (MODE == 0 ? 0 : 3 * 1024);
    bf16* H = (bf16*)(ws + WS_H);
    const int NR = (MODE == 1 && LAYER == 1) ? RL : RT;
    for (int r = bx * NWAVES + wave; r < NR; r += G * NWAVES) {
        const float* src = (MODE == 0) ? (r < RL ? A.in[0] + (size_t)r * DM : A.in[2] + (size_t)(r - RL) * DM) : resid_ptr(A.out, (float*)(ws + WS_XC), r);
        const int bb = row_bb(r);
        f32x4 v[4]; load_row_f32(src, v, lane);
        modulate_row(v, nw, mv + bb * 6144, mv + bb * 6144 + 1024, lane);
        store_row_bf16(H + (size_t)r * DM, v, lane);
        float sums[16]; row_gemv16(v, tab, lane, sums);
        const float red = reduce16(sums, lane); const int ee = eidx16(lane);
        if (MODE == 0) { if ((lane & 3) == 0) ((float*)(ws + WS_GATES))[(size_t)r * 16 + ee] = red; }
        else { const float mx = wave_max(red); const float ex = __expf(red - mx); const float den = wave_sum(ex) * 0.25f; const float mine = ex / den;
            if ((lane & 3) == 0) { float* af = (float*)(ws + WS_AFFT);
                if (r < RL) af[(size_t)(((r >> 13) * 16 + ee)) * 8192 + (r & 8191)] = mine;
                else { const int rr = r - RL; af[524288 + (size_t)(((rr >> 8) * 16 + ee)) * 256 + (rr & 255)] = mine; } } }
    }
}

DI void fnma_asm(float& acc, float a, float b) { asm("v_fma_f32 %0, -%1, %2, %0" : "+v"(acc) : "v"(a), "v"(b)); }
template <int J> DI void backsub_row(float (&t)[64], const LAS float* LT, int lane) {
    float acc0 = (lane == J) ? 1.0f : 0.0f, acc1 = 0.f;
    constexpr int K0 = (J + 1) >> 2;
#pragma unroll
    for (int k4 = K0; k4 < 16; ++k4) { const f32x4 l4 = *(const LAS f32x4*)(LT + J * 64 + 4 * k4);
#pragma unroll
        for (int q = 0; q < 4; ++q) { const int k = 4 * k4 + q; if (k > J) { if (q & 1) fnma_asm(acc1, t[k], l4[q]); else fnma_asm(acc0, t[k], l4[q]); } } }
    t[J] = acc0 + acc1;
    __builtin_amdgcn_sched_barrier(0);
}
template <int J> DI void backsub_all(float (&t)[64], const LAS float* LT, int lane) {
    backsub_row<J>(t, LT, lane);
    if constexpr (J > 0) backsub_all<J - 1>(t, LT, lane);
}
DI void gdn_dir(const Args& A, LAS unsigned char* lds, int lane, int dir, int b, int h, int seqsel, int cidx, int rowbase, int t0) {
    unsigned char* ws = A.ws;
    const int r32 = lane & 31, hi = lane >> 5;
    LAS unsigned char* Qn = lds; LAS unsigned char* Kn = lds + 16384;
    LAS unsigned char* DB = lds + 32768 + 49152 * dir;
    LAS float* LT = (LAS float*)DB; LAS unsigned char* TBG = DB; LAS unsigned char* TB = DB + 8192;
    LAS unsigned char* KT = DB + 16384; LAS unsigned char* VT = DB + 32768;
    LAS float* SM = (LAS float*)(lds + LDSX + 1024 + dir * 1280);
    LAS float* GC = SM; LAS float* EGC = SM + 64; LAS float* BETA = SM + 128; LAS float* BG = SM + 192; LAS float* KDEC = SM + 256;
    const int ch = (b * 4 + h) * 2 + dir;
    const int p = seqsel ? (dir ? 3 - cidx : cidx) : 4 + (dir ? 127 - cidx : cidx);
    unsigned char* blk = ws + WS_G + (size_t)(ch * NCHUNK + p) * GBLK;
    {
        const int tk = dir ? 63 - lane : lane; const float* gr = (const float*)(ws + WS_GATES) + (size_t)(rowbase + t0 + tk) * 16;
        const float av = gr[dir * 4 + h], bv = gr[8 + dir * 4 + h];
        const float xs = av + A.in[11][dir * 4 + h]; const float sp = xs > 20.f ? xs : log1pf(__expf(xs));
        const float g = -__expf(A.in[10][dir * 4 + h]) * sp; const float beta = 1.0f / (1.0f + __expf(-bv));
        float gc = g;
#pragma unroll
        for (int o = 1; o < 64; o <<= 1) { const float tv = __shfl_up(gc, o); if (lane >= o) gc += tv; }
        const float gl = __shfl(gc, 63); const float eg = __expf(gc);
        GC[lane] = gc; EGC[lane] = eg; BETA[lane] = beta; BG[lane] = beta * eg; KDEC[lane] = __expf(gl - gc);
        if (lane == 0) ((float*)(ws + WS_GLAST))[ch * NCHUNK + p] = __expf(gl);
    }
    LDS_WAIT(); asm volatile("" ::: "memory");
#pragma unroll
    for (int ib = 0; ib < 2; ++ib) {
        const int i = 32 * ib + r32; const int ti = dir ? 63 - i : i; const float gi = GC[i], bi = BETA[i];
#pragma unroll
        for (int jb = 0; jb < 2; ++jb) {
            f32x16 aK, aQ;
#pragma unroll
            for (int r = 0; r < 16; ++r) { aK[r] = 0.f; aQ[r] = 0.f; }
            if (jb <= ib) {
                const int j = 32 * jb + r32; const int tj = dir ? 63 - j : j;
#pragma unroll
                for (int kk = 0; kk < 8; ++kk) {
                    const bf16x8 a = *(const LAS bf16x8*)(Kn + sw128(tj, 2 * kk + hi));
                    const bf16x8 bK = *(const LAS bf16x8*)(Kn + sw128(ti, 2 * kk + hi));
                    const bf16x8 bQ = *(const LAS bf16x8*)(Qn + sw128(ti, 2 * kk + hi));
                    aK = MFMA32(a, bK, aK); aQ = MFMA32(a, bQ, aQ);
                }
            }
#pragma unroll
            for (int g4 = 0; g4 < 4; ++g4) { const f32x4 gj = *(const LAS f32x4*)(GC + 32 * jb + 8 * g4 + 4 * hi);
#pragma unroll
                for (int q = 0; q < 4; ++q) { const int r = 4 * g4 + q; const int j = 32 * jb + 8 * g4 + 4 * hi + q;
                    const float dec = __expf(fminf(gi - gj[q], 0.f));
                    const float lv = (j < i) ? bi * aK[r] * dec : 0.f;
                    LT[j * 64 + i] = lv;
                    aQ[r] = (j <= i) ? aQ[r] * dec : 0.f; } }
            *(bf16x8*)(blk + 32768 + ((ib * 4 + 2 * jb + 0) * 1024) + lane * 16) = pack8<0>(aQ);
            *(bf16x8*)(blk + 32768 + ((ib * 4 + 2 * jb + 1) * 1024) + lane * 16) = pack8<1>(aQ);
        }
    }
    LDS_WAIT(); asm volatile("" ::: "memory");
    float t[64];
    backsub_all<63>(t, LT, lane);
    LDS_WAIT(); asm volatile("" ::: "memory");
#pragma unroll
    for (int c = 0; c < 8; ++c) {
        const f32x4 b0 = *(const LAS f32x4*)(BETA + 8 * c), b1 = *(const LAS f32x4*)(BETA + 8 * c + 4), g0 = *(const LAS f32x4*)(BG + 8 * c), g1 = *(const LAS f32x4*)(BG + 8 * c + 4);
        u32x4 wb, wg;
        wb.x = pk2(t[8 * c] * b0[0], t[8 * c + 1] * b0[1]); wb.y = pk2(t[8 * c + 2] * b0[2], t[8 * c + 3] * b0[3]); wb.z = pk2(t[8 * c + 4] * b1[0], t[8 * c + 5] * b1[1]); wb.w = pk2(t[8 * c + 6] * b1[2], t[8 * c + 7] * b1[3]);
        wg.x = pk2(t[8 * c] * g0[0], t[8 * c + 1] * g0[1]); wg.y = pk2(t[8 * c + 2] * g0[2], t[8 * c + 3] * g0[3]); wg.z = pk2(t[8 * c + 4] * g1[0], t[8 * c + 5] * g1[1]); wg.w = pk2(t[8 * c + 6] * g1[2], t[8 * c + 7] * g1[3]);
        *(LAS u32x4*)(TB + sw64(lane, c)) = wb; *(LAS u32x4*)(TBG + sw64(lane, c)) = wg;
    }
    LDS_WAIT(); asm volatile("" ::: "memory");
#pragma unroll
    for (int ib = 0; ib < 2; ++ib) {
        bf16x8 tg[4], tb[4];
#pragma unroll
        for (int js = 0; js < 4; ++js) { tg[js] = *(const LAS bf16x8*)(TBG + sw64(32 * ib + r32, 2 * js + hi)); tb[js] = *(const LAS bf16x8*)(TB + sw64(32 * ib + r32, 2 * js + hi)); }
#pragma unroll
        for (int kb = 0; kb < 4; ++kb) {
            f32x16 acc;
#pragma unroll
            for (int r = 0; r < 16; ++r) acc[r] = 0.f;
#pragma unroll
            for (int js = 0; js < 4; ++js) { const bf16x8 a = *(const LAS bf16x8*)(KT + sw64(32 * kb + r32, 2 * js + hi)); acc = MFMA32(a, tg[js], acc); }
            *(bf16x8*)(blk + ((ib * 8 + 2 * kb + 0) * 1024) + lane * 16) = pack8<0>(acc);
            *(bf16x8*)(blk + ((ib * 8 + 2 * kb + 1) * 1024) + lane * 16) = pack8<1>(acc);
        }
#pragma unroll
        for (int dvb = 0; dvb < 4; ++dvb) {
            f32x16 acc;
#pragma unroll
            for (int r = 0; r < 16; ++r) acc[r] = 0.f;
#pragma unroll
            for (int js = 0; js < 4; ++js) { const bf16x8 bv = *(const LAS bf16x8*)(VT + sw64(32 * dvb + r32, 2 * js + hi)); acc = MFMA32(tb[js], bv, acc); }
            unsigned char* up = blk + 57344 + (dvb * 2 + ib) * 2048 + lane * 32;
            *(bf16x8*)(up) = pack8<0>(acc); *(bf16x8*)(up + 16) = pack8<1>(acc);
        }
    }
#pragma unroll
    for (int ib = 0; ib < 2; ++ib) { const int i = 32 * ib + r32; const int ti = dir ? 63 - i : i; const float eg = EGC[i];
#pragma unroll
        for (int ks = 0; ks < 8; ++ks) {
            const u32x2 lo = *(const LAS u32x2*)(Qn + sw128(ti, 2 * ks) + 8 * hi), hh = *(const LAS u32x2*)(Qn + sw128(ti, 2 * ks + 1) + 8 * hi);
            u32x4 o; o.x = pk2(bflo(lo.x) * eg, bfhi(lo.x) * eg); o.y = pk2(bflo(lo.y) * eg, bfhi(lo.y) * eg); o.z = pk2(bflo(hh.x) * eg, bfhi(hh.x) * eg); o.w = pk2(bflo(hh.y) * eg, bfhi(hh.y) * eg);
            *(u32x4*)(blk + 16384 + ((ib * 8 + ks) * 1024) + lane * 16) = o; } }
#pragma unroll
    for (int kb = 0; kb < 4; ++kb) { const int dk = 32 * kb + r32;
#pragma unroll
        for (int ks = 0; ks < 4; ++ks) {
            const u32x2 lo = *(const LAS u32x2*)(KT + sw64(dk, 2 * ks) + 8 * hi), hh = *(const LAS u32x2*)(KT + sw64(dk, 2 * ks + 1) + 8 * hi);
            const f32x4 d0 = *(const LAS f32x4*)(KDEC + 16 * ks + 4 * hi), d1 = *(const LAS f32x4*)(KDEC + 16 * ks + 8 + 4 * hi);
            u32x4 o; o.x = pk2(bflo(lo.x) * d0[0], bfhi(lo.x) * d0[1]); o.y = pk2(bflo(lo.y) * d0[2], bfhi(lo.y) * d0[3]); o.z = pk2(bflo(hh.x) * d1[0], bfhi(hh.x) * d1[1]); o.w = pk2(bflo(hh.y) * d1[2], bfhi(hh.y) * d1[3]);
            *(u32x4*)(blk + 40960 + ((kb * 4 + ks) * 1024) + lane * 16) = o; } }
}

DI void phase_gdn_prep(PH_ARGS) {
    unsigned char* ws = A.ws;
    const bf16* PROJ = (const bf16*)(ws + WS_BIG);
    LAS unsigned char* Qn = lds; LAS unsigned char* Kn = lds + 16384;
    const int lane_in = lane;
    for (int u = bx; u < 2112; u += G) {
        int lane = lane_in; asm volatile("" : "+v"(lane));
        int seqsel, b, cidx, h;
        if (u < 2048) { seqsel = 0; b = u >> 9; cidx = (u >> 2) & 127; h = u & 3; } else { const int q = u - 2048; seqsel = 1; b = q >> 4; cidx = (q >> 2) & 3; h = q & 3; }
        const int rowbase = seqsel ? RL + b * CTXL : b * SEQL; const int L = seqsel ? CTXL : SEQL; const int t0 = cidx * 64;
        {
            const int d = 2 * lane; float w[3][3][2];
#pragma unroll
            for (int s = 0; s < 3; ++s)
#pragma unroll
                for (int j = 0; j < 3; ++j) { const f32x2 wv = *(const f32x2*)(A.in[9] + j * 1536 + s * 512 + h * 128 + d); w[s][j][0] = wv[0]; w[s][j][1] = wv[1]; }
            unsigned raw[10][3];
#pragma unroll
            for (int rr = 0; rr < 10; ++rr) { const int t = t0 + 8 * wave - 1 + rr; const bool ok = (t >= 0) && (t < L);
#pragma unroll
                for (int s = 0; s < 3; ++s) raw[rr][s] = ok ? *(const unsigned*)(PROJ + (size_t)(rowbase + t) * NPROJ + 1536 + s * 512 + h * 128 + d) : 0u; }
#pragma unroll
            for (int ii = 0; ii < 8; ++ii) { const int i = 8 * wave + ii;
                float val[3][2];
#pragma unroll
                for (int s = 0; s < 3; ++s) {
                    const float x0 = w[s][0][0] * bflo(raw[ii][s]) + w[s][1][0] * bflo(raw[ii + 1][s]) + w[s][2][0] * bflo(raw[ii + 2][s]);
                    const float x1 = w[s][0][1] * bfhi(raw[ii][s]) + w[s][1][1] * bfhi(raw[ii + 1][s]) + w[s][2][1] * bfhi(raw[ii + 2][s]);
                    val[s][0] = silu_f(x0); val[s][1] = silu_f(x1); }
                const float qs = wave_sum(val[0][0] * val[0][0] + val[0][1] * val[0][1]), ksq = wave_sum(val[1][0] * val[1][0] + val[1][1] * val[1][1]);
                const float rq = 0.08838834764831845f / sqrtf(qs + EPSN), rk = 1.0f / sqrtf(ksq + EPSN);
                const unsigned qp = pk2(val[0][0] * rq, val[0][1] * rq), kp = pk2(val[1][0] * rk, val[1][1] * rk), vp = pk2(val[2][0], val[2][1]);
                *(LAS unsigned*)(Qn + sw128(i, lane >> 2) + (lane & 3) * 4) = qp;
                *(LAS unsigned*)(Kn + sw128(i, lane >> 2) + (lane & 3) * 4) = kp;
#pragma unroll
                for (int dir = 0; dir < 2; ++dir) { const int pi = dir ? 63 - i : i; LAS unsigned char* KT = lds + 32768 + 49152 * dir + 16384; LAS unsigned char* VT = KT + 16384;
                    *(LAS unsigned short*)(KT + sw64(d, pi >> 3) + (pi & 7) * 2) = (unsigned short)(kp & 0xffffu);
                    *(LAS unsigned short*)(KT + sw64(d + 1, pi >> 3) + (pi & 7) * 2) = (unsigned short)(kp >> 16);
                    *(LAS unsigned short*)(VT + sw64(d, pi >> 3) + (pi & 7) * 2) = (unsigned short)(vp & 0xffffu);
                    *(LAS unsigned short*)(VT + sw64(d + 1, pi >> 3) + (pi & 7) * 2) = (unsigned short)(vp >> 16); }
            }
        }
        __syncthreads();
        if (wave < 2) gdn_dir(A, lds, lane, wave, b, h, seqsel, cidx, rowbase, t0);
        __syncthreads();
    }
}

DI void expert_queue(const Args& A, LAS unsigned char* lds, int lane, int wave, unsigned* qword, const float* Wg, const float* Wu, const float* Wd, bf16* W1, bf16* W2) {
    LAS float* scr = (LAS float*)(lds + wave * 8704);
    for (;;) {
        unsigned it0 = 0u;
        if (lane == 0) it0 = __hip_atomic_fetch_add(qword, 4u, __ATOMIC_RELAXED, __HIP_MEMORY_SCOPE_AGENT);
        it0 = (unsigned)__builtin_amdgcn_readfirstlane((int)it0);
        if (it0 >= 49152u) break;
#pragma unroll 1
        for (int q = 0; q < 4; ++q) expert_item((int)it0 + q, Wg, Wu, Wd, W1, W2, scr, lane);
    }
}
DI void phase_gdn_scan(PH_ARGS) {
    unsigned char* ws = A.ws;
    unsigned* qword = (unsigned*)(ws + WS_CTL) + CW_Q0;
    if (bx < 128) {
    const int xcd = bx & 7, idx = bx >> 3; const int ch = xcd + 8 * (idx >> 2), v = idx & 3;
    const int dir = ch & 1, bh = ch >> 1, b = bh >> 2, h = bh & 3;
    const int r32 = lane & 31, hi = lane >> 5;
    bf16* PROJ = (bf16*)(ws + WS_BIG);
    const float* GL = (const float*)(ws + WS_GLAST) + ch * NCHUNK;
    const unsigned char* gbase = ws + WS_G + (size_t)ch * NCHUNK * GBLK;
    constexpr int SBUF = 61440;
    const int lt = tid - 64;
#define SCAN_LOAD(p, bufi) do { const unsigned char* gb = gbase + (size_t)(p) * GBLK; LAS unsigned char* lb = lds + (bufi) * SBUF; u32x4 tv[9]; \
        _Pragma("unroll") for (int k = 0; k < 8; ++k) tv[k] = *(const u32x4*)(gb + (lt + 448 * k) * 16); \
        if (lt < 256) tv[8] = *(const u32x4*)(gb + 57344 + v * 4096 + lt * 16); \
        _Pragma("unroll") for (int k = 0; k < 8; ++k) *(LAS u32x4*)(lb + (lt + 448 * k) * 16) = tv[k]; \
        if (lt < 256) *(LAS u32x4*)(lb + 57344 + lt * 16) = tv[8]; } while (0)
    if (wave > 0) SCAN_LOAD(0, 0);
    __syncthreads();
    f32x16 S[4];
#pragma unroll
    for (int kb = 0; kb < 4; ++kb)
#pragma unroll
        for (int r = 0; r < 16; ++r) S[kb][r] = 0.f;
    for (int p = 0; p < NCHUNK; ++p) {
      if (wave > 0) { if (p + 1 < NCHUNK) SCAN_LOAD(p + 1, (p + 1) & 1); }
      else {
        const LAS unsigned char* blk = lds + (p & 1) * SBUF + lane * 16;
        const float gl = GL[p];
        bf16x8 Sb[8];
        Sb[0] = pack8<0>(S[0]); Sb[1] = pack8<1>(S[0]); Sb[2] = pack8<0>(S[1]); Sb[3] = pack8<1>(S[1]);
        Sb[4] = pack8<0>(S[2]); Sb[5] = pack8<1>(S[2]); Sb[6] = pack8<0>(S[3]); Sb[7] = pack8<1>(S[3]);
        f32x16 P[2], O[2];
#pragma unroll
        for (int ib = 0; ib < 2; ++ib) {
#pragma unroll
            for (int r = 0; r < 16; ++r) { P[ib][r] = 0.f; O[ib][r] = 0.f; }
#pragma unroll
            for (int ks = 0; ks < 8; ++ks) { const bf16x8 wf = *(const LAS bf16x8*)(blk + (ib * 8 + ks) * 1024); P[ib] = MFMA32(wf, Sb[ks], P[ib]); }
            asm volatile("" ::: "memory");
#pragma unroll
            for (int ks = 0; ks < 8; ++ks) { const bf16x8 qf = *(const LAS bf16x8*)(blk + 16384 + (ib * 8 + ks) * 1024); O[ib] = MFMA32(qf, Sb[ks], O[ib]); }
            asm volatile("" ::: "memory");
        }
        bf16x8 Vb[4];
#pragma unroll
        for (int ib = 0; ib < 2; ++ib) {
            const LAS unsigned char* up = lds + (p & 1) * SBUF + 57344 + ib * 2048 + lane * 32;
            const u32x4 u0 = *(const LAS u32x4*)up, u1 = *(const LAS u32x4*)(up + 16);
            f32x16 vn;
            vn[0] = bflo(u0.x) - P[ib][0]; vn[1] = bfhi(u0.x) - P[ib][1]; vn[2] = bflo(u0.y) - P[ib][2]; vn[3] = bfhi(u0.y) - P[ib][3];
            vn[4] = bflo(u0.z) - P[ib][4]; vn[5] = bfhi(u0.z) - P[ib][5]; vn[6] = bflo(u0.w) - P[ib][6]; vn[7] = bfhi(u0.w) - P[ib][7];
            vn[8] = bflo(u1.x) - P[ib][8]; vn[9] = bfhi(u1.x) - P[ib][9]; vn[10] = bflo(u1.y) - P[ib][10]; vn[11] = bfhi(u1.y) - P[ib][11];
            vn[12] = bflo(u1.z) - P[ib][12]; vn[13] = bfhi(u1.z) - P[ib][13]; vn[14] = bflo(u1.w) - P[ib][14]; vn[15] = bfhi(u1.w) - P[ib][15];
            Vb[2 * ib] = pack8<0>(vn); Vb[2 * ib + 1] = pack8<1>(vn);
        }
#pragma unroll
        for (int ib = 0; ib < 2; ++ib)
#pragma unroll
            for (int kt = 0; kt < 4; ++kt) { const bf16x8 af = *(const LAS bf16x8*)(blk + 32768 + (ib * 4 + kt) * 1024); O[ib] = MFMA32(af, Vb[kt], O[ib]); }
        asm volatile("" ::: "memory");
#pragma unroll
        for (int kb = 0; kb < 4; ++kb) {
            asm volatile("" ::: "memory");
#pragma unroll
            for (int r = 0; r < 16; ++r) S[kb][r] *= gl;
#pragma unroll
            for (int kt = 0; kt < 4; ++kt) { const bf16x8 kf = *(const LAS bf16x8*)(blk + 40960 + (kb * 4 + kt) * 1024); S[kb] = MFMA32(kf, Vb[kt], S[kb]); }
        }
        int rowbase, cidx;
        if (p < 4) { cidx = dir ? 3 - p : p; rowbase = RL + b * CTXL; } else { cidx = dir ? 131 - p : p - 4; rowbase = b * SEQL; }
        int hiv = hi; asm volatile("" : "+v"(hiv));
        const long step = dir ? -(long)NPROJ : (long)NPROJ;
        bf16* ob = PROJ + (size_t)(rowbase + cidx * 64 + (dir ? 63 - 4 * hiv : 4 * hiv)) * NPROJ + 1536 + dir * 512 + h * 128 + 32 * v + r32;
#pragma unroll
        for (int ib = 0; ib < 2; ++ib)
#pragma unroll
            for (int r = 0; r < 16; ++r) { const int c = 32 * ib + (r & 3) + 8 * (r >> 2);
                ob[step * c] = (bf16)(pk2(O[ib][r], 0.f) & 0xffffu); }
      }
      __syncthreads();
    }
#undef SCAN_LOAD
    }
    expert_queue(A, lds, lane, wave, qword, A.in[16], A.in[17], A.in[18], (bf16*)(ws + WS_E0), (bf16*)(ws + WS_E0 + 128 * MiB));
}

DI void unpack8(const u32x4 w, float (&f)[8]) { f[0] = bflo(w.x); f[1] = bfhi(w.x); f[2] = bflo(w.y); f[3] = bfhi(w.y); f[4] = bflo(w.z); f[5] = bfhi(w.z); f[6] = bflo(w.w); f[7] = bfhi(w.w); }
DI void phase_ycat(PH_ARGS) {
    unsigned char* ws = A.ws;
    const bf16* PROJ = (const bf16*)(ws + WS_BIG); bf16* Y = (bf16*)(ws + WS_H);
    const int c0 = 8 * lane;
    float cw[3][8], gn[8];
#pragma unroll
    for (int j = 0; j < 3; ++j) { const f32x4 a = *(const f32x4*)(A.in[8] + j * 512 + c0), b2 = *(const f32x4*)(A.in[8] + j * 512 + c0 + 4);
        cw[j][0] = a[0]; cw[j][1] = a[1]; cw[j][2] = a[2]; cw[j][3] = a[3]; cw[j][4] = b2[0]; cw[j][5] = b2[1]; cw[j][6] = b2[2]; cw[j][7] = b2[3]; }
    { const f32x4 a = *(const f32x4*)(A.in[12] + (c0 & 127)), b2 = *(const f32x4*)(A.in[12] + (c0 & 127) + 4);
        gn[0] = a[0]; gn[1] = a[1]; gn[2] = a[2]; gn[3] = a[3]; gn[4] = b2[0]; gn[5] = b2[1]; gn[6] = b2[2]; gn[7] = b2[3]; }
    for (int r = bx * NWAVES + wave; r < RT; r += G * NWAVES) {
        const int t = r < RL ? (r & 8191) : ((r - RL) & 255); const int L = r < RL ? SEQL : CTXL;
        const bf16* pr = PROJ + (size_t)r * NPROJ;
        float pm[8], pc[8], pn[8], xa[8], gc_[8], gb[8];
        unpack8(*(const u32x4*)(pr + c0), xa); unpack8(*(const u32x4*)(pr + 1024 + c0), gc_); unpack8(*(const u32x4*)(pr + 512 + c0), gb);
#pragma unroll
        for (int q = 0; q < 8; ++q) pc[q] = gc_[q] * xa[q];
        if (t > 0) { unpack8(*(const u32x4*)(pr - NPROJ + c0), xa); unpack8(*(const u32x4*)(pr - NPROJ + 1024 + c0), gc_);
#pragma unroll
            for (int q = 0; q < 8; ++q) pm[q] = gc_[q] * xa[q]; }
        else {
#pragma unroll
            for (int q = 0; q < 8; ++q) pm[q] = 0.f; }
        if (t < L - 1) { unpack8(*(const u32x4*)(pr + NPROJ + c0), xa); unpack8(*(const u32x4*)(pr + NPROJ + 1024 + c0), gc_);
#pragma unroll
            for (int q = 0; q < 8; ++q) pn[q] = gc_[q] * xa[q]; }
        else {
#pragma unroll
            for (int q = 0; q < 8; ++q) pn[q] = 0.f; }
        u32x4 o;
        { float y[8];
#pragma unroll
            for (int q = 0; q < 8; ++q) y[q] = gb[q] * (cw[0][q] * pm[q] + cw[1][q] * pc[q] + cw[2][q] * pn[q]);
            o.x = pk2(y[0], y[1]); o.y = pk2(y[2], y[3]); o.z = pk2(y[4], y[5]); o.w = pk2(y[6], y[7]); }
        *(u32x4*)(Y + (size_t)r * DM + c0) = o;
        float of[8], ob[8], z[8];
        unpack8(*(const u32x4*)(pr + 1536 + c0), of); unpack8(*(const u32x4*)(pr + 2048 + c0), ob); unpack8(*(const u32x4*)(pr + 3072 + c0), z);
        float ss = 0.f;
#pragma unroll
        for (int q = 0; q < 8; ++q) { of[q] += ob[q]; ss += of[q] * of[q]; }
        ss += __shfl_xor(ss, 1); ss += __shfl_xor(ss, 2); ss += __shfl_xor(ss, 4); ss += __shfl_xor(ss, 8);
        const float rn = 1.0f / sqrtf(ss * (1.0f / 128.0f) + EPSN);
        { float y[8];
#pragma unroll
            for (int q = 0; q < 8; ++q) y[q] = of[q] * rn * gn[q] * silu_f(z[q]);
            o.x = pk2(y[0], y[1]); o.y = pk2(y[2], y[3]); o.z = pk2(y[4], y[5]); o.w = pk2(y[6], y[7]); }
        *(u32x4*)(Y + (size_t)r * DM + 512 + c0) = o;
    }
}

template <int LAYER> DI void phase_topk(PH_ARGS) {
    unsigned char* ws = A.ws;
    LAS unsigned* vals = (LAS unsigned*)lds; LAS unsigned* hist = (LAS unsigned*)(lds + 32768); LAS unsigned* misc = (LAS unsigned*)(lds + 34816);
    LAS unsigned* wsum = (LAS unsigned*)(lds + 35840); LAS int* slist = (LAS int*)(lds + 36864);
    const int SPE = LAYER ? SPE1 : SPE0; const int NTASK = LAYER ? 64 : 128;
    const bf16* H = (const bf16*)(ws + WS_H); bf16* XE = (bf16*)(ws + WS_G + (LAYER ? 192 * MiB : 0));
    float* gatev = (float*)(ws + WS_GATEV); int* INV = (int*)(ws + WS_INV);
    for (int task = bx; task < NTASK; task += G) {
        const int seqsel = task >> 6, b = (task >> 4) & 3, e = task & 15;
        const int n = seqsel ? CTXL : SEQL, cap = seqsel ? 32 : 1024;
        const float* af = (const float*)(ws + WS_AFFT) + (seqsel ? 524288 + (size_t)((b * 16 + e)) * 256 : (size_t)((b * 16 + e)) * 8192);
        const int rowbase = seqsel ? RL + b * CTXL : b * SEQL;
        const int slotbase = e * SPE + (seqsel ? 4096 + b * 32 : b * 1024);
        for (int i = tid; i < n; i += NTHR) vals[i] = __float_as_uint(af[i]);
        __syncthreads();
        unsigned prefix = 0u; int remaining = cap;
#pragma unroll 1
        for (int pass = 3; pass >= 0; --pass) { const int shift = pass * 8;
            if (tid < 256) hist[tid] = 0u;
            __syncthreads();
            for (int i = tid; i < n; i += NTHR) { const unsigned vv = vals[i]; const bool match = (pass == 3) || (((vv ^ prefix) >> (shift + 8)) == 0u); if (match) __hip_atomic_fetch_add(&hist[(vv >> shift) & 255u], 1u, __ATOMIC_RELAXED, __HIP_MEMORY_SCOPE_WORKGROUP); }
            __syncthreads();
            if (tid == 0) { int cum = 0, dsel = 0, rem = remaining;
                for (int d = 255; d >= 0; --d) { const int hc = (int)hist[d]; if (cum + hc >= remaining) { dsel = d; rem = remaining - cum; break; } cum += hc; }
                misc[0] = (unsigned)dsel; misc[1] = (unsigned)rem; }
            __syncthreads();
            prefix |= misc[0] << shift; remaining = (int)misc[1];
            __syncthreads();
        }
        const int per = seqsel ? 1 : 16; const int i0 = tid * per; const bool act = i0 < n;
        int cgt = 0, ceq = 0;
        if (act) for (int q = 0; q < per; ++q) { const unsigned vv = vals[i0 + q]; cgt += (vv > prefix); ceq += (vv == prefix); }
        unsigned pk = (unsigned)cgt | ((unsigned)ceq << 16), inc = pk;
#pragma unroll
        for (int o = 1; o < 64; o <<= 1) { const unsigned tv = __shfl_up(inc, o); if (lane >= o) inc += tv; }
        if (lane == 63) wsum[wave] = inc;
        __syncthreads();
        unsigned woff = 0u;
#pragma unroll
        for (int w = 0; w < NWAVES; ++w) { const unsigned s = wsum[w]; if (w < wave) woff += s; }
        const unsigned exc = woff + inc - pk; int gt_before = (int)(exc & 0xffffu), eq_before = (int)(exc >> 16);
        if (act) for (int q = 0; q < per; ++q) { const int i = i0 + q; const unsigned vv = vals[i]; int slot = -1;
            if (vv > prefix) { slot = gt_before + (eq_before < remaining ? eq_before : remaining); ++gt_before; }
            else if (vv == prefix) { if (eq_before < remaining) slot = gt_before + eq_before; ++eq_before; }
            INV[(size_t)(rowbase + i) * 16 + e] = slot >= 0 ? slotbase + slot : -1;
            if (slot >= 0) { slist[slot] = i; gatev[slotbase + slot] = __uint_as_float(vv); } }
        __syncthreads();
        for (int s = wave; s < cap; s += NWAVES) { const int tk = slist[s]; const u32x4* src = (const u32x4*)(H + (size_t)(rowbase + tk) * DM); u32x4* dst = (u32x4*)(XE + (size_t)(slotbase + s) * DM);
            dst[lane] = src[lane]; dst[64 + lane] = src[64 + lane]; }
        if (LAYER == 0 && seqsel == 1 && b == 0) {
            for (int s = wave; s < 128; s += NWAVES) { u32x4* dst = (u32x4*)(XE + (size_t)(e * SPE + 4224 + s) * DM); dst[lane] = (u32x4){0u, 0u, 0u, 0u}; dst[64 + lane] = (u32x4){0u, 0u, 0u, 0u}; }
            if (tid < 128) gatev[e * SPE + 4224 + tid] = 0.f; }
        __syncthreads();
    }
    if (LAYER == 1) expert_queue(A, lds, lane, wave, (unsigned*)(ws + WS_CTL) + CW_Q1, A.in[31], A.in[32], A.in[33], (bf16*)(ws + WS_G), (bf16*)(ws + WS_G + 128 * MiB));
}

template <int LAYER> DI void phase_combine(PH_ARGS) {
    unsigned char* ws = A.ws;
    const bf16* YE = (const bf16*)(LAYER ? ws + WS_E0 : ws + WS_G + 192 * MiB);
    const int* INV = (const int*)(ws + WS_INV);
    const float* mv = (const float*)(ws + WS_MODV) + LAYER * 5 * 6144;
    const int NR = LAYER ? RL : RT;
    for (int r = bx * NWAVES + wave; r < NR; r += G * NWAVES) {
        float* xr = resid_ptr(A.out, (float*)(ws + WS_XC), r); const int bb = row_bb(r);
        f32x4 v[4]; load_row_f32(xr, v, lane);
        moe_combine_row(v, INV + (size_t)r * 16, YE, mv + bb * 6144 + 5 * 1024, lane);
        if (LAYER == 0) {
#pragma unroll
            for (int j = 0; j < 4; ++j) *(f32x4*)(xr + 256 * j + 4 * lane) = v[j];
            const float* m1 = (const float*)(ws + WS_MODV) + 5 * 6144 + bb * 6144;
            modulate_row(v, A.in[21], m1, m1 + 1024, lane);
            store_row_bf16((bf16*)(ws + WS_H) + (size_t)r * DM, v, lane);
        } else {
            float ss = 0.f;
#pragma unroll
            for (int j = 0; j < 4; ++j) ss += (v[j][0] * v[j][0] + v[j][1] * v[j][1]) + (v[j][2] * v[j][2] + v[j][3] * v[j][3]);
            const float rstd = 1.0f / sqrtf(wave_sum(ss) * (1.0f / DM) + EPSN);
#pragma unroll
            for (int j = 0; j < 4; ++j) { const f32x4 w = *(const f32x4*)(A.in[34] + 256 * j + 4 * lane); *(f32x4*)(xr + 256 * j + 4 * lane) = v[j] * rstd * w; }
        }
    }
}

DI int swv(int dv, int c8, int half) { return dv * 128 + ((c8 ^ ((dv >> 1) & 7)) << 4) + ((half ^ ((dv >> 4) & 1)) << 3); }
DI void phase_attn(PH_ARGS) {
    unsigned char* ws = A.ws;
    const bf16* QK = (const bf16*)(ws + WS_BIG); const bf16* VTg = (const bf16*)(ws + WS_BIG + 132 * MiB); bf16* ATT = (bf16*)(ws + WS_H);
    const int r32 = lane & 31, hi = lane >> 5; const int isub = wave >> 2, rg = wave & 3;
    float lam;
    { const float s1 = wave_sum(A.in[23][lane] * A.in[24][lane]), s2 = wave_sum(A.in[25][lane] * A.in[26][lane]); lam = __expf(s1) - __expf(s2) + LAM_INIT; }
    const int vcu = (G % 8 == 0) ? (bx % 8) * (G / 8) + bx / 8 : bx;
    for (int u = vcu; u < 2048; u += G) {
        const int bh = u >> 6, b = bh >> 3, h = bh & 7, q0 = (u & 63) * 128;
        const int qrow = b * SEQL + q0 + 32 * rg + r32;
        bf16x8 qf[4];
#pragma unroll
        for (int kk = 0; kk < 4; ++kk) qf[kk] = *(const bf16x8*)(QK + (size_t)qrow * 2048 + h * 128 + isub * 64 + 16 * kk + 8 * hi);
        const int kkey0 = tid >> 4, kcc = tid & 15; const int vdv0 = tid >> 3, vc8 = tid & 7;
        const bf16* kg = QK + 1024 + h * 128 + kcc * 8; const bf16* vg = VTg + (size_t)(h * 128 + vdv0) * RT + vc8 * 8;
        const int kl0 = (kcc >> 3) * 8192 + sw64(kkey0, kcc & 7), kl1 = (kcc >> 3) * 8192 + sw64(kkey0 + 32, kcc & 7);
        const int vl0 = 16384 + sw64(vdv0, vc8), vl1 = 16384 + sw64(vdv0 + 64, vc8);
        const bool vswap0 = (vdv0 >> 4) & 1, vswap1 = ((vdv0 + 64) >> 4) & 1;
        u32x4 kr0, kr1, vr0, vr1;
#define ATT_LOAD(j) do { const int keyrow = ((j) < 4) ? (RL + b * CTXL + (j) * 64) : (b * SEQL + ((j) - 4) * 64); \
            kr0 = *(const u32x4*)(kg + (size_t)(keyrow + kkey0) * 2048); kr1 = *(const u32x4*)(kg + (size_t)(keyrow + kkey0 + 32) * 2048); \
            vr0 = *(const u32x4*)(vg + keyrow); vr1 = *(const u32x4*)(vg + (size_t)64 * RT + keyrow); } while (0)
#define ATT_STORE(buf) do { LAS unsigned char* bp = lds + (buf) * 32768; \
            *(LAS u32x4*)(bp + kl0) = kr0; *(LAS u32x4*)(bp + kl1) = kr1; \
            *(LAS u32x4*)(bp + vl0) = vswap0 ? (u32x4){vr0.z, vr0.w, vr0.x, vr0.y} : vr0; *(LAS u32x4*)(bp + vl1) = vswap1 ? (u32x4){vr1.z, vr1.w, vr1.x, vr1.y} : vr1; } while (0)
        float m_run = -1e30f, l_run = 0.f;
        f32x16 OT[4];
#pragma unroll
        for (int d = 0; d < 4; ++d)
#pragma unroll
            for (int r = 0; r < 16; ++r) OT[d][r] = 0.f;
        ATT_LOAD(0); ATT_STORE(0);
        __syncthreads();
        for (int j = 0; j < 132; ++j) {
            if (j + 1 < 132) ATT_LOAD(j + 1);
            const LAS unsigned char* bp = lds + (j & 1) * 32768; const LAS unsigned char* Kb = bp + isub * 8192; const LAS unsigned char* Vb = bp + 16384;
            f32x16 s0, s1;
#pragma unroll
            for (int r = 0; r < 16; ++r) { s0[r] = 0.f; s1[r] = 0.f; }
#pragma unroll
            for (int kk = 0; kk < 4; ++kk) { const bf16x8 a0 = *(const LAS bf16x8*)(Kb + sw64(r32, 2 * kk + hi)), a1 = *(const LAS bf16x8*)(Kb + sw64(32 + r32, 2 * kk + hi));
                s0 = MFMA32(a0, qf[kk], s0); s1 = MFMA32(a1, qf[kk], s1); }
            float mx = fmaxf(s0[0], s1[0]);
#pragma unroll
            for (int r = 1; r < 16; ++r) mx = fmaxf(mx, fmaxf(s0[r], s1[r]));
            mx = fmaxf(mx, __shfl_xor(mx, 32));
            const float mnew = fmaxf(m_run, mx);
            if (__any(mnew > m_run)) { const float al = __builtin_amdgcn_exp2f(m_run - mnew); l_run *= al;
#pragma unroll
                for (int d = 0; d < 4; ++d)
#pragma unroll
                    for (int r = 0; r < 16; ++r) OT[d][r] *= al;
                m_run = mnew; }
            float ls = 0.f;
#pragma unroll
            for (int r = 0; r < 16; ++r) { s0[r] = __builtin_amdgcn_exp2f(s0[r] - m_run); s1[r] = __builtin_amdgcn_exp2f(s1[r] - m_run); ls += s0[r] + s1[r]; }
            l_run += ls;
            bf16x8 Pb[4]; Pb[0] = pack8<0>(s0); Pb[1] = pack8<1>(s0); Pb[2] = pack8<0>(s1); Pb[3] = pack8<1>(s1);
#pragma unroll
            for (int dvb = 0; dvb < 4; ++dvb) { const int dv = 32 * dvb + r32;
#pragma unroll
                for (int js = 0; js < 4; ++js) { const u32x2 lo = *(const LAS u32x2*)(Vb + swv(dv, 2 * js, hi)), hh = *(const LAS u32x2*)(Vb + swv(dv, 2 * js + 1, hi));
                    const u32x4 av = {lo.x, lo.y, hh.x, hh.y};
                    OT[dvb] = MFMA32(__builtin_bit_cast(bf16x8, av), Pb[js], OT[dvb]); } }
            if (j + 1 < 132) ATT_STORE((j + 1) & 1);
            __syncthreads();
        }
        { const float lt = l_run + __shfl_xor(l_run, 32); const float il = 1.0f / lt;
#pragma unroll
            for (int d = 0; d < 4; ++d)
#pragma unroll
                for (int r = 0; r < 16; ++r) OT[d][r] *= il; }
        LAS float* ex = (LAS float*)lds;
        if (isub == 1) {
#pragma unroll
            for (int d = 0; d < 4; ++d)
#pragma unroll
                for (int r = 0; r < 16; ++r) ex[((rg * 4 + d) * 16 + r) * 64 + lane] = OT[d][r]; }
        __syncthreads();
        if (isub == 0) {
            float ss = 0.f;
#pragma unroll
            for (int d = 0; d < 4; ++d)
#pragma unroll
                for (int r = 0; r < 16; ++r) { const float o = OT[d][r] - lam * ex[((rg * 4 + d) * 16 + r) * 64 + lane]; OT[d][r] = o; ss += o * o; }
            ss += __shfl_xor(ss, 32);
            const float rn = (1.0f - LAM_INIT) / sqrtf(ss * (1.0f / 128.0f) + EPSN);
            bf16* orow = ATT + (size_t)qrow * DM + h * 128;
#pragma unroll
            for (int d = 0; d < 4; ++d)
#pragma unroll
                for (int g4 = 0; g4 < 4; ++g4) { const int dv = 32 * d + 8 * g4 + 4 * hi; const f32x4 w = *(const f32x4*)(A.in[27] + dv);
                    u32x2 o; o.x = pk2(OT[d][4 * g4] * rn * w[0], OT[d][4 * g4 + 1] * rn * w[1]); o.y = pk2(OT[d][4 * g4 + 2] * rn * w[2], OT[d][4 * g4 + 3] * rn * w[3]);
                    *(u32x2*)(orow + dv) = o; }
        }
        __syncthreads();
#undef ATT_LOAD
#undef ATT_STORE
    }
}

constexpr int NPHASE = 20;
__global__ void __launch_bounds__(NTHR, 2) mega_fwd(Args A) {
    extern __shared__ __attribute__((aligned(16))) unsigned char lds_raw[];
    LAS unsigned char* lds = (LAS unsigned char*)lds_raw;
    const int tid = threadIdx.x, lane = tid & 63, wave = __builtin_amdgcn_readfirstlane(tid >> 6);
    const int G = gridDim.x, bx = blockIdx.x;
    unsigned char* ws = A.ws;
    if (tid < 64) ((LAS unsigned*)(lds + LDSX))[tid] = 0u;
    __syncthreads();
    XcdBarrier bar; bar.bar = (unsigned*)(ws + WS_CTL) + CW_BAR; bar.x = 0; bar.st = nullptr;
    if (!MK_SPLIT) bar = xcd_barrier_post((unsigned*)(ws + WS_CTL) + CW_BAR, (volatile LAS unsigned*)(lds + LDSX));
    const int lo = A.ph_lo, hi_ = A.ph_hi;
#ifdef ONLY_PHASE
#define IN(k) ((k) == ONLY_PHASE && lo <= (k) && (k) < hi_)
#else
#define IN(k) (lo <= (k) && (k) < hi_)
#endif
#if defined(REPEAT_PHASE)
#define REPLOOP(k) for (int rep_ = 0, nrep_ = ((k) == REPEAT_PHASE ? A.ph_rep : 1); rep_ < nrep_; (++rep_ < nrep_) ? xcd_barrier(bar) : (void)0)
#else
#define REPLOOP(k)
#endif
#define SEAM(k) do { if (IN(k) && IN((k) + 1)) xcd_barrier(bar); } while (0)

    if (IN(0)) REPLOOP(0) { phase0(A, lds, tid, lane, wave, G, bx); } SEAM(0);
    if (IN(1)) REPLOOP(1) { phase_modulate<0, 0>(A, lds, tid, lane, wave, G, bx); } SEAM(1);
    if (IN(2)) REPLOOP(2) {
        pg8::Gemm g{(const pg8::bf16_t*)(ws + WS_H), (const pg8::bf16_t*)(ws + WS_WIN), RT, NPROJ, DM}; pg8::StaticOrder S; S.init(RT, NPROJ, G, bx);
        pg8::EpiBf16<0> E{(pg8::bf16_t*)(ws + WS_BIG), NPROJ, nullptr, 0, 0, 1.f};
        pg8::gemm_phase<pg8::EpiBf16<0>, pg8::StaticOrder, true, true>(lds, g, S, E);
    } SEAM(2);
    if (IN(3)) REPLOOP(3) { phase_gdn_prep(A, lds, tid, lane, wave, G, bx); } SEAM(3);
    if (IN(4)) REPLOOP(4) { phase_gdn_scan(A, lds, tid, lane, wave, G, bx); } SEAM(4);
    if (IN(5)) REPLOOP(5) { phase_ycat(A, lds, tid, lane, wave, G, bx); } SEAM(5);
    if (IN(6)) REPLOOP(6) {
        pg8::Gemm g{(const pg8::bf16_t*)(ws + WS_H), (const pg8::bf16_t*)(ws + WS_WOUT), RT, DM, DM}; pg8::StaticOrder S; S.init(RT, DM, G, bx);
        pg8::EpiResidual E{A.in[0], A.in[2], A.out, (float*)(ws + WS_XC), (const float*)(ws + WS_MODV) + 2 * 1024, RL};
        pg8::gemm_phase<pg8::EpiResidual, pg8::StaticOrder, true, true>(lds, g, S, E);
    } SEAM(6);
    if (IN(7)) REPLOOP(7) { phase_modulate<1, 0>(A, lds, tid, lane, wave, G, bx); } SEAM(7);
    if (IN(8)) REPLOOP(8) { phase_topk<0>(A, lds, tid, lane, wave, G, bx); } SEAM(8);
    if (IN(9)) REPLOOP(9) {
        pg8::Gemm g{(const pg8::bf16_t*)(ws + WS_G), (const pg8::bf16_t*)(ws + WS_E0), M1_0, 4096, DM}; pg8::MoeOrder S{17 * 16 * 16, G, bx, 17, 16};
        pg8::EpiMoe1 E{(pg8::bf16_t*)(ws + WS_BIG)};
        pg8::gemm_phase<pg8::EpiMoe1, pg8::MoeOrder, true, true>(lds, g, S, E);
    } SEAM(9);
    if (IN(10)) REPLOOP(10) {
        pg8::Gemm g{(const pg8::bf16_t*)(ws + WS_BIG), (const pg8::bf16_t*)(ws + WS_E0 + 128 * MiB), M1_0, DM, FFN}; pg8::MoeOrder S{17 * 16 * 4, G, bx, 17, 4};
        pg8::EpiMoe2 E{(pg8::bf16_t*)(ws + WS_G + 192 * MiB), (const float*)(ws + WS_GATEV)};
        pg8::gemm_phase<pg8::EpiMoe2, pg8::MoeOrder, true, true>(lds, g, S, E);
    } SEAM(10);
    if (IN(11)) REPLOOP(11) { phase_combine<0>(A, lds, tid, lane, wave, G, bx); } SEAM(11);
    if (IN(12)) REPLOOP(12) {
        { pg8::Gemm g{(const pg8::bf16_t*)(ws + WS_H), (const pg8::bf16_t*)(ws + WS_WQK), RT, 2048, DM}; pg8::StaticOrder S; S.init(RT, 2048, G, bx);
          pg8::EpiQK E{(pg8::bf16_t*)(ws + WS_BIG), (const float*)(ws + WS_ROPE), 0.125f * 1.4426950408889634f, RL};
          pg8::gemm_phase<pg8::EpiQK, pg8::StaticOrder, true, true>(lds, g, S, E); }
        { pg8::Gemm g{(const pg8::bf16_t*)(ws + WS_WV), (const pg8::bf16_t*)(ws + WS_H), DM, RT, DM}; pg8::StaticOrder S; S.init(DM, RT, G, bx);
          pg8::EpiBf16<0> E{(pg8::bf16_t*)(ws + WS_BIG + 132 * MiB), RT, nullptr, 0, 0, 1.f};
          pg8::gemm_phase<pg8::EpiBf16<0>, pg8::StaticOrder, true, true>(lds, g, S, E); }
    } SEAM(12);
    if (IN(13)) REPLOOP(13) { phase_attn(A, lds, tid, lane, wave, G, bx); } SEAM(13);
    if (IN(14)) REPLOOP(14) {
        pg8::Gemm g{(const pg8::bf16_t*)(ws + WS_H), (const pg8::bf16_t*)(ws + WS_WO), RL, DM, DM}; pg8::StaticOrder S; S.init(RL, DM, G, bx);
        pg8::EpiResidual E{A.out, A.out, A.out, A.out, (const float*)(ws + WS_MODV) + 5 * 6144 + 2 * 1024, RL};
        pg8::gemm_phase<pg8::EpiResidual, pg8::StaticOrder, true, true>(lds, g, S, E);
    } SEAM(14);
    if (IN(15)) REPLOOP(15) { phase_modulate<1, 1>(A, lds, tid, lane, wave, G, bx); } SEAM(15);
    if (IN(16)) REPLOOP(16) { phase_topk<1>(A, lds, tid, lane, wave, G, bx); } SEAM(16);
    if (IN(17)) REPLOOP(17) {
        pg8::Gemm g{(const pg8::bf16_t*)(ws + WS_G + 192 * MiB), (const pg8::bf16_t*)(ws + WS_G), M1_1, 4096, DM}; pg8::MoeOrder S{16 * 16 * 16, G, bx, 16, 16};
        pg8::EpiMoe1 E{(pg8::bf16_t*)(ws + WS_BIG)};
        pg8::gemm_phase<pg8::EpiMoe1, pg8::MoeOrder, true, true>(lds, g, S, E);
    } SEAM(17);
    if (IN(18)) REPLOOP(18) {
        pg8::Gemm g{(const pg8::bf16_t*)(ws + WS_BIG), (const pg8::bf16_t*)(ws + WS_G + 128 * MiB), M1_1, DM, FFN}; pg8::MoeOrder S{16 * 16 * 4, G, bx, 16, 4};
        pg8::EpiMoe2 E{(pg8::bf16_t*)(ws + WS_E0), (const float*)(ws + WS_GATEV)};
        pg8::gemm_phase<pg8::EpiMoe2, pg8::MoeOrder, true, true>(lds, g, S, E);
    } SEAM(18);
    if (IN(19)) REPLOOP(19) { phase_combine<1>(A, lds, tid, lane, wave, G, bx); }
#undef IN
#undef SEAM
}

extern "C" void kernel_launch(void* const* d_in, const int* in_sizes, int n_in, void* d_out, int out_size, void* d_ws, size_t ws_size, hipStream_t stream) {
    static int grid = 0;
    if (grid == 0) {
        if (n_in != 35 || out_size != RL * DM || ws_size < WS_END) { fprintf(stderr, "kernel_launch: unexpected problem (n_in %d, out %d, ws %zu < %zu)\n", n_in, out_size, ws_size, (size_t)WS_END); grid = -1; return; }
        int dev = 0, cus = 0, per_cu = 0;
        if (hipGetDevice(&dev) != hipSuccess || hipDeviceGetAttribute(&cus, hipDeviceAttributeMultiprocessorCount, dev) != hipSuccess) { grid = -1; return; }
        if (hipFuncSetAttribute((const void*)mega_fwd, hipFuncAttributeMaxDynamicSharedMemorySize, LDS_BYTES) != hipSuccess) { fprintf(stderr, "kernel_launch: hipFuncSetAttribute failed\n"); grid = -1; return; }
        if (hipOccupancyMaxActiveBlocksPerMultiprocessor(&per_cu, (const void*)mega_fwd, NTHR, LDS_BYTES) != hipSuccess || per_cu < 1) { fprintf(stderr, "kernel_launch: occupancy query reports %d\n", per_cu); }
        (void)hipGetLastError();
        grid = cus;
    }
    if (grid < 0) return;
    if (hipMemsetAsync((char*)d_ws + WS_CTL, 0, CTL_ZERO_BYTES, stream) != hipSuccess) return;
    Args a{};
    for (int i = 0; i < 35; ++i) a.in[i] = (const float*)d_in[i];
    a.out = (float*)d_out; a.ws = (unsigned char*)d_ws;
#if MK_SPLIT
    for (int p = 0; p < NPHASE; ++p) { a.ph_lo = p; a.ph_hi = p + 1; hipLaunchKernelGGL(mega_fwd, dim3(grid), dim3(NTHR), LDS_BYTES, stream, a); }
#else
    a.ph_lo = 0; a.ph_hi = NPHASE; a.ph_rep = 2;
    hipLaunchKernelGGL(mega_fwd, dim3(grid), dim3(NTHR), LDS_BYTES, stream, a);
#endif
}
```

```cpp
#include <hip/hip_runtime.h>
#include <cstdio>
#include <cstdint>
#ifndef MK_SPLIT
#define MK_SPLIT 0
#endif

namespace pg8 {
#define PG8_LAS __attribute__((address_space(3)))
typedef unsigned short bf16_t;
typedef short bf16x8 __attribute__((ext_vector_type(8)));
typedef float f32x4 __attribute__((ext_vector_type(4)));
typedef unsigned u32x4 __attribute__((ext_vector_type(4)));
constexpr int BM = 256, BK = 64, HALF = 128, HTB = HALF * BK * 2  , STAGE_BYTES = 8 * HTB, NXCD = 8, WGM = 8;

__host__ __device__ __forceinline__ int lds_byte(int r, int c) { const int st = (r >> 4) * 2 + (c >> 5), rr = r & 15, cc = c & 31, ob = rr * 64 + cc * 2; return st * 1024 + (ob ^ (((ob >> 9) & 1) << 5)); }
__host__ __device__ __forceinline__ void stage_rc(int b, int& R, int& C) { const int st = b / 1024, sb = b % 1024, swz = sb ^ (((sb >> 9) & 1) << 5); R = (st >> 1) * 16 + swz / 64; C = (st & 1) * 32 + (swz % 64) / 2; }
__host__ __device__ __forceinline__ int perm32(int rho) { const int n = rho >> 4, i = rho & 15; return 8 * (i >> 2) + 4 * n + (i & 3); }

struct Unit { int pm, pn; };
struct Gemm { const bf16_t* A; const bf16_t* Bt; int M, N, K; };

struct StaticOrder {
    int nM, nN, nwg, G, c;
    __host__ __device__ void init(int M, int N, int G_, int c_) { nM = M / BM; nN = N / BM; nwg = nM * nN; G = G_; c = c_; }
    __host__ __device__ bool next(int i, Unit& u) const {
        const long L = (long)i * G + c; if (L >= nwg) return false;
        int wgid = (int)L; { const int q = nwg / NXCD, r = nwg % NXCD, xcd = wgid % NXCD, off = wgid / NXCD; wgid = (xcd < r ? xcd * (q + 1) : r * (q + 1) + (xcd - r) * q) + off; }
        const int nig = WGM * nN, gid = wgid / nig, fm = gid * WGM, gsz = (nM - fm) < WGM ? (nM - fm) : WGM;
        u.pm = fm + ((wgid % nig) % gsz); u.pn = (wgid % nig) / gsz; return true;
    }
    __device__ __forceinline__ void a_ready(const Unit&) const {}
    __device__ __forceinline__ void done(const Unit&) const {}
};

__device__ __forceinline__ unsigned cvt_pk_bf16(float lo, float hi) { unsigned r; asm volatile("v_cvt_pk_bf16_f32 %0, %1, %2" : "=v"(r) : "v"(lo), "v"(hi)); return r; }
typedef float f32x2 __attribute__((ext_vector_type(2)));
__device__ __forceinline__ f32x2 gelu_pk(f32x2 v) {
    const f32x2 av = __builtin_elementwise_abs(v), d = av * 0.2316418882f + 1.0f;
    f32x2 t; t.x = __builtin_amdgcn_rcpf(d.x); t.y = __builtin_amdgcn_rcpf(d.y);
    f32x2 q = t * 0.5307027145f + (-0.7265760135f); q = q * t + 0.7107068705f; q = q * t + (-0.142248368f); q = q * t + 0.127414796f; q = q * t;
    const f32x2 s = (v * v) * (-0.72134752044f);
    f32x2 e; e.x = __builtin_amdgcn_exp2f(s.x); e.y = __builtin_amdgcn_exp2f(s.y);
    const f32x2 m = v * (q * e), r = v - m;
    f32x2 o; o.x = v.x < 0.f ? m.x : r.x; o.y = v.y < 0.f ? m.y : r.y; return o;
}

template <int ACT  > struct EpiBf16 {
    static constexpr bool PERM = true, AFTER_DRAIN = false; static_assert(ACT == 0 || ACT == 1, "EpiBf16: ACT is 0 (none) or 1 (gelu_pk)");
    bf16_t* O; int ldc; const float* bias; int split_cols; size_t split_stride; float scale0;
    __device__ __forceinline__ void operator()(const f32x4 (&acc)[2][2][4][2], const Unit& u, int wr, int wc, int fr, int fq) const {
        const int row0 = u.pm * BM + wr * 64 + fr; int colt = u.pn * BM; bf16_t* base = O;
        float sc = 1.f; if (split_cols) { const int t = colt / split_cols; base += (size_t)t * split_stride; colt -= t * split_cols; if (t == 0) sc = scale0; }
        const int col0 = colt + wc * 32 + 8 * fq, bcol0 = u.pn * BM + wc * 32 + 8 * fq;
        f32x4 bv[2][2];
#pragma unroll
        for (int bj = 0; bj < 2; ++bj)
#pragma unroll
            for (int n = 0; n < 2; ++n) bv[bj][n] = bias ? *(const f32x4*)(bias + bcol0 + bj * HALF + 4 * n) : (f32x4){0.f, 0.f, 0.f, 0.f};
#pragma unroll
        for (int ai = 0; ai < 2; ++ai)
#pragma unroll
            for (int m = 0; m < 4; ++m) { bf16_t* rowp = base + (size_t)(row0 + ai * HALF + m * 16) * ldc + col0;
#pragma unroll
                for (int bj = 0; bj < 2; ++bj) { f32x4 v0 = acc[ai][bj][m][0] + bv[bj][0], v1 = acc[ai][bj][m][1] + bv[bj][1];
                    if (ACT == 1) { f32x2 a = gelu_pk((f32x2){v0[0], v0[1]}), b = gelu_pk((f32x2){v0[2], v0[3]}), c = gelu_pk((f32x2){v1[0], v1[1]}), d = gelu_pk((f32x2){v1[2], v1[3]});
                        v0 = (f32x4){a.x, a.y, b.x, b.y}; v1 = (f32x4){c.x, c.y, d.x, d.y}; }
                    v0 = v0 * sc; v1 = v1 * sc; u32x4 w; w.x = cvt_pk_bf16(v0[0], v0[1]); w.y = cvt_pk_bf16(v0[2], v0[3]); w.z = cvt_pk_bf16(v1[0], v1[1]); w.w = cvt_pk_bf16(v1[2], v1[3]);
                    *(u32x4*)(rowp + bj * HALF) = w; } }
    }
};

__device__ __forceinline__ float silu_fast(float x) { return x * __builtin_amdgcn_rcpf(1.0f + __builtin_amdgcn_exp2f(-1.4426950408889634f * x)); }
struct EpiResidual {
    static constexpr bool PERM = false, AFTER_DRAIN = false;
    const float* base_lat; const float* base_ctx; float* out_lat; float* out_ctx; const float* gate; int RL;
    __device__ __forceinline__ void operator()(const f32x4 (&acc)[2][2][4][2], const Unit& u, int wr, int wc, int fr, int fq) const {
        const int col0 = u.pn * BM + wc * 32 + 4 * fq;
#pragma unroll
        for (int ai = 0; ai < 2; ++ai)
#pragma unroll
            for (int m = 0; m < 4; ++m) {
                const int row = u.pm * BM + ai * HALF + wr * 64 + m * 16 + fr;
                const bool lat = row < RL; const int rr = lat ? row : row - RL; const int bb = lat ? (row >> 13) : 4;
                const float* bp = (lat ? base_lat : base_ctx) + (size_t)rr * 1024 + col0; float* op = (lat ? out_lat : out_ctx) + (size_t)rr * 1024 + col0;
                const float* gp = gate + bb * 6144 + col0;
#pragma unroll
                for (int bj = 0; bj < 2; ++bj)
#pragma unroll
                    for (int n = 0; n < 2; ++n) { const int c = bj * HALF + n * 16; const f32x4 g = *(const f32x4*)(gp + c), b = *(const f32x4*)(bp + c); *(f32x4*)(op + c) = b + g * acc[ai][bj][m][n]; }
            }
    }
};
struct EpiMoe1 {
    static constexpr bool PERM = true, AFTER_DRAIN = false;
    bf16_t* O;
    __device__ __forceinline__ void operator()(const f32x4 (&acc)[2][2][4][2], const Unit& u, int wr, int wc, int fr, int fq) const {
        const int row0 = u.pm * BM + wr * 64 + fr; const int hcol0 = (u.pn & 15) * 128 + wc * 32 + 8 * fq;
#pragma unroll
        for (int ai = 0; ai < 2; ++ai)
#pragma unroll
            for (int m = 0; m < 4; ++m) { bf16_t* rowp = O + (size_t)(row0 + ai * HALF + m * 16) * 2048 + hcol0;
                const f32x4 g0 = acc[ai][0][m][0], g1 = acc[ai][0][m][1], u0 = acc[ai][1][m][0], u1 = acc[ai][1][m][1];
                u32x4 w; w.x = cvt_pk_bf16(silu_fast(g0[0]) * u0[0], silu_fast(g0[1]) * u0[1]); w.y = cvt_pk_bf16(silu_fast(g0[2]) * u0[2], silu_fast(g0[3]) * u0[3]);
                w.z = cvt_pk_bf16(silu_fast(g1[0]) * u1[0], silu_fast(g1[1]) * u1[1]); w.w = cvt_pk_bf16(silu_fast(g1[2]) * u1[2], silu_fast(g1[3]) * u1[3]);
                *(u32x4*)rowp = w; }
    }
};
struct EpiMoe2 {
    static constexpr bool PERM = true, AFTER_DRAIN = false;
    bf16_t* O; const float* gatev;
    __device__ __forceinline__ void operator()(const f32x4 (&acc)[2][2][4][2], const Unit& u, int wr, int wc, int fr, int fq) const {
        const int row0 = u.pm * BM + wr * 64 + fr; const int col0 = (u.pn & 3) * BM + wc * 32 + 8 * fq;
#pragma unroll
        for (int ai = 0; ai < 2; ++ai)
#pragma unroll
            for (int m = 0; m < 4; ++m) { const int row = row0 + ai * HALF + m * 16; const float gv = gatev[row]; bf16_t* rowp = O + (size_t)row * 1024 + col0;
#pragma unroll
                for (int bj = 0; bj < 2; ++bj) { const f32x4 v0 = acc[ai][bj][m][0] * gv, v1 = acc[ai][bj][m][1] * gv;
                    u32x4 w; w.x = cvt_pk_bf16(v0[0], v0[1]); w.y = cvt_pk_bf16(v0[2], v0[3]); w.z = cvt_pk_bf16(v1[0], v1[1]); w.w = cvt_pk_bf16(v1[2], v1[3]);
                    *(u32x4*)(rowp + bj * HALF) = w; } }
    }
};
struct EpiQK {
    static constexpr bool PERM = true, AFTER_DRAIN = false;
    bf16_t* O; const float* rope; float qscale; int RL;
    __device__ __forceinline__ void operator()(const f32x4 (&acc)[2][2][4][2], const Unit& u, int wr, int wc, int fr, int fq) const {
        const int row0 = u.pm * BM + wr * 64 + fr; const int colb = u.pn * BM + wc * 32 + 8 * fq;
#pragma unroll
        for (int ai = 0; ai < 2; ++ai)
#pragma unroll
            for (int m = 0; m < 4; ++m) { const int row = row0 + ai * HALF + m * 16; const bool lat = row < RL; const int t = row & 8191; const int pr = t >> 6, pc = t & 63;
#pragma unroll
                for (int bj = 0; bj < 2; ++bj) { const int col = colb + bj * HALF; f32x4 v0 = acc[ai][bj][m][0], v1 = acc[ai][bj][m][1];
                    if (lat) { const int half = (col >> 5) & 1, j0 = (col & 31) >> 1;
                        const float* cp = rope + (half ? 4096 + pc * 16 : pr * 16) + j0; const float* sp = cp + (half ? 1024 : 2048);
                        const f32x4 c = *(const f32x4*)cp, s = *(const f32x4*)sp;
                        f32x4 a, b;
                        a[0] = v0[0] * c[0] - v0[1] * s[0]; a[1] = v0[1] * c[0] + v0[0] * s[0]; a[2] = v0[2] * c[1] - v0[3] * s[1]; a[3] = v0[3] * c[1] + v0[2] * s[1];
                        b[0] = v1[0] * c[2] - v1[1] * s[2]; b[1] = v1[1] * c[2] + v1[0] * s[2]; b[2] = v1[2] * c[3] - v1[3] * s[3]; b[3] = v1[3] * c[3] + v1[2] * s[3];
                        v0 = a; v1 = b; }
                    const float sc = (col < 1024) ? qscale : 1.0f; v0 = v0 * sc; v1 = v1 * sc;
                    u32x4 w; w.x = cvt_pk_bf16(v0[0], v0[1]); w.y = cvt_pk_bf16(v0[2], v0[3]); w.z = cvt_pk_bf16(v1[0], v1[1]); w.w = cvt_pk_bf16(v1[2], v1[3]);
                    *(u32x4*)(O + (size_t)row * 2048 + col) = w; } }
    }
};
struct MoeOrder {
    int total, G, c, tiles_pe, ncol;
    __device__ __forceinline__ bool next(int i, Unit& u) const {
        const long L = (long)i * G + c; if (L >= total) return false;
        const int per = tiles_pe * ncol; const int e = (int)L / per, rem = (int)L % per; const int pml = rem % tiles_pe, pnl = rem / tiles_pe;
        u.pm = e * tiles_pe + pml; u.pn = e * ncol + pnl; return true; }
    __device__ __forceinline__ void a_ready(const Unit&) const {}
    __device__ __forceinline__ void done(const Unit&) const {}
};
template <class Epi, class Sched, bool ALIGN_EPI = false, bool SP2 = false>
__device__ __forceinline__ void gemm_phase(PG8_LAS unsigned char* lds, const Gemm g, const Sched& S, const Epi& E) {
    const int tid = threadIdx.x, wid = __builtin_amdgcn_readfirstlane(tid >> 6), lane = tid & 63, wr = wid >> 2, wc = wid & 3, fr = lane & 15, fq = lane >> 4;
    const int K = g.K, nt = K / BK;
    unsigned voffA[2], voffB[2];
#pragma unroll
    for (int i = 0; i < 2; ++i) { int R, C; stage_rc(tid * 16 + i * 8192, R, C); const int Rb = Epi::PERM ? ((R & ~31) + perm32(R & 31)) : R;
        voffA[i] = (unsigned)(R * K + C) * 2u; voffB[i] = (unsigned)(Rb * K + C) * 2u; }
    const size_t kstep = (size_t)(BK * 2);
    const size_t hstep = (size_t)HALF * K * 2;
    const size_t tstep = 2 * hstep;
    const unsigned ldsw = (unsigned)wid * 1024u;
    const int aoff = lds_byte(wr * 64 + fr, fq * 8), boff = lds_byte(wc * 32 + fr, fq * 8);
#define PG8_SA(b, h) (((b) * 2 + (h)) * HTB)
#define PG8_SB(b, h) ((4 + (b) * 2 + (h)) * HTB)
#define PG8_STAGE(bufoff, gbase, voff) do { _Pragma("unroll") for (int _i = 0; _i < 2; ++_i) \
        __builtin_amdgcn_global_load_lds((const unsigned*)((const char*)(gbase) + (voff)[_i]), (PG8_LAS unsigned*)(lds + (bufoff) + ldsw + _i * 8192), 16, 0, 0); } while (0)
#define PG8_LDA(dst, b, h) do { _Pragma("unroll") for (int m = 0; m < 4; ++m) _Pragma("unroll") for (int k = 0; k < 2; ++k) dst[m][k] = *(const PG8_LAS bf16x8*)(lds + PG8_SA(b, h) + aoff + m * 2048 + k * 1024); } while (0)
#define PG8_LDB(dst, b, h) do { _Pragma("unroll") for (int n = 0; n < 2; ++n) _Pragma("unroll") for (int k = 0; k < 2; ++k) dst[n][k] = *(const PG8_LAS bf16x8*)(lds + PG8_SB(b, h) + boff + n * 2048 + k * 1024); } while (0)
#define PG8_MMA(ai, bj, At, Bt) do { __builtin_amdgcn_s_setprio(1); _Pragma("unroll") for (int m = 0; m < 4; ++m) _Pragma("unroll") for (int n = 0; n < 2; ++n) _Pragma("unroll") for (int k = 0; k < 2; ++k) \
        acc[ai][bj][m][n] = __builtin_amdgcn_mfma_f32_16x16x32_bf16(Bt[n][k], At[m][k], acc[ai][bj][m][n], 0, 0, 0); __builtin_amdgcn_s_setprio(0); } while (0)
#define PG8_WAIT_V(n) asm volatile("s_waitcnt vmcnt(" #n ")" ::: "memory")
#define PG8_WAIT_L(n) asm volatile("s_waitcnt lgkmcnt(" #n ")" ::: "memory")
#define PG8_BAR __builtin_amdgcn_s_barrier()
#define PG8_SCHED __builtin_amdgcn_sched_barrier(0)
    Unit cur, nxt; int ui = 0;
    if (!S.next(0, cur)) return;
    f32x4 acc[2][2][4][2];
#pragma unroll
    for (int a = 0; a < 2; ++a)
#pragma unroll
        for (int b = 0; b < 2; ++b)
#pragma unroll
            for (int m = 0; m < 4; ++m)
#pragma unroll
                for (int n = 0; n < 2; ++n) acc[a][b][m][n] = (f32x4){0.f, 0.f, 0.f, 0.f};
    bf16x8 At[4][2], B0[2][2], B1[2][2];
    const char* cA = (const char*)g.A + (size_t)cur.pm * tstep; const char* cB = (const char*)g.Bt + (size_t)cur.pn * tstep;
    S.a_ready(cur);
    if constexpr (SP2) {
        PG8_STAGE(PG8_SB(0, 0), cB, voffB); PG8_STAGE(PG8_SB(0, 1), cB + hstep, voffB); PG8_STAGE(PG8_SA(0, 0), cA, voffA); PG8_STAGE(PG8_SA(0, 1), cA + hstep, voffA);
        if (wr == 1) PG8_BAR;
        PG8_WAIT_V(2); PG8_BAR;
        PG8_STAGE(PG8_SB(1, 0), cB + kstep, voffB); PG8_STAGE(PG8_SA(1, 0), cA + kstep, voffA); PG8_STAGE(PG8_SB(1, 1), cB + hstep + kstep, voffB);
        PG8_WAIT_V(6); PG8_BAR;
    } else {
        PG8_STAGE(PG8_SB(0, 0), cB, voffB); PG8_STAGE(PG8_SA(0, 0), cA, voffA); PG8_STAGE(PG8_SB(0, 1), cB + hstep, voffB); PG8_STAGE(PG8_SA(0, 1), cA + hstep, voffA);
        if (wr == 1) PG8_BAR;
        PG8_WAIT_V(4); PG8_BAR;
        PG8_STAGE(PG8_SB(1, 0), cB + kstep, voffB); PG8_STAGE(PG8_SA(1, 0), cA + kstep, voffA); PG8_STAGE(PG8_SB(1, 1), cB + hstep + kstep, voffB);
        PG8_WAIT_V(6); PG8_BAR;
    }
    for (;;) {
        const bool has_next = S.next(ui + 1, nxt);
        const char* nA = has_next ? (const char*)g.A + (size_t)nxt.pm * tstep : cA; const char* nB = has_next ? (const char*)g.Bt + (size_t)nxt.pn * tstep : cB;
        for (int t = 0; t < nt; t += 2) {
            const bool last = (t == nt - 2);
            const char* a1 = cA + (size_t)(t + 1) * kstep;
            const char* a2 = last ? nA : cA + (size_t)(t + 2) * kstep; const char* b2 = last ? nB : cB + (size_t)(t + 2) * kstep;
            const char* a3 = a2 + kstep; const char* b3 = b2 + kstep;
            if (last && has_next) S.a_ready(nxt);
            if constexpr (SP2) {
            PG8_LDB(B0, 0, 0); PG8_LDB(B1, 0, 1); PG8_SCHED; PG8_LDA(At, 0, 0); PG8_STAGE(PG8_SA(1, 1), a1 + hstep, voffA);
            PG8_WAIT_V(8); PG8_WAIT_L(0); PG8_BAR; PG8_MMA(0, 0, At, B0); PG8_MMA(0, 1, At, B1); PG8_BAR; PG8_SCHED;
            PG8_LDA(At, 0, 1); PG8_STAGE(PG8_SB(0, 0), b2, voffB); PG8_STAGE(PG8_SB(0, 1), b2 + hstep, voffB); PG8_STAGE(PG8_SA(0, 0), a2, voffA);
            PG8_WAIT_V(8); PG8_WAIT_L(0); PG8_BAR; PG8_MMA(1, 0, At, B0); PG8_MMA(1, 1, At, B1); PG8_BAR; PG8_SCHED;
            PG8_LDB(B0, 1, 0); PG8_LDB(B1, 1, 1); PG8_SCHED; PG8_LDA(At, 1, 0); PG8_STAGE(PG8_SA(0, 1), a2 + hstep, voffA);
            PG8_WAIT_V(8); PG8_WAIT_L(0); PG8_BAR; PG8_MMA(0, 0, At, B0); PG8_MMA(0, 1, At, B1); PG8_BAR; PG8_SCHED;
            PG8_LDA(At, 1, 1); PG8_STAGE(PG8_SB(1, 0), b3, voffB); PG8_STAGE(PG8_SB(1, 1), b3 + hstep, voffB); PG8_STAGE(PG8_SA(1, 0), a3, voffA);
            PG8_WAIT_V(8); PG8_WAIT_L(0); PG8_BAR; PG8_MMA(1, 0, At, B0); PG8_MMA(1, 1, At, B1); PG8_BAR; PG8_SCHED;
            } else {
            PG8_LDB(B0, 0, 0); PG8_SCHED; PG8_LDA(At, 0, 0); PG8_STAGE(PG8_SA(1, 1), a1 + hstep, voffA);
            PG8_WAIT_L(8); PG8_BAR; PG8_WAIT_L(0); PG8_MMA(0, 0, At, B0); PG8_BAR; PG8_SCHED;
            PG8_LDB(B1, 0, 1); PG8_STAGE(PG8_SB(0, 0), b2, voffB);
            PG8_BAR; PG8_WAIT_L(0); PG8_MMA(0, 1, At, B1); PG8_BAR;
            PG8_LDA(At, 0, 1); PG8_STAGE(PG8_SA(0, 0), a2, voffA);
            PG8_BAR; PG8_WAIT_L(0); PG8_MMA(1, 0, At, B0); PG8_BAR; PG8_SCHED;
            PG8_STAGE(PG8_SB(0, 1), b2 + hstep, voffB);
            PG8_WAIT_V(6); PG8_BAR; PG8_MMA(1, 1, At, B1); PG8_BAR;
            PG8_LDB(B0, 1, 0); PG8_SCHED; PG8_LDA(At, 1, 0); PG8_STAGE(PG8_SA(0, 1), a2 + hstep, voffA);
            PG8_WAIT_L(8); PG8_BAR; PG8_WAIT_L(0); PG8_MMA(0, 0, At, B0); PG8_BAR; PG8_SCHED;
            PG8_LDB(B1, 1, 1); PG8_STAGE(PG8_SB(1, 0), b3, voffB);
            PG8_BAR; PG8_WAIT_L(0); PG8_MMA(0, 1, At, B1); PG8_BAR;
            PG8_LDA(At, 1, 1); PG8_STAGE(PG8_SA(1, 0), a3, voffA);
            PG8_BAR; PG8_WAIT_L(0); PG8_MMA(1, 0, At, B0); PG8_BAR; PG8_SCHED;
            PG8_STAGE(PG8_SB(1, 1), b3 + hstep, voffB);
            PG8_WAIT_V(6); PG8_BAR; PG8_MMA(1, 1, At, B1); PG8_BAR;
            }
        }
        if constexpr (ALIGN_EPI) { if (wr == 0) PG8_BAR; }
        if constexpr (!Epi::AFTER_DRAIN) { E(acc, cur, wr, wc, fr, fq); S.done(cur); }
        if (!has_next) break;
#pragma unroll
        for (int a = 0; a < 2; ++a)
#pragma unroll
            for (int b = 0; b < 2; ++b)
#pragma unroll
                for (int m = 0; m < 4; ++m)
#pragma unroll
                    for (int n = 0; n < 2; ++n) acc[a][b][m][n] = (f32x4){0.f, 0.f, 0.f, 0.f};
        cur = nxt; cA = nA; cB = nB; ++ui;
        if constexpr (ALIGN_EPI) { if (wr == 1) PG8_BAR; }
    }
    PG8_WAIT_V(0);
    if constexpr (!ALIGN_EPI) { if (wr == 0) PG8_BAR; }
    PG8_BAR;
    if constexpr (Epi::AFTER_DRAIN) { E.fused(acc, cur, wr, wc, fr, fq, lds, wid, lane); S.done(cur); }
#undef PG8_SA
#undef PG8_SB
#undef PG8_STAGE
#undef PG8_LDA
#undef PG8_LDB
#undef PG8_MMA
#undef PG8_WAIT_V
#undef PG8_WAIT_L
#undef PG8_BAR
#undef PG8_SCHED
}
}

#define GAS __attribute__((address_space(1)))
#define LAS __attribute__((address_space(3)))
#define DI __device__ __forceinline__
typedef unsigned short bf16;
typedef float f32x4 __attribute__((ext_vector_type(4)));
typedef float f32x2 __attribute__((ext_vector_type(2)));
typedef float f32x16 __attribute__((ext_vector_type(16)));
typedef short bf16x8 __attribute__((ext_vector_type(8)));
typedef unsigned u32x4 __attribute__((ext_vector_type(4)));
typedef unsigned u32x2 __attribute__((ext_vector_type(2)));
typedef __bf16 bf16x2_t __attribute__((ext_vector_type(2)));
#define LDS_WAIT() asm volatile("s_waitcnt lgkmcnt(0)" ::: "memory")
#define MFMA32(a, b, c) __builtin_amdgcn_mfma_f32_32x32x16_bf16((a), (b), (c), 0, 0, 0)
DI unsigned pk2(float lo, float hi) { f32x2 v = {lo, hi}; bf16x2_t b = __builtin_convertvector(v, bf16x2_t); return __builtin_bit_cast(unsigned, b); }
DI float bflo(unsigned w) { return __uint_as_float(w << 16); }
DI float bfhi(unsigned w) { return __uint_as_float(w & 0xffff0000u); }
DI int crow(int r, int hi) { return (r & 3) + 8 * (r >> 2) + 4 * hi; }
DI float wave_sum(float v) {
#pragma unroll
    for (int o = 1; o < 64; o <<= 1) v += __shfl_xor(v, o);
    return v;
}
DI float wave_max(float v) {
#pragma unroll
    for (int o = 1; o < 64; o <<= 1) v = fmaxf(v, __shfl_xor(v, o));
    return v;
}
DI float silu_f(float x) { return x / (1.0f + __expf(-x)); }
template <int S> DI bf16x8 pack8(const f32x16& x) {
    u32x4 p; p.x = pk2(x[8 * S], x[8 * S + 1]); p.y = pk2(x[8 * S + 2], x[8 * S + 3]); p.z = pk2(x[8 * S + 4], x[8 * S + 5]); p.w = pk2(x[8 * S + 6], x[8 * S + 7]);
    return __builtin_bit_cast(bf16x8, p);
}
DI int sw64(int row, int c8) { return row * 128 + ((c8 ^ ((row >> 1) & 7)) << 4); }
DI int sw128(int row, int c16) { return row * 256 + ((c16 ^ (row & 15)) << 4); }

#define XB_TMO      128
#define XB_XCNT(j)  (256  + 64 * (j))
#define XB_XSUB(j)  (1280 + 64 * (j))
#define XB_XGEN(j)  (2304 + 64 * (j))
#define XB_TOP      3328
#define XB_TOPGEN   3392
#define XCD_BAR_WORDS 3456
#define XB_SPIN_CAP (1u << 18)

__device__ __forceinline__ unsigned xb_ld(unsigned* p)              { return __hip_atomic_load(p, __ATOMIC_RELAXED, __HIP_MEMORY_SCOPE_AGENT); }
__device__ __forceinline__ unsigned xb_add(unsigned* p, unsigned v) { return __hip_atomic_fetch_add(p, v, __ATOMIC_RELAXED, __HIP_MEMORY_SCOPE_AGENT); }
__device__ __forceinline__ unsigned xb_xcc_id() { return (unsigned)__builtin_amdgcn_s_getreg((3 << 11) | 20) & 0xFu; }
#define XB_SPIN(cond, bar) do { unsigned _sp = 0; while (cond) { __builtin_amdgcn_s_sleep(1); \
    if ((++_sp & 255u) == 0u) { if (xb_ld(&(bar)[XB_TMO])) break; if (_sp > XB_SPIN_CAP) { atomicAdd(&(bar)[XB_TMO], 1u); break; } } } } while (0)

struct XcdBarrier {
    unsigned* bar; unsigned x;
    volatile LAS unsigned* st;
};

__device__ __forceinline__ XcdBarrier xcd_barrier_post(unsigned* bar, volatile LAS unsigned* st) {
    XcdBarrier b; b.bar = bar; b.x = xb_xcc_id(); b.st = st;
    if (threadIdx.x == 0) (void)xb_add(&bar[XB_XCNT(b.x)], 1u);
    return b;
}
__device__ __forceinline__ void xcd_barrier_complete(unsigned* bar, unsigned x, unsigned& nloc, unsigned& nx) {
    const unsigned G = gridDim.x * gridDim.y * gridDim.z;
    unsigned sum, cnt, mine, sp = 0u;
    for (;;) {
        sum = 0u; cnt = 0u; mine = 0u;
#pragma unroll
        for (unsigned j = 0; j < 16; ++j) { const unsigned c = xb_ld(&bar[XB_XCNT(j)]); sum += c; cnt += (c > 0u) ? 1u : 0u; mine = (j == x) ? c : mine; }
        if (sum == G) break;
        __builtin_amdgcn_s_sleep(1);
        if ((++sp & 255u) == 0u) { if (xb_ld(&bar[XB_TMO])) break; if (sp > XB_SPIN_CAP) { atomicAdd(&bar[XB_TMO], 1u); break; } }
    }
    nloc = mine > 0u ? mine : 1u; nx = cnt > 0u ? cnt : 1u;
}

__device__ __forceinline__ void xcd_barrier(const XcdBarrier& b) {
    asm volatile("s_waitcnt vmcnt(0)" ::: "memory");
    __syncthreads();
    if (threadIdx.x == 0) {
        unsigned* bar = b.bar;
        __builtin_amdgcn_s_waitcnt(0);
        unsigned nloc = b.st[0], nx = b.st[1];
        if (nloc == 0u) { xcd_barrier_complete(bar, b.x, nloc, nx); b.st[0] = nloc; b.st[1] = nx; }
        const unsigned old = xb_add(&bar[XB_XSUB(b.x)], 1u);
        const unsigned gen = old / nloc;
        if (old + 1u == (gen + 1u) * nloc) {
            __builtin_amdgcn_fence(__ATOMIC_RELEASE, "agent");
            asm volatile("s_waitcnt vmcnt(0)" ::: "memory");
            const unsigned og = xb_add(&bar[XB_TOP], 1u);
            const unsigned tg = og / nx;
            if (og + 1u == (tg + 1u) * nx) xb_add(&bar[XB_TOPGEN], 1u);
            else XB_SPIN(xb_ld(&bar[XB_TOPGEN]) == tg, bar);
            __builtin_amdgcn_fence(__ATOMIC_ACQUIRE, "agent");
            xb_add(&bar[XB_XGEN(b.x)], 1u);
            asm volatile("s_waitcnt vmcnt(0)" ::: "memory");
        } else {
            XB_SPIN(xb_ld(&bar[XB_XGEN(b.x)]) == gen, bar);
            __builtin_amdgcn_fence(__ATOMIC_ACQUIRE, "agent");
            asm volatile("s_waitcnt vmcnt(0)" ::: "memory");
        }
    }
    __syncthreads();
}

constexpr int NWAVES = 8, NTHR = 512;
constexpr int DM = 1024, NBATCH = 4, SEQL = 8192, CTXL = 256, RL = NBATCH * SEQL, RC = NBATCH * CTXL, RT = RL + RC;
constexpr int NPROJ = 3584, INCOLS = 3600, NEXP = 16, FFN = 2048;
constexpr int SPE0 = 17 * 256, SPE1 = 16 * 256;
constexpr int M1_0 = NEXP * SPE0, M1_1 = NEXP * SPE1;
constexpr float EPSN = 1e-6f;
constexpr float LAM_INIT = 0.35550907f;
constexpr int NCHUNK = 132;
constexpr int GBLK = 73728;

constexpr size_t MiB = 1u << 20;
constexpr size_t WS_CTL = 0, CTL_ZERO_BYTES = 1 * MiB;
constexpr size_t WS_MODV = 1 * MiB;
constexpr size_t WS_ROPE = 1 * MiB + 256 * 1024;
constexpr size_t WS_ZROW = 1 * MiB + 512 * 1024;
constexpr size_t WS_GATES = 2 * MiB;
constexpr size_t WS_AFFT = 5 * MiB;
constexpr size_t WS_INV = 8 * MiB;
constexpr size_t WS_GATEV = 11 * MiB;
constexpr size_t WS_GLAST = 12 * MiB;
constexpr size_t WS_WIN = 17 * MiB, WS_WOUT = 24 * MiB, WS_WQK = 26 * MiB, WS_WV = 30 * MiB, WS_WO = 32 * MiB;
constexpr size_t WS_E0 = 36 * MiB;
constexpr size_t WS_XC = 228 * MiB;
constexpr size_t WS_H = 232 * MiB;
constexpr size_t WS_BIG = 298 * MiB;
constexpr size_t WS_G = 570 * MiB;
constexpr size_t WS_END = 898 * MiB;
constexpr int CW_BAR = 4096, CW_Q0 = 8192, CW_Q1 = 8256;

constexpr int RING_BYTES = 131072;
constexpr int LDSX = RING_BYTES;
constexpr int LDS_BYTES = 147456;

struct Args { const float* in[35]; float* out; unsigned char* ws; int ph_lo, ph_hi, ph_rep, pad; };

template <class F> DI void tr_item(const float* W, int ldw, bf16* WT, int ldk, int k0, F rowmap, LAS float* scr, int lane) {
#pragma unroll 8
    for (int i = 0; i < 32; ++i) { const int kk = 2 * i + (lane >> 5); scr[kk * 33 + (lane & 31)] = W[(size_t)kk * ldw + (lane & 31)]; }
    LDS_WAIT(); asm volatile("" ::: "memory");
    const int c = lane & 7;
#pragma unroll
    for (int j = 0; j < 4; ++j) { const int n = (lane >> 3) + 8 * j; const LAS float* s = scr + (8 * c) * 33 + n;
        u32x4 o; o.x = pk2(s[0 * 33], s[1 * 33]); o.y = pk2(s[2 * 33], s[3 * 33]); o.z = pk2(s[4 * 33], s[5 * 33]); o.w = pk2(s[6 * 33], s[7 * 33]);
        *(u32x4*)(WT + (size_t)rowmap(n) * ldk + k0 + 8 * c) = o; }
    LDS_WAIT(); asm volatile("" ::: "memory");
}
struct AddMap { int base; DI int operator()(int n) const { return base + n; } };
struct PairMap { int base; DI int operator()(int n) const { return base + (n < 16 ? 2 * n : 2 * (n - 16) + 1); } };
DI void expert_item(int r, const float* Wg, const float* Wu, const float* Wd, bf16* W1, bf16* W2, LAS float* scr, int lane) {
    if (r < 32768) { const int up = r >> 14, q = r & 16383, e = q >> 10, it = q & 1023, kb = it >> 6, nb = it & 63;
        const float* src = (up ? Wu : Wg) + (size_t)e * 1024 * 2048 + (size_t)(kb * 64) * 2048 + nb * 32;
        const int rbase = e * 4096 + (nb >> 2) * 256 + up * 128 + (nb & 3) * 32;
        tr_item(src, 2048, W1, 1024, kb * 64, AddMap{rbase}, scr, lane);
    } else { const int q = r - 32768, e = q >> 10, it = q & 1023, kb = it >> 5, nb = it & 31;
        const float* src = Wd + (size_t)e * 2048 * 1024 + (size_t)(kb * 64) * 1024 + nb * 32;
        const int rbase = e * 1024 + nb * 32;
        tr_item(src, 1024, W2, 2048, kb * 64, AddMap{rbase}, scr, lane);
    }
}
DI void stage_tab16(const float* W, int ldw, LAS float* tab, int tid) {
    for (int idx = tid; idx < 16384; idx += NTHR) { const int d = idx >> 4, e = idx & 15; const int j = d >> 8, l = (d >> 2) & 63, c = d & 3;
        tab[((((j * 4 + c) * 4 + (e >> 2)) * 64 + l) << 2) + (e & 3)] = W[(size_t)d * ldw + e]; }
}
DI void row_gemv16(const f32x4 (&h)[4], const LAS float* tab, int lane, float (&sums)[16]) {
#pragma unroll
    for (int e = 0; e < 16; ++e) sums[e] = 0.f;
#pragma unroll
    for (int j = 0; j < 4; ++j)
#pragma unroll
        for (int c = 0; c < 4; ++c) { const float hv = h[j][c];
#pragma unroll
            for (int q = 0; q < 4; ++q) { const f32x4 w = *(const LAS f32x4*)(tab + ((((j * 4 + c) * 4 + q) * 64 + lane) << 2));
                sums[4 * q + 0] += hv * w[0]; sums[4 * q + 1] += hv * w[1]; sums[4 * q + 2] += hv * w[2]; sums[4 * q + 3] += hv * w[3]; }
            asm volatile("" ::: "memory"); }
}
DI int eidx16(int lane) { return ((lane >> 5) & 1) * 8 + ((lane >> 4) & 1) * 4 + ((lane >> 3) & 1) * 2 + ((lane >> 2) & 1); }
DI float reduce16(const float (&s)[16], int lane) {
    float a8[8], a4[4], a2[2];
    const bool u5 = (lane & 32) != 0, u4 = (lane & 16) != 0, u3 = (lane & 8) != 0, u2 = (lane & 4) != 0;
#pragma unroll
    for (int k = 0; k < 8; ++k) { const float keep = u5 ? s[k + 8] : s[k], send = u5 ? s[k] : s[k + 8]; a8[k] = keep + __shfl_xor(send, 32); }
#pragma unroll
    for (int k = 0; k < 4; ++k) { const float keep = u4 ? a8[k + 4] : a8[k], send = u4 ? a8[k] : a8[k + 4]; a4[k] = keep + __shfl_xor(send, 16); }
#pragma unroll
    for (int k = 0; k < 2; ++k) { const float keep = u3 ? a4[k + 2] : a4[k], send = u3 ? a4[k] : a4[k + 2]; a2[k] = keep + __shfl_xor(send, 8); }
    float r; { const float keep = u2 ? a2[1] : a2[0], send = u2 ? a2[0] : a2[1]; r = keep + __shfl_xor(send, 4); }
    r += __shfl_xor(r, 2); r += __shfl_xor(r, 1);
    return r;
}
DI float* resid_ptr(float* lat, float* ctx, int r) { return r < RL ? lat + (size_t)r * DM : ctx + (size_t)(r - RL) * DM; }
DI int row_bb(int r) { return r < RL ? (r >> 13) : 4; }
DI void modulate_row(f32x4 (&v)[4], const float* nw, const float* shift, const float* scale, int lane) {
    float ss = 0.f;
#pragma unroll
    for (int j = 0; j < 4; ++j) ss += (v[j][0] * v[j][0] + v[j][1] * v[j][1]) + (v[j][2] * v[j][2] + v[j][3] * v[j][3]);
    const float rstd = 1.0f / sqrtf(wave_sum(ss) * (1.0f / DM) + EPSN);
#pragma unroll
    for (int j = 0; j < 4; ++j) { const int d = 256 * j + 4 * lane; const f32x4 w = *(const f32x4*)(nw + d), sc = *(const f32x4*)(scale + d), sh = *(const f32x4*)(shift + d);
        v[j] = v[j] * rstd * w * (sc + 1.0f) + sh; }
}
DI void store_row_bf16(bf16* dst, const f32x4 (&v)[4], int lane) {
#pragma unroll
    for (int j = 0; j < 4; ++j) { u32x2 o; o.x = pk2(v[j][0], v[j][1]); o.y = pk2(v[j][2], v[j][3]); *(u32x2*)(dst + 256 * j + 4 * lane) = o; }
}
DI void load_row_f32(const float* src, f32x4 (&v)[4], int lane) {
#pragma unroll
    for (int j = 0; j < 4; ++j) v[j] = *(const f32x4*)(src + 256 * j + 4 * lane);
}
DI void moe_combine_row(f32x4 (&v)[4], const int* invrow, const bf16* YE, const float* gvec, int lane) {
    const int mine = invrow[lane & 15];
    f32x4 a[4];
#pragma unroll
    for (int j = 0; j < 4; ++j) a[j] = (f32x4){0.f, 0.f, 0.f, 0.f};
#pragma unroll
    for (int e = 0; e < 16; ++e) { const int s = __builtin_amdgcn_readlane(mine, e);
        if (s >= 0) { const bf16* yr = YE + (size_t)s * DM;
#pragma unroll
            for (int j = 0; j < 4; ++j) { const u32x2 w = *(const u32x2*)(yr + 256 * j + 4 * lane); a[j][0] += bflo(w.x); a[j][1] += bfhi(w.x); a[j][2] += bflo(w.y); a[j][3] += bfhi(w.y); } } }
#pragma unroll
    for (int j = 0; j < 4; ++j) { const f32x4 g = *(const f32x4*)(gvec + 256 * j + 4 * lane); v[j] = v[j] + g * a[j]; }
}

#define PH_ARGS const Args& A, LAS unsigned char* lds, int tid, int lane, int wave, int G, int bx
DI void sincos_d(double a, float& sn, float& cs) {
    const double TWO_OVER_PI = 0.63661977236758134308, PIO2 = 1.57079632679489661923;
    const double kq = (double)(long long)(a * TWO_OVER_PI + 0.5); const double y = a - kq * PIO2; const double y2 = y * y;
    const double s = y * (1.0 + y2 * (-1.0 / 6 + y2 * (1.0 / 120 + y2 * (-1.0 / 5040 + y2 * (1.0 / 362880 + y2 * (-1.0 / 39916800 + y2 * (1.0 / 6227020800.0)))))));
    const double c = 1.0 + y2 * (-0.5 + y2 * (1.0 / 24 + y2 * (-1.0 / 720 + y2 * (1.0 / 40320 + y2 * (-1.0 / 3628800 + y2 * (1.0 / 479001600.0))))));
    const int k = (int)((long long)kq & 3);
    const double ss = (k == 0) ? s : (k == 1) ? c : (k == 2) ? -s : -c;
    const double cc = (k == 0) ? c : (k == 1) ? -s : (k == 2) ? -c : s;
    sn = (float)ss; cs = (float)cc;
}

DI void phase0(PH_ARGS) {
    unsigned char* ws = A.ws;
    LAS float* sil = (LAS float*)(lds + 73728);
    for (int i = tid; i < 5120; i += NTHR) { const int bb = i >> 10, k = i & 1023; const float cv = bb < 4 ? A.in[1][bb * 1024 + k] : A.in[3][k]; sil[i] = silu_f(cv); }
    __syncthreads();
    {
        const int t = wave * G + bx;
        if (t < 192) { const int layer = t / 96, n = (t % 96) * 64 + lane; const float* W = A.in[layer ? 19 : 4] + n; const float* Bv = A.in[layer ? 20 : 5];
            float a0 = 0.f, a1 = 0.f, a2 = 0.f, a3 = 0.f, a4 = 0.f;
#pragma unroll 8
            for (int k = 0; k < 1024; ++k) { const float w = W[(size_t)k * 6144]; a0 += sil[k] * w; a1 += sil[1024 + k] * w; a2 += sil[2048 + k] * w; a3 += sil[3072 + k] * w; a4 += sil[4096 + k] * w; }
            float* mv = (float*)(ws + WS_MODV) + layer * 5 * 6144 + n; const float bv = Bv[n];
            mv[0] = a0 + bv; mv[6144] = a1 + bv; mv[2 * 6144] = a2 + bv; mv[3 * 6144] = a3 + bv; mv[4 * 6144] = a4 + bv; }
    }
    if (bx == G - 1) {
        float* rope = (float*)(ws + WS_ROPE);
        for (int i = tid; i < 3072; i += NTHR) { const int isc = i >= 2048, ii = isc ? i - 2048 : i; const int pos = ii >> 4, j = ii & 15;
            double f = 1.0; for (int q = 0; q < j; ++q) f *= 0.56234132519034908;
            float sn, cs; sincos_d((double)pos * f, sn, cs);
            if (isc) { rope[4096 + ii] = cs; rope[5120 + ii] = sn; } else { rope[ii] = cs; rope[2048 + ii] = sn; } }
        unsigned* z = (unsigned*)(ws + WS_ZROW); for (int i = tid; i < 512; i += NTHR) z[i] = 0u;
    }
    LAS float* scr = (LAS float*)(lds + wave * 8704);
    const int gw = bx * NWAVES + wave, NGW = G * NWAVES;
    constexpr int I_IN = 16 * 112, I_OUT = 16 * 32, I_QK = 16 * 64, I_V = 16 * 32, I_O = 16 * 32;
    constexpr int NITEMS = I_IN + I_OUT + I_QK + I_V + I_O;
    for (int it = gw; it < NITEMS; it += NGW) {
        int r = it;
        if (r < I_IN) { const int kb = r / 112, nb = r % 112; tr_item(A.in[7] + (size_t)(kb * 64) * INCOLS + nb * 32, INCOLS, (bf16*)(ws + WS_WIN), 1024, kb * 64, AddMap{nb * 32}, scr, lane); continue; } r -= I_IN;
        if (r < I_OUT) { const int kb = r >> 5, nb = r & 31; tr_item(A.in[13] + (size_t)(kb * 64) * 1024 + nb * 32, 1024, (bf16*)(ws + WS_WOUT), 1024, kb * 64, AddMap{nb * 32}, scr, lane); continue; } r -= I_OUT;
        if (r < I_QK) { const int kb = r >> 6, nb = r & 63; tr_item(A.in[22] + (size_t)(kb * 64) * 3072 + nb * 32, 3072, (bf16*)(ws + WS_WQK), 1024, kb * 64, PairMap{nb * 32}, scr, lane); continue; } r -= I_QK;
        if (r < I_V) { const int kb = r >> 5, nb = r & 31; tr_item(A.in[22] + (size_t)(kb * 64) * 3072 + 2048 + nb * 32, 3072, (bf16*)(ws + WS_WV), 1024, kb * 64, AddMap{nb * 32}, scr, lane); continue; } r -= I_V;
        { const int kb = r >> 5, nb = r & 31; tr_item(A.in[28] + (size_t)(kb * 64) * 1024 + nb * 32, 1024, (bf16*)(ws + WS_WO), 1024, kb * 64, AddMap{nb * 32}, scr, lane); }
    }
}

template <int MODE, int LAYER> DI void phase_modulate(PH_ARGS) {
    unsigned char* ws = A.ws;
    LAS float* tab = (LAS float*)lds;
    if (MODE == 0) stage_tab16(A.in[7] + NPROJ, INCOLS, tab, tid); else stage_tab16(A.in[LAYER ? 30 : 15], 16, tab, tid);
    __syncthreads();
    const float* nw = A.in[MODE == 0 ? 6 : (LAYER ? 29 : 14)];
    const float* mv = (const float*)(ws + WS_MODV) + LAYER * 5 * 6144 + (MODE == 0 ? 0 : 3 * 1024);
    bf16* H = (bf16*)(ws + WS_H);
    const int NR = (MODE == 1 && LAYER == 1) ? RL : RT;
    for (int r = bx * NWAVES + wave; r < NR; r += G * NWAVES) {
        const float* src = (MODE == 0) ? (r < RL ? A.in[0] + (size_t)r * DM : A.in[2] + (size_t)(r - RL) * DM) : resid_ptr(A.out, (float*)(ws + WS_XC), r);
        const int bb = row_bb(r);
        f32x4 v[4]; load_row_f32(src, v, lane);
        modulate_row(v, nw, mv + bb * 6144, mv + bb * 6144 + 1024, lane);
        store_row_bf16(H + (size_t)r * DM, v, lane);
        float sums[16]; row_gemv16(v, tab, lane, sums);
        const float red = reduce16(sums, lane); const int ee = eidx16(lane);
        if (MODE == 0) { if ((lane & 3) == 0) ((float*)(ws + WS_GATES))[(size_t)r * 16 + ee] = red; }
        else { const float mx = wave_max(red); const float ex = __expf(red - mx); const float den = wave_sum(ex) * 0.25f; const float mine = ex / den;
            if ((lane & 3) == 0) { float* af = (float*)(ws + WS_AFFT);
                if (r < RL) af[(size_t)(((r >> 13) * 16 + ee)) * 8192 + (r & 8191)] = mine;
                else { const int rr = r - RL; af[524288 + (size_t)(((rr >> 8) * 16 + ee)) * 256 + (rr & 255)] = mine; } } }
    }
}

DI void fnma_asm(float& acc, float a, float b) { asm("v_fma_f32 %0, -%1, %2, %0" : "+v"(acc) : "v"(a), "v"(b)); }
template <int J> DI void backsub_row(float (&t)[64], const LAS float* LT, int lane) {
    float acc0 = (lane == J) ? 1.0f : 0.0f, acc1 = 0.f;
    constexpr int K0 = (J + 1) >> 2;
#pragma unroll
    for (int k4 = K0; k4 < 16; ++k4) { const f32x4 l4 = *(const LAS f32x4*)(LT + J * 64 + 4 * k4);
#pragma unroll
        for (int q = 0; q < 4; ++q) { const int k = 4 * k4 + q; if (k > J) { if (q & 1) fnma_asm(acc1, t[k], l4[q]); else fnma_asm(acc0, t[k], l4[q]); } } }
    t[J] = acc0 + acc1;
    __builtin_amdgcn_sched_barrier(0);
}
template <int J> DI void backsub_all(float (&t)[64], const LAS float* LT, int lane) {
    backsub_row<J>(t, LT, lane);
    if constexpr (J > 0) backsub_all<J - 1>(t, LT, lane);
}
DI void gdn_dir(const Args& A, LAS unsigned char* lds, int lane, int dir, int b, int h, int seqsel, int cidx, int rowbase, int t0) {
    unsigned char* ws = A.ws;
    const int r32 = lane & 31, hi = lane >> 5;
    LAS unsigned char* Qn = lds; LAS unsigned char* Kn = lds + 16384;
    LAS unsigned char* DB = lds + 32768 + 49152 * dir;
    LAS float* LT = (LAS float*)DB; LAS unsigned char* TBG = DB; LAS unsigned char* TB = DB + 8192;
    LAS unsigned char* KT = DB + 16384; LAS unsigned char* VT = DB + 32768;
    LAS float* SM = (LAS float*)(lds + LDSX + 1024 + dir * 1280);
    LAS float* GC = SM; LAS float* EGC = SM + 64; LAS float* BETA = SM + 128; LAS float* BG = SM + 192; LAS float* KDEC = SM + 256;
    const int ch = (b * 4 + h) * 2 + dir;
    const int p = seqsel ? (dir ? 3 - cidx : cidx) : 4 + (dir ? 127 - cidx : cidx);
    unsigned char* blk = ws + WS_G + (size_t)(ch * NCHUNK + p) * GBLK;
    {
        const int tk = dir ? 63 - lane : lane; const float* gr = (const float*)(ws + WS_GATES) + (size_t)(rowbase + t0 + tk) * 16;
        const float av = gr[dir * 4 + h], bv = gr[8 + dir * 4 + h];
        const float xs = av + A.in[11][dir * 4 + h]; const float sp = xs > 20.f ? xs : log1pf(__expf(xs));
        const float g = -__expf(A.in[10][dir * 4 + h]) * sp; const float beta = 1.0f / (1.0f + __expf(-bv));
        float gc = g;
#pragma unroll
        for (int o = 1; o < 64; o <<= 1) { const float tv = __shfl_up(gc, o); if (lane >= o) gc += tv; }
        const float gl = __shfl(gc, 63); const float eg = __expf(gc);
        GC[lane] = gc; EGC[lane] = eg; BETA[lane] = beta; BG[lane] = beta * eg; KDEC[lane] = __expf(gl - gc);
        if (lane == 0) ((float*)(ws + WS_GLAST))[ch * NCHUNK + p] = __expf(gl);
    }
    LDS_WAIT(); asm volatile("" ::: "memory");
#pragma unroll
    for (int ib = 0; ib < 2; ++ib) {
        const int i = 32 * ib + r32; const int ti = dir ? 63 - i : i; const float gi = GC[i], bi = BETA[i];
#pragma unroll
        for (int jb = 0; jb < 2; ++jb) {
            f32x16 aK, aQ;
#pragma unroll
            for (int r = 0; r < 16; ++r) { aK[r] = 0.f; aQ[r] = 0.f; }
            if (jb <= ib) {
                const int j = 32 * jb + r32; const int tj = dir ? 63 - j : j;
#pragma unroll
                for (int kk = 0; kk < 8; ++kk) {
                    const bf16x8 a = *(const LAS bf16x8*)(Kn + sw128(tj, 2 * kk + hi));
                    const bf16x8 bK = *(const LAS bf16x8*)(Kn + sw128(ti, 2 * kk + hi));
                    const bf16x8 bQ = *(const LAS bf16x8*)(Qn + sw128(ti, 2 * kk + hi));
                    aK = MFMA32(a, bK, aK); aQ = MFMA32(a, bQ, aQ);
                }
            }
#pragma unroll
            for (int g4 = 0; g4 < 4; ++g4) { const f32x4 gj = *(const LAS f32x4*)(GC + 32 * jb + 8 * g4 + 4 * hi);
#pragma unroll
                for (int q = 0; q < 4; ++q) { const int r = 4 * g4 + q; const int j = 32 * jb + 8 * g4 + 4 * hi + q;
                    const float dec = __expf(fminf(gi - gj[q], 0.f));
                    const float lv = (j < i) ? bi * aK[r] * dec : 0.f;
                    LT[j * 64 + i] = lv;
                    aQ[r] = (j <= i) ? aQ[r] * dec : 0.f; } }
            *(bf16x8*)(blk + 32768 + ((ib * 4 + 2 * jb + 0) * 1024) + lane * 16) = pack8<0>(aQ);
            *(bf16x8*)(blk + 32768 + ((ib * 4 + 2 * jb + 1) * 1024) + lane * 16) = pack8<1>(aQ);
        }
    }
    LDS_WAIT(); asm volatile("" ::: "memory");
    float t[64];
    backsub_all<63>(t, LT, lane);
    LDS_WAIT(); asm volatile("" ::: "memory");
#pragma unroll
    for (int c = 0; c < 8; ++c) {
        const f32x4 b0 = *(const LAS f32x4*)(BETA + 8 * c), b1 = *(const LAS f32x4*)(BETA + 8 * c + 4), g0 = *(const LAS f32x4*)(BG + 8 * c), g1 = *(const LAS f32x4*)(BG + 8 * c + 4);
        u32x4 wb, wg;
        wb.x = pk2(t[8 * c] * b0[0], t[8 * c + 1] * b0[1]); wb.y = pk2(t[8 * c + 2] * b0[2], t[8 * c + 3] * b0[3]); wb.z = pk2(t[8 * c + 4] * b1[0], t[8 * c + 5] * b1[1]); wb.w = pk2(t[8 * c + 6] * b1[2], t[8 * c + 7] * b1[3]);
        wg.x = pk2(t[8 * c] * g0[0], t[8 * c + 1] * g0[1]); wg.y = pk2(t[8 * c + 2] * g0[2], t[8 * c + 3] * g0[3]); wg.z = pk2(t[8 * c + 4] * g1[0], t[8 * c + 5] * g1[1]); wg.w = pk2(t[8 * c + 6] * g1[2], t[8 * c + 7] * g1[3]);
        *(LAS u32x4*)(TB + sw64(lane, c)) = wb; *(LAS u32x4*)(TBG + sw64(lane, c)) = wg;
    }
    LDS_WAIT(); asm volatile("" ::: "memory");
#pragma unroll
    for (int ib = 0; ib < 2; ++ib) {
        bf16x8 tg[4], tb[4];
#pragma unroll
        for (int js = 0; js < 4; ++js) { tg[js] = *(const LAS bf16x8*)(TBG + sw64(32 * ib + r32, 2 * js + hi)); tb[js] = *(const LAS bf16x8*)(TB + sw64(32 * ib + r32, 2 * js + hi)); }
#pragma unroll
        for (int kb = 0; kb < 4; ++kb) {
            f32x16 acc;
#pragma unroll
            for (int r = 0; r < 16; ++r) acc[r] = 0.f;
#pragma unroll
            for (int js = 0; js < 4; ++js) { const bf16x8 a = *(const LAS bf16x8*)(KT + sw64(32 * kb + r32, 2 * js + hi)); acc = MFMA32(a, tg[js], acc); }
            *(bf16x8*)(blk + ((ib * 8 + 2 * kb + 0) * 1024) + lane * 16) = pack8<0>(acc);
            *(bf16x8*)(blk + ((ib * 8 + 2 * kb + 1) * 1024) + lane * 16) = pack8<1>(acc);
        }
#pragma unroll
        for (int dvb = 0; dvb < 4; ++dvb) {
            f32x16 acc;
#pragma unroll
            for (int r = 0; r < 16; ++r) acc[r] = 0.f;
#pragma unroll
            for (int js = 0; js < 4; ++js) { const bf16x8 bv = *(const LAS bf16x8*)(VT + sw64(32 * dvb + r32, 2 * js + hi)); acc = MFMA32(tb[js], bv, acc); }
            unsigned char* up = blk + 57344 + (dvb * 2 + ib) * 2048 + lane * 32;
            *(bf16x8*)(up) = pack8<0>(acc); *(bf16x8*)(up + 16) = pack8<1>(acc);
        }
    }
#pragma unroll
    for (int ib = 0; ib < 2; ++ib) { const int i = 32 * ib + r32; const int ti = dir ? 63 - i : i; const float eg = EGC[i];
#pragma unroll
        for (int ks = 0; ks < 8; ++ks) {
            const u32x2 lo = *(const LAS u32x2*)(Qn + sw128(ti, 2 * ks) + 8 * hi), hh = *(const LAS u32x2*)(Qn + sw128(ti, 2 * ks + 1) + 8 * hi);
            u32x4 o; o.x = pk2(bflo(lo.x) * eg, bfhi(lo.x) * eg); o.y = pk2(bflo(lo.y) * eg, bfhi(lo.y) * eg); o.z = pk2(bflo(hh.x) * eg, bfhi(hh.x) * eg); o.w = pk2(bflo(hh.y) * eg, bfhi(hh.y) * eg);
            *(u32x4*)(blk + 16384 + ((ib * 8 + ks) * 1024) + lane * 16) = o; } }
#pragma unroll
    for (int kb = 0; kb < 4; ++kb) { const int dk = 32 * kb + r32;
#pragma unroll
        for (int ks = 0; ks < 4; ++ks) {
            const u32x2 lo = *(const LAS u32x2*)(KT + sw64(dk, 2 * ks) + 8 * hi), hh = *(const LAS u32x2*)(KT + sw64(dk, 2 * ks + 1) + 8 * hi);
            const f32x4 d0 = *(const LAS f32x4*)(KDEC + 16 * ks + 4 * hi), d1 = *(const LAS f32x4*)(KDEC + 16 * ks + 8 + 4 * hi);
            u32x4 o; o.x = pk2(bflo(lo.x) * d0[0], bfhi(lo.x) * d0[1]); o.y = pk2(bflo(lo.y) * d0[2], bfhi(lo.y) * d0[3]); o.z = pk2(bflo(hh.x) * d1[0], bfhi(hh.x) * d1[1]); o.w = pk2(bflo(hh.y) * d1[2], bfhi(hh.y) * d1[3]);
            *(u32x4*)(blk + 40960 + ((kb * 4 + ks) * 1024) + lane * 16) = o; } }
}

DI void phase_gdn_prep(PH_ARGS) {
    unsigned char* ws = A.ws;
    const bf16* PROJ = (const bf16*)(ws + WS_BIG);
    LAS unsigned char* Qn = lds; LAS unsigned char* Kn = lds + 16384;
    const int lane_in = lane;
    for (int u = bx; u < 2112; u += G) {
        int lane = lane_in; asm volatile("" : "+v"(lane));
        int seqsel, b, cidx, h;
        if (u < 2048) { seqsel = 0; b = u >> 9; cidx = (u >> 2) & 127; h = u & 3; } else { const int q = u - 2048; seqsel = 1; b = q >> 4; cidx = (q >> 2) & 3; h = q & 3; }
        const int rowbase = seqsel ? RL + b * CTXL : b * SEQL; const int L = seqsel ? CTXL : SEQL; const int t0 = cidx * 64;
        {
            const int d = 2 * lane; float w[3][3][2];
#pragma unroll
            for (int s = 0; s < 3; ++s)
#pragma unroll
                for (int j = 0; j < 3; ++j) { const f32x2 wv = *(const f32x2*)(A.in[9] + j * 1536 + s * 512 + h * 128 + d); w[s][j][0] = wv[0]; w[s][j][1] = wv[1]; }
            unsigned raw[10][3];
#pragma unroll
            for (int rr = 0; rr < 10; ++rr) { const int t = t0 + 8 * wave - 1 + rr; const bool ok = (t >= 0) && (t < L);
#pragma unroll
                for (int s = 0; s < 3; ++s) raw[rr][s] = ok ? *(const unsigned*)(PROJ + (size_t)(rowbase + t) * NPROJ + 1536 + s * 512 + h * 128 + d) : 0u; }
#pragma unroll
            for (int ii = 0; ii < 8; ++ii) { const int i = 8 * wave + ii;
                float val[3][2];
#pragma unroll
                for (int s = 0; s < 3; ++s) {
                    const float x0 = w[s][0][0] * bflo(raw[ii][s]) + w[s][1][0] * bflo(raw[ii + 1][s]) + w[s][2][0] * bflo(raw[ii + 2][s]);
                    const float x1 = w[s][0][1] * bfhi(raw[ii][s]) + w[s][1][1] * bfhi(raw[ii + 1][s]) + w[s][2][1] * bfhi(raw[ii + 2][s]);
                    val[s][0] = silu_f(x0); val[s][1] = silu_f(x1); }
                const float qs = wave_sum(val[0][0] * val[0][0] + val[0][1] * val[0][1]), ksq = wave_sum(val[1][0] * val[1][0] + val[1][1] * val[1][1]);
                const float rq = 0.08838834764831845f / sqrtf(qs + EPSN), rk = 1.0f / sqrtf(ksq + EPSN);
                const unsigned qp = pk2(val[0][0] * rq, val[0][1] * rq), kp = pk2(val[1][0] * rk, val[1][1] * rk), vp = pk2(val[2][0], val[2][1]);
                *(LAS unsigned*)(Qn + sw128(i, lane >> 2) + (lane & 3) * 4) = qp;
                *(LAS unsigned*)(Kn + sw128(i, lane >> 2) + (lane & 3) * 4) = kp;
#pragma unroll
                for (int dir = 0; dir < 2; ++dir) { const int pi = dir ? 63 - i : i; LAS unsigned char* KT = lds + 32768 + 49152 * dir + 16384; LAS unsigned char* VT = KT + 16384;
                    *(LAS unsigned short*)(KT + sw64(d, pi >> 3) + (pi & 7) * 2) = (unsigned short)(kp & 0xffffu);
                    *(LAS unsigned short*)(KT + sw64(d + 1, pi >> 3) + (pi & 7) * 2) = (unsigned short)(kp >> 16);
                    *(LAS unsigned short*)(VT + sw64(d, pi >> 3) + (pi & 7) * 2) = (unsigned short)(vp & 0xffffu);
                    *(LAS unsigned short*)(VT + sw64(d + 1, pi >> 3) + (pi & 7) * 2) = (unsigned short)(vp >> 16); }
            }
        }
        __syncthreads();
        if (wave < 2) gdn_dir(A, lds, lane, wave, b, h, seqsel, cidx, rowbase, t0);
        __syncthreads();
    }
}

DI void expert_queue(const Args& A, LAS unsigned char* lds, int lane, int wave, unsigned* qword, const float* Wg, const float* Wu, const float* Wd, bf16* W1, bf16* W2) {
    LAS float* scr = (LAS float*)(lds + wave * 8704);
    for (;;) {
        unsigned it0 = 0u;
        if (lane == 0) it0 = __hip_atomic_fetch_add(qword, 4u, __ATOMIC_RELAXED, __HIP_MEMORY_SCOPE_AGENT);
        it0 = (unsigned)__builtin_amdgcn_readfirstlane((int)it0);
        if (it0 >= 49152u) break;
#pragma unroll 1
        for (int q = 0; q < 4; ++q) expert_item((int)it0 + q, Wg, Wu, Wd, W1, W2, scr, lane);
    }
}
DI void phase_gdn_scan(PH_ARGS) {
    unsigned char* ws = A.ws;
    unsigned* qword = (unsigned*)(ws + WS_CTL) + CW_Q0;
    if (bx < 128) {
    const int xcd = bx & 7, idx = bx >> 3; const int ch = xcd + 8 * (idx >> 2), v = idx & 3;
    const int dir = ch & 1, bh = ch >> 1, b = bh >> 2, h = bh & 3;
    const int r32 = lane & 31, hi = lane >> 5;
    bf16* PROJ = (bf16*)(ws + WS_BIG);
    const float* GL = (const float*)(ws + WS_GLAST) + ch * NCHUNK;
    const unsigned char* gbase = ws + WS_G + (size_t)ch * NCHUNK * GBLK;
    constexpr int SBUF = 61440;
    const int lt = tid - 64;
#define SCAN_LOAD(p, bufi) do { const unsigned char* gb = gbase + (size_t)(p) * GBLK; LAS unsigned char* lb = lds + (bufi) * SBUF; u32x4 tv[9]; \
        _Pragma("unroll") for (int k = 0; k < 8; ++k) tv[k] = *(const u32x4*)(gb + (lt + 448 * k) * 16); \
        if (lt < 256) tv[8] = *(const u32x4*)(gb + 57344 + v * 4096 + lt * 16); \
        _Pragma("unroll") for (int k = 0; k < 8; ++k) *(LAS u32x4*)(lb + (lt + 448 * k) * 16) = tv[k]; \
        if (lt < 256) *(LAS u32x4*)(lb + 57344 + lt * 16) = tv[8]; } while (0)
    if (wave > 0) SCAN_LOAD(0, 0);
    __syncthreads();
    f32x16 S[4];
#pragma unroll
    for (int kb = 0; kb < 4; ++kb)
#pragma unroll
        for (int r = 0; r < 16; ++r) S[kb][r] = 0.f;
    for (int p = 0; p < NCHUNK; ++p) {
      if (wave > 0) { if (p + 1 < NCHUNK) SCAN_LOAD(p + 1, (p + 1) & 1); }
      else {
        const LAS unsigned char* blk = lds + (p & 1) * SBUF + lane * 16;
        const float gl = GL[p];
        bf16x8 Sb[8];
        Sb[0] = pack8<0>(S[0]); Sb[1] = pack8<1>(S[0]); Sb[2] = pack8<0>(S[1]); Sb[3] = pack8<1>(S[1]);
        Sb[4] = pack8<0>(S[2]); Sb[5] = pack8<1>(S[2]); Sb[6] = pack8<0>(S[3]); Sb[7] = pack8<1>(S[3]);
        f32x16 P[2], O[2];
#pragma unroll
        for (int ib = 0; ib < 2; ++ib) {
#pragma unroll
            for (int r = 0; r < 16; ++r) { P[ib][r] = 0.f; O[ib][r] = 0.f; }
#pragma unroll
            for (int ks = 0; ks < 8; ++ks) { const bf16x8 wf = *(const LAS bf16x8*)(blk + (ib * 8 + ks) * 1024); P[ib] = MFMA32(wf, Sb[ks], P[ib]); }
            asm volatile("" ::: "memory");
#pragma unroll
            for (int ks = 0; ks < 8; ++ks) { const bf16x8 qf = *(const LAS bf16x8*)(blk + 16384 + (ib * 8 + ks) * 1024); O[ib] = MFMA32(qf, Sb[ks], O[ib]); }
            asm volatile("" ::: "memory");
        }
        bf16x8 Vb[4];
#pragma unroll
        for (int ib = 0; ib < 2; ++ib) {
            const LAS unsigned char* up = lds + (p & 1) * SBUF + 57344 + ib * 2048 + lane * 32;
            const u32x4 u0 = *(const LAS u32x4*)up, u1 = *(const LAS u32x4*)(up + 16);
            f32x16 vn;
            vn[0] = bflo(u0.x) - P[ib][0]; vn[1] = bfhi(u0.x) - P[ib][1]; vn[2] = bflo(u0.y) - P[ib][2]; vn[3] = bfhi(u0.y) - P[ib][3];
            vn[4] = bflo(u0.z) - P[ib][4]; vn[5] = bfhi(u0.z) - P[ib][5]; vn[6] = bflo(u0.w) - P[ib][6]; vn[7] = bfhi(u0.w) - P[ib][7];
            vn[8] = bflo(u1.x) - P[ib][8]; vn[9] = bfhi(u1.x) - P[ib][9]; vn[10] = bflo(u1.y) - P[ib][10]; vn[11] = bfhi(u1.y) - P[ib][11];
            vn[12] = bflo(u1.z) - P[ib][12]; vn[13] = bfhi(u1.z) - P[ib][13]; vn[14] = bflo(u1.w) - P[ib][14]; vn[15] = bfhi(u1.w) - P[ib][15];
            Vb[2 * ib] = pack8<0>(vn); Vb[2 * ib + 1] = pack8<1>(vn);
        }
#pragma unroll
        for (int ib = 0; ib < 2; ++ib)
#pragma unroll
            for (int kt = 0; kt < 4; ++kt) { const bf16x8 af = *(const LAS bf16x8*)(blk + 32768 + (ib * 4 + kt) * 1024); O[ib] = MFMA32(af, Vb[kt], O[ib]); }
        asm volatile("" ::: "memory");
#pragma unroll
        for (int kb = 0; kb < 4; ++kb) {
            asm volatile("" ::: "memory");
#pragma unroll
            for (int r = 0; r < 16; ++r) S[kb][r] *= gl;
#pragma unroll
            for (int kt = 0; kt < 4; ++kt) { const bf16x8 kf = *(const LAS bf16x8*)(blk + 40960 + (kb * 4 + kt) * 1024); S[kb] = MFMA32(kf, Vb[kt], S[kb]); }
        }
        int rowbase, cidx;
        if (p < 4) { cidx = dir ? 3 - p : p; rowbase = RL + b * CTXL; } else { cidx = dir ? 131 - p : p - 4; rowbase = b * SEQL; }
        int hiv = hi; asm volatile("" : "+v"(hiv));
        const long step = dir ? -(long)NPROJ : (long)NPROJ;
        bf16* ob = PROJ + (size_t)(rowbase + cidx * 64 + (dir ? 63 - 4 * hiv : 4 * hiv)) * NPROJ + 1536 + dir * 512 + h * 128 + 32 * v + r32;
#pragma unroll
        for (int ib = 0; ib < 2; ++ib)
#pragma unroll
            for (int r = 0; r < 16; ++r) { const int c = 32 * ib + (r & 3) + 8 * (r >> 2);
                ob[step * c] = (bf16)(pk2(O[ib][r], 0.f) & 0xffffu); }
      }
      __syncthreads();
    }
#undef SCAN_LOAD
    }
    expert_queue(A, lds, lane, wave, qword, A.in[16], A.in[17], A.in[18], (bf16*)(ws + WS_E0), (bf16*)(ws + WS_E0 + 128 * MiB));
}

DI void unpack8(const u32x4 w, float (&f)[8]) { f[0] = bflo(w.x); f[1] = bfhi(w.x); f[2] = bflo(w.y); f[3] = bfhi(w.y); f[4] = bflo(w.z); f[5] = bfhi(w.z); f[6] = bflo(w.w); f[7] = bfhi(w.w); }
DI void phase_ycat(PH_ARGS) {
    unsigned char* ws = A.ws;
    const bf16* PROJ = (const bf16*)(ws + WS_BIG); bf16* Y = (bf16*)(ws + WS_H);
    const int c0 = 8 * lane;
    float cw[3][8], gn[8];
#pragma unroll
    for (int j = 0; j < 3; ++j) { const f32x4 a = *(const f32x4*)(A.in[8] + j * 512 + c0), b2 = *(const f32x4*)(A.in[8] + j * 512 + c0 + 4);
        cw[j][0] = a[0]; cw[j][1] = a[1]; cw[j][2] = a[2]; cw[j][3] = a[3]; cw[j][4] = b2[0]; cw[j][5] = b2[1]; cw[j][6] = b2[2]; cw[j][7] = b2[3]; }
    { const f32x4 a = *(const f32x4*)(A.in[12] + (c0 & 127)), b2 = *(const f32x4*)(A.in[12] + (c0 & 127) + 4);
        gn[0] = a[0]; gn[1] = a[1]; gn[2] = a[2]; gn[3] = a[3]; gn[4] = b2[0]; gn[5] = b2[1]; gn[6] = b2[2]; gn[7] = b2[3]; }
    for (int r = bx * NWAVES + wave; r < RT; r += G * NWAVES) {
        const int t = r < RL ? (r & 8191) : ((r - RL) & 255); const int L = r < RL ? SEQL : CTXL;
        const bf16* pr = PROJ + (size_t)r * NPROJ;
        float pm[8], pc[8], pn[8], xa[8], gc_[8], gb[8];
        unpack8(*(const u32x4*)(pr + c0), xa); unpack8(*(const u32x4*)(pr + 1024 + c0), gc_); unpack8(*(const u32x4*)(pr + 512 + c0), gb);
#pragma unroll
        for (int q = 0; q < 8; ++q) pc[q] = gc_[q] * xa[q];
        if (t > 0) { unpack8(*(const u32x4*)(pr - NPROJ + c0), xa); unpack8(*(const u32x4*)(pr - NPROJ + 1024 + c0), gc_);
#pragma unroll
            for (int q = 0; q < 8; ++q) pm[q] = gc_[q] * xa[q]; }
        else {
#pragma unroll
            for (int q = 0; q < 8; ++q) pm[q] = 0.f; }
        if (t < L - 1) { unpack8(*(const u32x4*)(pr + NPROJ + c0), xa); unpack8(*(const u32x4*)(pr + NPROJ + 1024 + c0), gc_);
#pragma unroll
            for (int q = 0; q < 8; ++q) pn[q] = gc_[q] * xa[q]; }
        else {
#pragma unroll
            for (int q = 0; q < 8; ++q) pn[q] = 0.f; }
        u32x4 o;
        { float y[8];
#pragma unroll
            for (int q = 0; q < 8; ++q) y[q] = gb[q] * (cw[0][q] * pm[q] + cw[1][q] * pc[q] + cw[2][q] * pn[q]);
            o.x = pk2(y[0], y[1]); o.y = pk2(y[2], y[3]); o.z = pk2(y[4], y[5]); o.w = pk2(y[6], y[7]); }
        *(u32x4*)(Y + (size_t)r * DM + c0) = o;
        float of[8], ob[8], z[8];
        unpack8(*(const u32x4*)(pr + 1536 + c0), of); unpack8(*(const u32x4*)(pr + 2048 + c0), ob); unpack8(*(const u32x4*)(pr + 3072 + c0), z);
        float ss = 0.f;
#pragma unroll
        for (int q = 0; q < 8; ++q) { of[q] += ob[q]; ss += of[q] * of[q]; }
        ss += __shfl_xor(ss, 1); ss += __shfl_xor(ss, 2); ss += __shfl_xor(ss, 4); ss += __shfl_xor(ss, 8);
        const float rn = 1.0f / sqrtf(ss * (1.0f / 128.0f) + EPSN);
        { float y[8];
#pragma unroll
            for (int q = 0; q < 8; ++q) y[q] = of[q] * rn * gn[q] * silu_f(z[q]);
            o.x = pk2(y[0], y[1]); o.y = pk2(y[2], y[3]); o.z = pk2(y[4], y[5]); o.w = pk2(y[6], y[7]); }
        *(u32x4*)(Y + (size_t)r * DM + 512 + c0) = o;
    }
}

template <int LAYER> DI void phase_topk(PH_ARGS) {
    unsigned char* ws = A.ws;
    LAS unsigned* vals = (LAS unsigned*)lds; LAS unsigned* hist = (LAS unsigned*)(lds + 32768); LAS unsigned* misc = (LAS unsigned*)(lds + 34816);
    LAS unsigned* wsum = (LAS unsigned*)(lds + 35840); LAS int* slist = (LAS int*)(lds + 36864);
    const int SPE = LAYER ? SPE1 : SPE0; const int NTASK = LAYER ? 64 : 128;
    const bf16* H = (const bf16*)(ws + WS_H); bf16* XE = (bf16*)(ws + WS_G + (LAYER ? 192 * MiB : 0));
    float* gatev = (float*)(ws + WS_GATEV); int* INV = (int*)(ws + WS_INV);
    for (int task = bx; task < NTASK; task += G) {
        const int seqsel = task >> 6, b = (task >> 4) & 3, e = task & 15;
        const int n = seqsel ? CTXL : SEQL, cap = seqsel ? 32 : 1024;
        const float* af = (const float*)(ws + WS_AFFT) + (seqsel ? 524288 + (size_t)((b * 16 + e)) * 256 : (size_t)((b * 16 + e)) * 8192);
        const int rowbase = seqsel ? RL + b * CTXL : b * SEQL;
        const int slotbase = e * SPE + (seqsel ? 4096 + b * 32 : b * 1024);
        for (int i = tid; i < n; i += NTHR) vals[i] = __float_as_uint(af[i]);
        __syncthreads();
        unsigned prefix = 0u; int remaining = cap;
#pragma unroll 1
        for (int pass = 3; pass >= 0; --pass) { const int shift = pass * 8;
            if (tid < 256) hist[tid] = 0u;
            __syncthreads();
            for (int i = tid; i < n; i += NTHR) { const unsigned vv = vals[i]; const bool match = (pass == 3) || (((vv ^ prefix) >> (shift + 8)) == 0u); if (match) __hip_atomic_fetch_add(&hist[(vv >> shift) & 255u], 1u, __ATOMIC_RELAXED, __HIP_MEMORY_SCOPE_WORKGROUP); }
            __syncthreads();
            if (tid == 0) { int cum = 0, dsel = 0, rem = remaining;
                for (int d = 255; d >= 0; --d) { const int hc = (int)hist[d]; if (cum + hc >= remaining) { dsel = d; rem = remaining - cum; break; } cum += hc; }
                misc[0] = (unsigned)dsel; misc[1] = (unsigned)rem; }
            __syncthreads();
            prefix |= misc[0] << shift; remaining = (int)misc[1];
            __syncthreads();
        }
        const int per = seqsel ? 1 : 16; const int i0 = tid * per; const bool act = i0 < n;
        int cgt = 0, ceq = 0;
        if (act) for (int q = 0; q < per; ++q) { const unsigned vv = vals[i0 + q]; cgt += (vv > prefix); ceq += (vv == prefix); }
        unsigned pk = (unsigned)cgt | ((unsigned)ceq << 16), inc = pk;
#pragma unroll
        for (int o = 1; o < 64; o <<= 1) { const unsigned tv = __shfl_up(inc, o); if (lane >= o) inc += tv; }
        if (lane == 63) wsum[wave] = inc;
        __syncthreads();
        unsigned woff = 0u;
#pragma unroll
        for (int w = 0; w < NWAVES; ++w) { const unsigned s = wsum[w]; if (w < wave) woff += s; }
        const unsigned exc = woff + inc - pk; int gt_before = (int)(exc & 0xffffu), eq_before = (int)(exc >> 16);
        if (act) for (int q = 0; q < per; ++q) { const int i = i0 + q; const unsigned vv = vals[i]; int slot = -1;
            if (vv > prefix) { slot = gt_before + (eq_before < remaining ? eq_before : remaining); ++gt_before; }
            else if (vv == prefix) { if (eq_before < remaining) slot = gt_before + eq_before; ++eq_before; }
            INV[(size_t)(rowbase + i) * 16 + e] = slot >= 0 ? slotbase + slot : -1;
            if (slot >= 0) { slist[slot] = i; gatev[slotbase + slot] = __uint_as_float(vv); } }
        __syncthreads();
        for (int s = wave; s < cap; s += NWAVES) { const int tk = slist[s]; const u32x4* src = (const u32x4*)(H + (size_t)(rowbase + tk) * DM); u32x4* dst = (u32x4*)(XE + (size_t)(slotbase + s) * DM);
            dst[lane] = src[lane]; dst[64 + lane] = src[64 + lane]; }
        if (LAYER == 0 && seqsel == 1 && b == 0) {
            for (int s = wave; s < 128; s += NWAVES) { u32x4* dst = (u32x4*)(XE + (size_t)(e * SPE + 4224 + s) * DM); dst[lane] = (u32x4){0u, 0u, 0u, 0u}; dst[64 + lane] = (u32x4){0u, 0u, 0u, 0u}; }
            if (tid < 128) gatev[e * SPE + 4224 + tid] = 0.f; }
        __syncthreads();
    }
    if (LAYER == 1) expert_queue(A, lds, lane, wave, (unsigned*)(ws + WS_CTL) + CW_Q1, A.in[31], A.in[32], A.in[33], (bf16*)(ws + WS_G), (bf16*)(ws + WS_G + 128 * MiB));
}

template <int LAYER> DI void phase_combine(PH_ARGS) {
    unsigned char* ws = A.ws;
    const bf16* YE = (const bf16*)(LAYER ? ws + WS_E0 : ws + WS_G + 192 * MiB);
    const int* INV = (const int*)(ws + WS_INV);
    const float* mv = (const float*)(ws + WS_MODV) + LAYER * 5 * 6144;
    const int NR = LAYER ? RL : RT;
    for (int r = bx * NWAVES + wave; r < NR; r += G * NWAVES) {
        float* xr = resid_ptr(A.out, (float*)(ws + WS_XC), r); const int bb = row_bb(r);
        f32x4 v[4]; load_row_f32(xr, v, lane);
        moe_combine_row(v, INV + (size_t)r * 16, YE, mv + bb * 6144 + 5 * 1024, lane);
        if (LAYER == 0) {
#pragma unroll
            for (int j = 0; j < 4; ++j) *(f32x4*)(xr + 256 * j + 4 * lane) = v[j];
            const float* m1 = (const float*)(ws + WS_MODV) + 5 * 6144 + bb * 6144;
            modulate_row(v, A.in[21], m1, m1 + 1024, lane);
            store_row_bf16((bf16*)(ws + WS_H) + (size_t)r * DM, v, lane);
        } else {
            float ss = 0.f;
#pragma unroll
            for (int j = 0; j < 4; ++j) ss += (v[j][0] * v[j][0] + v[j][1] * v[j][1]) + (v[j][2] * v[j][2] + v[j][3] * v[j][3]);
            const float rstd = 1.0f / sqrtf(wave_sum(ss) * (1.0f / DM) + EPSN);
#pragma unroll
            for (int j = 0; j < 4; ++j) { const f32x4 w = *(const f32x4*)(A.in[34] + 256 * j + 4 * lane); *(f32x4*)(xr + 256 * j + 4 * lane) = v[j] * rstd * w; }
        }
    }
}

DI void glds16(const void* g, LAS unsigned char* l) { __builtin_amdgcn_global_load_lds((const unsigned*)g, (LAS unsigned*)l, 16, 0, 0); }
#define AT_WAIT_BAR(N) do { asm volatile("s_waitcnt vmcnt(" #N ") lgkmcnt(0)" ::: "memory"); __builtin_amdgcn_s_barrier(); asm volatile("" ::: "memory"); } while (0)
DI void phase_attn(PH_ARGS) {
    unsigned char* ws = A.ws;
    const bf16* QK = (const bf16*)(ws + WS_BIG); const bf16* VTg = (const bf16*)(ws + WS_BIG + 132 * MiB); bf16* ATT = (bf16*)(ws + WS_H);
    const int r32 = lane & 31, hi = lane >> 5; const int isub = wave >> 2, rg = wave & 3;
    constexpr int NT = 132, KRING = 0, VRING = 49152, SLOT = 16384;
    float lam;
    { const float s1 = wave_sum(A.in[23][lane] * A.in[24][lane]), s2 = wave_sum(A.in[25][lane] * A.in[26][lane]); lam = __expf(s1) - __expf(s2) + LAM_INIT; }
    const int vcu = (G % 8 == 0) ? (bx % 8) * (G / 8) + bx / 8 : bx;
    const int krow = (r32 & ~12) | ((r32 >> 1) & 4) | ((r32 << 1) & 8);
    int koff0[4], koff1[4];
#pragma unroll
    for (int kk = 0; kk < 4; ++kk) { koff0[kk] = isub * 8192 + sw64(krow, 2 * kk + hi); koff1[kk] = isub * 8192 + sw64(32 + krow, 2 * kk + hi); }
    const int dl = lane >> 3, dpc = lane & 7;
    for (int u = vcu; u < 2048; u += G) {
        const int bh = u >> 6, b = bh >> 3, h = bh & 7, q0 = (u & 63) * 128;
        const int qrow = b * SEQL + q0 + 32 * rg + r32;
        bf16x8 qf[4];
#pragma unroll
        for (int kk = 0; kk < 4; ++kk) qf[kk] = *(const bf16x8*)(QK + (size_t)qrow * 2048 + h * 128 + isub * 64 + 16 * kk + 8 * hi);
        const bf16* srck[2]; const bf16* srcv[2];
#pragma unroll
        for (int i = 0; i < 2; ++i) { const int n = 2 * wave + i;
            const int sub = n >> 3, key = 8 * (n & 7) + dl, ck = dpc ^ ((key >> 1) & 7); srck[i] = QK + 1024 + h * 128 + sub * 64 + ck * 8 + (size_t)key * 2048;
            const int dv = 8 * n + dl, cv = dpc ^ ((dv >> 1) & 7); srcv[i] = VTg + (size_t)(h * 128 + dv) * RT + cv * 8; }
        LAS unsigned char* kdst = lds + KRING + (2 * wave) * 1024; LAS unsigned char* vdst = lds + VRING + (2 * wave) * 1024;
#define KEYROW(t) (((t) < 4) ? (RL + b * CTXL + (t) * 64) : (b * SEQL + ((t) - 4) * 64))
#define DMA_K(t, slot) do { const size_t ko_ = (size_t)KEYROW(t) * 2048; glds16(srck[0] + ko_, kdst + (slot) * SLOT); glds16(srck[1] + ko_, kdst + (slot) * SLOT + 1024); } while (0)
#define DMA_V(t, slot) do { const size_t vo_ = (size_t)KEYROW(t); glds16(srcv[0] + vo_, vdst + (slot) * SLOT); glds16(srcv[1] + vo_, vdst + (slot) * SLOT + 1024); } while (0)
#define QKT(Sx0, Sx1, kslot) do { const LAS unsigned char* kb_ = lds + KRING + (kslot) * SLOT; \
            _Pragma("unroll") for (int r = 0; r < 16; ++r) { Sx0[r] = 0.f; Sx1[r] = 0.f; } \
            _Pragma("unroll") for (int kk = 0; kk < 4; ++kk) { const bf16x8 a0 = *(const LAS bf16x8*)(kb_ + koff0[kk]), a1 = *(const LAS bf16x8*)(kb_ + koff1[kk]); \
                Sx0 = MFMA32(a0, qf[kk], Sx0); Sx1 = MFMA32(a1, qf[kk], Sx1); } } while (0)
        float m_run = -1e30f, l_run = 0.f;
        f32x16 OT[4];
#pragma unroll
        for (int d = 0; d < 4; ++d)
#pragma unroll
            for (int r = 0; r < 16; ++r) OT[d][r] = 0.f;
        f32x16 SA0, SA1, SB0, SB1;
        DMA_K(0, 0); DMA_V(0, 0); DMA_K(1, 1); DMA_K(2, 2); DMA_V(1, 1);
        AT_WAIT_BAR(4);
        QKT(SA0, SA1, 0);
        AT_WAIT_BAR(4);
        int ks_next = 1, ks_free = 0, vs_cur = 0, vs_free = 2;
#define AT_STEP(Sc0, Sc1, Sn0, Sn1, t) do { \
            if ((t) + 3 < NT) DMA_K((t) + 3, ks_free); \
            if ((t) + 2 < NT) DMA_V((t) + 2, vs_free); \
            QKT(Sn0, Sn1, ks_next); \
            float mx = fmaxf(Sc0[0], Sc1[0]); \
            _Pragma("unroll") for (int r = 1; r < 16; ++r) mx = fmaxf(mx, fmaxf(Sc0[r], Sc1[r])); \
            mx = fmaxf(mx, __shfl_xor(mx, 32)); \
            const float mnew = fmaxf(m_run, mx); \
            if (__any(mnew > m_run)) { const float al = __builtin_amdgcn_exp2f(m_run - mnew); l_run *= al; \
                _Pragma("unroll") for (int d = 0; d < 4; ++d) _Pragma("unroll") for (int r = 0; r < 16; ++r) OT[d][r] *= al; \
                m_run = mnew; } \
            float ls = 0.f; \
            _Pragma("unroll") for (int r = 0; r < 16; ++r) { Sc0[r] = __builtin_amdgcn_exp2f(Sc0[r] - m_run); Sc1[r] = __builtin_amdgcn_exp2f(Sc1[r] - m_run); ls += Sc0[r] + Sc1[r]; } \
            l_run += ls; \
            bf16x8 Pb[4]; Pb[0] = pack8<0>(Sc0); Pb[1] = pack8<1>(Sc0); Pb[2] = pack8<0>(Sc1); Pb[3] = pack8<1>(Sc1); \
            { const LAS unsigned char* vb_ = lds + VRING + vs_cur * SLOT; \
              _Pragma("unroll") for (int dvb = 0; dvb < 4; ++dvb) _Pragma("unroll") for (int js = 0; js < 4; ++js) { \
                  const bf16x8 av = *(const LAS bf16x8*)(vb_ + sw64(32 * dvb + r32, 2 * js + hi)); OT[dvb] = MFMA32(av, Pb[js], OT[dvb]); } } \
            if ((t) + 3 < NT) AT_WAIT_BAR(4); else if ((t) + 2 < NT) AT_WAIT_BAR(2); else AT_WAIT_BAR(0); \
            ks_free = ks_next; ks_next = (ks_next == 2) ? 0 : ks_next + 1; vs_free = vs_cur; vs_cur = (vs_cur == 2) ? 0 : vs_cur + 1; } while (0)
        for (int t = 0; t < NT; t += 2) { AT_STEP(SA0, SA1, SB0, SB1, t); AT_STEP(SB0, SB1, SA0, SA1, t + 1); }
#undef AT_STEP
#undef QKT
#undef DMA_K
#undef DMA_V
#undef KEYROW
        { const float lt = l_run + __shfl_xor(l_run, 32); const float il = 1.0f / lt;
#pragma unroll
            for (int d = 0; d < 4; ++d)
#pragma unroll
                for (int r = 0; r < 16; ++r) OT[d][r] *= il; }
        LAS float* ex = (LAS float*)lds;
        if (isub == 1) {
#pragma unroll
            for (int d = 0; d < 4; ++d)
#pragma unroll
                for (int r = 0; r < 16; ++r) ex[((rg * 4 + d) * 16 + r) * 64 + lane] = OT[d][r]; }
        __syncthreads();
        if (isub == 0) {
            float ss = 0.f;
#pragma unroll
            for (int d = 0; d < 4; ++d)
#pragma unroll
                for (int r = 0; r < 16; ++r) { const float o = OT[d][r] - lam * ex[((rg * 4 + d) * 16 + r) * 64 + lane]; OT[d][r] = o; ss += o * o; }
            ss += __shfl_xor(ss, 32);
            const float rn = (1.0f - LAM_INIT) / sqrtf(ss * (1.0f / 128.0f) + EPSN);
            bf16* orow = ATT + (size_t)qrow * DM + h * 128;
#pragma unroll
            for (int d = 0; d < 4; ++d)
#pragma unroll
                for (int g4 = 0; g4 < 4; ++g4) { const int dv = 32 * d + 8 * g4 + 4 * hi; const f32x4 w = *(const f32x4*)(A.in[27] + dv);
                    u32x2 o; o.x = pk2(OT[d][4 * g4] * rn * w[0], OT[d][4 * g4 + 1] * rn * w[1]); o.y = pk2(OT[d][4 * g4 + 2] * rn * w[2], OT[d][4 * g4 + 3] * rn * w[3]);
                    *(u32x2*)(orow + dv) = o; }
        }
        __syncthreads();
    }
}
#undef AT_WAIT_BAR

constexpr int NPHASE = 20;
__global__ void __launch_bounds__(NTHR, 2) mega_fwd(Args A) {
    extern __shared__ __attribute__((aligned(16))) unsigned char lds_raw[];
    LAS unsigned char* lds = (LAS unsigned char*)lds_raw;
    const int tid = threadIdx.x, lane = tid & 63, wave = __builtin_amdgcn_readfirstlane(tid >> 6);
    const int G = gridDim.x, bx = blockIdx.x;
    unsigned char* ws = A.ws;
    if (tid < 64) ((LAS unsigned*)(lds + LDSX))[tid] = 0u;
    __syncthreads();
    XcdBarrier bar; bar.bar = (unsigned*)(ws + WS_CTL) + CW_BAR; bar.x = 0; bar.st = nullptr;
    if (!MK_SPLIT) bar = xcd_barrier_post((unsigned*)(ws + WS_CTL) + CW_BAR, (volatile LAS unsigned*)(lds + LDSX));
    const int lo = A.ph_lo, hi_ = A.ph_hi;
#ifdef ONLY_PHASE
#define IN(k) ((k) == ONLY_PHASE && lo <= (k) && (k) < hi_)
#else
#define IN(k) (lo <= (k) && (k) < hi_)
#endif
#if defined(REPEAT_PHASE)
#define REPLOOP(k) for (int rep_ = 0, nrep_ = ((k) == REPEAT_PHASE ? A.ph_rep : 1); rep_ < nrep_; (++rep_ < nrep_) ? xcd_barrier(bar) : (void)0)
#else
#define REPLOOP(k)
#endif
#define SEAM(k) do { if (IN(k) && IN((k) + 1)) xcd_barrier(bar); } while (0)

    if (IN(0)) REPLOOP(0) { phase0(A, lds, tid, lane, wave, G, bx); } SEAM(0);
    if (IN(1)) REPLOOP(1) { phase_modulate<0, 0>(A, lds, tid, lane, wave, G, bx); } SEAM(1);
    if (IN(2)) REPLOOP(2) {
        pg8::Gemm g{(const pg8::bf16_t*)(ws + WS_H), (const pg8::bf16_t*)(ws + WS_WIN), RT, NPROJ, DM}; pg8::StaticOrder S; S.init(RT, NPROJ, G, bx);
        pg8::EpiBf16<0> E{(pg8::bf16_t*)(ws + WS_BIG), NPROJ, nullptr, 0, 0, 1.f};
        pg8::gemm_phase<pg8::EpiBf16<0>, pg8::StaticOrder, true, true>(lds, g, S, E);
    } SEAM(2);
    if (IN(3)) REPLOOP(3) { phase_gdn_prep(A, lds, tid, lane, wave, G, bx); } SEAM(3);
    if (IN(4)) REPLOOP(4) { phase_gdn_scan(A, lds, tid, lane, wave, G, bx); } SEAM(4);
    if (IN(5)) REPLOOP(5) { phase_ycat(A, lds, tid, lane, wave, G, bx); } SEAM(5);
    if (IN(6)) REPLOOP(6) {
        pg8::Gemm g{(const pg8::bf16_t*)(ws + WS_H), (const pg8::bf16_t*)(ws + WS_WOUT), RT, DM, DM}; pg8::StaticOrder S; S.init(RT, DM, G, bx);
        pg8::EpiResidual E{A.in[0], A.in[2], A.out, (float*)(ws + WS_XC), (const float*)(ws + WS_MODV) + 2 * 1024, RL};
        pg8::gemm_phase<pg8::EpiResidual, pg8::StaticOrder, true, true>(lds, g, S, E);
    } SEAM(6);
    if (IN(7)) REPLOOP(7) { phase_modulate<1, 0>(A, lds, tid, lane, wave, G, bx); } SEAM(7);
    if (IN(8)) REPLOOP(8) { phase_topk<0>(A, lds, tid, lane, wave, G, bx); } SEAM(8);
    if (IN(9)) REPLOOP(9) {
        pg8::Gemm g{(const pg8::bf16_t*)(ws + WS_G), (const pg8::bf16_t*)(ws + WS_E0), M1_0, 4096, DM}; pg8::MoeOrder S{17 * 16 * 16, G, bx, 17, 16};
        pg8::EpiMoe1 E{(pg8::bf16_t*)(ws + WS_BIG)};
        pg8::gemm_phase<pg8::EpiMoe1, pg8::MoeOrder, true, true>(lds, g, S, E);
    } SEAM(9);
    if (IN(10)) REPLOOP(10) {
        pg8::Gemm g{(const pg8::bf16_t*)(ws + WS_BIG), (const pg8::bf16_t*)(ws + WS_E0 + 128 * MiB), M1_0, DM, FFN}; pg8::MoeOrder S{17 * 16 * 4, G, bx, 17, 4};
        pg8::EpiMoe2 E{(pg8::bf16_t*)(ws + WS_G + 192 * MiB), (const float*)(ws + WS_GATEV)};
        pg8::gemm_phase<pg8::EpiMoe2, pg8::MoeOrder, true, true>(lds, g, S, E);
    } SEAM(10);
    if (IN(11)) REPLOOP(11) { phase_combine<0>(A, lds, tid, lane, wave, G, bx); } SEAM(11);
    if (IN(12)) REPLOOP(12) {
        { pg8::Gemm g{(const pg8::bf16_t*)(ws + WS_H), (const pg8::bf16_t*)(ws + WS_WQK), RT, 2048, DM}; pg8::StaticOrder S; S.init(RT, 2048, G, bx);
          pg8::EpiQK E{(pg8::bf16_t*)(ws + WS_BIG), (const float*)(ws + WS_ROPE), 0.125f * 1.4426950408889634f, RL};
          pg8::gemm_phase<pg8::EpiQK, pg8::StaticOrder, true, true>(lds, g, S, E); }
        { pg8::Gemm g{(const pg8::bf16_t*)(ws + WS_WV), (const pg8::bf16_t*)(ws + WS_H), DM, RT, DM}; pg8::StaticOrder S; S.init(DM, RT, G, bx);
          pg8::EpiBf16<0> E{(pg8::bf16_t*)(ws + WS_BIG + 132 * MiB), RT, nullptr, 0, 0, 1.f};
          pg8::gemm_phase<pg8::EpiBf16<0>, pg8::StaticOrder, true, true>(lds, g, S, E); }
    } SEAM(12);
    if (IN(13)) REPLOOP(13) { phase_attn(A, lds, tid, lane, wave, G, bx); } SEAM(13);
    if (IN(14)) REPLOOP(14) {
        pg8::Gemm g{(const pg8::bf16_t*)(ws + WS_H), (const pg8::bf16_t*)(ws + WS_WO), RL, DM, DM}; pg8::StaticOrder S; S.init(RL, DM, G, bx);
        pg8::EpiResidual E{A.out, A.out, A.out, A.out, (const float*)(ws + WS_MODV) + 5 * 6144 + 2 * 1024, RL};
        pg8::gemm_phase<pg8::EpiResidual, pg8::StaticOrder, true, true>(lds, g, S, E);
    } SEAM(14);
    if (IN(15)) REPLOOP(15) { phase_modulate<1, 1>(A, lds, tid, lane, wave, G, bx); } SEAM(15);
    if (IN(16)) REPLOOP(16) { phase_topk<1>(A, lds, tid, lane, wave, G, bx); } SEAM(16);
    if (IN(17)) REPLOOP(17) {
        pg8::Gemm g{(const pg8::bf16_t*)(ws + WS_G + 192 * MiB), (const pg8::bf16_t*)(ws + WS_G), M1_1, 4096, DM}; pg8::MoeOrder S{16 * 16 * 16, G, bx, 16, 16};
        pg8::EpiMoe1 E{(pg8::bf16_t*)(ws + WS_BIG)};
        pg8::gemm_phase<pg8::EpiMoe1, pg8::MoeOrder, true, true>(lds, g, S, E);
    } SEAM(17);
    if (IN(18)) REPLOOP(18) {
        pg8::Gemm g{(const pg8::bf16_t*)(ws + WS_BIG), (const pg8::bf16_t*)(ws + WS_G + 128 * MiB), M1_1, DM, FFN}; pg8::MoeOrder S{16 * 16 * 4, G, bx, 16, 4};
        pg8::EpiMoe2 E{(pg8::bf16_t*)(ws + WS_E0), (const float*)(ws + WS_GATEV)};
        pg8::gemm_phase<pg8::EpiMoe2, pg8::MoeOrder, true, true>(lds, g, S, E);
    } SEAM(18);
    if (IN(19)) REPLOOP(19) { phase_combine<1>(A, lds, tid, lane, wave, G, bx); }
#undef IN
#undef SEAM
}

extern "C" void kernel_launch(void* const* d_in, const int* in_sizes, int n_in, void* d_out, int out_size, void* d_ws, size_t ws_size, hipStream_t stream) {
    static int grid = 0;
    if (grid == 0) {
        if (n_in != 35 || out_size != RL * DM || ws_size < WS_END) { fprintf(stderr, "kernel_launch: unexpected problem (n_in %d, out %d, ws %zu < %zu)\n", n_in, out_size, ws_size, (size_t)WS_END); grid = -1; return; }
        int dev = 0, cus = 0, per_cu = 0;
        if (hipGetDevice(&dev) != hipSuccess || hipDeviceGetAttribute(&cus, hipDeviceAttributeMultiprocessorCount, dev) != hipSuccess) { grid = -1; return; }
        if (hipFuncSetAttribute((const void*)mega_fwd, hipFuncAttributeMaxDynamicSharedMemorySize, LDS_BYTES) != hipSuccess) { fprintf(stderr, "kernel_launch: hipFuncSetAttribute failed\n"); grid = -1; return; }
        if (hipOccupancyMaxActiveBlocksPerMultiprocessor(&per_cu, (const void*)mega_fwd, NTHR, LDS_BYTES) != hipSuccess || per_cu < 1) { fprintf(stderr, "kernel_launch: occupancy query reports %d\n", per_cu); }
        (void)hipGetLastError();
        grid = cus;
    }
    if (grid < 0) return;
    if (hipMemsetAsync((char*)d_ws + WS_CTL, 0, CTL_ZERO_BYTES, stream) != hipSuccess) return;
    Args a{};
    for (int i = 0; i < 35; ++i) a.in[i] = (const float*)d_in[i];
    a.out = (float*)d_out; a.ws = (unsigned char*)d_ws;
#if MK_SPLIT
    for (int p = 0; p < NPHASE; ++p) { a.ph_lo = p; a.ph_hi = p + 1; hipLaunchKernelGGL(mega_fwd, dim3(grid), dim3(NTHR), LDS_BYTES, stream, a); }
#else
    a.ph_lo = 0; a.ph_hi = NPHASE; a.ph_rep = 2;
    hipLaunchKernelGGL(mega_fwd, dim3(grid), dim3(NTHR), LDS_BYTES, stream, a);
#endif
}
```

```cpp
#include <hip/hip_runtime.h>
#include <cstdio>
#include <cstdint>
#ifndef MK_SPLIT
#define MK_SPLIT 0
#endif

namespace pg8 {
#define PG8_LAS __attribute__((address_space(3)))
typedef unsigned short bf16_t;
typedef short bf16x8 __attribute__((ext_vector_type(8)));
typedef float f32x4 __attribute__((ext_vector_type(4)));
typedef unsigned u32x4 __attribute__((ext_vector_type(4)));
constexpr int BM = 256, BK = 64, HALF = 128, HTB = HALF * BK * 2  , STAGE_BYTES = 8 * HTB, NXCD = 8, WGM = 8;

__host__ __device__ __forceinline__ int lds_byte(int r, int c) { const int st = (r >> 4) * 2 + (c >> 5), rr = r & 15, cc = c & 31, ob = rr * 64 + cc * 2; return st * 1024 + (ob ^ (((ob >> 9) & 1) << 5)); }
__host__ __device__ __forceinline__ void stage_rc(int b, int& R, int& C) { const int st = b / 1024, sb = b % 1024, swz = sb ^ (((sb >> 9) & 1) << 5); R = (st >> 1) * 16 + swz / 64; C = (st & 1) * 32 + (swz % 64) / 2; }
__host__ __device__ __forceinline__ int perm32(int rho) { const int n = rho >> 4, i = rho & 15; return 8 * (i >> 2) + 4 * n + (i & 3); }

struct Unit { int pm, pn; };
struct Gemm { const bf16_t* A; const bf16_t* Bt; int M, N, K; };

struct StaticOrder {
    int nM, nN, nwg, G, c;
    __host__ __device__ void init(int M, int N, int G_, int c_) { nM = M / BM; nN = N / BM; nwg = nM * nN; G = G_; c = c_; }
    __host__ __device__ bool next(int i, Unit& u) const {
        const long L = (long)i * G + c; if (L >= nwg) return false;
        int wgid = (int)L; { const int q = nwg / NXCD, r = nwg % NXCD, xcd = wgid % NXCD, off = wgid / NXCD; wgid = (xcd < r ? xcd * (q + 1) : r * (q + 1) + (xcd - r) * q) + off; }
        const int nig = WGM * nN, gid = wgid / nig, fm = gid * WGM, gsz = (nM - fm) < WGM ? (nM - fm) : WGM;
        u.pm = fm + ((wgid % nig) % gsz); u.pn = (wgid % nig) / gsz; return true;
    }
    __device__ __forceinline__ void a_ready(const Unit&) const {}
    __device__ __forceinline__ void done(const Unit&) const {}
};

__device__ __forceinline__ unsigned cvt_pk_bf16(float lo, float hi) { unsigned r; asm volatile("v_cvt_pk_bf16_f32 %0, %1, %2" : "=v"(r) : "v"(lo), "v"(hi)); return r; }
typedef float f32x2 __attribute__((ext_vector_type(2)));
__device__ __forceinline__ f32x2 gelu_pk(f32x2 v) {
    const f32x2 av = __builtin_elementwise_abs(v), d = av * 0.2316418882f + 1.0f;
    f32x2 t; t.x = __builtin_amdgcn_rcpf(d.x); t.y = __builtin_amdgcn_rcpf(d.y);
    f32x2 q = t * 0.5307027145f + (-0.7265760135f); q = q * t + 0.7107068705f; q = q * t + (-0.142248368f); q = q * t + 0.127414796f; q = q * t;
    const f32x2 s = (v * v) * (-0.72134752044f);
    f32x2 e; e.x = __builtin_amdgcn_exp2f(s.x); e.y = __builtin_amdgcn_exp2f(s.y);
    const f32x2 m = v * (q * e), r = v - m;
    f32x2 o; o.x = v.x < 0.f ? m.x : r.x; o.y = v.y < 0.f ? m.y : r.y; return o;
}

template <int ACT  > struct EpiBf16 {
    static constexpr bool PERM = true, AFTER_DRAIN = false; static_assert(ACT == 0 || ACT == 1, "EpiBf16: ACT is 0 (none) or 1 (gelu_pk)");
    bf16_t* O; int ldc; const float* bias; int split_cols; size_t split_stride; float scale0;
    __device__ __forceinline__ void operator()(const f32x4 (&acc)[2][2][4][2], const Unit& u, int wr, int wc, int fr, int fq) const {
        const int row0 = u.pm * BM + wr * 64 + fr; int colt = u.pn * BM; bf16_t* base = O;
        float sc = 1.f; if (split_cols) { const int t = colt / split_cols; base += (size_t)t * split_stride; colt -= t * split_cols; if (t == 0) sc = scale0; }
        const int col0 = colt + wc * 32 + 8 * fq, bcol0 = u.pn * BM + wc * 32 + 8 * fq;
        f32x4 bv[2][2];
#pragma unroll
        for (int bj = 0; bj < 2; ++bj)
#pragma unroll
            for (int n = 0; n < 2; ++n) bv[bj][n] = bias ? *(const f32x4*)(bias + bcol0 + bj * HALF + 4 * n) : (f32x4){0.f, 0.f, 0.f, 0.f};
#pragma unroll
        for (int ai = 0; ai < 2; ++ai)
#pragma unroll
            for (int m = 0; m < 4; ++m) { bf16_t* rowp = base + (size_t)(row0 + ai * HALF + m * 16) * ldc + col0;
#pragma unroll
                for (int bj = 0; bj < 2; ++bj) { f32x4 v0 = acc[ai][bj][m][0] + bv[bj][0], v1 = acc[ai][bj][m][1] + bv[bj][1];
                    if (ACT == 1) { f32x2 a = gelu_pk((f32x2){v0[0], v0[1]}), b = gelu_pk((f32x2){v0[2], v0[3]}), c = gelu_pk((f32x2){v1[0], v1[1]}), d = gelu_pk((f32x2){v1[2], v1[3]});
                        v0 = (f32x4){a.x, a.y, b.x, b.y}; v1 = (f32x4){c.x, c.y, d.x, d.y}; }
                    v0 = v0 * sc; v1 = v1 * sc; u32x4 w; w.x = cvt_pk_bf16(v0[0], v0[1]); w.y = cvt_pk_bf16(v0[2], v0[3]); w.z = cvt_pk_bf16(v1[0], v1[1]); w.w = cvt_pk_bf16(v1[2], v1[3]);
                    *(u32x4*)(rowp + bj * HALF) = w; } }
    }
};

__device__ __forceinline__ float silu_fast(float x) { return x * __builtin_amdgcn_rcpf(1.0f + __builtin_amdgcn_exp2f(-1.4426950408889634f * x)); }
struct EpiResidual {
    static constexpr bool PERM = false, AFTER_DRAIN = false;
    const float* base_lat; const float* base_ctx; float* out_lat; float* out_ctx; const float* gate; int RL;
    __device__ __forceinline__ void operator()(const f32x4 (&acc)[2][2][4][2], const Unit& u, int wr, int wc, int fr, int fq) const {
        const int col0 = u.pn * BM + wc * 32 + 4 * fq;
#pragma unroll
        for (int ai = 0; ai < 2; ++ai)
#pragma unroll
            for (int m = 0; m < 4; ++m) {
                const int row = u.pm * BM + ai * HALF + wr * 64 + m * 16 + fr;
                const bool lat = row < RL; const int rr = lat ? row : row - RL; const int bb = lat ? (row >> 13) : 4;
                const float* bp = (lat ? base_lat : base_ctx) + (size_t)rr * 1024 + col0; float* op = (lat ? out_lat : out_ctx) + (size_t)rr * 1024 + col0;
                const float* gp = gate + bb * 6144 + col0;
#pragma unroll
                for (int bj = 0; bj < 2; ++bj)
#pragma unroll
                    for (int n = 0; n < 2; ++n) { const int c = bj * HALF + n * 16; const f32x4 g = *(const f32x4*)(gp + c), b = *(const f32x4*)(bp + c); *(f32x4*)(op + c) = b + g * acc[ai][bj][m][n]; }
            }
    }
};
struct EpiMoe1 {
    static constexpr bool PERM = true, AFTER_DRAIN = false;
    bf16_t* O;
    __device__ __forceinline__ void operator()(const f32x4 (&acc)[2][2][4][2], const Unit& u, int wr, int wc, int fr, int fq) const {
        const int row0 = u.pm * BM + wr * 64 + fr; const int hcol0 = (u.pn & 15) * 128 + wc * 32 + 8 * fq;
#pragma unroll
        for (int ai = 0; ai < 2; ++ai)
#pragma unroll
            for (int m = 0; m < 4; ++m) { bf16_t* rowp = O + (size_t)(row0 + ai * HALF + m * 16) * 2048 + hcol0;
                const f32x4 g0 = acc[ai][0][m][0], g1 = acc[ai][0][m][1], u0 = acc[ai][1][m][0], u1 = acc[ai][1][m][1];
                u32x4 w; w.x = cvt_pk_bf16(silu_fast(g0[0]) * u0[0], silu_fast(g0[1]) * u0[1]); w.y = cvt_pk_bf16(silu_fast(g0[2]) * u0[2], silu_fast(g0[3]) * u0[3]);
                w.z = cvt_pk_bf16(silu_fast(g1[0]) * u1[0], silu_fast(g1[1]) * u1[1]); w.w = cvt_pk_bf16(silu_fast(g1[2]) * u1[2], silu_fast(g1[3]) * u1[3]);
                *(u32x4*)rowp = w; }
    }
};
struct EpiMoe2 {
    static constexpr bool PERM = true, AFTER_DRAIN = false;
    bf16_t* O; const float* gatev;
    __device__ __forceinline__ void operator()(const f32x4 (&acc)[2][2][4][2], const Unit& u, int wr, int wc, int fr, int fq) const {
        const int row0 = u.pm * BM + wr * 64 + fr; const int col0 = (u.pn & 3) * BM + wc * 32 + 8 * fq;
#pragma unroll
        for (int ai = 0; ai < 2; ++ai)
#pragma unroll
            for (int m = 0; m < 4; ++m) { const int row = row0 + ai * HALF + m * 16; const float gv = gatev[row]; bf16_t* rowp = O + (size_t)row * 1024 + col0;
#pragma unroll
                for (int bj = 0; bj < 2; ++bj) { const f32x4 v0 = acc[ai][bj][m][0] * gv, v1 = acc[ai][bj][m][1] * gv;
                    u32x4 w; w.x = cvt_pk_bf16(v0[0], v0[1]); w.y = cvt_pk_bf16(v0[2], v0[3]); w.z = cvt_pk_bf16(v1[0], v1[1]); w.w = cvt_pk_bf16(v1[2], v1[3]);
                    *(u32x4*)(rowp + bj * HALF) = w; } }
    }
};
struct EpiQK {
    static constexpr bool PERM = true, AFTER_DRAIN = false;
    bf16_t* O; const float* rope; float qscale; int RL;
    __device__ __forceinline__ void operator()(const f32x4 (&acc)[2][2][4][2], const Unit& u, int wr, int wc, int fr, int fq) const {
        const int row0 = u.pm * BM + wr * 64 + fr; const int colb = u.pn * BM + wc * 32 + 8 * fq;
#pragma unroll
        for (int ai = 0; ai < 2; ++ai)
#pragma unroll
            for (int m = 0; m < 4; ++m) { const int row = row0 + ai * HALF + m * 16; const bool lat = row < RL; const int t = row & 8191; const int pr = t >> 6, pc = t & 63;
#pragma unroll
                for (int bj = 0; bj < 2; ++bj) { const int col = colb + bj * HALF; f32x4 v0 = acc[ai][bj][m][0], v1 = acc[ai][bj][m][1];
                    if (lat) { const int half = (col >> 5) & 1, j0 = (col & 31) >> 1;
                        const float* cp = rope + (half ? 4096 + pc * 16 : pr * 16) + j0; const float* sp = cp + (half ? 1024 : 2048);
                        const f32x4 c = *(const f32x4*)cp, s = *(const f32x4*)sp;
                        f32x4 a, b;
                        a[0] = v0[0] * c[0] - v0[1] * s[0]; a[1] = v0[1] * c[0] + v0[0] * s[0]; a[2] = v0[2] * c[1] - v0[3] * s[1]; a[3] = v0[3] * c[1] + v0[2] * s[1];
                        b[0] = v1[0] * c[2] - v1[1] * s[2]; b[1] = v1[1] * c[2] + v1[0] * s[2]; b[2] = v1[2] * c[3] - v1[3] * s[3]; b[3] = v1[3] * c[3] + v1[2] * s[3];
                        v0 = a; v1 = b; }
                    const float sc = (col < 1024) ? qscale : 1.0f; v0 = v0 * sc; v1 = v1 * sc;
                    u32x4 w; w.x = cvt_pk_bf16(v0[0], v0[1]); w.y = cvt_pk_bf16(v0[2], v0[3]); w.z = cvt_pk_bf16(v1[0], v1[1]); w.w = cvt_pk_bf16(v1[2], v1[3]);
                    *(u32x4*)(O + (size_t)row * 2048 + col) = w; } }
    }
};
struct MoeOrder {
    int total, G, c, tiles_pe, ncol;
    __device__ __forceinline__ bool next(int i, Unit& u) const {
        const long L = (long)i * G + c; if (L >= total) return false;
        const int per = tiles_pe * ncol; const int e = (int)L / per, rem = (int)L % per; const int pml = rem % tiles_pe, pnl = rem / tiles_pe;
        u.pm = e * tiles_pe + pml; u.pn = e * ncol + pnl; return true; }
    __device__ __forceinline__ void a_ready(const Unit&) const {}
    __device__ __forceinline__ void done(const Unit&) const {}
};
template <class Epi, class Sched, bool ALIGN_EPI = false, bool SP2 = false>
__device__ __forceinline__ void gemm_phase(PG8_LAS unsigned char* lds, const Gemm g, const Sched& S, const Epi& E) {
    const int tid = threadIdx.x, wid = __builtin_amdgcn_readfirstlane(tid >> 6), lane = tid & 63, wr = wid >> 2, wc = wid & 3, fr = lane & 15, fq = lane >> 4;
    const int K = g.K, nt = K / BK;
    unsigned voffA[2], voffB[2];
#pragma unroll
    for (int i = 0; i < 2; ++i) { int R, C; stage_rc(tid * 16 + i * 8192, R, C); const int Rb = Epi::PERM ? ((R & ~31) + perm32(R & 31)) : R;
        voffA[i] = (unsigned)(R * K + C) * 2u; voffB[i] = (unsigned)(Rb * K + C) * 2u; }
    const size_t kstep = (size_t)(BK * 2);
    const size_t hstep = (size_t)HALF * K * 2;
    const size_t tstep = 2 * hstep;
    const unsigned ldsw = (unsigned)wid * 1024u;
    const int aoff = lds_byte(wr * 64 + fr, fq * 8), boff = lds_byte(wc * 32 + fr, fq * 8);
#define PG8_SA(b, h) (((b) * 2 + (h)) * HTB)
#define PG8_SB(b, h) ((4 + (b) * 2 + (h)) * HTB)
#define PG8_STAGE(bufoff, gbase, voff) do { _Pragma("unroll") for (int _i = 0; _i < 2; ++_i) \
        __builtin_amdgcn_global_load_lds((const unsigned*)((const char*)(gbase) + (voff)[_i]), (PG8_LAS unsigned*)(lds + (bufoff) + ldsw + _i * 8192), 16, 0, 0); } while (0)
#define PG8_LDA(dst, b, h) do { _Pragma("unroll") for (int m = 0; m < 4; ++m) _Pragma("unroll") for (int k = 0; k < 2; ++k) dst[m][k] = *(const PG8_LAS bf16x8*)(lds + PG8_SA(b, h) + aoff + m * 2048 + k * 1024); } while (0)
#define PG8_LDB(dst, b, h) do { _Pragma("unroll") for (int n = 0; n < 2; ++n) _Pragma("unroll") for (int k = 0; k < 2; ++k) dst[n][k] = *(const PG8_LAS bf16x8*)(lds + PG8_SB(b, h) + boff + n * 2048 + k * 1024); } while (0)
#define PG8_MMA(ai, bj, At, Bt) do { __builtin_amdgcn_s_setprio(1); _Pragma("unroll") for (int m = 0; m < 4; ++m) _Pragma("unroll") for (int n = 0; n < 2; ++n) _Pragma("unroll") for (int k = 0; k < 2; ++k) \
        acc[ai][bj][m][n] = __builtin_amdgcn_mfma_f32_16x16x32_bf16(Bt[n][k], At[m][k], acc[ai][bj][m][n], 0, 0, 0); __builtin_amdgcn_s_setprio(0); } while (0)
#define PG8_WAIT_V(n) asm volatile("s_waitcnt vmcnt(" #n ")" ::: "memory")
#define PG8_WAIT_L(n) asm volatile("s_waitcnt lgkmcnt(" #n ")" ::: "memory")
#define PG8_BAR __builtin_amdgcn_s_barrier()
#define PG8_SCHED __builtin_amdgcn_sched_barrier(0)
    Unit cur, nxt; int ui = 0;
    if (!S.next(0, cur)) return;
    f32x4 acc[2][2][4][2];
#pragma unroll
    for (int a = 0; a < 2; ++a)
#pragma unroll
        for (int b = 0; b < 2; ++b)
#pragma unroll
            for (int m = 0; m < 4; ++m)
#pragma unroll
                for (int n = 0; n < 2; ++n) acc[a][b][m][n] = (f32x4){0.f, 0.f, 0.f, 0.f};
    bf16x8 At[4][2], B0[2][2], B1[2][2];
    const char* cA = (const char*)g.A + (size_t)cur.pm * tstep; const char* cB = (const char*)g.Bt + (size_t)cur.pn * tstep;
    S.a_ready(cur);
    if constexpr (SP2) {
        PG8_STAGE(PG8_SB(0, 0), cB, voffB); PG8_STAGE(PG8_SB(0, 1), cB + hstep, voffB); PG8_STAGE(PG8_SA(0, 0), cA, voffA); PG8_STAGE(PG8_SA(0, 1), cA + hstep, voffA);
        if (wr == 1) PG8_BAR;
        PG8_WAIT_V(2); PG8_BAR;
        PG8_STAGE(PG8_SB(1, 0), cB + kstep, voffB); PG8_STAGE(PG8_SA(1, 0), cA + kstep, voffA); PG8_STAGE(PG8_SB(1, 1), cB + hstep + kstep, voffB);
        PG8_WAIT_V(6); PG8_BAR;
    } else {
        PG8_STAGE(PG8_SB(0, 0), cB, voffB); PG8_STAGE(PG8_SA(0, 0), cA, voffA); PG8_STAGE(PG8_SB(0, 1), cB + hstep, voffB); PG8_STAGE(PG8_SA(0, 1), cA + hstep, voffA);
        if (wr == 1) PG8_BAR;
        PG8_WAIT_V(4); PG8_BAR;
        PG8_STAGE(PG8_SB(1, 0), cB + kstep, voffB); PG8_STAGE(PG8_SA(1, 0), cA + kstep, voffA); PG8_STAGE(PG8_SB(1, 1), cB + hstep + kstep, voffB);
        PG8_WAIT_V(6); PG8_BAR;
    }
    for (;;) {
        const bool has_next = S.next(ui + 1, nxt);
        const char* nA = has_next ? (const char*)g.A + (size_t)nxt.pm * tstep : cA; const char* nB = has_next ? (const char*)g.Bt + (size_t)nxt.pn * tstep : cB;
        for (int t = 0; t < nt; t += 2) {
            const bool last = (t == nt - 2);
            const char* a1 = cA + (size_t)(t + 1) * kstep;
            const char* a2 = last ? nA : cA + (size_t)(t + 2) * kstep; const char* b2 = last ? nB : cB + (size_t)(t + 2) * kstep;
            const char* a3 = a2 + kstep; const char* b3 = b2 + kstep;
            if (last && has_next) S.a_ready(nxt);
            if constexpr (SP2) {
            PG8_LDB(B0, 0, 0); PG8_LDB(B1, 0, 1); PG8_SCHED; PG8_LDA(At, 0, 0); PG8_STAGE(PG8_SA(1, 1), a1 + hstep, voffA);
            PG8_WAIT_V(8); PG8_WAIT_L(0); PG8_BAR; PG8_MMA(0, 0, At, B0); PG8_MMA(0, 1, At, B1); PG8_BAR; PG8_SCHED;
            PG8_LDA(At, 0, 1); PG8_STAGE(PG8_SB(0, 0), b2, voffB); PG8_STAGE(PG8_SB(0, 1), b2 + hstep, voffB); PG8_STAGE(PG8_SA(0, 0), a2, voffA);
            PG8_WAIT_V(8); PG8_WAIT_L(0); PG8_BAR; PG8_MMA(1, 0, At, B0); PG8_MMA(1, 1, At, B1); PG8_BAR; PG8_SCHED;
            PG8_LDB(B0, 1, 0); PG8_LDB(B1, 1, 1); PG8_SCHED; PG8_LDA(At, 1, 0); PG8_STAGE(PG8_SA(0, 1), a2 + hstep, voffA);
            PG8_WAIT_V(8); PG8_WAIT_L(0); PG8_BAR; PG8_MMA(0, 0, At, B0); PG8_MMA(0, 1, At, B1); PG8_BAR; PG8_SCHED;
            PG8_LDA(At, 1, 1); PG8_STAGE(PG8_SB(1, 0), b3, voffB); PG8_STAGE(PG8_SB(1, 1), b3 + hstep, voffB); PG8_STAGE(PG8_SA(1, 0), a3, voffA);
            PG8_WAIT_V(8); PG8_WAIT_L(0); PG8_BAR; PG8_MMA(1, 0, At, B0); PG8_MMA(1, 1, At, B1); PG8_BAR; PG8_SCHED;
            } else {
            PG8_LDB(B0, 0, 0); PG8_SCHED; PG8_LDA(At, 0, 0); PG8_STAGE(PG8_SA(1, 1), a1 + hstep, voffA);
            PG8_WAIT_L(8); PG8_BAR; PG8_WAIT_L(0); PG8_MMA(0, 0, At, B0); PG8_BAR; PG8_SCHED;
            PG8_LDB(B1, 0, 1); PG8_STAGE(PG8_SB(0, 0), b2, voffB);
            PG8_BAR; PG8_WAIT_L(0); PG8_MMA(0, 1, At, B1); PG8_BAR;
            PG8_LDA(At, 0, 1); PG8_STAGE(PG8_SA(0, 0), a2, voffA);
            PG8_BAR; PG8_WAIT_L(0); PG8_MMA(1, 0, At, B0); PG8_BAR; PG8_SCHED;
            PG8_STAGE(PG8_SB(0, 1), b2 + hstep, voffB);
            PG8_WAIT_V(6); PG8_BAR; PG8_MMA(1, 1, At, B1); PG8_BAR;
            PG8_LDB(B0, 1, 0); PG8_SCHED; PG8_LDA(At, 1, 0); PG8_STAGE(PG8_SA(0, 1), a2 + hstep, voffA);
            PG8_WAIT_L(8); PG8_BAR; PG8_WAIT_L(0); PG8_MMA(0, 0, At, B0); PG8_BAR; PG8_SCHED;
            PG8_LDB(B1, 1, 1); PG8_STAGE(PG8_SB(1, 0), b3, voffB);
            PG8_BAR; PG8_WAIT_L(0); PG8_MMA(0, 1, At, B1); PG8_BAR;
            PG8_LDA(At, 1, 1); PG8_STAGE(PG8_SA(1, 0), a3, voffA);
            PG8_BAR; PG8_WAIT_L(0); PG8_MMA(1, 0, At, B0); PG8_BAR; PG8_SCHED;
            PG8_STAGE(PG8_SB(1, 1), b3 + hstep, voffB);
            PG8_WAIT_V(6); PG8_BAR; PG8_MMA(1, 1, At, B1); PG8_BAR;
            }
        }
        if constexpr (ALIGN_EPI) { if (wr == 0) PG8_BAR; }
        if constexpr (!Epi::AFTER_DRAIN) { E(acc, cur, wr, wc, fr, fq); S.done(cur); }
        if (!has_next) break;
#pragma unroll
        for (int a = 0; a < 2; ++a)
#pragma unroll
            for (int b = 0; b < 2; ++b)
#pragma unroll
                for (int m = 0; m < 4; ++m)
#pragma unroll
                    for (int n = 0; n < 2; ++n) acc[a][b][m][n] = (f32x4){0.f, 0.f, 0.f, 0.f};
        cur = nxt; cA = nA; cB = nB; ++ui;
        if constexpr (ALIGN_EPI) { if (wr == 1) PG8_BAR; }
    }
    PG8_WAIT_V(0);
    if constexpr (!ALIGN_EPI) { if (wr == 0) PG8_BAR; }
    PG8_BAR;
    if constexpr (Epi::AFTER_DRAIN) { E.fused(acc, cur, wr, wc, fr, fq, lds, wid, lane); S.done(cur); }
#undef PG8_SA
#undef PG8_SB
#undef PG8_STAGE
#undef PG8_LDA
#undef PG8_LDB
#undef PG8_MMA
#undef PG8_WAIT_V
#undef PG8_WAIT_L
#undef PG8_BAR
#undef PG8_SCHED
}
}

#define GAS __attribute__((address_space(1)))
#define LAS __attribute__((address_space(3)))
#define DI __device__ __forceinline__
typedef unsigned short bf16;
typedef float f32x4 __attribute__((ext_vector_type(4)));
typedef float f32x2 __attribute__((ext_vector_type(2)));
typedef float f32x16 __attribute__((ext_vector_type(16)));
typedef short bf16x8 __attribute__((ext_vector_type(8)));
typedef unsigned u32x4 __attribute__((ext_vector_type(4)));
typedef unsigned u32x2 __attribute__((ext_vector_type(2)));
typedef __bf16 bf16x2_t __attribute__((ext_vector_type(2)));
#define LDS_WAIT() asm volatile("s_waitcnt lgkmcnt(0)" ::: "memory")
#define MFMA32(a, b, c) __builtin_amdgcn_mfma_f32_32x32x16_bf16((a), (b), (c), 0, 0, 0)
DI unsigned pk2(float lo, float hi) { f32x2 v = {lo, hi}; bf16x2_t b = __builtin_convertvector(v, bf16x2_t); return __builtin_bit_cast(unsigned, b); }
DI float bflo(unsigned w) { return __uint_as_float(w << 16); }
DI float bfhi(unsigned w) { return __uint_as_float(w & 0xffff0000u); }
DI int crow(int r, int hi) { return (r & 3) + 8 * (r >> 2) + 4 * hi; }
DI float wave_sum(float v) {
#pragma unroll
    for (int o = 1; o < 64; o <<= 1) v += __shfl_xor(v, o);
    return v;
}
DI float wave_max(float v) {
#pragma unroll
    for (int o = 1; o < 64; o <<= 1) v = fmaxf(v, __shfl_xor(v, o));
    return v;
}
DI float silu_f(float x) { return x / (1.0f + __expf(-x)); }
template <int S> DI bf16x8 pack8(const f32x16& x) {
    u32x4 p; p.x = pk2(x[8 * S], x[8 * S + 1]); p.y = pk2(x[8 * S + 2], x[8 * S + 3]); p.z = pk2(x[8 * S + 4], x[8 * S + 5]); p.w = pk2(x[8 * S + 6], x[8 * S + 7]);
    return __builtin_bit_cast(bf16x8, p);
}
DI int sw64(int row, int c8) { return row * 128 + ((c8 ^ ((row >> 1) & 7)) << 4); }
DI int sw128(int row, int c16) { return row * 256 + ((c16 ^ (row & 15)) << 4); }

#define XB_TMO      128
#define XB_XCNT(j)  (256  + 64 * (j))
#define XB_XSUB(j)  (1280 + 64 * (j))
#define XB_XGEN(j)  (2304 + 64 * (j))
#define XB_TOP      3328
#define XB_TOPGEN   3392
#define XCD_BAR_WORDS 3456
#define XB_SPIN_CAP (1u << 18)

__device__ __forceinline__ unsigned xb_ld(unsigned* p)              { return __hip_atomic_load(p, __ATOMIC_RELAXED, __HIP_MEMORY_SCOPE_AGENT); }
__device__ __forceinline__ unsigned xb_add(unsigned* p, unsigned v) { return __hip_atomic_fetch_add(p, v, __ATOMIC_RELAXED, __HIP_MEMORY_SCOPE_AGENT); }
__device__ __forceinline__ unsigned xb_xcc_id() { return (unsigned)__builtin_amdgcn_s_getreg((3 << 11) | 20) & 0xFu; }
#define XB_SPIN(cond, bar) do { unsigned _sp = 0; while (cond) { __builtin_amdgcn_s_sleep(1); \
    if ((++_sp & 255u) == 0u) { if (xb_ld(&(bar)[XB_TMO])) break; if (_sp > XB_SPIN_CAP) { atomicAdd(&(bar)[XB_TMO], 1u); break; } } } } while (0)

struct XcdBarrier {
    unsigned* bar; unsigned x;
    volatile LAS unsigned* st;
};

__device__ __forceinline__ XcdBarrier xcd_barrier_post(unsigned* bar, volatile LAS unsigned* st) {
    XcdBarrier b; b.bar = bar; b.x = xb_xcc_id(); b.st = st;
    if (threadIdx.x == 0) (void)xb_add(&bar[XB_XCNT(b.x)], 1u);
    return b;
}
__device__ __forceinline__ void xcd_barrier_complete(unsigned* bar, unsigned x, unsigned& nloc, unsigned& nx) {
    const unsigned G = gridDim.x * gridDim.y * gridDim.z;
    unsigned sum, cnt, mine, sp = 0u;
    for (;;) {
        sum = 0u; cnt = 0u; mine = 0u;
#pragma unroll
        for (unsigned j = 0; j < 16; ++j) { const unsigned c = xb_ld(&bar[XB_XCNT(j)]); sum += c; cnt += (c > 0u) ? 1u : 0u; mine = (j == x) ? c : mine; }
        if (sum == G) break;
        __builtin_amdgcn_s_sleep(1);
        if ((++sp & 255u) == 0u) { if (xb_ld(&bar[XB_TMO])) break; if (sp > XB_SPIN_CAP) { atomicAdd(&bar[XB_TMO], 1u); break; } }
    }
    nloc = mine > 0u ? mine : 1u; nx = cnt > 0u ? cnt : 1u;
}

__device__ __forceinline__ void xcd_barrier(const XcdBarrier& b) {
    asm volatile("s_waitcnt vmcnt(0)" ::: "memory");
    __syncthreads();
    if (threadIdx.x == 0) {
        unsigned* bar = b.bar;
        __builtin_amdgcn_s_waitcnt(0);
        unsigned nloc = b.st[0], nx = b.st[1];
        if (nloc == 0u) { xcd_barrier_complete(bar, b.x, nloc, nx); b.st[0] = nloc; b.st[1] = nx; }
        const unsigned old = xb_add(&bar[XB_XSUB(b.x)], 1u);
        const unsigned gen = old / nloc;
        if (old + 1u == (gen + 1u) * nloc) {
            __builtin_amdgcn_fence(__ATOMIC_RELEASE, "agent");
            asm volatile("s_waitcnt vmcnt(0)" ::: "memory");
            const unsigned og = xb_add(&bar[XB_TOP], 1u);
            const unsigned tg = og / nx;
            if (og + 1u == (tg + 1u) * nx) xb_add(&bar[XB_TOPGEN], 1u);
            else XB_SPIN(xb_ld(&bar[XB_TOPGEN]) == tg, bar);
            __builtin_amdgcn_fence(__ATOMIC_ACQUIRE, "agent");
            xb_add(&bar[XB_XGEN(b.x)], 1u);
            asm volatile("s_waitcnt vmcnt(0)" ::: "memory");
        } else {
            XB_SPIN(xb_ld(&bar[XB_XGEN(b.x)]) == gen, bar);
            __builtin_amdgcn_fence(__ATOMIC_ACQUIRE, "agent");
            asm volatile("s_waitcnt vmcnt(0)" ::: "memory");
        }
    }
    __syncthreads();
}

constexpr int NWAVES = 8, NTHR = 512;
constexpr int DM = 1024, NBATCH = 4, SEQL = 8192, CTXL = 256, RL = NBATCH * SEQL, RC = NBATCH * CTXL, RT = RL + RC;
constexpr int NPROJ = 3584, INCOLS = 3600, NEXP = 16, FFN = 2048;
constexpr int SPE0 = 17 * 256, SPE1 = 16 * 256;
constexpr int M1_0 = NEXP * SPE0, M1_1 = NEXP * SPE1;
constexpr float EPSN = 1e-6f;
constexpr float LAM_INIT = 0.35550907f;
constexpr int NCHUNK = 132;
constexpr int GBLK = 73728;

constexpr size_t MiB = 1u << 20;
constexpr size_t WS_CTL = 0, CTL_ZERO_BYTES = 1 * MiB;
constexpr size_t WS_MODV = 1 * MiB;
constexpr size_t WS_ROPE = 1 * MiB + 256 * 1024;
constexpr size_t WS_ZROW = 1 * MiB + 512 * 1024;
constexpr size_t WS_GATES = 2 * MiB;
constexpr size_t WS_AFFT = 5 * MiB;
constexpr size_t WS_INV = 8 * MiB;
constexpr size_t WS_GATEV = 11 * MiB;
constexpr size_t WS_GLAST = 12 * MiB;
constexpr size_t WS_WIN = 17 * MiB, WS_WOUT = 24 * MiB, WS_WQK = 26 * MiB, WS_WV = 30 * MiB, WS_WO = 32 * MiB;
constexpr size_t WS_E0 = 36 * MiB;
constexpr size_t WS_XC = 228 * MiB;
constexpr size_t WS_H = 232 * MiB;
constexpr size_t WS_BIG = 298 * MiB;
constexpr size_t WS_G = 570 * MiB;
constexpr size_t WS_END = 898 * MiB;
constexpr int CW_BAR = 4096, CW_Q0 = 8192, CW_Q1 = 8256;

constexpr int RING_BYTES = 131072;
constexpr int LDSX = RING_BYTES;
constexpr int LDS_BYTES = 147456;

struct Args { const float* in[35]; float* out; unsigned char* ws; int ph_lo, ph_hi, ph_rep, pad; };

template <class F> DI void tr_item(const float* W, int ldw, bf16* WT, int ldk, int k0, F rowmap, LAS float* scr, int lane) {
#pragma unroll 8
    for (int i = 0; i < 32; ++i) { const int kk = 2 * i + (lane >> 5); scr[kk * 33 + (lane & 31)] = W[(size_t)kk * ldw + (lane & 31)]; }
    LDS_WAIT(); asm volatile("" ::: "memory");
    const int c = lane & 7;
#pragma unroll
    for (int j = 0; j < 4; ++j) { const int n = (lane >> 3) + 8 * j; const LAS float* s = scr + (8 * c) * 33 + n;
        u32x4 o; o.x = pk2(s[0 * 33], s[1 * 33]); o.y = pk2(s[2 * 33], s[3 * 33]); o.z = pk2(s[4 * 33], s[5 * 33]); o.w = pk2(s[6 * 33], s[7 * 33]);
        *(u32x4*)(WT + (size_t)rowmap(n) * ldk + k0 + 8 * c) = o; }
    LDS_WAIT(); asm volatile("" ::: "memory");
}
struct AddMap { int base; DI int operator()(int n) const { return base + n; } };
struct PairMap { int base; DI int operator()(int n) const { return base + (n < 16 ? 2 * n : 2 * (n - 16) + 1); } };
DI void expert_item(int r, const float* Wg, const float* Wu, const float* Wd, bf16* W1, bf16* W2, LAS float* scr, int lane) {
    if (r < 32768) { const int up = r >> 14, q = r & 16383, e = q >> 10, it = q & 1023, kb = it >> 6, nb = it & 63;
        const float* src = (up ? Wu : Wg) + (size_t)e * 1024 * 2048 + (size_t)(kb * 64) * 2048 + nb * 32;
        const int rbase = e * 4096 + (nb >> 2) * 256 + up * 128 + (nb & 3) * 32;
        tr_item(src, 2048, W1, 1024, kb * 64, AddMap{rbase}, scr, lane);
    } else { const int q = r - 32768, e = q >> 10, it = q & 1023, kb = it >> 5, nb = it & 31;
        const float* src = Wd + (size_t)e * 2048 * 1024 + (size_t)(kb * 64) * 1024 + nb * 32;
        const int rbase = e * 1024 + nb * 32;
        tr_item(src, 1024, W2, 2048, kb * 64, AddMap{rbase}, scr, lane);
    }
}
DI void stage_tab16(const float* W, int ldw, LAS float* tab, int tid) {
    for (int idx = tid; idx < 16384; idx += NTHR) { const int d = idx >> 4, e = idx & 15; const int j = d >> 8, l = (d >> 2) & 63, c = d & 3;
        tab[((((j * 4 + c) * 4 + (e >> 2)) * 64 + l) << 2) + (e & 3)] = W[(size_t)d * ldw + e]; }
}
DI void row_gemv16(const f32x4 (&h)[4], const LAS float* tab, int lane, float (&sums)[16]) {
#pragma unroll
    for (int e = 0; e < 16; ++e) sums[e] = 0.f;
#pragma unroll
    for (int j = 0; j < 4; ++j)
#pragma unroll
        for (int c = 0; c < 4; ++c) { const float hv = h[j][c];
#pragma unroll
            for (int q = 0; q < 4; ++q) { const f32x4 w = *(const LAS f32x4*)(tab + ((((j * 4 + c) * 4 + q) * 64 + lane) << 2));
                sums[4 * q + 0] += hv * w[0]; sums[4 * q + 1] += hv * w[1]; sums[4 * q + 2] += hv * w[2]; sums[4 * q + 3] += hv * w[3]; }
            asm volatile("" ::: "memory"); }
}
DI int eidx16(int lane) { return ((lane >> 5) & 1) * 8 + ((lane >> 4) & 1) * 4 + ((lane >> 3) & 1) * 2 + ((lane >> 2) & 1); }
DI float reduce16(const float (&s)[16], int lane) {
    float a8[8], a4[4], a2[2];
    const bool u5 = (lane & 32) != 0, u4 = (lane & 16) != 0, u3 = (lane & 8) != 0, u2 = (lane & 4) != 0;
#pragma unroll
    for (int k = 0; k < 8; ++k) { const float keep = u5 ? s[k + 8] : s[k], send = u5 ? s[k] : s[k + 8]; a8[k] = keep + __shfl_xor(send, 32); }
#pragma unroll
    for (int k = 0; k < 4; ++k) { const float keep = u4 ? a8[k + 4] : a8[k], send = u4 ? a8[k] : a8[k + 4]; a4[k] = keep + __shfl_xor(send, 16); }
#pragma unroll
    for (int k = 0; k < 2; ++k) { const float keep = u3 ? a4[k + 2] : a4[k], send = u3 ? a4[k] : a4[k + 2]; a2[k] = keep + __shfl_xor(send, 8); }
    float r; { const float keep = u2 ? a2[1] : a2[0], send = u2 ? a2[0] : a2[1]; r = keep + __shfl_xor(send, 4); }
    r += __shfl_xor(r, 2); r += __shfl_xor(r, 1);
    return r;
}
DI float* resid_ptr(float* lat, float* ctx, int r) { return r < RL ? lat + (size_t)r * DM : ctx + (size_t)(r - RL) * DM; }
DI int row_bb(int r) { return r < RL ? (r >> 13) : 4; }
DI void modulate_row(f32x4 (&v)[4], const float* nw, const float* shift, const float* scale, int lane) {
    float ss = 0.f;
#pragma unroll
    for (int j = 0; j < 4; ++j) ss += (v[j][0] * v[j][0] + v[j][1] * v[j][1]) + (v[j][2] * v[j][2] + v[j][3] * v[j][3]);
    const float rstd = 1.0f / sqrtf(wave_sum(ss) * (1.0f / DM) + EPSN);
#pragma unroll
    for (int j = 0; j < 4; ++j) { const int d = 256 * j + 4 * lane; const f32x4 w = *(const f32x4*)(nw + d), sc = *(const f32x4*)(scale + d), sh = *(const f32x4*)(shift + d);
        v[j] = v[j] * rstd * w * (sc + 1.0f) + sh; }
}
DI void store_row_bf16(bf16* dst, const f32x4 (&v)[4], int lane) {
#pragma unroll
    for (int j = 0; j < 4; ++j) { u32x2 o; o.x = pk2(v[j][0], v[j][1]); o.y = pk2(v[j][2], v[j][3]); *(u32x2*)(dst + 256 * j + 4 * lane) = o; }
}
DI void load_row_f32(const float* src, f32x4 (&v)[4], int lane) {
#pragma unroll
    for (int j = 0; j < 4; ++j) v[j] = *(const f32x4*)(src + 256 * j + 4 * lane);
}
DI void moe_combine_row(f32x4 (&v)[4], const int* invrow, const bf16* YE, const float* gvec, int lane) {
    const int mine = invrow[lane & 15];
    f32x4 a[4];
#pragma unroll
    for (int j = 0; j < 4; ++j) a[j] = (f32x4){0.f, 0.f, 0.f, 0.f};
#pragma unroll
    for (int e = 0; e < 16; ++e) { const int s = __builtin_amdgcn_readlane(mine, e);
        if (s >= 0) { const bf16* yr = YE + (size_t)s * DM;
#pragma unroll
            for (int j = 0; j < 4; ++j) { const u32x2 w = *(const u32x2*)(yr + 256 * j + 4 * lane); a[j][0] += bflo(w.x); a[j][1] += bfhi(w.x); a[j][2] += bflo(w.y); a[j][3] += bfhi(w.y); } } }
#pragma unroll
    for (int j = 0; j < 4; ++j) { const f32x4 g = *(const f32x4*)(gvec + 256 * j + 4 * lane); v[j] = v[j] + g * a[j]; }
}

#define PH_ARGS const Args& A, LAS unsigned char* lds, int tid, int lane, int wave, int G, int bx
DI void sincos_d(double a, float& sn, float& cs) {
    const double TWO_OVER_PI = 0.63661977236758134308, PIO2 = 1.57079632679489661923;
    const double kq = (double)(long long)(a * TWO_OVER_PI + 0.5); const double y = a - kq * PIO2; const double y2 = y * y;
    const double s = y * (1.0 + y2 * (-1.0 / 6 + y2 * (1.0 / 120 + y2 * (-1.0 / 5040 + y2 * (1.0 / 362880 + y2 * (-1.0 / 39916800 + y2 * (1.0 / 6227020800.0)))))));
    const double c = 1.0 + y2 * (-0.5 + y2 * (1.0 / 24 + y2 * (-1.0 / 720 + y2 * (1.0 / 40320 + y2 * (-1.0 / 3628800 + y2 * (1.0 / 479001600.0))))));
    const int k = (int)((long long)kq & 3);
    const double ss = (k == 0) ? s : (k == 1) ? c : (k == 2) ? -s : -c;
    const double cc = (k == 0) ? c : (k == 1) ? -s : (k == 2) ? -c : s;
    sn = (float)ss; cs = (float)cc;
}

DI void phase0(PH_ARGS) {
    unsigned char* ws = A.ws;
    LAS float* sil = (LAS float*)(lds + 73728);
    for (int i = tid; i < 5120; i += NTHR) { const int bb = i >> 10, k = i & 1023; const float cv = bb < 4 ? A.in[1][bb * 1024 + k] : A.in[3][k]; sil[i] = silu_f(cv); }
    __syncthreads();
    {
        const int t = wave * G + bx;
        if (t < 192) { const int layer = t / 96, n = (t % 96) * 64 + lane; const float* W = A.in[layer ? 19 : 4] + n; const float* Bv = A.in[layer ? 20 : 5];
            float a0 = 0.f, a1 = 0.f, a2 = 0.f, a3 = 0.f, a4 = 0.f;
#pragma unroll 8
            for (int k = 0; k < 1024; ++k) { const float w = W[(size_t)k * 6144]; a0 += sil[k] * w; a1 += sil[1024 + k] * w; a2 += sil[2048 + k] * w; a3 += sil[3072 + k] * w; a4 += sil[4096 + k] * w; }
            float* mv = (float*)(ws + WS_MODV) + layer * 5 * 6144 + n; const float bv = Bv[n];
            mv[0] = a0 + bv; mv[6144] = a1 + bv; mv[2 * 6144] = a2 + bv; mv[3 * 6144] = a3 + bv; mv[4 * 6144] = a4 + bv; }
    }
    if (bx == G - 1) {
        float* rope = (float*)(ws + WS_ROPE);
        for (int i = tid; i < 3072; i += NTHR) { const int isc = i >= 2048, ii = isc ? i - 2048 : i; const int pos = ii >> 4, j = ii & 15;
            double f = 1.0; for (int q = 0; q < j; ++q) f *= 0.56234132519034908;
            float sn, cs; sincos_d((double)pos * f, sn, cs);
            if (isc) { rope[4096 + ii] = cs; rope[5120 + ii] = sn; } else { rope[ii] = cs; rope[2048 + ii] = sn; } }
        unsigned* z = (unsigned*)(ws + WS_ZROW); for (int i = tid; i < 512; i += NTHR) z[i] = 0u;
    }
    LAS float* scr = (LAS float*)(lds + wave * 8704);
    const int gw = bx * NWAVES + wave, NGW = G * NWAVES;
    constexpr int I_IN = 16 * 112, I_OUT = 16 * 32, I_QK = 16 * 64, I_V = 16 * 32, I_O = 16 * 32;
    constexpr int NITEMS = I_IN + I_OUT + I_QK + I_V + I_O;
    for (int it = gw; it < NITEMS; it += NGW) {
        int r = it;
        if (r < I_IN) { const int kb = r / 112, nb = r % 112; tr_item(A.in[7] + (size_t)(kb * 64) * INCOLS + nb * 32, INCOLS, (bf16*)(ws + WS_WIN), 1024, kb * 64, AddMap{nb * 32}, scr, lane); continue; } r -= I_IN;
        if (r < I_OUT) { const int kb = r >> 5, nb = r & 31; tr_item(A.in[13] + (size_t)(kb * 64) * 1024 + nb * 32, 1024, (bf16*)(ws + WS_WOUT), 1024, kb * 64, AddMap{nb * 32}, scr, lane); continue; } r -= I_OUT;
        if (r < I_QK) { const int kb = r >> 6, nb = r & 63; tr_item(A.in[22] + (size_t)(kb * 64) * 3072 + nb * 32, 3072, (bf16*)(ws + WS_WQK), 1024, kb * 64, PairMap{nb * 32}, scr, lane); continue; } r -= I_QK;
        if (r < I_V) { const int kb = r >> 5, nb = r & 31; tr_item(A.in[22] + (size_t)(kb * 64) * 3072 + 2048 + nb * 32, 3072, (bf16*)(ws + WS_WV), 1024, kb * 64, AddMap{nb * 32}, scr, lane); continue; } r -= I_V;
        { const int kb = r >> 5, nb = r & 31; tr_item(A.in[28] + (size_t)(kb * 64) * 1024 + nb * 32, 1024, (bf16*)(ws + WS_WO), 1024, kb * 64, AddMap{nb * 32}, scr, lane); }
    }
}

template <int MODE, int LAYER> DI void phase_modulate(PH_ARGS) {
    unsigned char* ws = A.ws;
    LAS float* tab = (LAS float*)lds;
    if (MODE == 0) stage_tab16(A.in[7] + NPROJ, INCOLS, tab, tid); else stage_tab16(A.in[LAYER ? 30 : 15], 16, tab, tid);
    __syncthreads();
    const float* nw = A.in[MODE == 0 ? 6 : (LAYER ? 29 : 14)];
    const float* mv = (const float*)(ws + WS_MODV) + LAYER * 5 * 6144 + (MODE == 0 ? 0 : 3 * 1024);
    bf16* H = (bf16*)(ws + WS_H);
    const int NR = (MODE == 1 && LAYER == 1) ? RL : RT;
    for (int r = bx * NWAVES + wave; r < NR; r += G * NWAVES) {
        const float* src = (MODE == 0) ? (r < RL ? A.in[0] + (size_t)r * DM : A.in[2] + (size_t)(r - RL) * DM) : resid_ptr(A.out, (float*)(ws + WS_XC), r);
        const int bb = row_bb(r);
        f32x4 v[4]; load_row_f32(src, v, lane);
        modulate_row(v, nw, mv + bb * 6144, mv + bb * 6144 + 1024, lane);
        store_row_bf16(H + (size_t)r * DM, v, lane);
        float sums[16]; row_gemv16(v, tab, lane, sums);
        const float red = reduce16(sums, lane); const int ee = eidx16(lane);
        if (MODE == 0) { if ((lane & 3) == 0) ((float*)(ws + WS_GATES))[(size_t)r * 16 + ee] = red; }
        else { const float mx = wave_max(red); const float ex = __expf(red - mx); const float den = wave_sum(ex) * 0.25f; const float mine = ex / den;
            if ((lane & 3) == 0) { float* af = (float*)(ws + WS_AFFT);
                if (r < RL) af[(size_t)(((r >> 13) * 16 + ee)) * 8192 + (r & 8191)] = mine;
                else { const int rr = r - RL; af[524288 + (size_t)(((rr >> 8) * 16 + ee)) * 256 + (rr & 255)] = mine; } } }
    }
}

DI void fnma_asm(float& acc, float a, float b) { asm("v_fma_f32 %0, -%1, %2, %0" : "+v"(acc) : "v"(a), "v"(b)); }
template <int J> DI void backsub_row(float (&t)[64], const LAS float* LT, int lane) {
    float acc0 = (lane == J) ? 1.0f : 0.0f, acc1 = 0.f;
    constexpr int K0 = (J + 1) >> 2;
#pragma unroll
    for (int k4 = K0; k4 < 16; ++k4) { const f32x4 l4 = *(const LAS f32x4*)(LT + J * 64 + 4 * k4);
#pragma unroll
        for (int q = 0; q < 4; ++q) { const int k = 4 * k4 + q; if (k > J) { if (q & 1) fnma_asm(acc1, t[k], l4[q]); else fnma_asm(acc0, t[k], l4[q]); } } }
    t[J] = acc0 + acc1;
    __builtin_amdgcn_sched_barrier(0);
}
template <int J> DI void backsub_all(float (&t)[64], const LAS float* LT, int lane) {
    backsub_row<J>(t, LT, lane);
    if constexpr (J > 0) backsub_all<J - 1>(t, LT, lane);
}
DI void gdn_dir(const Args& A, LAS unsigned char* lds, int lane, int dir, int b, int h, int seqsel, int cidx, int rowbase, int t0) {
    unsigned char* ws = A.ws;
    const int r32 = lane & 31, hi = lane >> 5;
    LAS unsigned char* Qn = lds; LAS unsigned char* Kn = lds + 16384;
    LAS unsigned char* DB = lds + 32768 + 49152 * dir;
    LAS float* LT = (LAS float*)DB; LAS unsigned char* TBG = DB; LAS unsigned char* TB = DB + 8192;
    LAS unsigned char* KT = DB + 16384; LAS unsigned char* VT = DB + 32768;
    LAS float* SM = (LAS float*)(lds + LDSX + 1024 + dir * 1280);
    LAS float* GC = SM; LAS float* EGC = SM + 64; LAS float* BETA = SM + 128; LAS float* BG = SM + 192; LAS float* KDEC = SM + 256;
    const int ch = (b * 4 + h) * 2 + dir;
    const int p = seqsel ? (dir ? 3 - cidx : cidx) : 4 + (dir ? 127 - cidx : cidx);
    unsigned char* blk = ws + WS_G + (size_t)(ch * NCHUNK + p) * GBLK;
    {
        const int tk = dir ? 63 - lane : lane; const float* gr = (const float*)(ws + WS_GATES) + (size_t)(rowbase + t0 + tk) * 16;
        const float av = gr[dir * 4 + h], bv = gr[8 + dir * 4 + h];
        const float xs = av + A.in[11][dir * 4 + h]; const float sp = xs > 20.f ? xs : log1pf(__expf(xs));
        const float g = -__expf(A.in[10][dir * 4 + h]) * sp; const float beta = 1.0f / (1.0f + __expf(-bv));
        float gc = g;
#pragma unroll
        for (int o = 1; o < 64; o <<= 1) { const float tv = __shfl_up(gc, o); if (lane >= o) gc += tv; }
        const float gl = __shfl(gc, 63); const float eg = __expf(gc);
        GC[lane] = gc; EGC[lane] = eg; BETA[lane] = beta; BG[lane] = beta * eg; KDEC[lane] = __expf(gl - gc);
        if (lane == 0) ((float*)(ws + WS_GLAST))[ch * NCHUNK + p] = __expf(gl);
    }
    LDS_WAIT(); asm volatile("" ::: "memory");
#pragma unroll
    for (int ib = 0; ib < 2; ++ib) {
        const int i = 32 * ib + r32; const int ti = dir ? 63 - i : i; const float gi = GC[i], bi = BETA[i];
#pragma unroll
        for (int jb = 0; jb < 2; ++jb) {
            f32x16 aK, aQ;
#pragma unroll
            for (int r = 0; r < 16; ++r) { aK[r] = 0.f; aQ[r] = 0.f; }
            if (jb <= ib) {
                const int j = 32 * jb + r32; const int tj = dir ? 63 - j : j;
#pragma unroll
                for (int kk = 0; kk < 8; ++kk) {
                    const bf16x8 a = *(const LAS bf16x8*)(Kn + sw128(tj, 2 * kk + hi));
                    const bf16x8 bK = *(const LAS bf16x8*)(Kn + sw128(ti, 2 * kk + hi));
                    const bf16x8 bQ = *(const LAS bf16x8*)(Qn + sw128(ti, 2 * kk + hi));
                    aK = MFMA32(a, bK, aK); aQ = MFMA32(a, bQ, aQ);
                }
            }
#pragma unroll
            for (int g4 = 0; g4 < 4; ++g4) { const f32x4 gj = *(const LAS f32x4*)(GC + 32 * jb + 8 * g4 + 4 * hi);
#pragma unroll
                for (int q = 0; q < 4; ++q) { const int r = 4 * g4 + q; const int j = 32 * jb + 8 * g4 + 4 * hi + q;
                    const float dec = __expf(fminf(gi - gj[q], 0.f));
                    const float lv = (j < i) ? bi * aK[r] * dec : 0.f;
                    LT[j * 64 + i] = lv;
                    aQ[r] = (j <= i) ? aQ[r] * dec : 0.f; } }
            *(bf16x8*)(blk + 32768 + ((ib * 4 + 2 * jb + 0) * 1024) + lane * 16) = pack8<0>(aQ);
            *(bf16x8*)(blk + 32768 + ((ib * 4 + 2 * jb + 1) * 1024) + lane * 16) = pack8<1>(aQ);
        }
    }
    LDS_WAIT(); asm volatile("" ::: "memory");
    float t[64];
    backsub_all<63>(t, LT, lane);
    LDS_WAIT(); asm volatile("" ::: "memory");
#pragma unroll
    for (int c = 0; c < 8; ++c) {
        const f32x4 b0 = *(const LAS f32x4*)(BETA + 8 * c), b1 = *(const LAS f32x4*)(BETA + 8 * c + 4), g0 = *(const LAS f32x4*)(BG + 8 * c), g1 = *(const LAS f32x4*)(BG + 8 * c + 4);
        u32x4 wb, wg;
        wb.x = pk2(t[8 * c] * b0[0], t[8 * c + 1] * b0[1]); wb.y = pk2(t[8 * c + 2] * b0[2], t[8 * c + 3] * b0[3]); wb.z = pk2(t[8 * c + 4] * b1[0], t[8 * c + 5] * b1[1]); wb.w = pk2(t[8 * c + 6] * b1[2], t[8 * c + 7] * b1[3]);
        wg.x = pk2(t[8 * c] * g0[0], t[8 * c + 1] * g0[1]); wg.y = pk2(t[8 * c + 2] * g0[2], t[8 * c + 3] * g0[3]); wg.z = pk2(t[8 * c + 4] * g1[0], t[8 * c + 5] * g1[1]); wg.w = pk2(t[8 * c + 6] * g1[2], t[8 * c + 7] * g1[3]);
        *(LAS u32x4*)(TB + sw64(lane, c)) = wb; *(LAS u32x4*)(TBG + sw64(lane, c)) = wg;
    }
    LDS_WAIT(); asm volatile("" ::: "memory");
#pragma unroll
    for (int ib = 0; ib < 2; ++ib) {
        bf16x8 tg[4], tb[4];
#pragma unroll
        for (int js = 0; js < 4; ++js) { tg[js] = *(const LAS bf16x8*)(TBG + sw64(32 * ib + r32, 2 * js + hi)); tb[js] = *(const LAS bf16x8*)(TB + sw64(32 * ib + r32, 2 * js + hi)); }
#pragma unroll
        for (int kb = 0; kb < 4; ++kb) {
            f32x16 acc;
#pragma unroll
            for (int r = 0; r < 16; ++r) acc[r] = 0.f;
#pragma unroll
            for (int js = 0; js < 4; ++js) { const bf16x8 a = *(const LAS bf16x8*)(KT + sw64(32 * kb + r32, 2 * js + hi)); acc = MFMA32(a, tg[js], acc); }
            *(bf16x8*)(blk + ((ib * 8 + 2 * kb + 0) * 1024) + lane * 16) = pack8<0>(acc);
            *(bf16x8*)(blk + ((ib * 8 + 2 * kb + 1) * 1024) + lane * 16) = pack8<1>(acc);
        }
#pragma unroll
        for (int dvb = 0; dvb < 4; ++dvb) {
            f32x16 acc;
#pragma unroll
            for (int r = 0; r < 16; ++r) acc[r] = 0.f;
#pragma unroll
            for (int js = 0; js < 4; ++js) { const bf16x8 bv = *(const LAS bf16x8*)(VT + sw64(32 * dvb + r32, 2 * js + hi)); acc = MFMA32(tb[js], bv, acc); }
            unsigned char* up = blk + 57344 + (dvb * 2 + ib) * 2048 + lane * 32;
            *(bf16x8*)(up) = pack8<0>(acc); *(bf16x8*)(up + 16) = pack8<1>(acc);
        }
    }
#pragma unroll
    for (int ib = 0; ib < 2; ++ib) { const int i = 32 * ib + r32; const int ti = dir ? 63 - i : i; const float eg = EGC[i];
#pragma unroll
        for (int ks = 0; ks < 8; ++ks) {
            const u32x2 lo = *(const LAS u32x2*)(Qn + sw128(ti, 2 * ks) + 8 * hi), hh = *(const LAS u32x2*)(Qn + sw128(ti, 2 * ks + 1) + 8 * hi);
            u32x4 o; o.x = pk2(bflo(lo.x) * eg, bfhi(lo.x) * eg); o.y = pk2(bflo(lo.y) * eg, bfhi(lo.y) * eg); o.z = pk2(bflo(hh.x) * eg, bfhi(hh.x) * eg); o.w = pk2(bflo(hh.y) * eg, bfhi(hh.y) * eg);
            *(u32x4*)(blk + 16384 + ((ib * 8 + ks) * 1024) + lane * 16) = o; } }
#pragma unroll
    for (int kb = 0; kb < 4; ++kb) { const int dk = 32 * kb + r32;
#pragma unroll
        for (int ks = 0; ks < 4; ++ks) {
            const u32x2 lo = *(const LAS u32x2*)(KT + sw64(dk, 2 * ks) + 8 * hi), hh = *(const LAS u32x2*)(KT + sw64(dk, 2 * ks + 1) + 8 * hi);
            const f32x4 d0 = *(const LAS f32x4*)(KDEC + 16 * ks + 4 * hi), d1 = *(const LAS f32x4*)(KDEC + 16 * ks + 8 + 4 * hi);
            u32x4 o; o.x = pk2(bflo(lo.x) * d0[0], bfhi(lo.x) * d0[1]); o.y = pk2(bflo(lo.y) * d0[2], bfhi(lo.y) * d0[3]); o.z = pk2(bflo(hh.x) * d1[0], bfhi(hh.x) * d1[1]); o.w = pk2(bflo(hh.y) * d1[2], bfhi(hh.y) * d1[3]);
            *(u32x4*)(blk + 40960 + ((kb * 4 + ks) * 1024) + lane * 16) = o; } }
}

DI void phase_gdn_prep(PH_ARGS) {
    unsigned char* ws = A.ws;
    const bf16* PROJ = (const bf16*)(ws + WS_BIG);
    LAS unsigned char* Qn = lds; LAS unsigned char* Kn = lds + 16384;
    const int lane_in = lane;
    for (int u = bx; u < 2112; u += G) {
        int lane = lane_in; asm volatile("" : "+v"(lane));
        int seqsel, b, cidx, h;
        if (u < 2048) { seqsel = 0; b = u >> 9; cidx = (u >> 2) & 127; h = u & 3; } else { const int q = u - 2048; seqsel = 1; b = q >> 4; cidx = (q >> 2) & 3; h = q & 3; }
        const int rowbase = seqsel ? RL + b * CTXL : b * SEQL; const int L = seqsel ? CTXL : SEQL; const int t0 = cidx * 64;
        {
            const int d = 2 * lane; float w[3][3][2];
#pragma unroll
            for (int s = 0; s < 3; ++s)
#pragma unroll
                for (int j = 0; j < 3; ++j) { const f32x2 wv = *(const f32x2*)(A.in[9] + j * 1536 + s * 512 + h * 128 + d); w[s][j][0] = wv[0]; w[s][j][1] = wv[1]; }
            unsigned raw[10][3];
#pragma unroll
            for (int rr = 0; rr < 10; ++rr) { const int t = t0 + 8 * wave - 1 + rr; const bool ok = (t >= 0) && (t < L);
#pragma unroll
                for (int s = 0; s < 3; ++s) raw[rr][s] = ok ? *(const unsigned*)(PROJ + (size_t)(rowbase + t) * NPROJ + 1536 + s * 512 + h * 128 + d) : 0u; }
#pragma unroll
            for (int ii = 0; ii < 8; ++ii) { const int i = 8 * wave + ii;
                float val[3][2];
#pragma unroll
                for (int s = 0; s < 3; ++s) {
                    const float x0 = w[s][0][0] * bflo(raw[ii][s]) + w[s][1][0] * bflo(raw[ii + 1][s]) + w[s][2][0] * bflo(raw[ii + 2][s]);
                    const float x1 = w[s][0][1] * bfhi(raw[ii][s]) + w[s][1][1] * bfhi(raw[ii + 1][s]) + w[s][2][1] * bfhi(raw[ii + 2][s]);
                    val[s][0] = silu_f(x0); val[s][1] = silu_f(x1); }
                const float qs = wave_sum(val[0][0] * val[0][0] + val[0][1] * val[0][1]), ksq = wave_sum(val[1][0] * val[1][0] + val[1][1] * val[1][1]);
                const float rq = 0.08838834764831845f / sqrtf(qs + EPSN), rk = 1.0f / sqrtf(ksq + EPSN);
                const unsigned qp = pk2(val[0][0] * rq, val[0][1] * rq), kp = pk2(val[1][0] * rk, val[1][1] * rk), vp = pk2(val[2][0], val[2][1]);
                *(LAS unsigned*)(Qn + sw128(i, lane >> 2) + (lane & 3) * 4) = qp;
                *(LAS unsigned*)(Kn + sw128(i, lane >> 2) + (lane & 3) * 4) = kp;
#pragma unroll
                for (int dir = 0; dir < 2; ++dir) { const int pi = dir ? 63 - i : i; LAS unsigned char* KT = lds + 32768 + 49152 * dir + 16384; LAS unsigned char* VT = KT + 16384;
                    *(LAS unsigned short*)(KT + sw64(d, pi >> 3) + (pi & 7) * 2) = (unsigned short)(kp & 0xffffu);
                    *(LAS unsigned short*)(KT + sw64(d + 1, pi >> 3) + (pi & 7) * 2) = (unsigned short)(kp >> 16);
                    *(LAS unsigned short*)(VT + sw64(d, pi >> 3) + (pi & 7) * 2) = (unsigned short)(vp & 0xffffu);
                    *(LAS unsigned short*)(VT + sw64(d + 1, pi >> 3) + (pi & 7) * 2) = (unsigned short)(vp >> 16); }
            }
        }
        __syncthreads();
        if (wave < 2) gdn_dir(A, lds, lane, wave, b, h, seqsel, cidx, rowbase, t0);
        __syncthreads();
    }
}

DI void expert_queue(const Args& A, LAS unsigned char* lds, int lane, int wave, unsigned* qword, const float* Wg, const float* Wu, const float* Wd, bf16* W1, bf16* W2) {
    LAS float* scr = (LAS float*)(lds + wave * 8704);
    for (;;) {
        unsigned it0 = 0u;
        if (lane == 0) it0 = __hip_atomic_fetch_add(qword, 4u, __ATOMIC_RELAXED, __HIP_MEMORY_SCOPE_AGENT);
        it0 = (unsigned)__builtin_amdgcn_readfirstlane((int)it0);
        if (it0 >= 49152u) break;
#pragma unroll 1
        for (int q = 0; q < 4; ++q) expert_item((int)it0 + q, Wg, Wu, Wd, W1, W2, scr, lane);
    }
}
DI void phase_gdn_scan(PH_ARGS) {
    unsigned char* ws = A.ws;
    unsigned* qword = (unsigned*)(ws + WS_CTL) + CW_Q0;
    if (bx < 128) {
    const int xcd = bx & 7, idx = bx >> 3; const int ch = xcd + 8 * (idx >> 2), v = idx & 3;
    const int dir = ch & 1, bh = ch >> 1, b = bh >> 2, h = bh & 3;
    const int r32 = lane & 31, hi = lane >> 5;
    bf16* PROJ = (bf16*)(ws + WS_BIG);
    const float* GL = (const float*)(ws + WS_GLAST) + ch * NCHUNK;
    const unsigned char* gbase = ws + WS_G + (size_t)ch * NCHUNK * GBLK;
    constexpr int SBUF = 61440;
    const int lt = tid - 64;
#define SCAN_LOAD(p, bufi) do { const unsigned char* gb = gbase + (size_t)(p) * GBLK; LAS unsigned char* lb = lds + (bufi) * SBUF; u32x4 tv[9]; \
        _Pragma("unroll") for (int k = 0; k < 8; ++k) tv[k] = *(const u32x4*)(gb + (lt + 448 * k) * 16); \
        if (lt < 256) tv[8] = *(const u32x4*)(gb + 57344 + v * 4096 + lt * 16); \
        _Pragma("unroll") for (int k = 0; k < 8; ++k) *(LAS u32x4*)(lb + (lt + 448 * k) * 16) = tv[k]; \
        if (lt < 256) *(LAS u32x4*)(lb + 57344 + lt * 16) = tv[8]; } while (0)
    if (wave > 0) SCAN_LOAD(0, 0);
    __syncthreads();
    f32x16 S[4];
#pragma unroll
    for (int kb = 0; kb < 4; ++kb)
#pragma unroll
        for (int r = 0; r < 16; ++r) S[kb][r] = 0.f;
    for (int p = 0; p < NCHUNK; ++p) {
      if (wave > 0) { if (p + 1 < NCHUNK) SCAN_LOAD(p + 1, (p + 1) & 1); }
      else {
        const LAS unsigned char* blk = lds + (p & 1) * SBUF + lane * 16;
        const float gl = GL[p];
        bf16x8 Sb[8];
        Sb[0] = pack8<0>(S[0]); Sb[1] = pack8<1>(S[0]); Sb[2] = pack8<0>(S[1]); Sb[3] = pack8<1>(S[1]);
        Sb[4] = pack8<0>(S[2]); Sb[5] = pack8<1>(S[2]); Sb[6] = pack8<0>(S[3]); Sb[7] = pack8<1>(S[3]);
        f32x16 P[2], O[2];
#pragma unroll
        for (int ib = 0; ib < 2; ++ib) {
#pragma unroll
            for (int r = 0; r < 16; ++r) { P[ib][r] = 0.f; O[ib][r] = 0.f; }
#pragma unroll
            for (int ks = 0; ks < 8; ++ks) { const bf16x8 wf = *(const LAS bf16x8*)(blk + (ib * 8 + ks) * 1024); P[ib] = MFMA32(wf, Sb[ks], P[ib]); }
            asm volatile("" ::: "memory");
#pragma unroll
            for (int ks = 0; ks < 8; ++ks) { const bf16x8 qf = *(const LAS bf16x8*)(blk + 16384 + (ib * 8 + ks) * 1024); O[ib] = MFMA32(qf, Sb[ks], O[ib]); }
            asm volatile("" ::: "memory");
        }
        bf16x8 Vb[4];
#pragma unroll
        for (int ib = 0; ib < 2; ++ib) {
            const LAS unsigned char* up = lds + (p & 1) * SBUF + 57344 + ib * 2048 + lane * 32;
            const u32x4 u0 = *(const LAS u32x4*)up, u1 = *(const LAS u32x4*)(up + 16);
            f32x16 vn;
            vn[0] = bflo(u0.x) - P[ib][0]; vn[1] = bfhi(u0.x) - P[ib][1]; vn[2] = bflo(u0.y) - P[ib][2]; vn[3] = bfhi(u0.y) - P[ib][3];
            vn[4] = bflo(u0.z) - P[ib][4]; vn[5] = bfhi(u0.z) - P[ib][5]; vn[6] = bflo(u0.w) - P[ib][6]; vn[7] = bfhi(u0.w) - P[ib][7];
            vn[8] = bflo(u1.x) - P[ib][8]; vn[9] = bfhi(u1.x) - P[ib][9]; vn[10] = bflo(u1.y) - P[ib][10]; vn[11] = bfhi(u1.y) - P[ib][11];
            vn[12] = bflo(u1.z) - P[ib][12]; vn[13] = bfhi(u1.z) - P[ib][13]; vn[14] = bflo(u1.w) - P[ib][14]; vn[15] = bfhi(u1.w) - P[ib][15];
            Vb[2 * ib] = pack8<0>(vn); Vb[2 * ib + 1] = pack8<1>(vn);
        }
#pragma unroll
        for (int ib = 0; ib < 2; ++ib)
#pragma unroll
            for (int kt = 0; kt < 4; ++kt) { const bf16x8 af = *(const LAS bf16x8*)(blk + 32768 + (ib * 4 + kt) * 1024); O[ib] = MFMA32(af, Vb[kt], O[ib]); }
        asm volatile("" ::: "memory");
#pragma unroll
        for (int kb = 0; kb < 4; ++kb) {
            asm volatile("" ::: "memory");
#pragma unroll
            for (int r = 0; r < 16; ++r) S[kb][r] *= gl;
#pragma unroll
            for (int kt = 0; kt < 4; ++kt) { const bf16x8 kf = *(const LAS bf16x8*)(blk + 40960 + (kb * 4 + kt) * 1024); S[kb] = MFMA32(kf, Vb[kt], S[kb]); }
        }
        int rowbase, cidx;
        if (p < 4) { cidx = dir ? 3 - p : p; rowbase = RL + b * CTXL; } else { cidx = dir ? 131 - p : p - 4; rowbase = b * SEQL; }
        int hiv = hi; asm volatile("" : "+v"(hiv));
        const long step = dir ? -(long)NPROJ : (long)NPROJ;
        bf16* ob = PROJ + (size_t)(rowbase + cidx * 64 + (dir ? 63 - 4 * hiv : 4 * hiv)) * NPROJ + 1536 + dir * 512 + h * 128 + 32 * v + r32;
#pragma unroll
        for (int ib = 0; ib < 2; ++ib)
#pragma unroll
            for (int r = 0; r < 16; ++r) { const int c = 32 * ib + (r & 3) + 8 * (r >> 2);
                ob[step * c] = (bf16)(pk2(O[ib][r], 0.f) & 0xffffu); }
      }
      __syncthreads();
    }
#undef SCAN_LOAD
    }
    expert_queue(A, lds, lane, wave, qword, A.in[16], A.in[17], A.in[18], (bf16*)(ws + WS_E0), (bf16*)(ws + WS_E0 + 128 * MiB));
}

DI void unpack8(const u32x4 w, float (&f)[8]) { f[0] = bflo(w.x); f[1] = bfhi(w.x); f[2] = bflo(w.y); f[3] = bfhi(w.y); f[4] = bflo(w.z); f[5] = bfhi(w.z); f[6] = bflo(w.w); f[7] = bfhi(w.w); }
DI void phase_ycat(PH_ARGS) {
    unsigned char* ws = A.ws;
    const bf16* PROJ = (const bf16*)(ws + WS_BIG); bf16* Y = (bf16*)(ws + WS_H);
    const int c0 = 8 * lane;
    float cw[3][8], gn[8];
#pragma unroll
    for (int j = 0; j < 3; ++j) { const f32x4 a = *(const f32x4*)(A.in[8] + j * 512 + c0), b2 = *(const f32x4*)(A.in[8] + j * 512 + c0 + 4);
        cw[j][0] = a[0]; cw[j][1] = a[1]; cw[j][2] = a[2]; cw[j][3] = a[3]; cw[j][4] = b2[0]; cw[j][5] = b2[1]; cw[j][6] = b2[2]; cw[j][7] = b2[3]; }
    { const f32x4 a = *(const f32x4*)(A.in[12] + (c0 & 127)), b2 = *(const f32x4*)(A.in[12] + (c0 & 127) + 4);
        gn[0] = a[0]; gn[1] = a[1]; gn[2] = a[2]; gn[3] = a[3]; gn[4] = b2[0]; gn[5] = b2[1]; gn[6] = b2[2]; gn[7] = b2[3]; }
    for (int r = bx * NWAVES + wave; r < RT; r += G * NWAVES) {
        const int t = r < RL ? (r & 8191) : ((r - RL) & 255); const int L = r < RL ? SEQL : CTXL;
        const bf16* pr = PROJ + (size_t)r * NPROJ;
        float pm[8], pc[8], pn[8], xa[8], gc_[8], gb[8];
        unpack8(*(const u32x4*)(pr + c0), xa); unpack8(*(const u32x4*)(pr + 1024 + c0), gc_); unpack8(*(const u32x4*)(pr + 512 + c0), gb);
#pragma unroll
        for (int q = 0; q < 8; ++q) pc[q] = gc_[q] * xa[q];
        if (t > 0) { unpack8(*(const u32x4*)(pr - NPROJ + c0), xa); unpack8(*(const u32x4*)(pr - NPROJ + 1024 + c0), gc_);
#pragma unroll
            for (int q = 0; q < 8; ++q) pm[q] = gc_[q] * xa[q]; }
        else {
#pragma unroll
            for (int q = 0; q < 8; ++q) pm[q] = 0.f; }
        if (t < L - 1) { unpack8(*(const u32x4*)(pr + NPROJ + c0), xa); unpack8(*(const u32x4*)(pr + NPROJ + 1024 + c0), gc_);
#pragma unroll
            for (int q = 0; q < 8; ++q) pn[q] = gc_[q] * xa[q]; }
        else {
#pragma unroll
            for (int q = 0; q < 8; ++q) pn[q] = 0.f; }
        u32x4 o;
        { float y[8];
#pragma unroll
            for (int q = 0; q < 8; ++q) y[q] = gb[q] * (cw[0][q] * pm[q] + cw[1][q] * pc[q] + cw[2][q] * pn[q]);
            o.x = pk2(y[0], y[1]); o.y = pk2(y[2], y[3]); o.z = pk2(y[4], y[5]); o.w = pk2(y[6], y[7]); }
        *(u32x4*)(Y + (size_t)r * DM + c0) = o;
        float of[8], ob[8], z[8];
        unpack8(*(const u32x4*)(pr + 1536 + c0), of); unpack8(*(const u32x4*)(pr + 2048 + c0), ob); unpack8(*(const u32x4*)(pr + 3072 + c0), z);
        float ss = 0.f;
#pragma unroll
        for (int q = 0; q < 8; ++q) { of[q] += ob[q]; ss += of[q] * of[q]; }
        ss += __shfl_xor(ss, 1); ss += __shfl_xor(ss, 2); ss += __shfl_xor(ss, 4); ss += __shfl_xor(ss, 8);
        const float rn = 1.0f / sqrtf(ss * (1.0f / 128.0f) + EPSN);
        { float y[8];
#pragma unroll
            for (int q = 0; q < 8; ++q) y[q] = of[q] * rn * gn[q] * silu_f(z[q]);
            o.x = pk2(y[0], y[1]); o.y = pk2(y[2], y[3]); o.z = pk2(y[4], y[5]); o.w = pk2(y[6], y[7]); }
        *(u32x4*)(Y + (size_t)r * DM + 512 + c0) = o;
    }
}

template <int LAYER> DI void phase_topk(PH_ARGS) {
    unsigned char* ws = A.ws;
    LAS unsigned* vals = (LAS unsigned*)lds; LAS unsigned* hist = (LAS unsigned*)(lds + 32768); LAS unsigned* misc = (LAS unsigned*)(lds + 34816);
    LAS unsigned* wsum = (LAS unsigned*)(lds + 35840); LAS int* slist = (LAS int*)(lds + 36864);
    const int SPE = LAYER ? SPE1 : SPE0; const int NTASK = LAYER ? 64 : 128;
    const bf16* H = (const bf16*)(ws + WS_H); bf16* XE = (bf16*)(ws + WS_G + (LAYER ? 192 * MiB : 0));
    float* gatev = (float*)(ws + WS_GATEV); int* INV = (int*)(ws + WS_INV);
    for (int task = bx; task < NTASK; task += G) {
        const int seqsel = task >> 6, b = (task >> 4) & 3, e = task & 15;
        const int n = seqsel ? CTXL : SEQL, cap = seqsel ? 32 : 1024;
        const float* af = (const float*)(ws + WS_AFFT) + (seqsel ? 524288 + (size_t)((b * 16 + e)) * 256 : (size_t)((b * 16 + e)) * 8192);
        const int rowbase = seqsel ? RL + b * CTXL : b * SEQL;
        const int slotbase = e * SPE + (seqsel ? 4096 + b * 32 : b * 1024);
        for (int i = tid; i < n; i += NTHR) vals[i] = __float_as_uint(af[i]);
        __syncthreads();
        unsigned prefix = 0u; int remaining = cap;
#pragma unroll 1
        for (int pass = 3; pass >= 0; --pass) { const int shift = pass * 8;
            if (tid < 256) hist[tid] = 0u;
            __syncthreads();
            for (int i = tid; i < n; i += NTHR) { const unsigned vv = vals[i]; const bool match = (pass == 3) || (((vv ^ prefix) >> (shift + 8)) == 0u); if (match) __hip_atomic_fetch_add(&hist[(vv >> shift) & 255u], 1u, __ATOMIC_RELAXED, __HIP_MEMORY_SCOPE_WORKGROUP); }
            __syncthreads();
            if (tid == 0) { int cum = 0, dsel = 0, rem = remaining;
                for (int d = 255; d >= 0; --d) { const int hc = (int)hist[d]; if (cum + hc >= remaining) { dsel = d; rem = remaining - cum; break; } cum += hc; }
                misc[0] = (unsigned)dsel; misc[1] = (unsigned)rem; }
            __syncthreads();
            prefix |= misc[0] << shift; remaining = (int)misc[1];
            __syncthreads();
        }
        const int per = seqsel ? 1 : 16; const int i0 = tid * per; const bool act = i0 < n;
        int cgt = 0, ceq = 0;
        if (act) for (int q = 0; q < per; ++q) { const unsigned vv = vals[i0 + q]; cgt += (vv > prefix); ceq += (vv == prefix); }
        unsigned pk = (unsigned)cgt | ((unsigned)ceq << 16), inc = pk;
#pragma unroll
        for (int o = 1; o < 64; o <<= 1) { const unsigned tv = __shfl_up(inc, o); if (lane >= o) inc += tv; }
        if (lane == 63) wsum[wave] = inc;
        __syncthreads();
        unsigned woff = 0u;
#pragma unroll
        for (int w = 0; w < NWAVES; ++w) { const unsigned s = wsum[w]; if (w < wave) woff += s; }
        const unsigned exc = woff + inc - pk; int gt_before = (int)(exc & 0xffffu), eq_before = (int)(exc >> 16);
        if (act) for (int q = 0; q < per; ++q) { const int i = i0 + q; const unsigned vv = vals[i]; int slot = -1;
            if (vv > prefix) { slot = gt_before + (eq_before < remaining ? eq_before : remaining); ++gt_before; }
            else if (vv == prefix) { if (eq_before < remaining) slot = gt_before + eq_before; ++eq_before; }
            INV[(size_t)(rowbase + i) * 16 + e] = slot >= 0 ? slotbase + slot : -1;
            if (slot >= 0) { slist[slot] = i; gatev[slotbase + slot] = __uint_as_float(vv); } }
        __syncthreads();
        for (int s = wave; s < cap; s += NWAVES) { const int tk = slist[s]; const u32x4* src = (const u32x4*)(H + (size_t)(rowbase + tk) * DM); u32x4* dst = (u32x4*)(XE + (size_t)(slotbase + s) * DM);
            dst[lane] = src[lane]; dst[64 + lane] = src[64 + lane]; }
        if (LAYER == 0 && seqsel == 1 && b == 0) {
            for (int s = wave; s < 128; s += NWAVES) { u32x4* dst = (u32x4*)(XE + (size_t)(e * SPE + 4224 + s) * DM); dst[lane] = (u32x4){0u, 0u, 0u, 0u}; dst[64 + lane] = (u32x4){0u, 0u, 0u, 0u}; }
            if (tid < 128) gatev[e * SPE + 4224 + tid] = 0.f; }
        __syncthreads();
    }
    if (LAYER == 1) expert_queue(A, lds, lane, wave, (unsigned*)(ws + WS_CTL) + CW_Q1, A.in[31], A.in[32], A.in[33], (bf16*)(ws + WS_G), (bf16*)(ws + WS_G + 128 * MiB));
}

template <int LAYER> DI void phase_combine(PH_ARGS) {
    unsigned char* ws = A.ws;
    const bf16* YE = (const bf16*)(LAYER ? ws + WS_E0 : ws + WS_G + 192 * MiB);
    const int* INV = (const int*)(ws + WS_INV);
    const float* mv = (const float*)(ws + WS_MODV) + LAYER * 5 * 6144;
    const int NR = LAYER ? RL : RT;
    for (int r = bx * NWAVES + wave; r < NR; r += G * NWAVES) {
        float* xr = resid_ptr(A.out, (float*)(ws + WS_XC), r); const int bb = row_bb(r);
        f32x4 v[4]; load_row_f32(xr, v, lane);
        moe_combine_row(v, INV + (size_t)r * 16, YE, mv + bb * 6144 + 5 * 1024, lane);
        if (LAYER == 0) {
#pragma unroll
            for (int j = 0; j < 4; ++j) *(f32x4*)(xr + 256 * j + 4 * lane) = v[j];
            const float* m1 = (const float*)(ws + WS_MODV) + 5 * 6144 + bb * 6144;
            modulate_row(v, A.in[21], m1, m1 + 1024, lane);
            store_row_bf16((bf16*)(ws + WS_H) + (size_t)r * DM, v, lane);
        } else {
            float ss = 0.f;
#pragma unroll
            for (int j = 0; j < 4; ++j) ss += (v[j][0] * v[j][0] + v[j][1] * v[j][1]) + (v[j][2] * v[j][2] + v[j][3] * v[j][3]);
            const float rstd = 1.0f / sqrtf(wave_sum(ss) * (1.0f / DM) + EPSN);
#pragma unroll
            for (int j = 0; j < 4; ++j) { const f32x4 w = *(const f32x4*)(A.in[34] + 256 * j + 4 * lane); *(f32x4*)(xr + 256 * j + 4 * lane) = v[j] * rstd * w; }
        }
    }
}

DI void glds16(const void* g, LAS unsigned char* l) { __builtin_amdgcn_global_load_lds((const unsigned*)g, (LAS unsigned*)l, 16, 0, 0); }
#define AT_WAIT_BAR(N) do { asm volatile("s_waitcnt vmcnt(" #N ") lgkmcnt(0)" ::: "memory"); __builtin_amdgcn_s_barrier(); asm volatile("" ::: "memory"); } while (0)
DI void phase_attn(PH_ARGS) {
    unsigned char* ws = A.ws;
    const bf16* QK = (const bf16*)(ws + WS_BIG); const bf16* VTg = (const bf16*)(ws + WS_BIG + 132 * MiB); bf16* ATT = (bf16*)(ws + WS_H);
    const int r32 = lane & 31, hi = lane >> 5; const int isub = wave >> 2, rg = wave & 3;
    constexpr int NT = 132, KRING = 0, VRING = 49152, SLOT = 16384;
    float lam;
    { const float s1 = wave_sum(A.in[23][lane] * A.in[24][lane]), s2 = wave_sum(A.in[25][lane] * A.in[26][lane]); lam = __expf(s1) - __expf(s2) + LAM_INIT; }
    const int vcu = (G % 8 == 0) ? (bx % 8) * (G / 8) + bx / 8 : bx;
    const int krow = (r32 & ~12) | ((r32 >> 1) & 4) | ((r32 << 1) & 8);
    int koff0[4], koff1[4];
#pragma unroll
    for (int kk = 0; kk < 4; ++kk) { koff0[kk] = isub * 8192 + sw64(krow, 2 * kk + hi); koff1[kk] = isub * 8192 + sw64(32 + krow, 2 * kk + hi); }
    const int dl = lane >> 3, dpc = lane & 7;
    for (int u = vcu; u < 2048; u += G) {
        const int bh = u >> 6, b = bh >> 3, h = bh & 7, q0 = (u & 63) * 128;
        const int qrow = b * SEQL + q0 + 32 * rg + r32;
        bf16x8 qf[4];
#pragma unroll
        for (int kk = 0; kk < 4; ++kk) qf[kk] = *(const bf16x8*)(QK + (size_t)qrow * 2048 + h * 128 + isub * 64 + 16 * kk + 8 * hi);
        const bf16* srck[2]; const bf16* srcv[2];
#pragma unroll
        for (int i = 0; i < 2; ++i) { const int n = 2 * wave + i;
            const int sub = n >> 3, key = 8 * (n & 7) + dl, ck = dpc ^ ((key >> 1) & 7); srck[i] = QK + 1024 + h * 128 + sub * 64 + ck * 8 + (size_t)key * 2048;
            const int dv = 8 * n + dl, cv = dpc ^ ((dv >> 1) & 7); srcv[i] = VTg + (size_t)(h * 128 + dv) * RT + cv * 8; }
        LAS unsigned char* kdst = lds + KRING + (2 * wave) * 1024; LAS unsigned char* vdst = lds + VRING + (2 * wave) * 1024;
#define KEYROW(t) (((t) < 4) ? (RL + b * CTXL + (t) * 64) : (b * SEQL + ((t) - 4) * 64))
#define DMA_K(t, slot) do { const size_t ko_ = (size_t)KEYROW(t) * 2048; glds16(srck[0] + ko_, kdst + (slot) * SLOT); glds16(srck[1] + ko_, kdst + (slot) * SLOT + 1024); } while (0)
#define DMA_V(t, slot) do { const size_t vo_ = (size_t)KEYROW(t); glds16(srcv[0] + vo_, vdst + (slot) * SLOT); glds16(srcv[1] + vo_, vdst + (slot) * SLOT + 1024); } while (0)
#define QKT(Sx0, Sx1, kslot, negm) do { const LAS unsigned char* kb_ = lds + KRING + (kslot) * SLOT; \
            _Pragma("unroll") for (int r = 0; r < 16; ++r) { Sx0[r] = (negm); Sx1[r] = (negm); } \
            _Pragma("unroll") for (int kk = 0; kk < 4; ++kk) { const bf16x8 a0 = *(const LAS bf16x8*)(kb_ + koff0[kk]), a1 = *(const LAS bf16x8*)(kb_ + koff1[kk]); \
                Sx0 = MFMA32(a0, qf[kk], Sx0); Sx1 = MFMA32(a1, qf[kk], Sx1); } } while (0)
        float m_run = 0.f, l_run = 0.f, mcA = 0.f, mcB = 0.f;
        f32x16 OT[4];
#pragma unroll
        for (int d = 0; d < 4; ++d)
#pragma unroll
            for (int r = 0; r < 16; ++r) OT[d][r] = 0.f;
        f32x16 SA0, SA1, SB0, SB1;
        DMA_K(0, 0); DMA_V(0, 0); DMA_K(1, 1); DMA_K(2, 2); DMA_V(1, 1);
        AT_WAIT_BAR(4);
        QKT(SA0, SA1, 0, 0.f);
        AT_WAIT_BAR(4);
        int ks_next = 1, ks_free = 0, vs_cur = 0, vs_free = 2;
#define AT_STEP(Sc0, Sc1, mc, Sn0, Sn1, mn, t) do { \
            if ((t) + 3 < NT) DMA_K((t) + 3, ks_free); \
            if ((t) + 2 < NT) DMA_V((t) + 2, vs_free); \
            mn = m_run; QKT(Sn0, Sn1, ks_next, -m_run); \
            float mx = fmaxf(Sc0[0], Sc1[0]); \
            _Pragma("unroll") for (int r = 1; r < 16; ++r) mx = fmaxf(mx, fmaxf(Sc0[r], Sc1[r])); \
            mx = fmaxf(mx, __shfl_xor(mx, 32)); \
            const float cand = mc + mx; \
            const bool up_ = (cand > m_run + 8.0f) || ((t) == 0); \
            if (__any(up_ || (mc != m_run))) { const float mnew = up_ ? cand : m_run; \
                const float al = __builtin_amdgcn_exp2f(m_run - mnew); l_run *= al; \
                _Pragma("unroll") for (int d = 0; d < 4; ++d) _Pragma("unroll") for (int r = 0; r < 16; ++r) OT[d][r] *= al; \
                const float dl = mnew - mc; \
                _Pragma("unroll") for (int r = 0; r < 16; ++r) { Sc0[r] -= dl; Sc1[r] -= dl; } \
                m_run = mnew; } \
            float ls = 0.f; \
            _Pragma("unroll") for (int r = 0; r < 16; ++r) { Sc0[r] = __builtin_amdgcn_exp2f(Sc0[r]); Sc1[r] = __builtin_amdgcn_exp2f(Sc1[r]); ls += Sc0[r] + Sc1[r]; } \
            l_run += ls; \
            bf16x8 Pb[4]; Pb[0] = pack8<0>(Sc0); Pb[1] = pack8<1>(Sc0); Pb[2] = pack8<0>(Sc1); Pb[3] = pack8<1>(Sc1); \
            { const LAS unsigned char* vb_ = lds + VRING + vs_cur * SLOT; \
              _Pragma("unroll") for (int dvb = 0; dvb < 4; ++dvb) _Pragma("unroll") for (int js = 0; js < 4; ++js) { \
                  const bf16x8 av = *(const LAS bf16x8*)(vb_ + sw64(32 * dvb + r32, 2 * js + hi)); OT[dvb] = MFMA32(av, Pb[js], OT[dvb]); } } \
            if ((t) + 3 < NT) AT_WAIT_BAR(4); else if ((t) + 2 < NT) AT_WAIT_BAR(2); else AT_WAIT_BAR(0); \
            ks_free = ks_next; ks_next = (ks_next == 2) ? 0 : ks_next + 1; vs_free = vs_cur; vs_cur = (vs_cur == 2) ? 0 : vs_cur + 1; } while (0)
        for (int t = 0; t < NT; t += 2) { AT_STEP(SA0, SA1, mcA, SB0, SB1, mcB, t); AT_STEP(SB0, SB1, mcB, SA0, SA1, mcA, t + 1); }
#undef AT_STEP
#undef QKT
#undef DMA_K
#undef DMA_V
#undef KEYROW
        { const float lt = l_run + __shfl_xor(l_run, 32); const float il = 1.0f / lt;
#pragma unroll
            for (int d = 0; d < 4; ++d)
#pragma unroll
                for (int r = 0; r < 16; ++r) OT[d][r] *= il; }
        LAS float* ex = (LAS float*)lds;
        if (isub == 1) {
#pragma unroll
            for (int d = 0; d < 4; ++d)
#pragma unroll
                for (int r = 0; r < 16; ++r) ex[((rg * 4 + d) * 16 + r) * 64 + lane] = OT[d][r]; }
        __syncthreads();
        if (isub == 0) {
            float ss = 0.f;
#pragma unroll
            for (int d = 0; d < 4; ++d)
#pragma unroll
                for (int r = 0; r < 16; ++r) { const float o = OT[d][r] - lam * ex[((rg * 4 + d) * 16 + r) * 64 + lane]; OT[d][r] = o; ss += o * o; }
            ss += __shfl_xor(ss, 32);
            const float rn = (1.0f - LAM_INIT) / sqrtf(ss * (1.0f / 128.0f) + EPSN);
            bf16* orow = ATT + (size_t)qrow * DM + h * 128;
#pragma unroll
            for (int d = 0; d < 4; ++d)
#pragma unroll
                for (int g4 = 0; g4 < 4; ++g4) { const int dv = 32 * d + 8 * g4 + 4 * hi; const f32x4 w = *(const f32x4*)(A.in[27] + dv);
                    u32x2 o; o.x = pk2(OT[d][4 * g4] * rn * w[0], OT[d][4 * g4 + 1] * rn * w[1]); o.y = pk2(OT[d][4 * g4 + 2] * rn * w[2], OT[d][4 * g4 + 3] * rn * w[3]);
                    *(u32x2*)(orow + dv) = o; }
        }
        __syncthreads();
    }
}
#undef AT_WAIT_BAR

constexpr int NPHASE = 20;
__global__ void __launch_bounds__(NTHR, 2) mega_fwd(Args A) {
    extern __shared__ __attribute__((aligned(16))) unsigned char lds_raw[];
    LAS unsigned char* lds = (LAS unsigned char*)lds_raw;
    const int tid = threadIdx.x, lane = tid & 63, wave = __builtin_amdgcn_readfirstlane(tid >> 6);
    const int G = gridDim.x, bx = blockIdx.x;
    unsigned char* ws = A.ws;
    if (tid < 64) ((LAS unsigned*)(lds + LDSX))[tid] = 0u;
    __syncthreads();
    XcdBarrier bar; bar.bar = (unsigned*)(ws + WS_CTL) + CW_BAR; bar.x = 0; bar.st = nullptr;
    if (!MK_SPLIT) bar = xcd_barrier_post((unsigned*)(ws + WS_CTL) + CW_BAR, (volatile LAS unsigned*)(lds + LDSX));
    const int lo = A.ph_lo, hi_ = A.ph_hi;
#ifdef ONLY_PHASE
#define IN(k) ((k) == ONLY_PHASE && lo <= (k) && (k) < hi_)
#else
#define IN(k) (lo <= (k) && (k) < hi_)
#endif
#if defined(REPEAT_PHASE)
#define REPLOOP(k) for (int rep_ = 0, nrep_ = ((((REPEAT_PHASE) >> (k)) & 1) ? A.ph_rep : 1); rep_ < nrep_; (++rep_ < nrep_) ? xcd_barrier(bar) : (void)0)
#else
#define REPLOOP(k)
#endif
#define SEAM(k) do { if (IN(k) && IN((k) + 1)) xcd_barrier(bar); } while (0)

    if (IN(0)) REPLOOP(0) { phase0(A, lds, tid, lane, wave, G, bx); } SEAM(0);
    if (IN(1)) REPLOOP(1) { phase_modulate<0, 0>(A, lds, tid, lane, wave, G, bx); } SEAM(1);
    if (IN(2)) REPLOOP(2) {
        pg8::Gemm g{(const pg8::bf16_t*)(ws + WS_H), (const pg8::bf16_t*)(ws + WS_WIN), RT, NPROJ, DM}; pg8::StaticOrder S; S.init(RT, NPROJ, G, bx);
        pg8::EpiBf16<0> E{(pg8::bf16_t*)(ws + WS_BIG), NPROJ, nullptr, 0, 0, 1.f};
        pg8::gemm_phase<pg8::EpiBf16<0>, pg8::StaticOrder, true, true>(lds, g, S, E);
    } SEAM(2);
    if (IN(3)) REPLOOP(3) { phase_gdn_prep(A, lds, tid, lane, wave, G, bx); } SEAM(3);
    if (IN(4)) REPLOOP(4) { phase_gdn_scan(A, lds, tid, lane, wave, G, bx); } SEAM(4);
    if (IN(5)) REPLOOP(5) { phase_ycat(A, lds, tid, lane, wave, G, bx); } SEAM(5);
    if (IN(6)) REPLOOP(6) {
        pg8::Gemm g{(const pg8::bf16_t*)(ws + WS_H), (const pg8::bf16_t*)(ws + WS_WOUT), RT, DM, DM}; pg8::StaticOrder S; S.init(RT, DM, G, bx);
        pg8::EpiResidual E{A.in[0], A.in[2], A.out, (float*)(ws + WS_XC), (const float*)(ws + WS_MODV) + 2 * 1024, RL};
        pg8::gemm_phase<pg8::EpiResidual, pg8::StaticOrder, true, true>(lds, g, S, E);
    } SEAM(6);
    if (IN(7)) REPLOOP(7) { phase_modulate<1, 0>(A, lds, tid, lane, wave, G, bx); } SEAM(7);
    if (IN(8)) REPLOOP(8) { phase_topk<0>(A, lds, tid, lane, wave, G, bx); } SEAM(8);
    if (IN(9)) REPLOOP(9) {
        pg8::Gemm g{(const pg8::bf16_t*)(ws + WS_G), (const pg8::bf16_t*)(ws + WS_E0), M1_0, 4096, DM}; pg8::MoeOrder S{17 * 16 * 16, G, bx, 17, 16};
        pg8::EpiMoe1 E{(pg8::bf16_t*)(ws + WS_BIG)};
        pg8::gemm_phase<pg8::EpiMoe1, pg8::MoeOrder, true, true>(lds, g, S, E);
    } SEAM(9);
    if (IN(10)) REPLOOP(10) {
        pg8::Gemm g{(const pg8::bf16_t*)(ws + WS_BIG), (const pg8::bf16_t*)(ws + WS_E0 + 128 * MiB), M1_0, DM, FFN}; pg8::MoeOrder S{17 * 16 * 4, G, bx, 17, 4};
        pg8::EpiMoe2 E{(pg8::bf16_t*)(ws + WS_G + 192 * MiB), (const float*)(ws + WS_GATEV)};
        pg8::gemm_phase<pg8::EpiMoe2, pg8::MoeOrder, true, true>(lds, g, S, E);
    } SEAM(10);
    if (IN(11)) REPLOOP(11) { phase_combine<0>(A, lds, tid, lane, wave, G, bx); } SEAM(11);
    if (IN(12)) REPLOOP(12) {
        { pg8::Gemm g{(const pg8::bf16_t*)(ws + WS_H), (const pg8::bf16_t*)(ws + WS_WQK), RT, 2048, DM}; pg8::StaticOrder S; S.init(RT, 2048, G, bx);
          pg8::EpiQK E{(pg8::bf16_t*)(ws + WS_BIG), (const float*)(ws + WS_ROPE), 0.125f * 1.4426950408889634f, RL};
          pg8::gemm_phase<pg8::EpiQK, pg8::StaticOrder, true, true>(lds, g, S, E); }
        { pg8::Gemm g{(const pg8::bf16_t*)(ws + WS_WV), (const pg8::bf16_t*)(ws + WS_H), DM, RT, DM}; pg8::StaticOrder S; S.init(DM, RT, G, bx);
          pg8::EpiBf16<0> E{(pg8::bf16_t*)(ws + WS_BIG + 132 * MiB), RT, nullptr, 0, 0, 1.f};
          pg8::gemm_phase<pg8::EpiBf16<0>, pg8::StaticOrder, true, true>(lds, g, S, E); }
    } SEAM(12);
    if (IN(13)) REPLOOP(13) { phase_attn(A, lds, tid, lane, wave, G, bx); } SEAM(13);
    if (IN(14)) REPLOOP(14) {
        pg8::Gemm g{(const pg8::bf16_t*)(ws + WS_H), (const pg8::bf16_t*)(ws + WS_WO), RL, DM, DM}; pg8::StaticOrder S; S.init(RL, DM, G, bx);
        pg8::EpiResidual E{A.out, A.out, A.out, A.out, (const float*)(ws + WS_MODV) + 5 * 6144 + 2 * 1024, RL};
        pg8::gemm_phase<pg8::EpiResidual, pg8::StaticOrder, true, true>(lds, g, S, E);
    } SEAM(14);
    if (IN(15)) REPLOOP(15) { phase_modulate<1, 1>(A, lds, tid, lane, wave, G, bx); } SEAM(15);
    if (IN(16)) REPLOOP(16) { phase_topk<1>(A, lds, tid, lane, wave, G, bx); } SEAM(16);
    if (IN(17)) REPLOOP(17) {
        pg8::Gemm g{(const pg8::bf16_t*)(ws + WS_G + 192 * MiB), (const pg8::bf16_t*)(ws + WS_G), M1_1, 4096, DM}; pg8::MoeOrder S{16 * 16 * 16, G, bx, 16, 16};
        pg8::EpiMoe1 E{(pg8::bf16_t*)(ws + WS_BIG)};
        pg8::gemm_phase<pg8::EpiMoe1, pg8::MoeOrder, true, true>(lds, g, S, E);
    } SEAM(17);
    if (IN(18)) REPLOOP(18) {
        pg8::Gemm g{(const pg8::bf16_t*)(ws + WS_BIG), (const pg8::bf16_t*)(ws + WS_G + 128 * MiB), M1_1, DM, FFN}; pg8::MoeOrder S{16 * 16 * 4, G, bx, 16, 4};
        pg8::EpiMoe2 E{(pg8::bf16_t*)(ws + WS_E0), (const float*)(ws + WS_GATEV)};
        pg8::gemm_phase<pg8::EpiMoe2, pg8::MoeOrder, true, true>(lds, g, S, E);
    } SEAM(18);
    if (IN(19)) REPLOOP(19) { phase_combine<1>(A, lds, tid, lane, wave, G, bx); }
#undef IN
#undef SEAM
}

extern "C" void kernel_launch(void* const* d_in, const int* in_sizes, int n_in, void* d_out, int out_size, void* d_ws, size_t ws_size, hipStream_t stream) {
    static int grid = 0;
    if (grid == 0) {
        if (n_in != 35 || out_size != RL * DM || ws_size < WS_END) { fprintf(stderr, "kernel_launch: unexpected problem (n_in %d, out %d, ws %zu < %zu)\n", n_in, out_size, ws_size, (size_t)WS_END); grid = -1; return; }
        int dev = 0, cus = 0, per_cu = 0;
        if (hipGetDevice(&dev) != hipSuccess || hipDeviceGetAttribute(&cus, hipDeviceAttributeMultiprocessorCount, dev) != hipSuccess) { grid = -1; return; }
        if (hipFuncSetAttribute((const void*)mega_fwd, hipFuncAttributeMaxDynamicSharedMemorySize, LDS_BYTES) != hipSuccess) { fprintf(stderr, "kernel_launch: hipFuncSetAttribute failed\n"); grid = -1; return; }
        if (hipOccupancyMaxActiveBlocksPerMultiprocessor(&per_cu, (const void*)mega_fwd, NTHR, LDS_BYTES) != hipSuccess || per_cu < 1) { fprintf(stderr, "kernel_launch: occupancy query reports %d\n", per_cu); }
        (void)hipGetLastError();
        grid = cus;
    }
    if (grid < 0) return;
    if (hipMemsetAsync((char*)d_ws + WS_CTL, 0, CTL_ZERO_BYTES, stream) != hipSuccess) return;
    Args a{};
    for (int i = 0; i < 35; ++i) a.in[i] = (const float*)d_in[i];
    a.out = (float*)d_out; a.ws = (unsigned char*)d_ws;
#if MK_SPLIT
    for (int p = 0; p < NPHASE; ++p) { a.ph_lo = p; a.ph_hi = p + 1; hipLaunchKernelGGL(mega_fwd, dim3(grid), dim3(NTHR), LDS_BYTES, stream, a); }
#else
    a.ph_lo = 0; a.ph_hi = NPHASE; a.ph_rep = 2;
    hipLaunchKernelGGL(mega_fwd, dim3(grid), dim3(NTHR), LDS_BYTES, stream, a);
#endif
}
```

```cpp
#include <hip/hip_runtime.h>
#include <cstdio>
#include <cstdint>
#ifndef MK_SPLIT
#define MK_SPLIT 0
#endif

namespace pg8 {
#define PG8_LAS __attribute__((address_space(3)))
typedef unsigned short bf16_t;
typedef short bf16x8 __attribute__((ext_vector_type(8)));
typedef float f32x4 __attribute__((ext_vector_type(4)));
typedef unsigned u32x4 __attribute__((ext_vector_type(4)));
constexpr int BM = 256, BK = 64, HALF = 128, HTB = HALF * BK * 2  , STAGE_BYTES = 8 * HTB, NXCD = 8, WGM = 8;

__host__ __device__ __forceinline__ int lds_byte(int r, int c) { const int st = (r >> 4) * 2 + (c >> 5), rr = r & 15, cc = c & 31, ob = rr * 64 + cc * 2; return st * 1024 + (ob ^ (((ob >> 9) & 1) << 5)); }
__host__ __device__ __forceinline__ void stage_rc(int b, int& R, int& C) { const int st = b / 1024, sb = b % 1024, swz = sb ^ (((sb >> 9) & 1) << 5); R = (st >> 1) * 16 + swz / 64; C = (st & 1) * 32 + (swz % 64) / 2; }
__host__ __device__ __forceinline__ int perm32(int rho) { const int n = rho >> 4, i = rho & 15; return 8 * (i >> 2) + 4 * n + (i & 3); }

struct Unit { int pm, pn; };
struct Gemm { const bf16_t* A; const bf16_t* Bt; int M, N, K; };

struct StaticOrder {
    int nM, nN, nwg, G, c;
    __host__ __device__ void init(int M, int N, int G_, int c_) { nM = M / BM; nN = N / BM; nwg = nM * nN; G = G_; c = c_; }
    __host__ __device__ bool next(int i, Unit& u) const {
        const long L = (long)i * G + c; if (L >= nwg) return false;
        int wgid = (int)L; { const int q = nwg / NXCD, r = nwg % NXCD, xcd = wgid % NXCD, off = wgid / NXCD; wgid = (xcd < r ? xcd * (q + 1) : r * (q + 1) + (xcd - r) * q) + off; }
        const int nig = WGM * nN, gid = wgid / nig, fm = gid * WGM, gsz = (nM - fm) < WGM ? (nM - fm) : WGM;
        u.pm = fm + ((wgid % nig) % gsz); u.pn = (wgid % nig) / gsz; return true;
    }
    __device__ __forceinline__ void a_ready(const Unit&) const {}
    __device__ __forceinline__ void done(const Unit&) const {}
};

__device__ __forceinline__ unsigned cvt_pk_bf16(float lo, float hi) { unsigned r; asm volatile("v_cvt_pk_bf16_f32 %0, %1, %2" : "=v"(r) : "v"(lo), "v"(hi)); return r; }
typedef float f32x2 __attribute__((ext_vector_type(2)));
__device__ __forceinline__ f32x2 gelu_pk(f32x2 v) {
    const f32x2 av = __builtin_elementwise_abs(v), d = av * 0.2316418882f + 1.0f;
    f32x2 t; t.x = __builtin_amdgcn_rcpf(d.x); t.y = __builtin_amdgcn_rcpf(d.y);
    f32x2 q = t * 0.5307027145f + (-0.7265760135f); q = q * t + 0.7107068705f; q = q * t + (-0.142248368f); q = q * t + 0.127414796f; q = q * t;
    const f32x2 s = (v * v) * (-0.72134752044f);
    f32x2 e; e.x = __builtin_amdgcn_exp2f(s.x); e.y = __builtin_amdgcn_exp2f(s.y);
    const f32x2 m = v * (q * e), r = v - m;
    f32x2 o; o.x = v.x < 0.f ? m.x : r.x; o.y = v.y < 0.f ? m.y : r.y; return o;
}

template <int ACT  > struct EpiBf16 {
    static constexpr bool PERM = true, AFTER_DRAIN = false; static_assert(ACT == 0 || ACT == 1, "EpiBf16: ACT is 0 (none) or 1 (gelu_pk)");
    bf16_t* O; int ldc; const float* bias; int split_cols; size_t split_stride; float scale0;
    __device__ __forceinline__ void operator()(const f32x4 (&acc)[2][2][4][2], const Unit& u, int wr, int wc, int fr, int fq) const {
        const int row0 = u.pm * BM + wr * 64 + fr; int colt = u.pn * BM; bf16_t* base = O;
        float sc = 1.f; if (split_cols) { const int t = colt / split_cols; base += (size_t)t * split_stride; colt -= t * split_cols; if (t == 0) sc = scale0; }
        const int col0 = colt + wc * 32 + 8 * fq, bcol0 = u.pn * BM + wc * 32 + 8 * fq;
        f32x4 bv[2][2];
#pragma unroll
        for (int bj = 0; bj < 2; ++bj)
#pragma unroll
            for (int n = 0; n < 2; ++n) bv[bj][n] = bias ? *(const f32x4*)(bias + bcol0 + bj * HALF + 4 * n) : (f32x4){0.f, 0.f, 0.f, 0.f};
#pragma unroll
        for (int ai = 0; ai < 2; ++ai)
#pragma unroll
            for (int m = 0; m < 4; ++m) { bf16_t* rowp = base + (size_t)(row0 + ai * HALF + m * 16) * ldc + col0;
#pragma unroll
                for (int bj = 0; bj < 2; ++bj) { f32x4 v0 = acc[ai][bj][m][0] + bv[bj][0], v1 = acc[ai][bj][m][1] + bv[bj][1];
                    if (ACT == 1) { f32x2 a = gelu_pk((f32x2){v0[0], v0[1]}), b = gelu_pk((f32x2){v0[2], v0[3]}), c = gelu_pk((f32x2){v1[0], v1[1]}), d = gelu_pk((f32x2){v1[2], v1[3]});
                        v0 = (f32x4){a.x, a.y, b.x, b.y}; v1 = (f32x4){c.x, c.y, d.x, d.y}; }
                    v0 = v0 * sc; v1 = v1 * sc; u32x4 w; w.x = cvt_pk_bf16(v0[0], v0[1]); w.y = cvt_pk_bf16(v0[2], v0[3]); w.z = cvt_pk_bf16(v1[0], v1[1]); w.w = cvt_pk_bf16(v1[2], v1[3]);
                    *(u32x4*)(rowp + bj * HALF) = w; } }
    }
};

__device__ __forceinline__ float silu_fast(float x) { return x * __builtin_amdgcn_rcpf(1.0f + __builtin_amdgcn_exp2f(-1.4426950408889634f * x)); }
struct EpiResidual {
    static constexpr bool PERM = false, AFTER_DRAIN = false;
    const float* base_lat; const float* base_ctx; float* out_lat; float* out_ctx; const float* gate; int RL;
    __device__ __forceinline__ void operator()(const f32x4 (&acc)[2][2][4][2], const Unit& u, int wr, int wc, int fr, int fq) const {
        const int col0 = u.pn * BM + wc * 32 + 4 * fq;
#pragma unroll
        for (int ai = 0; ai < 2; ++ai)
#pragma unroll
            for (int m = 0; m < 4; ++m) {
                const int row = u.pm * BM + ai * HALF + wr * 64 + m * 16 + fr;
                const bool lat = row < RL; const int rr = lat ? row : row - RL; const int bb = lat ? (row >> 13) : 4;
                const float* bp = (lat ? base_lat : base_ctx) + (size_t)rr * 1024 + col0; float* op = (lat ? out_lat : out_ctx) + (size_t)rr * 1024 + col0;
                const float* gp = gate + bb * 6144 + col0;
#pragma unroll
                for (int bj = 0; bj < 2; ++bj)
#pragma unroll
                    for (int n = 0; n < 2; ++n) { const int c = bj * HALF + n * 16; const f32x4 g = *(const f32x4*)(gp + c), b = *(const f32x4*)(bp + c); *(f32x4*)(op + c) = b + g * acc[ai][bj][m][n]; }
            }
    }
};
struct EpiMoe1 {
    static constexpr bool PERM = true, AFTER_DRAIN = false;
    bf16_t* O;
    __device__ __forceinline__ void operator()(const f32x4 (&acc)[2][2][4][2], const Unit& u, int wr, int wc, int fr, int fq) const {
        const int row0 = u.pm * BM + wr * 64 + fr; const int hcol0 = (u.pn & 15) * 128 + wc * 32 + 8 * fq;
#pragma unroll
        for (int ai = 0; ai < 2; ++ai)
#pragma unroll
            for (int m = 0; m < 4; ++m) { bf16_t* rowp = O + (size_t)(row0 + ai * HALF + m * 16) * 2048 + hcol0;
                const f32x4 g0 = acc[ai][0][m][0], g1 = acc[ai][0][m][1], u0 = acc[ai][1][m][0], u1 = acc[ai][1][m][1];
                u32x4 w; w.x = cvt_pk_bf16(silu_fast(g0[0]) * u0[0], silu_fast(g0[1]) * u0[1]); w.y = cvt_pk_bf16(silu_fast(g0[2]) * u0[2], silu_fast(g0[3]) * u0[3]);
                w.z = cvt_pk_bf16(silu_fast(g1[0]) * u1[0], silu_fast(g1[1]) * u1[1]); w.w = cvt_pk_bf16(silu_fast(g1[2]) * u1[2], silu_fast(g1[3]) * u1[3]);
                *(u32x4*)rowp = w; }
    }
};
struct EpiMoe2 {
    static constexpr bool PERM = true, AFTER_DRAIN = false;
    bf16_t* O; const float* gatev;
    __device__ __forceinline__ void operator()(const f32x4 (&acc)[2][2][4][2], const Unit& u, int wr, int wc, int fr, int fq) const {
        const int row0 = u.pm * BM + wr * 64 + fr; const int col0 = (u.pn & 3) * BM + wc * 32 + 8 * fq;
#pragma unroll
        for (int ai = 0; ai < 2; ++ai)
#pragma unroll
            for (int m = 0; m < 4; ++m) { const int row = row0 + ai * HALF + m * 16; const float gv = gatev[row]; bf16_t* rowp = O + (size_t)row * 1024 + col0;
#pragma unroll
                for (int bj = 0; bj < 2; ++bj) { const f32x4 v0 = acc[ai][bj][m][0] * gv, v1 = acc[ai][bj][m][1] * gv;
                    u32x4 w; w.x = cvt_pk_bf16(v0[0], v0[1]); w.y = cvt_pk_bf16(v0[2], v0[3]); w.z = cvt_pk_bf16(v1[0], v1[1]); w.w = cvt_pk_bf16(v1[2], v1[3]);
                    *(u32x4*)(rowp + bj * HALF) = w; } }
    }
};
struct EpiQK {
    static constexpr bool PERM = true, AFTER_DRAIN = false;
    bf16_t* O; const float* rope; float qscale; int RL;
    __device__ __forceinline__ void operator()(const f32x4 (&acc)[2][2][4][2], const Unit& u, int wr, int wc, int fr, int fq) const {
        const int row0 = u.pm * BM + wr * 64 + fr; const int colb = u.pn * BM + wc * 32 + 8 * fq;
#pragma unroll
        for (int ai = 0; ai < 2; ++ai)
#pragma unroll
            for (int m = 0; m < 4; ++m) { const int row = row0 + ai * HALF + m * 16; const bool lat = row < RL; const int t = row & 8191; const int pr = t >> 6, pc = t & 63;
#pragma unroll
                for (int bj = 0; bj < 2; ++bj) { const int col = colb + bj * HALF; f32x4 v0 = acc[ai][bj][m][0], v1 = acc[ai][bj][m][1];
                    if (lat) { const int half = (col >> 5) & 1, j0 = (col & 31) >> 1;
                        const float* cp = rope + (half ? 4096 + pc * 16 : pr * 16) + j0; const float* sp = cp + (half ? 1024 : 2048);
                        const f32x4 c = *(const f32x4*)cp, s = *(const f32x4*)sp;
                        f32x4 a, b;
                        a[0] = v0[0] * c[0] - v0[1] * s[0]; a[1] = v0[1] * c[0] + v0[0] * s[0]; a[2] = v0[2] * c[1] - v0[3] * s[1]; a[3] = v0[3] * c[1] + v0[2] * s[1];
                        b[0] = v1[0] * c[2] - v1[1] * s[2]; b[1] = v1[1] * c[2] + v1[0] * s[2]; b[2] = v1[2] * c[3] - v1[3] * s[3]; b[3] = v1[3] * c[3] + v1[2] * s[3];
                        v0 = a; v1 = b; }
                    const float sc = (col < 1024) ? qscale : 1.0f; v0 = v0 * sc; v1 = v1 * sc;
                    u32x4 w; w.x = cvt_pk_bf16(v0[0], v0[1]); w.y = cvt_pk_bf16(v0[2], v0[3]); w.z = cvt_pk_bf16(v1[0], v1[1]); w.w = cvt_pk_bf16(v1[2], v1[3]);
                    *(u32x4*)(O + (size_t)row * 2048 + col) = w; } }
    }
};
struct MoeOrder {
    int total, G, c, tiles_pe, ncol;
    __device__ __forceinline__ bool next(int i, Unit& u) const {
        const long L = (long)i * G + c; if (L >= total) return false;
        const int per = tiles_pe * ncol; const int e = (int)L / per, rem = (int)L % per; const int pml = rem % tiles_pe, pnl = rem / tiles_pe;
        u.pm = e * tiles_pe + pml; u.pn = e * ncol + pnl; return true; }
    __device__ __forceinline__ void a_ready(const Unit&) const {}
    __device__ __forceinline__ void done(const Unit&) const {}
};
template <class Epi, class Sched, bool ALIGN_EPI = false, bool SP2 = false>
__device__ __forceinline__ void gemm_phase(PG8_LAS unsigned char* lds, const Gemm g, const Sched& S, const Epi& E) {
    const int tid = threadIdx.x, wid = __builtin_amdgcn_readfirstlane(tid >> 6), lane = tid & 63, wr = wid >> 2, wc = wid & 3, fr = lane & 15, fq = lane >> 4;
    const int K = g.K, nt = K / BK;
    unsigned voffA[2], voffB[2];
#pragma unroll
    for (int i = 0; i < 2; ++i) { int R, C; stage_rc(tid * 16 + i * 8192, R, C); const int Rb = Epi::PERM ? ((R & ~31) + perm32(R & 31)) : R;
        voffA[i] = (unsigned)(R * K + C) * 2u; voffB[i] = (unsigned)(Rb * K + C) * 2u; }
    const size_t kstep = (size_t)(BK * 2);
    const size_t hstep = (size_t)HALF * K * 2;
    const size_t tstep = 2 * hstep;
    const unsigned ldsw = (unsigned)wid * 1024u;
    const int aoff = lds_byte(wr * 64 + fr, fq * 8), boff = lds_byte(wc * 32 + fr, fq * 8);
#define PG8_SA(b, h) (((b) * 2 + (h)) * HTB)
#define PG8_SB(b, h) ((4 + (b) * 2 + (h)) * HTB)
#define PG8_STAGE(bufoff, gbase, voff) do { _Pragma("unroll") for (int _i = 0; _i < 2; ++_i) \
        __builtin_amdgcn_global_load_lds((const unsigned*)((const char*)(gbase) + (voff)[_i]), (PG8_LAS unsigned*)(lds + (bufoff) + ldsw + _i * 8192), 16, 0, 0); } while (0)
#define PG8_LDA(dst, b, h) do { _Pragma("unroll") for (int m = 0; m < 4; ++m) _Pragma("unroll") for (int k = 0; k < 2; ++k) dst[m][k] = *(const PG8_LAS bf16x8*)(lds + PG8_SA(b, h) + aoff + m * 2048 + k * 1024); } while (0)
#define PG8_LDB(dst, b, h) do { _Pragma("unroll") for (int n = 0; n < 2; ++n) _Pragma("unroll") for (int k = 0; k < 2; ++k) dst[n][k] = *(const PG8_LAS bf16x8*)(lds + PG8_SB(b, h) + boff + n * 2048 + k * 1024); } while (0)
#define PG8_MMA(ai, bj, At, Bt) do { __builtin_amdgcn_s_setprio(1); _Pragma("unroll") for (int m = 0; m < 4; ++m) _Pragma("unroll") for (int n = 0; n < 2; ++n) _Pragma("unroll") for (int k = 0; k < 2; ++k) \
        acc[ai][bj][m][n] = __builtin_amdgcn_mfma_f32_16x16x32_bf16(Bt[n][k], At[m][k], acc[ai][bj][m][n], 0, 0, 0); __builtin_amdgcn_s_setprio(0); } while (0)
#define PG8_WAIT_V(n) asm volatile("s_waitcnt vmcnt(" #n ")" ::: "memory")
#define PG8_WAIT_L(n) asm volatile("s_waitcnt lgkmcnt(" #n ")" ::: "memory")
#define PG8_BAR __builtin_amdgcn_s_barrier()
#define PG8_SCHED __builtin_amdgcn_sched_barrier(0)
    Unit cur, nxt; int ui = 0;
    if (!S.next(0, cur)) return;
    f32x4 acc[2][2][4][2];
#pragma unroll
    for (int a = 0; a < 2; ++a)
#pragma unroll
        for (int b = 0; b < 2; ++b)
#pragma unroll
            for (int m = 0; m < 4; ++m)
#pragma unroll
                for (int n = 0; n < 2; ++n) acc[a][b][m][n] = (f32x4){0.f, 0.f, 0.f, 0.f};
    bf16x8 At[4][2], B0[2][2], B1[2][2];
    const char* cA = (const char*)g.A + (size_t)cur.pm * tstep; const char* cB = (const char*)g.Bt + (size_t)cur.pn * tstep;
    S.a_ready(cur);
    if constexpr (SP2) {
        PG8_STAGE(PG8_SB(0, 0), cB, voffB); PG8_STAGE(PG8_SB(0, 1), cB + hstep, voffB); PG8_STAGE(PG8_SA(0, 0), cA, voffA); PG8_STAGE(PG8_SA(0, 1), cA + hstep, voffA);
        if (wr == 1) PG8_BAR;
        PG8_WAIT_V(2); PG8_BAR;
        PG8_STAGE(PG8_SB(1, 0), cB + kstep, voffB); PG8_STAGE(PG8_SA(1, 0), cA + kstep, voffA); PG8_STAGE(PG8_SB(1, 1), cB + hstep + kstep, voffB);
        PG8_WAIT_V(6); PG8_BAR;
    } else {
        PG8_STAGE(PG8_SB(0, 0), cB, voffB); PG8_STAGE(PG8_SA(0, 0), cA, voffA); PG8_STAGE(PG8_SB(0, 1), cB + hstep, voffB); PG8_STAGE(PG8_SA(0, 1), cA + hstep, voffA);
        if (wr == 1) PG8_BAR;
        PG8_WAIT_V(4); PG8_BAR;
        PG8_STAGE(PG8_SB(1, 0), cB + kstep, voffB); PG8_STAGE(PG8_SA(1, 0), cA + kstep, voffA); PG8_STAGE(PG8_SB(1, 1), cB + hstep + kstep, voffB);
        PG8_WAIT_V(6); PG8_BAR;
    }
    for (;;) {
        const bool has_next = S.next(ui + 1, nxt);
        const char* nA = has_next ? (const char*)g.A + (size_t)nxt.pm * tstep : cA; const char* nB = has_next ? (const char*)g.Bt + (size_t)nxt.pn * tstep : cB;
        for (int t = 0; t < nt; t += 2) {
            const bool last = (t == nt - 2);
            const char* a1 = cA + (size_t)(t + 1) * kstep;
            const char* a2 = last ? nA : cA + (size_t)(t + 2) * kstep; const char* b2 = last ? nB : cB + (size_t)(t + 2) * kstep;
            const char* a3 = a2 + kstep; const char* b3 = b2 + kstep;
            if (last && has_next) S.a_ready(nxt);
            if constexpr (SP2) {
            PG8_LDB(B0, 0, 0); PG8_LDB(B1, 0, 1); PG8_SCHED; PG8_LDA(At, 0, 0); PG8_STAGE(PG8_SA(1, 1), a1 + hstep, voffA);
            PG8_WAIT_V(8); PG8_WAIT_L(0); PG8_BAR; PG8_MMA(0, 0, At, B0); PG8_MMA(0, 1, At, B1); PG8_BAR; PG8_SCHED;
            PG8_LDA(At, 0, 1); PG8_STAGE(PG8_SB(0, 0), b2, voffB); PG8_STAGE(PG8_SB(0, 1), b2 + hstep, voffB); PG8_STAGE(PG8_SA(0, 0), a2, voffA);
            PG8_WAIT_V(8); PG8_WAIT_L(0); PG8_BAR; PG8_MMA(1, 0, At, B0); PG8_MMA(1, 1, At, B1); PG8_BAR; PG8_SCHED;
            PG8_LDB(B0, 1, 0); PG8_LDB(B1, 1, 1); PG8_SCHED; PG8_LDA(At, 1, 0); PG8_STAGE(PG8_SA(0, 1), a2 + hstep, voffA);
            PG8_WAIT_V(8); PG8_WAIT_L(0); PG8_BAR; PG8_MMA(0, 0, At, B0); PG8_MMA(0, 1, At, B1); PG8_BAR; PG8_SCHED;
            PG8_LDA(At, 1, 1); PG8_STAGE(PG8_SB(1, 0), b3, voffB); PG8_STAGE(PG8_SB(1, 1), b3 + hstep, voffB); PG8_STAGE(PG8_SA(1, 0), a3, voffA);
            PG8_WAIT_V(8); PG8_WAIT_L(0); PG8_BAR; PG8_MMA(1, 0, At, B0); PG8_MMA(1, 1, At, B1); PG8_BAR; PG8_SCHED;
            } else {
            PG8_LDB(B0, 0, 0); PG8_SCHED; PG8_LDA(At, 0, 0); PG8_STAGE(PG8_SA(1, 1), a1 + hstep, voffA);
            PG8_WAIT_L(8); PG8_BAR; PG8_WAIT_L(0); PG8_MMA(0, 0, At, B0); PG8_BAR; PG8_SCHED;
            PG8_LDB(B1, 0, 1); PG8_STAGE(PG8_SB(0, 0), b2, voffB);
            PG8_BAR; PG8_WAIT_L(0); PG8_MMA(0, 1, At, B1); PG8_BAR;
            PG8_LDA(At, 0, 1); PG8_STAGE(PG8_SA(0, 0), a2, voffA);
            PG8_BAR; PG8_WAIT_L(0); PG8_MMA(1, 0, At, B0); PG8_BAR; PG8_SCHED;
            PG8_STAGE(PG8_SB(0, 1), b2 + hstep, voffB);
            PG8_WAIT_V(6); PG8_BAR; PG8_MMA(1, 1, At, B1); PG8_BAR;
            PG8_LDB(B0, 1, 0); PG8_SCHED; PG8_LDA(At, 1, 0); PG8_STAGE(PG8_SA(0, 1), a2 + hstep, voffA);
            PG8_WAIT_L(8); PG8_BAR; PG8_WAIT_L(0); PG8_MMA(0, 0, At, B0); PG8_BAR; PG8_SCHED;
            PG8_LDB(B1, 1, 1); PG8_STAGE(PG8_SB(1, 0), b3, voffB);
            PG8_BAR; PG8_WAIT_L(0); PG8_MMA(0, 1, At, B1); PG8_BAR;
            PG8_LDA(At, 1, 1); PG8_STAGE(PG8_SA(1, 0), a3, voffA);
            PG8_BAR; PG8_WAIT_L(0); PG8_MMA(1, 0, At, B0); PG8_BAR; PG8_SCHED;
            PG8_STAGE(PG8_SB(1, 1), b3 + hstep, voffB);
            PG8_WAIT_V(6); PG8_BAR; PG8_MMA(1, 1, At, B1); PG8_BAR;
            }
        }
        if constexpr (ALIGN_EPI) { if (wr == 0) PG8_BAR; }
        if constexpr (!Epi::AFTER_DRAIN) { E(acc, cur, wr, wc, fr, fq); S.done(cur); }
        if (!has_next) break;
#pragma unroll
        for (int a = 0; a < 2; ++a)
#pragma unroll
            for (int b = 0; b < 2; ++b)
#pragma unroll
                for (int m = 0; m < 4; ++m)
#pragma unroll
                    for (int n = 0; n < 2; ++n) acc[a][b][m][n] = (f32x4){0.f, 0.f, 0.f, 0.f};
        cur = nxt; cA = nA; cB = nB; ++ui;
        if constexpr (ALIGN_EPI) { if (wr == 1) PG8_BAR; }
    }
    PG8_WAIT_V(0);
    if constexpr (!ALIGN_EPI) { if (wr == 0) PG8_BAR; }
    PG8_BAR;
    if constexpr (Epi::AFTER_DRAIN) { E.fused(acc, cur, wr, wc, fr, fq, lds, wid, lane); S.done(cur); }
#undef PG8_SA
#undef PG8_SB
#undef PG8_STAGE
#undef PG8_LDA
#undef PG8_LDB
#undef PG8_MMA
#undef PG8_WAIT_V
#undef PG8_WAIT_L
#undef PG8_BAR
#undef PG8_SCHED
}
}

#define GAS __attribute__((address_space(1)))
#define LAS __attribute__((address_space(3)))
#define DI __device__ __forceinline__
typedef unsigned short bf16;
typedef float f32x4 __attribute__((ext_vector_type(4)));
typedef float f32x2 __attribute__((ext_vector_type(2)));
typedef float f32x16 __attribute__((ext_vector_type(16)));
typedef short bf16x8 __attribute__((ext_vector_type(8)));
typedef unsigned u32x4 __attribute__((ext_vector_type(4)));
typedef unsigned u32x2 __attribute__((ext_vector_type(2)));
typedef __bf16 bf16x2_t __attribute__((ext_vector_type(2)));
#define LDS_WAIT() asm volatile("s_waitcnt lgkmcnt(0)" ::: "memory")
#define MFMA32(a, b, c) __builtin_amdgcn_mfma_f32_32x32x16_bf16((a), (b), (c), 0, 0, 0)
DI unsigned pk2(float lo, float hi) { f32x2 v = {lo, hi}; bf16x2_t b = __builtin_convertvector(v, bf16x2_t); return __builtin_bit_cast(unsigned, b); }
DI float bflo(unsigned w) { return __uint_as_float(w << 16); }
DI float bfhi(unsigned w) { return __uint_as_float(w & 0xffff0000u); }
DI int crow(int r, int hi) { return (r & 3) + 8 * (r >> 2) + 4 * hi; }
DI float wave_sum(float v) {
#pragma unroll
    for (int o = 1; o < 64; o <<= 1) v += __shfl_xor(v, o);
    return v;
}
DI float wave_max(float v) {
#pragma unroll
    for (int o = 1; o < 64; o <<= 1) v = fmaxf(v, __shfl_xor(v, o));
    return v;
}
DI float silu_f(float x) { return x / (1.0f + __expf(-x)); }
template <int S> DI bf16x8 pack8(const f32x16& x) {
    u32x4 p; p.x = pk2(x[8 * S], x[8 * S + 1]); p.y = pk2(x[8 * S + 2], x[8 * S + 3]); p.z = pk2(x[8 * S + 4], x[8 * S + 5]); p.w = pk2(x[8 * S + 6], x[8 * S + 7]);
    return __builtin_bit_cast(bf16x8, p);
}
DI int sw64(int row, int c8) { return row * 128 + ((c8 ^ ((row >> 1) & 7)) << 4); }
DI int sw128(int row, int c16) { return row * 256 + ((c16 ^ (row & 15)) << 4); }

#define XB_TMO      128
#define XB_XCNT(j)  (256  + 64 * (j))
#define XB_XSUB(j)  (1280 + 64 * (j))
#define XB_XGEN(j)  (2304 + 64 * (j))
#define XB_TOP      3328
#define XB_TOPGEN   3392
#define XCD_BAR_WORDS 3456
#define XB_SPIN_CAP (1u << 18)

__device__ __forceinline__ unsigned xb_ld(unsigned* p)              { return __hip_atomic_load(p, __ATOMIC_RELAXED, __HIP_MEMORY_SCOPE_AGENT); }
__device__ __forceinline__ unsigned xb_add(unsigned* p, unsigned v) { return __hip_atomic_fetch_add(p, v, __ATOMIC_RELAXED, __HIP_MEMORY_SCOPE_AGENT); }
__device__ __forceinline__ unsigned xb_xcc_id() { return (unsigned)__builtin_amdgcn_s_getreg((3 << 11) | 20) & 0xFu; }
#define XB_SPIN(cond, bar) do { unsigned _sp = 0; while (cond) { __builtin_amdgcn_s_sleep(1); \
    if ((++_sp & 255u) == 0u) { if (xb_ld(&(bar)[XB_TMO])) break; if (_sp > XB_SPIN_CAP) { atomicAdd(&(bar)[XB_TMO], 1u); break; } } } } while (0)

struct XcdBarrier {
    unsigned* bar; unsigned x;
    volatile LAS unsigned* st;
};

__device__ __forceinline__ XcdBarrier xcd_barrier_post(unsigned* bar, volatile LAS unsigned* st) {
    XcdBarrier b; b.bar = bar; b.x = xb_xcc_id(); b.st = st;
    if (threadIdx.x == 0) (void)xb_add(&bar[XB_XCNT(b.x)], 1u);
    return b;
}
__device__ __forceinline__ void xcd_barrier_complete(unsigned* bar, unsigned x, unsigned& nloc, unsigned& nx) {
    const unsigned G = gridDim.x * gridDim.y * gridDim.z;
    unsigned sum, cnt, mine, sp = 0u;
    for (;;) {
        sum = 0u; cnt = 0u; mine = 0u;
#pragma unroll
        for (unsigned j = 0; j < 16; ++j) { const unsigned c = xb_ld(&bar[XB_XCNT(j)]); sum += c; cnt += (c > 0u) ? 1u : 0u; mine = (j == x) ? c : mine; }
        if (sum == G) break;
        __builtin_amdgcn_s_sleep(1);
        if ((++sp & 255u) == 0u) { if (xb_ld(&bar[XB_TMO])) break; if (sp > XB_SPIN_CAP) { atomicAdd(&bar[XB_TMO], 1u); break; } }
    }
    nloc = mine > 0u ? mine : 1u; nx = cnt > 0u ? cnt : 1u;
}

__device__ __forceinline__ void xcd_barrier(const XcdBarrier& b) {
    asm volatile("s_waitcnt vmcnt(0)" ::: "memory");
    __syncthreads();
    if (threadIdx.x == 0) {
        unsigned* bar = b.bar;
        __builtin_amdgcn_s_waitcnt(0);
        unsigned nloc = b.st[0], nx = b.st[1];
        if (nloc == 0u) { xcd_barrier_complete(bar, b.x, nloc, nx); b.st[0] = nloc; b.st[1] = nx; }
        const unsigned old = xb_add(&bar[XB_XSUB(b.x)], 1u);
        const unsigned gen = old / nloc;
        if (old + 1u == (gen + 1u) * nloc) {
            __builtin_amdgcn_fence(__ATOMIC_RELEASE, "agent");
            asm volatile("s_waitcnt vmcnt(0)" ::: "memory");
            const unsigned og = xb_add(&bar[XB_TOP], 1u);
            const unsigned tg = og / nx;
            if (og + 1u == (tg + 1u) * nx) xb_add(&bar[XB_TOPGEN], 1u);
            else XB_SPIN(xb_ld(&bar[XB_TOPGEN]) == tg, bar);
            __builtin_amdgcn_fence(__ATOMIC_ACQUIRE, "agent");
            xb_add(&bar[XB_XGEN(b.x)], 1u);
            asm volatile("s_waitcnt vmcnt(0)" ::: "memory");
        } else {
            XB_SPIN(xb_ld(&bar[XB_XGEN(b.x)]) == gen, bar);
            __builtin_amdgcn_fence(__ATOMIC_ACQUIRE, "agent");
            asm volatile("s_waitcnt vmcnt(0)" ::: "memory");
        }
    }
    __syncthreads();
}

constexpr int NWAVES = 8, NTHR = 512;
constexpr int DM = 1024, NBATCH = 4, SEQL = 8192, CTXL = 256, RL = NBATCH * SEQL, RC = NBATCH * CTXL, RT = RL + RC;
constexpr int NPROJ = 3584, INCOLS = 3600, NEXP = 16, FFN = 2048;
constexpr int SPE0 = 17 * 256, SPE1 = 16 * 256;
constexpr int M1_0 = NEXP * SPE0, M1_1 = NEXP * SPE1;
constexpr float EPSN = 1e-6f;
constexpr float LAM_INIT = 0.35550907f;
constexpr int NCHUNK = 132;
constexpr int GBLK = 73728;

constexpr size_t MiB = 1u << 20;
constexpr size_t WS_CTL = 0, CTL_ZERO_BYTES = 1 * MiB;
constexpr size_t WS_MODV = 1 * MiB;
constexpr size_t WS_ROPE = 1 * MiB + 256 * 1024;
constexpr size_t WS_ZROW = 1 * MiB + 512 * 1024;
constexpr size_t WS_GATES = 2 * MiB;
constexpr size_t WS_AFFT = 5 * MiB;
constexpr size_t WS_INV = 8 * MiB;
constexpr size_t WS_GATEV = 11 * MiB;
constexpr size_t WS_GLAST = 12 * MiB;
constexpr size_t WS_WIN = 17 * MiB, WS_WOUT = 24 * MiB, WS_WQK = 26 * MiB, WS_WV = 30 * MiB, WS_WO = 32 * MiB;
constexpr size_t WS_E0 = 36 * MiB;
constexpr size_t WS_XC = 228 * MiB;
constexpr size_t WS_H = 232 * MiB;
constexpr size_t WS_BIG = 298 * MiB;
constexpr size_t WS_G = 570 * MiB;
constexpr size_t WS_END = 898 * MiB;
constexpr int CW_BAR = 4096, CW_Q0 = 8192, CW_Q1 = 8256;

constexpr int RING_BYTES = 131072;
constexpr int LDSX = RING_BYTES;
constexpr int LDS_BYTES = 147456;

struct Args { const float* in[35]; float* out; unsigned char* ws; int ph_lo, ph_hi, ph_rep, pad; };

template <class F> DI void tr_item(const float* W, int ldw, bf16* WT, int ldk, int k0, F rowmap, LAS float* scr, int lane) {
#pragma unroll 8
    for (int i = 0; i < 32; ++i) { const int kk = 2 * i + (lane >> 5); scr[kk * 33 + (lane & 31)] = W[(size_t)kk * ldw + (lane & 31)]; }
    LDS_WAIT(); asm volatile("" ::: "memory");
    const int c = lane & 7;
#pragma unroll
    for (int j = 0; j < 4; ++j) { const int n = (lane >> 3) + 8 * j; const LAS float* s = scr + (8 * c) * 33 + n;
        u32x4 o; o.x = pk2(s[0 * 33], s[1 * 33]); o.y = pk2(s[2 * 33], s[3 * 33]); o.z = pk2(s[4 * 33], s[5 * 33]); o.w = pk2(s[6 * 33], s[7 * 33]);
        *(u32x4*)(WT + (size_t)rowmap(n) * ldk + k0 + 8 * c) = o; }
    LDS_WAIT(); asm volatile("" ::: "memory");
}
struct AddMap { int base; DI int operator()(int n) const { return base + n; } };
struct PairMap { int base; DI int operator()(int n) const { return base + (n < 16 ? 2 * n : 2 * (n - 16) + 1); } };
DI void expert_item(int r, const float* Wg, const float* Wu, const float* Wd, bf16* W1, bf16* W2, LAS float* scr, int lane) {
    if (r < 32768) { const int up = r >> 14, q = r & 16383, e = q >> 10, it = q & 1023, kb = it >> 6, nb = it & 63;
        const float* src = (up ? Wu : Wg) + (size_t)e * 1024 * 2048 + (size_t)(kb * 64) * 2048 + nb * 32;
        const int rbase = e * 4096 + (nb >> 2) * 256 + up * 128 + (nb & 3) * 32;
        tr_item(src, 2048, W1, 1024, kb * 64, AddMap{rbase}, scr, lane);
    } else { const int q = r - 32768, e = q >> 10, it = q & 1023, kb = it >> 5, nb = it & 31;
        const float* src = Wd + (size_t)e * 2048 * 1024 + (size_t)(kb * 64) * 1024 + nb * 32;
        const int rbase = e * 1024 + nb * 32;
        tr_item(src, 1024, W2, 2048, kb * 64, AddMap{rbase}, scr, lane);
    }
}
DI void stage_tab16(const float* W, int ldw, LAS float* tab, int tid) {
    for (int idx = tid; idx < 16384; idx += NTHR) { const int d = idx >> 4, e = idx & 15; const int j = d >> 8, l = (d >> 2) & 63, c = d & 3;
        tab[((((j * 4 + c) * 4 + (e >> 2)) * 64 + l) << 2) + (e & 3)] = W[(size_t)d * ldw + e]; }
}
DI void row_gemv16(const f32x4 (&h)[4], const LAS float* tab, int lane, float (&sums)[16]) {
#pragma unroll
    for (int e = 0; e < 16; ++e) sums[e] = 0.f;
#pragma unroll
    for (int j = 0; j < 4; ++j)
#pragma unroll
        for (int c = 0; c < 4; ++c) { const float hv = h[j][c];
#pragma unroll
            for (int q = 0; q < 4; ++q) { const f32x4 w = *(const LAS f32x4*)(tab + ((((j * 4 + c) * 4 + q) * 64 + lane) << 2));
                sums[4 * q + 0] += hv * w[0]; sums[4 * q + 1] += hv * w[1]; sums[4 * q + 2] += hv * w[2]; sums[4 * q + 3] += hv * w[3]; }
            asm volatile("" ::: "memory"); }
}
DI int eidx16(int lane) { return ((lane >> 5) & 1) * 8 + ((lane >> 4) & 1) * 4 + ((lane >> 3) & 1) * 2 + ((lane >> 2) & 1); }
DI float reduce16(const float (&s)[16], int lane) {
    float a8[8], a4[4], a2[2];
    const bool u5 = (lane & 32) != 0, u4 = (lane & 16) != 0, u3 = (lane & 8) != 0, u2 = (lane & 4) != 0;
#pragma unroll
    for (int k = 0; k < 8; ++k) { const float keep = u5 ? s[k + 8] : s[k], send = u5 ? s[k] : s[k + 8]; a8[k] = keep + __shfl_xor(send, 32); }
#pragma unroll
    for (int k = 0; k < 4; ++k) { const float keep = u4 ? a8[k + 4] : a8[k], send = u4 ? a8[k] : a8[k + 4]; a4[k] = keep + __shfl_xor(send, 16); }
#pragma unroll
    for (int k = 0; k < 2; ++k) { const float keep = u3 ? a4[k + 2] : a4[k], send = u3 ? a4[k] : a4[k + 2]; a2[k] = keep + __shfl_xor(send, 8); }
    float r; { const float keep = u2 ? a2[1] : a2[0], send = u2 ? a2[0] : a2[1]; r = keep + __shfl_xor(send, 4); }
    r += __shfl_xor(r, 2); r += __shfl_xor(r, 1);
    return r;
}
DI float* resid_ptr(float* lat, float* ctx, int r) { return r < RL ? lat + (size_t)r * DM : ctx + (size_t)(r - RL) * DM; }
DI int row_bb(int r) { return r < RL ? (r >> 13) : 4; }
DI void modulate_row(f32x4 (&v)[4], const float* nw, const float* shift, const float* scale, int lane) {
    float ss = 0.f;
#pragma unroll
    for (int j = 0; j < 4; ++j) ss += (v[j][0] * v[j][0] + v[j][1] * v[j][1]) + (v[j][2] * v[j][2] + v[j][3] * v[j][3]);
    const float rstd = 1.0f / sqrtf(wave_sum(ss) * (1.0f / DM) + EPSN);
#pragma unroll
    for (int j = 0; j < 4; ++j) { const int d = 256 * j + 4 * lane; const f32x4 w = *(const f32x4*)(nw + d), sc = *(const f32x4*)(scale + d), sh = *(const f32x4*)(shift + d);
        v[j] = v[j] * rstd * w * (sc + 1.0f) + sh; }
}
DI void store_row_bf16(bf16* dst, const f32x4 (&v)[4], int lane) {
#pragma unroll
    for (int j = 0; j < 4; ++j) { u32x2 o; o.x = pk2(v[j][0], v[j][1]); o.y = pk2(v[j][2], v[j][3]); *(u32x2*)(dst + 256 * j + 4 * lane) = o; }
}
DI void load_row_f32(const float* src, f32x4 (&v)[4], int lane) {
#pragma unroll
    for (int j = 0; j < 4; ++j) v[j] = *(const f32x4*)(src + 256 * j + 4 * lane);
}
DI void moe_combine_row(f32x4 (&v)[4], const int* invrow, const bf16* YE, const float* gvec, int lane) {
    const int mine = invrow[lane & 15];
    f32x4 a[4];
#pragma unroll
    for (int j = 0; j < 4; ++j) a[j] = (f32x4){0.f, 0.f, 0.f, 0.f};
#pragma unroll
    for (int e = 0; e < 16; ++e) { const int s = __builtin_amdgcn_readlane(mine, e);
        if (s >= 0) { const bf16* yr = YE + (size_t)s * DM;
#pragma unroll
            for (int j = 0; j < 4; ++j) { const u32x2 w = *(const u32x2*)(yr + 256 * j + 4 * lane); a[j][0] += bflo(w.x); a[j][1] += bfhi(w.x); a[j][2] += bflo(w.y); a[j][3] += bfhi(w.y); } } }
#pragma unroll
    for (int j = 0; j < 4; ++j) { const f32x4 g = *(const f32x4*)(gvec + 256 * j + 4 * lane); v[j] = v[j] + g * a[j]; }
}

#define PH_ARGS const Args& A, LAS unsigned char* lds, int tid, int lane, int wave, int G, int bx
DI void sincos_d(double a, float& sn, float& cs) {
    const double TWO_OVER_PI = 0.63661977236758134308, PIO2 = 1.57079632679489661923;
    const double kq = (double)(long long)(a * TWO_OVER_PI + 0.5); const double y = a - kq * PIO2; const double y2 = y * y;
    const double s = y * (1.0 + y2 * (-1.0 / 6 + y2 * (1.0 / 120 + y2 * (-1.0 / 5040 + y2 * (1.0 / 362880 + y2 * (-1.0 / 39916800 + y2 * (1.0 / 6227020800.0)))))));
    const double c = 1.0 + y2 * (-0.5 + y2 * (1.0 / 24 + y2 * (-1.0 / 720 + y2 * (1.0 / 40320 + y2 * (-1.0 / 3628800 + y2 * (1.0 / 479001600.0))))));
    const int k = (int)((long long)kq & 3);
    const double ss = (k == 0) ? s : (k == 1) ? c : (k == 2) ? -s : -c;
    const double cc = (k == 0) ? c : (k == 1) ? -s : (k == 2) ? -c : s;
    sn = (float)ss; cs = (float)cc;
}

DI void phase0(PH_ARGS) {
    unsigned char* ws = A.ws;
    LAS float* sil = (LAS float*)(lds + 73728);
    for (int i = tid; i < 5120; i += NTHR) { const int bb = i >> 10, k = i & 1023; const float cv = bb < 4 ? A.in[1][bb * 1024 + k] : A.in[3][k]; sil[i] = silu_f(cv); }
    __syncthreads();
    {
        const int t = wave * G + bx;
        if (t < 192) { const int layer = t / 96, n = (t % 96) * 64 + lane; const float* W = A.in[layer ? 19 : 4] + n; const float* Bv = A.in[layer ? 20 : 5];
            float a0 = 0.f, a1 = 0.f, a2 = 0.f, a3 = 0.f, a4 = 0.f;
#pragma unroll 8
            for (int k = 0; k < 1024; ++k) { const float w = W[(size_t)k * 6144]; a0 += sil[k] * w; a1 += sil[1024 + k] * w; a2 += sil[2048 + k] * w; a3 += sil[3072 + k] * w; a4 += sil[4096 + k] * w; }
            float* mv = (float*)(ws + WS_MODV) + layer * 5 * 6144 + n; const float bv = Bv[n];
            mv[0] = a0 + bv; mv[6144] = a1 + bv; mv[2 * 6144] = a2 + bv; mv[3 * 6144] = a3 + bv; mv[4 * 6144] = a4 + bv; }
    }
    if (bx == G - 1) {
        float* rope = (float*)(ws + WS_ROPE);
        for (int i = tid; i < 3072; i += NTHR) { const int isc = i >= 2048, ii = isc ? i - 2048 : i; const int pos = ii >> 4, j = ii & 15;
            double f = 1.0; for (int q = 0; q < j; ++q) f *= 0.56234132519034908;
            float sn, cs; sincos_d((double)pos * f, sn, cs);
            if (isc) { rope[4096 + ii] = cs; rope[5120 + ii] = sn; } else { rope[ii] = cs; rope[2048 + ii] = sn; } }
        unsigned* z = (unsigned*)(ws + WS_ZROW); for (int i = tid; i < 512; i += NTHR) z[i] = 0u;
    }
    LAS float* scr = (LAS float*)(lds + wave * 8704);
    const int gw = bx * NWAVES + wave, NGW = G * NWAVES;
    constexpr int I_IN = 16 * 112, I_OUT = 16 * 32, I_QK = 16 * 64, I_V = 16 * 32, I_O = 16 * 32;
    constexpr int NITEMS = I_IN + I_OUT + I_QK + I_V + I_O;
    for (int it = gw; it < NITEMS; it += NGW) {
        int r = it;
        if (r < I_IN) { const int kb = r / 112, nb = r % 112; tr_item(A.in[7] + (size_t)(kb * 64) * INCOLS + nb * 32, INCOLS, (bf16*)(ws + WS_WIN), 1024, kb * 64, AddMap{nb * 32}, scr, lane); continue; } r -= I_IN;
        if (r < I_OUT) { const int kb = r >> 5, nb = r & 31; tr_item(A.in[13] + (size_t)(kb * 64) * 1024 + nb * 32, 1024, (bf16*)(ws + WS_WOUT), 1024, kb * 64, AddMap{nb * 32}, scr, lane); continue; } r -= I_OUT;
        if (r < I_QK) { const int kb = r >> 6, nb = r & 63; tr_item(A.in[22] + (size_t)(kb * 64) * 3072 + nb * 32, 3072, (bf16*)(ws + WS_WQK), 1024, kb * 64, PairMap{nb * 32}, scr, lane); continue; } r -= I_QK;
        if (r < I_V) { const int kb = r >> 5, nb = r & 31; tr_item(A.in[22] + (size_t)(kb * 64) * 3072 + 2048 + nb * 32, 3072, (bf16*)(ws + WS_WV), 1024, kb * 64, AddMap{nb * 32}, scr, lane); continue; } r -= I_V;
        { const int kb = r >> 5, nb = r & 31; tr_item(A.in[28] + (size_t)(kb * 64) * 1024 + nb * 32, 1024, (bf16*)(ws + WS_WO), 1024, kb * 64, AddMap{nb * 32}, scr, lane); }
    }
}

template <int MODE, int LAYER> DI void phase_modulate(PH_ARGS) {
    unsigned char* ws = A.ws;
    LAS float* tab = (LAS float*)lds;
    if (MODE == 0) stage_tab16(A.in[7] + NPROJ, INCOLS, tab, tid); else stage_tab16(A.in[LAYER ? 30 : 15], 16, tab, tid);
    __syncthreads();
    const float* nw = A.in[MODE == 0 ? 6 : (LAYER ? 29 : 14)];
    const float* mv = (const float*)(ws + WS_MODV) + LAYER * 5 * 6144 + (MODE == 0 ? 0 : 3 * 1024);
    bf16* H = (bf16*)(ws + WS_H);
    const int NR = (MODE == 1 && LAYER == 1) ? RL : RT;
    for (int r = bx * NWAVES + wave; r < NR; r += G * NWAVES) {
        const float* src = (MODE == 0) ? (r < RL ? A.in[0] + (size_t)r * DM : A.in[2] + (size_t)(r - RL) * DM) : resid_ptr(A.out, (float*)(ws + WS_XC), r);
        const int bb = row_bb(r);
        f32x4 v[4]; load_row_f32(src, v, lane);
        modulate_row(v, nw, mv + bb * 6144, mv + bb * 6144 + 1024, lane);
        store_row_bf16(H + (size_t)r * DM, v, lane);
        float sums[16]; row_gemv16(v, tab, lane, sums);
        const float red = reduce16(sums, lane); const int ee = eidx16(lane);
        if (MODE == 0) { if ((lane & 3) == 0) ((float*)(ws + WS_GATES))[(size_t)r * 16 + ee] = red; }
        else { const float mx = wave_max(red); const float ex = __expf(red - mx); const float den = wave_sum(ex) * 0.25f; const float mine = ex / den;
            if ((lane & 3) == 0) { float* af = (float*)(ws + WS_AFFT);
                if (r < RL) af[(size_t)(((r >> 13) * 16 + ee)) * 8192 + (r & 8191)] = mine;
                else { const int rr = r - RL; af[524288 + (size_t)(((rr >> 8) * 16 + ee)) * 256 + (rr & 255)] = mine; } } }
    }
}

DI void fnma_asm(float& acc, float a, float b) { asm("v_fma_f32 %0, -%1, %2, %0" : "+v"(acc) : "v"(a), "v"(b)); }
template <int J> DI void backsub_row(float (&t)[64], const LAS float* LT, int lane) {
    float acc0 = (lane == J) ? 1.0f : 0.0f, acc1 = 0.f;
    constexpr int K0 = (J + 1) >> 2;
#pragma unroll
    for (int k4 = K0; k4 < 16; ++k4) { const f32x4 l4 = *(const LAS f32x4*)(LT + J * 64 + 4 * k4);
#pragma unroll
        for (int q = 0; q < 4; ++q) { const int k = 4 * k4 + q; if (k > J) { if (q & 1) fnma_asm(acc1, t[k], l4[q]); else fnma_asm(acc0, t[k], l4[q]); } } }
    t[J] = acc0 + acc1;
    __builtin_amdgcn_sched_barrier(0);
}
template <int J> DI void backsub_all(float (&t)[64], const LAS float* LT, int lane) {
    backsub_row<J>(t, LT, lane);
    if constexpr (J > 0) backsub_all<J - 1>(t, LT, lane);
}
DI void gdn_dir(const Args& A, LAS unsigned char* lds, int lane, int dir, int b, int h, int seqsel, int cidx, int rowbase, int t0) {
    unsigned char* ws = A.ws;
    const int r32 = lane & 31, hi = lane >> 5;
    LAS unsigned char* Qn = lds; LAS unsigned char* Kn = lds + 16384;
    LAS unsigned char* DB = lds + 32768 + 49152 * dir;
    LAS float* LT = (LAS float*)DB; LAS unsigned char* TBG = DB; LAS unsigned char* TB = DB + 8192;
    LAS unsigned char* KT = DB + 16384; LAS unsigned char* VT = DB + 32768;
    LAS float* SM = (LAS float*)(lds + LDSX + 1024 + dir * 1280);
    LAS float* GC = SM; LAS float* EGC = SM + 64; LAS float* BETA = SM + 128; LAS float* BG = SM + 192; LAS float* KDEC = SM + 256;
    const int ch = (b * 4 + h) * 2 + dir;
    const int p = seqsel ? (dir ? 3 - cidx : cidx) : 4 + (dir ? 127 - cidx : cidx);
    unsigned char* blk = ws + WS_G + (size_t)(ch * NCHUNK + p) * GBLK;
    {
        const int tk = dir ? 63 - lane : lane; const float* gr = (const float*)(ws + WS_GATES) + (size_t)(rowbase + t0 + tk) * 16;
        const float av = gr[dir * 4 + h], bv = gr[8 + dir * 4 + h];
        const float xs = av + A.in[11][dir * 4 + h]; const float sp = xs > 20.f ? xs : log1pf(__expf(xs));
        const float g = -__expf(A.in[10][dir * 4 + h]) * sp; const float beta = 1.0f / (1.0f + __expf(-bv));
        float gc = g;
#pragma unroll
        for (int o = 1; o < 64; o <<= 1) { const float tv = __shfl_up(gc, o); if (lane >= o) gc += tv; }
        const float gl = __shfl(gc, 63); const float eg = __expf(gc);
        GC[lane] = gc; EGC[lane] = eg; BETA[lane] = beta; BG[lane] = beta * eg; KDEC[lane] = __expf(gl - gc);
        if (lane == 0) ((float*)(ws + WS_GLAST))[ch * NCHUNK + p] = __expf(gl);
    }
    LDS_WAIT(); asm volatile("" ::: "memory");
#pragma unroll
    for (int ib = 0; ib < 2; ++ib) {
        const int i = 32 * ib + r32; const int ti = dir ? 63 - i : i; const float gi = GC[i], bi = BETA[i];
#pragma unroll
        for (int jb = 0; jb < 2; ++jb) {
            f32x16 aK, aQ;
#pragma unroll
            for (int r = 0; r < 16; ++r) { aK[r] = 0.f; aQ[r] = 0.f; }
            if (jb <= ib) {
                const int j = 32 * jb + r32; const int tj = dir ? 63 - j : j;
#pragma unroll
                for (int kk = 0; kk < 8; ++kk) {
                    const bf16x8 a = *(const LAS bf16x8*)(Kn + sw128(tj, 2 * kk + hi));
                    const bf16x8 bK = *(const LAS bf16x8*)(Kn + sw128(ti, 2 * kk + hi));
                    const bf16x8 bQ = *(const LAS bf16x8*)(Qn + sw128(ti, 2 * kk + hi));
                    aK = MFMA32(a, bK, aK); aQ = MFMA32(a, bQ, aQ);
                }
            }
#pragma unroll
            for (int g4 = 0; g4 < 4; ++g4) { const f32x4 gj = *(const LAS f32x4*)(GC + 32 * jb + 8 * g4 + 4 * hi);
#pragma unroll
                for (int q = 0; q < 4; ++q) { const int r = 4 * g4 + q; const int j = 32 * jb + 8 * g4 + 4 * hi + q;
                    const float dec = __expf(fminf(gi - gj[q], 0.f));
                    const float lv = (j < i) ? bi * aK[r] * dec : 0.f;
                    LT[j * 64 + i] = lv;
                    aQ[r] = (j <= i) ? aQ[r] * dec : 0.f; } }
            *(bf16x8*)(blk + 32768 + ((ib * 4 + 2 * jb + 0) * 1024) + lane * 16) = pack8<0>(aQ);
            *(bf16x8*)(blk + 32768 + ((ib * 4 + 2 * jb + 1) * 1024) + lane * 16) = pack8<1>(aQ);
        }
    }
    LDS_WAIT(); asm volatile("" ::: "memory");
    float t[64];
    backsub_all<63>(t, LT, lane);
    LDS_WAIT(); asm volatile("" ::: "memory");
#pragma unroll
    for (int c = 0; c < 8; ++c) {
        const f32x4 b0 = *(const LAS f32x4*)(BETA + 8 * c), b1 = *(const LAS f32x4*)(BETA + 8 * c + 4), g0 = *(const LAS f32x4*)(BG + 8 * c), g1 = *(const LAS f32x4*)(BG + 8 * c + 4);
        u32x4 wb, wg;
        wb.x = pk2(t[8 * c] * b0[0], t[8 * c + 1] * b0[1]); wb.y = pk2(t[8 * c + 2] * b0[2], t[8 * c + 3] * b0[3]); wb.z = pk2(t[8 * c + 4] * b1[0], t[8 * c + 5] * b1[1]); wb.w = pk2(t[8 * c + 6] * b1[2], t[8 * c + 7] * b1[3]);
        wg.x = pk2(t[8 * c] * g0[0], t[8 * c + 1] * g0[1]); wg.y = pk2(t[8 * c + 2] * g0[2], t[8 * c + 3] * g0[3]); wg.z = pk2(t[8 * c + 4] * g1[0], t[8 * c + 5] * g1[1]); wg.w = pk2(t[8 * c + 6] * g1[2], t[8 * c + 7] * g1[3]);
        *(LAS u32x4*)(TB + sw64(lane, c)) = wb; *(LAS u32x4*)(TBG + sw64(lane, c)) = wg;
    }
    LDS_WAIT(); asm volatile("" ::: "memory");
#pragma unroll
    for (int ib = 0; ib < 2; ++ib) {
        bf16x8 tg[4], tb[4];
#pragma unroll
        for (int js = 0; js < 4; ++js) { tg[js] = *(const LAS bf16x8*)(TBG + sw64(32 * ib + r32, 2 * js + hi)); tb[js] = *(const LAS bf16x8*)(TB + sw64(32 * ib + r32, 2 * js + hi)); }
#pragma unroll
        for (int kb = 0; kb < 4; ++kb) {
            f32x16 acc;
#pragma unroll
            for (int r = 0; r < 16; ++r) acc[r] = 0.f;
#pragma unroll
            for (int js = 0; js < 4; ++js) { const bf16x8 a = *(const LAS bf16x8*)(KT + sw64(32 * kb + r32, 2 * js + hi)); acc = MFMA32(a, tg[js], acc); }
            *(bf16x8*)(blk + ((ib * 8 + 2 * kb + 0) * 1024) + lane * 16) = pack8<0>(acc);
            *(bf16x8*)(blk + ((ib * 8 + 2 * kb + 1) * 1024) + lane * 16) = pack8<1>(acc);
        }
#pragma unroll
        for (int dvb = 0; dvb < 4; ++dvb) {
            f32x16 acc;
#pragma unroll
            for (int r = 0; r < 16; ++r) acc[r] = 0.f;
#pragma unroll
            for (int js = 0; js < 4; ++js) { const bf16x8 bv = *(const LAS bf16x8*)(VT + sw64(32 * dvb + r32, 2 * js + hi)); acc = MFMA32(tb[js], bv, acc); }
            unsigned char* up = blk + 57344 + (dvb * 2 + ib) * 2048 + lane * 32;
            *(bf16x8*)(up) = pack8<0>(acc); *(bf16x8*)(up + 16) = pack8<1>(acc);
        }
    }
#pragma unroll
    for (int ib = 0; ib < 2; ++ib) { const int i = 32 * ib + r32; const int ti = dir ? 63 - i : i; const float eg = EGC[i];
#pragma unroll
        for (int ks = 0; ks < 8; ++ks) {
            const u32x2 lo = *(const LAS u32x2*)(Qn + sw128(ti, 2 * ks) + 8 * hi), hh = *(const LAS u32x2*)(Qn + sw128(ti, 2 * ks + 1) + 8 * hi);
            u32x4 o; o.x = pk2(bflo(lo.x) * eg, bfhi(lo.x) * eg); o.y = pk2(bflo(lo.y) * eg, bfhi(lo.y) * eg); o.z = pk2(bflo(hh.x) * eg, bfhi(hh.x) * eg); o.w = pk2(bflo(hh.y) * eg, bfhi(hh.y) * eg);
            *(u32x4*)(blk + 16384 + ((ib * 8 + ks) * 1024) + lane * 16) = o; } }
#pragma unroll
    for (int kb = 0; kb < 4; ++kb) { const int dk = 32 * kb + r32;
#pragma unroll
        for (int ks = 0; ks < 4; ++ks) {
            const u32x2 lo = *(const LAS u32x2*)(KT + sw64(dk, 2 * ks) + 8 * hi), hh = *(const LAS u32x2*)(KT + sw64(dk, 2 * ks + 1) + 8 * hi);
            const f32x4 d0 = *(const LAS f32x4*)(KDEC + 16 * ks + 4 * hi), d1 = *(const LAS f32x4*)(KDEC + 16 * ks + 8 + 4 * hi);
            u32x4 o; o.x = pk2(bflo(lo.x) * d0[0], bfhi(lo.x) * d0[1]); o.y = pk2(bflo(lo.y) * d0[2], bfhi(lo.y) * d0[3]); o.z = pk2(bflo(hh.x) * d1[0], bfhi(hh.x) * d1[1]); o.w = pk2(bflo(hh.y) * d1[2], bfhi(hh.y) * d1[3]);
            *(u32x4*)(blk + 40960 + ((kb * 4 + ks) * 1024) + lane * 16) = o; } }
}

DI void phase_gdn_prep(PH_ARGS) {
    unsigned char* ws = A.ws;
    const bf16* PROJ = (const bf16*)(ws + WS_BIG);
    LAS unsigned char* Qn = lds; LAS unsigned char* Kn = lds + 16384;
    const int lane_in = lane;
    for (int u = bx; u < 2112; u += G) {
        int lane = lane_in; asm volatile("" : "+v"(lane));
        int seqsel, b, cidx, h;
        if (u < 2048) { seqsel = 0; b = u >> 9; cidx = (u >> 2) & 127; h = u & 3; } else { const int q = u - 2048; seqsel = 1; b = q >> 4; cidx = (q >> 2) & 3; h = q & 3; }
        const int rowbase = seqsel ? RL + b * CTXL : b * SEQL; const int L = seqsel ? CTXL : SEQL; const int t0 = cidx * 64;
        {
            const int d = 2 * lane; float w[3][3][2];
#pragma unroll
            for (int s = 0; s < 3; ++s)
#pragma unroll
                for (int j = 0; j < 3; ++j) { const f32x2 wv = *(const f32x2*)(A.in[9] + j * 1536 + s * 512 + h * 128 + d); w[s][j][0] = wv[0]; w[s][j][1] = wv[1]; }
            unsigned raw[10][3];
#pragma unroll
            for (int rr = 0; rr < 10; ++rr) { const int t = t0 + 8 * wave - 1 + rr; const bool ok = (t >= 0) && (t < L);
#pragma unroll
                for (int s = 0; s < 3; ++s) raw[rr][s] = ok ? *(const unsigned*)(PROJ + (size_t)(rowbase + t) * NPROJ + 1536 + s * 512 + h * 128 + d) : 0u; }
#pragma unroll
            for (int ii = 0; ii < 8; ++ii) { const int i = 8 * wave + ii;
                float val[3][2];
#pragma unroll
                for (int s = 0; s < 3; ++s) {
                    const float x0 = w[s][0][0] * bflo(raw[ii][s]) + w[s][1][0] * bflo(raw[ii + 1][s]) + w[s][2][0] * bflo(raw[ii + 2][s]);
                    const float x1 = w[s][0][1] * bfhi(raw[ii][s]) + w[s][1][1] * bfhi(raw[ii + 1][s]) + w[s][2][1] * bfhi(raw[ii + 2][s]);
                    val[s][0] = silu_f(x0); val[s][1] = silu_f(x1); }
                const float qs = wave_sum(val[0][0] * val[0][0] + val[0][1] * val[0][1]), ksq = wave_sum(val[1][0] * val[1][0] + val[1][1] * val[1][1]);
                const float rq = 0.08838834764831845f / sqrtf(qs + EPSN), rk = 1.0f / sqrtf(ksq + EPSN);
                const unsigned qp = pk2(val[0][0] * rq, val[0][1] * rq), kp = pk2(val[1][0] * rk, val[1][1] * rk), vp = pk2(val[2][0], val[2][1]);
                *(LAS unsigned*)(Qn + sw128(i, lane >> 2) + (lane & 3) * 4) = qp;
                *(LAS unsigned*)(Kn + sw128(i, lane >> 2) + (lane & 3) * 4) = kp;
#pragma unroll
                for (int dir = 0; dir < 2; ++dir) { const int pi = dir ? 63 - i : i; LAS unsigned char* KT = lds + 32768 + 49152 * dir + 16384; LAS unsigned char* VT = KT + 16384;
                    *(LAS unsigned short*)(KT + sw64(d, pi >> 3) + (pi & 7) * 2) = (unsigned short)(kp & 0xffffu);
                    *(LAS unsigned short*)(KT + sw64(d + 1, pi >> 3) + (pi & 7) * 2) = (unsigned short)(kp >> 16);
                    *(LAS unsigned short*)(VT + sw64(d, pi >> 3) + (pi & 7) * 2) = (unsigned short)(vp & 0xffffu);
                    *(LAS unsigned short*)(VT + sw64(d + 1, pi >> 3) + (pi & 7) * 2) = (unsigned short)(vp >> 16); }
            }
        }
        __syncthreads();
        if (wave < 2) gdn_dir(A, lds, lane, wave, b, h, seqsel, cidx, rowbase, t0);
        __syncthreads();
    }
}

DI void expert_queue(const Args& A, LAS unsigned char* lds, int lane, int wave, unsigned* qword, const float* Wg, const float* Wu, const float* Wd, bf16* W1, bf16* W2) {
    LAS float* scr = (LAS float*)(lds + wave * 8704);
    for (;;) {
        unsigned it0 = 0u;
        if (lane == 0) it0 = __hip_atomic_fetch_add(qword, 4u, __ATOMIC_RELAXED, __HIP_MEMORY_SCOPE_AGENT);
        it0 = (unsigned)__builtin_amdgcn_readfirstlane((int)it0);
        if (it0 >= 49152u) break;
#pragma unroll 1
        for (int q = 0; q < 4; ++q) expert_item((int)it0 + q, Wg, Wu, Wd, W1, W2, scr, lane);
    }
}
DI void phase_gdn_scan(PH_ARGS) {
    unsigned char* ws = A.ws;
    unsigned* qword = (unsigned*)(ws + WS_CTL) + CW_Q0;
    if (bx < 128) {
    const int xcd = bx & 7, idx = bx >> 3; const int ch = xcd + 8 * (idx >> 2), v = idx & 3;
    const int dir = ch & 1, bh = ch >> 1, b = bh >> 2, h = bh & 3;
    const int r32 = lane & 31, hi = lane >> 5;
    bf16* PROJ = (bf16*)(ws + WS_BIG);
    const float* GL = (const float*)(ws + WS_GLAST) + ch * NCHUNK;
    const unsigned char* gbase = ws + WS_G + (size_t)ch * NCHUNK * GBLK;
    constexpr int SBUF = 61440;
    const int lt = tid - 64;
#define SCAN_LOAD(p, bufi) do { const unsigned char* gb = gbase + (size_t)(p) * GBLK; LAS unsigned char* lb = lds + (bufi) * SBUF; u32x4 tv[9]; \
        _Pragma("unroll") for (int k = 0; k < 8; ++k) tv[k] = *(const u32x4*)(gb + (lt + 448 * k) * 16); \
        if (lt < 256) tv[8] = *(const u32x4*)(gb + 57344 + v * 4096 + lt * 16); \
        _Pragma("unroll") for (int k = 0; k < 8; ++k) *(LAS u32x4*)(lb + (lt + 448 * k) * 16) = tv[k]; \
        if (lt < 256) *(LAS u32x4*)(lb + 57344 + lt * 16) = tv[8]; } while (0)
    if (wave > 0) SCAN_LOAD(0, 0);
    __syncthreads();
    f32x16 S[4];
#pragma unroll
    for (int kb = 0; kb < 4; ++kb)
#pragma unroll
        for (int r = 0; r < 16; ++r) S[kb][r] = 0.f;
    for (int p = 0; p < NCHUNK; ++p) {
      if (wave > 0) { if (p + 1 < NCHUNK) SCAN_LOAD(p + 1, (p + 1) & 1); }
      else {
        const LAS unsigned char* blk = lds + (p & 1) * SBUF + lane * 16;
        const float gl = GL[p];
        bf16x8 Sb[8];
        Sb[0] = pack8<0>(S[0]); Sb[1] = pack8<1>(S[0]); Sb[2] = pack8<0>(S[1]); Sb[3] = pack8<1>(S[1]);
        Sb[4] = pack8<0>(S[2]); Sb[5] = pack8<1>(S[2]); Sb[6] = pack8<0>(S[3]); Sb[7] = pack8<1>(S[3]);
        f32x16 P[2], O[2];
#pragma unroll
        for (int ib = 0; ib < 2; ++ib) {
#pragma unroll
            for (int r = 0; r < 16; ++r) { P[ib][r] = 0.f; O[ib][r] = 0.f; }
#pragma unroll
            for (int ks = 0; ks < 8; ++ks) { const bf16x8 wf = *(const LAS bf16x8*)(blk + (ib * 8 + ks) * 1024); P[ib] = MFMA32(wf, Sb[ks], P[ib]); }
            asm volatile("" ::: "memory");
#pragma unroll
            for (int ks = 0; ks < 8; ++ks) { const bf16x8 qf = *(const LAS bf16x8*)(blk + 16384 + (ib * 8 + ks) * 1024); O[ib] = MFMA32(qf, Sb[ks], O[ib]); }
            asm volatile("" ::: "memory");
        }
        bf16x8 Vb[4];
#pragma unroll
        for (int ib = 0; ib < 2; ++ib) {
            const LAS unsigned char* up = lds + (p & 1) * SBUF + 57344 + ib * 2048 + lane * 32;
            const u32x4 u0 = *(const LAS u32x4*)up, u1 = *(const LAS u32x4*)(up + 16);
            f32x16 vn;
            vn[0] = bflo(u0.x) - P[ib][0]; vn[1] = bfhi(u0.x) - P[ib][1]; vn[2] = bflo(u0.y) - P[ib][2]; vn[3] = bfhi(u0.y) - P[ib][3];
            vn[4] = bflo(u0.z) - P[ib][4]; vn[5] = bfhi(u0.z) - P[ib][5]; vn[6] = bflo(u0.w) - P[ib][6]; vn[7] = bfhi(u0.w) - P[ib][7];
            vn[8] = bflo(u1.x) - P[ib][8]; vn[9] = bfhi(u1.x) - P[ib][9]; vn[10] = bflo(u1.y) - P[ib][10]; vn[11] = bfhi(u1.y) - P[ib][11];
            vn[12] = bflo(u1.z) - P[ib][12]; vn[13] = bfhi(u1.z) - P[ib][13]; vn[14] = bflo(u1.w) - P[ib][14]; vn[15] = bfhi(u1.w) - P[ib][15];
            Vb[2 * ib] = pack8<0>(vn); Vb[2 * ib + 1] = pack8<1>(vn);
        }
#pragma unroll
        for (int ib = 0; ib < 2; ++ib)
#pragma unroll
            for (int kt = 0; kt < 4; ++kt) { const bf16x8 af = *(const LAS bf16x8*)(blk + 32768 + (ib * 4 + kt) * 1024); O[ib] = MFMA32(af, Vb[kt], O[ib]); }
        asm volatile("" ::: "memory");
#pragma unroll
        for (int kb = 0; kb < 4; ++kb) {
            asm volatile("" ::: "memory");
#pragma unroll
            for (int r = 0; r < 16; ++r) S[kb][r] *= gl;
#pragma unroll
            for (int kt = 0; kt < 4; ++kt) { const bf16x8 kf = *(const LAS bf16x8*)(blk + 40960 + (kb * 4 + kt) * 1024); S[kb] = MFMA32(kf, Vb[kt], S[kb]); }
        }
        int rowbase, cidx;
        if (p < 4) { cidx = dir ? 3 - p : p; rowbase = RL + b * CTXL; } else { cidx = dir ? 131 - p : p - 4; rowbase = b * SEQL; }
        int hiv = hi; asm volatile("" : "+v"(hiv));
        const long step = dir ? -(long)NPROJ : (long)NPROJ;
        bf16* ob = PROJ + (size_t)(rowbase + cidx * 64 + (dir ? 63 - 4 * hiv : 4 * hiv)) * NPROJ + 1536 + dir * 512 + h * 128 + 32 * v + r32;
#pragma unroll
        for (int ib = 0; ib < 2; ++ib)
#pragma unroll
            for (int r = 0; r < 16; ++r) { const int c = 32 * ib + (r & 3) + 8 * (r >> 2);
                ob[step * c] = (bf16)(pk2(O[ib][r], 0.f) & 0xffffu); }
      }
      __syncthreads();
    }
#undef SCAN_LOAD
    }
    expert_queue(A, lds, lane, wave, qword, A.in[16], A.in[17], A.in[18], (bf16*)(ws + WS_E0), (bf16*)(ws + WS_E0 + 128 * MiB));
}

DI void unpack8(const u32x4 w, float (&f)[8]) { f[0] = bflo(w.x); f[1] = bfhi(w.x); f[2] = bflo(w.y); f[3] = bfhi(w.y); f[4] = bflo(w.z); f[5] = bfhi(w.z); f[6] = bflo(w.w); f[7] = bfhi(w.w); }
DI void phase_ycat(PH_ARGS) {
    unsigned char* ws = A.ws;
    const bf16* PROJ = (const bf16*)(ws + WS_BIG); bf16* Y = (bf16*)(ws + WS_H);
    const int c0 = 8 * lane;
    float cw[3][8], gn[8];
#pragma unroll
    for (int j = 0; j < 3; ++j) { const f32x4 a = *(const f32x4*)(A.in[8] + j * 512 + c0), b2 = *(const f32x4*)(A.in[8] + j * 512 + c0 + 4);
        cw[j][0] = a[0]; cw[j][1] = a[1]; cw[j][2] = a[2]; cw[j][3] = a[3]; cw[j][4] = b2[0]; cw[j][5] = b2[1]; cw[j][6] = b2[2]; cw[j][7] = b2[3]; }
    { const f32x4 a = *(const f32x4*)(A.in[12] + (c0 & 127)), b2 = *(const f32x4*)(A.in[12] + (c0 & 127) + 4);
        gn[0] = a[0]; gn[1] = a[1]; gn[2] = a[2]; gn[3] = a[3]; gn[4] = b2[0]; gn[5] = b2[1]; gn[6] = b2[2]; gn[7] = b2[3]; }
    for (int r = bx * NWAVES + wave; r < RT; r += G * NWAVES) {
        const int t = r < RL ? (r & 8191) : ((r - RL) & 255); const int L = r < RL ? SEQL : CTXL;
        const bf16* pr = PROJ + (size_t)r * NPROJ;
        float pm[8], pc[8], pn[8], xa[8], gc_[8], gb[8];
        unpack8(*(const u32x4*)(pr + c0), xa); unpack8(*(const u32x4*)(pr + 1024 + c0), gc_); unpack8(*(const u32x4*)(pr + 512 + c0), gb);
#pragma unroll
        for (int q = 0; q < 8; ++q) pc[q] = gc_[q] * xa[q];
        if (t > 0) { unpack8(*(const u32x4*)(pr - NPROJ + c0), xa); unpack8(*(const u32x4*)(pr - NPROJ + 1024 + c0), gc_);
#pragma unroll
            for (int q = 0; q < 8; ++q) pm[q] = gc_[q] * xa[q]; }
        else {
#pragma unroll
            for (int q = 0; q < 8; ++q) pm[q] = 0.f; }
        if (t < L - 1) { unpack8(*(const u32x4*)(pr + NPROJ + c0), xa); unpack8(*(const u32x4*)(pr + NPROJ + 1024 + c0), gc_);
#pragma unroll
            for (int q = 0; q < 8; ++q) pn[q] = gc_[q] * xa[q]; }
        else {
#pragma unroll
            for (int q = 0; q < 8; ++q) pn[q] = 0.f; }
        u32x4 o;
        { float y[8];
#pragma unroll
            for (int q = 0; q < 8; ++q) y[q] = gb[q] * (cw[0][q] * pm[q] + cw[1][q] * pc[q] + cw[2][q] * pn[q]);
            o.x = pk2(y[0], y[1]); o.y = pk2(y[2], y[3]); o.z = pk2(y[4], y[5]); o.w = pk2(y[6], y[7]); }
        *(u32x4*)(Y + (size_t)r * DM + c0) = o;
        float of[8], ob[8], z[8];
        unpack8(*(const u32x4*)(pr + 1536 + c0), of); unpack8(*(const u32x4*)(pr + 2048 + c0), ob); unpack8(*(const u32x4*)(pr + 3072 + c0), z);
        float ss = 0.f;
#pragma unroll
        for (int q = 0; q < 8; ++q) { of[q] += ob[q]; ss += of[q] * of[q]; }
        ss += __shfl_xor(ss, 1); ss += __shfl_xor(ss, 2); ss += __shfl_xor(ss, 4); ss += __shfl_xor(ss, 8);
        const float rn = 1.0f / sqrtf(ss * (1.0f / 128.0f) + EPSN);
        { float y[8];
#pragma unroll
            for (int q = 0; q < 8; ++q) y[q] = of[q] * rn * gn[q] * silu_f(z[q]);
            o.x = pk2(y[0], y[1]); o.y = pk2(y[2], y[3]); o.z = pk2(y[4], y[5]); o.w = pk2(y[6], y[7]); }
        *(u32x4*)(Y + (size_t)r * DM + 512 + c0) = o;
    }
}

template <int LAYER> DI void phase_topk(PH_ARGS) {
    unsigned char* ws = A.ws;
    LAS unsigned* vals = (LAS unsigned*)lds; LAS unsigned* hist = (LAS unsigned*)(lds + 32768); LAS unsigned* misc = (LAS unsigned*)(lds + 34816);
    LAS unsigned* wsum = (LAS unsigned*)(lds + 35840); LAS int* slist = (LAS int*)(lds + 36864);
    const int SPE = LAYER ? SPE1 : SPE0; const int NTASK = LAYER ? 64 : 128;
    const bf16* H = (const bf16*)(ws + WS_H); bf16* XE = (bf16*)(ws + WS_G + (LAYER ? 192 * MiB : 0));
    float* gatev = (float*)(ws + WS_GATEV); int* INV = (int*)(ws + WS_INV);
    for (int task = bx; task < NTASK; task += G) {
        const int seqsel = task >> 6, b = (task >> 4) & 3, e = task & 15;
        const int n = seqsel ? CTXL : SEQL, cap = seqsel ? 32 : 1024;
        const float* af = (const float*)(ws + WS_AFFT) + (seqsel ? 524288 + (size_t)((b * 16 + e)) * 256 : (size_t)((b * 16 + e)) * 8192);
        const int rowbase = seqsel ? RL + b * CTXL : b * SEQL;
        const int slotbase = e * SPE + (seqsel ? 4096 + b * 32 : b * 1024);
        for (int i = tid; i < n; i += NTHR) vals[i] = __float_as_uint(af[i]);
        __syncthreads();
        unsigned prefix = 0u; int remaining = cap;
#pragma unroll 1
        for (int pass = 3; pass >= 0; --pass) { const int shift = pass * 8;
            if (tid < 256) hist[tid] = 0u;
            __syncthreads();
            for (int i = tid; i < n; i += NTHR) { const unsigned vv = vals[i]; const bool match = (pass == 3) || (((vv ^ prefix) >> (shift + 8)) == 0u); if (match) __hip_atomic_fetch_add(&hist[(vv >> shift) & 255u], 1u, __ATOMIC_RELAXED, __HIP_MEMORY_SCOPE_WORKGROUP); }
            __syncthreads();
            if (tid == 0) { int cum = 0, dsel = 0, rem = remaining;
                for (int d = 255; d >= 0; --d) { const int hc = (int)hist[d]; if (cum + hc >= remaining) { dsel = d; rem = remaining - cum; break; } cum += hc; }
                misc[0] = (unsigned)dsel; misc[1] = (unsigned)rem; }
            __syncthreads();
            prefix |= misc[0] << shift; remaining = (int)misc[1];
            __syncthreads();
        }
        const int per = seqsel ? 1 : 16; const int i0 = tid * per; const bool act = i0 < n;
        int cgt = 0, ceq = 0;
        if (act) for (int q = 0; q < per; ++q) { const unsigned vv = vals[i0 + q]; cgt += (vv > prefix); ceq += (vv == prefix); }
        unsigned pk = (unsigned)cgt | ((unsigned)ceq << 16), inc = pk;
#pragma unroll
        for (int o = 1; o < 64; o <<= 1) { const unsigned tv = __shfl_up(inc, o); if (lane >= o) inc += tv; }
        if (lane == 63) wsum[wave] = inc;
        __syncthreads();
        unsigned woff = 0u;
#pragma unroll
        for (int w = 0; w < NWAVES; ++w) { const unsigned s = wsum[w]; if (w < wave) woff += s; }
        const unsigned exc = woff + inc - pk; int gt_before = (int)(exc & 0xffffu), eq_before = (int)(exc >> 16);
        if (act) for (int q = 0; q < per; ++q) { const int i = i0 + q; const unsigned vv = vals[i]; int slot = -1;
            if (vv > prefix) { slot = gt_before + (eq_before < remaining ? eq_before : remaining); ++gt_before; }
            else if (vv == prefix) { if (eq_before < remaining) slot = gt_before + eq_before; ++eq_before; }
            INV[(size_t)(rowbase + i) * 16 + e] = slot >= 0 ? slotbase + slot : -1;
            if (slot >= 0) { slist[slot] = i; gatev[slotbase + slot] = __uint_as_float(vv); } }
        __syncthreads();
        for (int s = wave; s < cap; s += NWAVES) { const int tk = slist[s]; const u32x4* src = (const u32x4*)(H + (size_t)(rowbase + tk) * DM); u32x4* dst = (u32x4*)(XE + (size_t)(slotbase + s) * DM);
            dst[lane] = src[lane]; dst[64 + lane] = src[64 + lane]; }
        if (LAYER == 0 && seqsel == 1 && b == 0) {
            for (int s = wave; s < 128; s += NWAVES) { u32x4* dst = (u32x4*)(XE + (size_t)(e * SPE + 4224 + s) * DM); dst[lane] = (u32x4){0u, 0u, 0u, 0u}; dst[64 + lane] = (u32x4){0u, 0u, 0u, 0u}; }
            if (tid < 128) gatev[e * SPE + 4224 + tid] = 0.f; }
        __syncthreads();
    }
    if (LAYER == 1) expert_queue(A, lds, lane, wave, (unsigned*)(ws + WS_CTL) + CW_Q1, A.in[31], A.in[32], A.in[33], (bf16*)(ws + WS_G), (bf16*)(ws + WS_G + 128 * MiB));
}

template <int LAYER> DI void phase_combine(PH_ARGS) {
    unsigned char* ws = A.ws;
    const bf16* YE = (const bf16*)(LAYER ? ws + WS_E0 : ws + WS_G + 192 * MiB);
    const int* INV = (const int*)(ws + WS_INV);
    const float* mv = (const float*)(ws + WS_MODV) + LAYER * 5 * 6144;
    const int NR = LAYER ? RL : RT;
    for (int r = bx * NWAVES + wave; r < NR; r += G * NWAVES) {
        float* xr = resid_ptr(A.out, (float*)(ws + WS_XC), r); const int bb = row_bb(r);
        f32x4 v[4]; load_row_f32(xr, v, lane);
        moe_combine_row(v, INV + (size_t)r * 16, YE, mv + bb * 6144 + 5 * 1024, lane);
        if (LAYER == 0) {
#pragma unroll
            for (int j = 0; j < 4; ++j) *(f32x4*)(xr + 256 * j + 4 * lane) = v[j];
            const float* m1 = (const float*)(ws + WS_MODV) + 5 * 6144 + bb * 6144;
            modulate_row(v, A.in[21], m1, m1 + 1024, lane);
            store_row_bf16((bf16*)(ws + WS_H) + (size_t)r * DM, v, lane);
        } else {
            float ss = 0.f;
#pragma unroll
            for (int j = 0; j < 4; ++j) ss += (v[j][0] * v[j][0] + v[j][1] * v[j][1]) + (v[j][2] * v[j][2] + v[j][3] * v[j][3]);
            const float rstd = 1.0f / sqrtf(wave_sum(ss) * (1.0f / DM) + EPSN);
#pragma unroll
            for (int j = 0; j < 4; ++j) { const f32x4 w = *(const f32x4*)(A.in[34] + 256 * j + 4 * lane); *(f32x4*)(xr + 256 * j + 4 * lane) = v[j] * rstd * w; }
        }
    }
}

DI float max3_asm(float a, float b, float c) { float r; asm("v_max3_f32 %0, %1, %2, %3" : "=v"(r) : "v"(a), "v"(b), "v"(c)); return r; }
DI void glds16(const void* g, LAS unsigned char* l) { __builtin_amdgcn_global_load_lds((const unsigned*)g, (LAS unsigned*)l, 16, 0, 0); }
#define AT_WAIT_BAR(N) do { asm volatile("s_waitcnt vmcnt(" #N ") lgkmcnt(0)" ::: "memory"); __builtin_amdgcn_s_barrier(); asm volatile("" ::: "memory"); } while (0)
DI void phase_attn(PH_ARGS) {
    unsigned char* ws = A.ws;
    const bf16* QK = (const bf16*)(ws + WS_BIG); const bf16* VTg = (const bf16*)(ws + WS_BIG + 132 * MiB); bf16* ATT = (bf16*)(ws + WS_H);
    const int r32 = lane & 31, hi = lane >> 5; const int isub = wave >> 2, rg = wave & 3;
    constexpr int NT = 132, KRING = 0, VRING = 49152, SLOT = 16384;
    float lam;
    { const float s1 = wave_sum(A.in[23][lane] * A.in[24][lane]), s2 = wave_sum(A.in[25][lane] * A.in[26][lane]); lam = __expf(s1) - __expf(s2) + LAM_INIT; }
    const int vcu = (G % 8 == 0) ? (bx % 8) * (G / 8) + bx / 8 : bx;
    const int krow = (r32 & ~12) | ((r32 >> 1) & 4) | ((r32 << 1) & 8);
    int koff0[4], koff1[4];
#pragma unroll
    for (int kk = 0; kk < 4; ++kk) { koff0[kk] = isub * 8192 + sw64(krow, 2 * kk + hi); koff1[kk] = isub * 8192 + sw64(32 + krow, 2 * kk + hi); }
    const int dl = lane >> 3, dpc = lane & 7;
    for (int u = vcu; u < 2048; u += G) {
        const int bh = u >> 6, b = bh >> 3, h = bh & 7, q0 = (u & 63) * 128;
        const int qrow = b * SEQL + q0 + 32 * rg + r32;
        bf16x8 qf[4];
#pragma unroll
        for (int kk = 0; kk < 4; ++kk) qf[kk] = *(const bf16x8*)(QK + (size_t)qrow * 2048 + h * 128 + isub * 64 + 16 * kk + 8 * hi);
        const bf16* srck[2]; const bf16* srcv[2];
#pragma unroll
        for (int i = 0; i < 2; ++i) { const int n = 2 * wave + i;
            const int sub = n >> 3, key = 8 * (n & 7) + dl, ck = dpc ^ ((key >> 1) & 7); srck[i] = QK + 1024 + h * 128 + sub * 64 + ck * 8 + (size_t)key * 2048;
            const int dv = 8 * n + dl, cv = dpc ^ ((dv >> 1) & 7); srcv[i] = VTg + (size_t)(h * 128 + dv) * RT + cv * 8; }
        LAS unsigned char* kdst = lds + KRING + (2 * wave) * 1024; LAS unsigned char* vdst = lds + VRING + (2 * wave) * 1024;
#define KEYROW(t) (((t) < 4) ? (RL + b * CTXL + (t) * 64) : (b * SEQL + ((t) - 4) * 64))
#define DMA_K(t, slot) do { const size_t ko_ = (size_t)KEYROW(t) * 2048; glds16(srck[0] + ko_, kdst + (slot) * SLOT); glds16(srck[1] + ko_, kdst + (slot) * SLOT + 1024); } while (0)
#define DMA_V(t, slot) do { const size_t vo_ = (size_t)KEYROW(t); glds16(srcv[0] + vo_, vdst + (slot) * SLOT); glds16(srcv[1] + vo_, vdst + (slot) * SLOT + 1024); } while (0)
#define QKT(Sx0, Sx1, kslot, negm) do { const LAS unsigned char* kb_ = lds + KRING + (kslot) * SLOT; \
            _Pragma("unroll") for (int r = 0; r < 16; ++r) { Sx0[r] = (negm); Sx1[r] = (negm); } \
            _Pragma("unroll") for (int kk = 0; kk < 4; ++kk) { const bf16x8 a0 = *(const LAS bf16x8*)(kb_ + koff0[kk]), a1 = *(const LAS bf16x8*)(kb_ + koff1[kk]); \
                Sx0 = MFMA32(a0, qf[kk], Sx0); Sx1 = MFMA32(a1, qf[kk], Sx1); } } while (0)
        float m_run = 0.f, l_run = 0.f, mcA = 0.f, mcB = 0.f;
        f32x16 OT[4];
#pragma unroll
        for (int d = 0; d < 4; ++d)
#pragma unroll
            for (int r = 0; r < 16; ++r) OT[d][r] = 0.f;
        f32x16 SA0, SA1, SB0, SB1;
        bf16x8 PX[4], PY[4];
        DMA_K(0, 0); DMA_V(0, 0); DMA_K(1, 1); DMA_K(2, 2); DMA_V(1, 1);
        AT_WAIT_BAR(4);
        QKT(SA0, SA1, 0, 0.f);
        AT_WAIT_BAR(4);
        int ks_next = 1, ks_free = 0;
#define SCE(Sc0, Sc1, e) (((e) < 16) ? Sc0[(e) & 15] : Sc1[(e) & 15])
#define AT_STEP(Sc0, Sc1, mc, Sn0, Sn1, mn, Pp, Pn, t, DO_PV) do { \
            if ((t) + 3 < NT) DMA_K((t) + 3, ks_free); \
            if ((t) + 2 < NT) DMA_V((t) + 2, ((t) + 2) & 3); \
            mn = m_run; \
            const LAS unsigned char* kb_ = lds + KRING + ks_next * SLOT; const LAS unsigned char* vb_ = lds + VRING + (((t) - 1) & 3) * SLOT; \
            { const float nm_ = -m_run; _Pragma("unroll") for (int r = 0; r < 16; ++r) { Sn0[r] = nm_; Sn1[r] = nm_; } } \
            bf16x8 fr_[3]; float mxa_ = 0.f, mxb_ = 0.f; \
            fr_[0] = *(const LAS bf16x8*)(kb_ + koff0[0]); fr_[1] = *(const LAS bf16x8*)(kb_ + koff1[0]); \
            __builtin_amdgcn_sched_barrier(0); \
            _Pragma("unroll") for (int g = 0; g < 8; ++g) { \
                if (g + 2 < 8) fr_[(g + 2) % 3] = *(const LAS bf16x8*)(kb_ + (((g + 2) & 1) ? koff1[(g + 2) >> 1] : koff0[(g + 2) >> 1])); \
                else if (DO_PV) fr_[(g + 2) % 3] = *(const LAS bf16x8*)(vb_ + sw64(r32, 2 * (g - 6) + hi)); \
                if (g & 1) Sn1 = MFMA32(fr_[g % 3], qf[g >> 1], Sn1); else Sn0 = MFMA32(fr_[g % 3], qf[g >> 1], Sn0); \
                if (g == 0) { mxa_ = max3_asm(Sc0[0], Sc0[1], Sc0[2]); mxb_ = max3_asm(Sc1[0], Sc1[1], Sc1[2]); } \
                else if (g < 7) { mxa_ = max3_asm(mxa_, Sc0[2 * g + 1], Sc0[2 * g + 2]); mxb_ = max3_asm(mxb_, Sc1[2 * g + 1], Sc1[2 * g + 2]); } \
                else { mxa_ = max3_asm(mxa_, Sc0[15], Sc1[15]); } \
                __builtin_amdgcn_sched_barrier(0); } \
            float mx = fmaxf(mxa_, mxb_); mx = fmaxf(mx, __shfl_xor(mx, 32)); \
            const float cand = mc + mx; \
            const bool up_ = (cand > m_run + 8.0f) || ((t) == 0); \
            if (__any(up_ || (mc != m_run))) { const float mnew = up_ ? cand : m_run; \
                const float al = __builtin_amdgcn_exp2f(m_run - mnew); l_run *= al; \
                _Pragma("unroll") for (int d = 0; d < 4; ++d) _Pragma("unroll") for (int r = 0; r < 16; ++r) OT[d][r] *= al; \
                if (DO_PV) { _Pragma("unroll") for (int js = 0; js < 4; ++js) { u32x4 w_ = __builtin_bit_cast(u32x4, Pp[js]); \
                    w_.x = pk2(bflo(w_.x) * al, bfhi(w_.x) * al); w_.y = pk2(bflo(w_.y) * al, bfhi(w_.y) * al); w_.z = pk2(bflo(w_.z) * al, bfhi(w_.z) * al); w_.w = pk2(bflo(w_.w) * al, bfhi(w_.w) * al); \
                    Pp[js] = __builtin_bit_cast(bf16x8, w_); } } \
                const float dl = mnew - mc; \
                _Pragma("unroll") for (int r = 0; r < 16; ++r) { Sc0[r] -= dl; Sc1[r] -= dl; } \
                m_run = mnew; } \
            float ls = 0.f; u32x4 pw_[4]; \
            __builtin_amdgcn_sched_barrier(0); \
            _Pragma("unroll") for (int g = 0; g < 16; ++g) { \
                if (DO_PV) { if (g + 2 < 16) fr_[(g + 4) % 3] = *(const LAS bf16x8*)(vb_ + sw64(32 * ((g + 2) >> 2) + r32, 2 * ((g + 2) & 3) + hi)); \
                    OT[g >> 2] = MFMA32(fr_[(g + 2) % 3], Pp[g & 3], OT[g >> 2]); } \
                float x0_ = SCE(Sc0, Sc1, 2 * g), x1_ = SCE(Sc0, Sc1, 2 * g + 1); asm volatile("" : "+v"(x0_), "+v"(x1_)); \
                float e0_ = __builtin_amdgcn_exp2f(x0_), e1_ = __builtin_amdgcn_exp2f(x1_); \
                ls += e0_; ls += e1_; unsigned pk_ = pk2(e0_, e1_); asm volatile("" : "+v"(pk_), "+v"(ls)); pw_[g >> 2][g & 3] = pk_; \
                __builtin_amdgcn_sched_barrier(0); } \
            l_run += ls; \
            Pn[0] = __builtin_bit_cast(bf16x8, pw_[0]); Pn[1] = __builtin_bit_cast(bf16x8, pw_[1]); Pn[2] = __builtin_bit_cast(bf16x8, pw_[2]); Pn[3] = __builtin_bit_cast(bf16x8, pw_[3]); \
            if ((t) + 3 < NT) AT_WAIT_BAR(6); else AT_WAIT_BAR(0); \
            ks_free = ks_next; ks_next = (ks_next == 2) ? 0 : ks_next + 1; } while (0)
        AT_STEP(SA0, SA1, mcA, SB0, SB1, mcB, PX, PY, 0, false);
        for (int t = 1; t < NT - 1; t += 2) { AT_STEP(SB0, SB1, mcB, SA0, SA1, mcA, PY, PX, t, true); AT_STEP(SA0, SA1, mcA, SB0, SB1, mcB, PX, PY, t + 1, true); }
        AT_STEP(SB0, SB1, mcB, SA0, SA1, mcA, PY, PX, NT - 1, true);
        { const LAS unsigned char* vb_ = lds + VRING + ((NT - 1) & 3) * SLOT;
#pragma unroll
          for (int dvb = 0; dvb < 4; ++dvb)
#pragma unroll
            for (int js = 0; js < 4; ++js) { const bf16x8 av = *(const LAS bf16x8*)(vb_ + sw64(32 * dvb + r32, 2 * js + hi)); OT[dvb] = MFMA32(av, PX[js], OT[dvb]); } }
        asm volatile("s_waitcnt lgkmcnt(0)" ::: "memory");
        __syncthreads();
#undef AT_STEP
#undef SCE
#undef QKT
#undef DMA_K
#undef DMA_V
#undef KEYROW
        { const float lt = l_run + __shfl_xor(l_run, 32); const float il = 1.0f / lt;
#pragma unroll
            for (int d = 0; d < 4; ++d)
#pragma unroll
                for (int r = 0; r < 16; ++r) OT[d][r] *= il; }
        LAS float* ex = (LAS float*)lds;
        if (isub == 1) {
#pragma unroll
            for (int d = 0; d < 4; ++d)
#pragma unroll
                for (int r = 0; r < 16; ++r) ex[((rg * 4 + d) * 16 + r) * 64 + lane] = OT[d][r]; }
        __syncthreads();
        if (isub == 0) {
            float ss = 0.f;
#pragma unroll
            for (int d = 0; d < 4; ++d)
#pragma unroll
                for (int r = 0; r < 16; ++r) { const float o = OT[d][r] - lam * ex[((rg * 4 + d) * 16 + r) * 64 + lane]; OT[d][r] = o; ss += o * o; }
            ss += __shfl_xor(ss, 32);
            const float rn = (1.0f - LAM_INIT) / sqrtf(ss * (1.0f / 128.0f) + EPSN);
            bf16* orow = ATT + (size_t)qrow * DM + h * 128;
#pragma unroll
            for (int d = 0; d < 4; ++d)
#pragma unroll
                for (int g4 = 0; g4 < 4; ++g4) { const int dv = 32 * d + 8 * g4 + 4 * hi; const f32x4 w = *(const f32x4*)(A.in[27] + dv);
                    u32x2 o; o.x = pk2(OT[d][4 * g4] * rn * w[0], OT[d][4 * g4 + 1] * rn * w[1]); o.y = pk2(OT[d][4 * g4 + 2] * rn * w[2], OT[d][4 * g4 + 3] * rn * w[3]);
                    *(u32x2*)(orow + dv) = o; }
        }
        __syncthreads();
    }
}
#undef AT_WAIT_BAR

constexpr int NPHASE = 20;
__global__ void __launch_bounds__(NTHR, 2) mega_fwd(Args A) {
    extern __shared__ __attribute__((aligned(16))) unsigned char lds_raw[];
    LAS unsigned char* lds = (LAS unsigned char*)lds_raw;
    const int tid = threadIdx.x, lane = tid & 63, wave = __builtin_amdgcn_readfirstlane(tid >> 6);
    const int G = gridDim.x, bx = blockIdx.x;
    unsigned char* ws = A.ws;
    if (tid < 64) ((LAS unsigned*)(lds + LDSX))[tid] = 0u;
    __syncthreads();
    XcdBarrier bar; bar.bar = (unsigned*)(ws + WS_CTL) + CW_BAR; bar.x = 0; bar.st = nullptr;
    if (!MK_SPLIT) bar = xcd_barrier_post((unsigned*)(ws + WS_CTL) + CW_BAR, (volatile LAS unsigned*)(lds + LDSX));
    const int lo = A.ph_lo, hi_ = A.ph_hi;
#ifdef ONLY_PHASE
#define IN(k) ((k) == ONLY_PHASE && lo <= (k) && (k) < hi_)
#else
#define IN(k) (lo <= (k) && (k) < hi_)
#endif
#if defined(REPEAT_PHASE)
#define REPLOOP(k) for (int rep_ = 0, nrep_ = ((((REPEAT_PHASE) >> (k)) & 1) ? A.ph_rep : 1); rep_ < nrep_; (++rep_ < nrep_) ? xcd_barrier(bar) : (void)0)
#else
#define REPLOOP(k)
#endif
#define SEAM(k) do { if (IN(k) && IN((k) + 1)) xcd_barrier(bar); } while (0)

    if (IN(0)) REPLOOP(0) { phase0(A, lds, tid, lane, wave, G, bx); } SEAM(0);
    if (IN(1)) REPLOOP(1) { phase_modulate<0, 0>(A, lds, tid, lane, wave, G, bx); } SEAM(1);
    if (IN(2)) REPLOOP(2) {
        pg8::Gemm g{(const pg8::bf16_t*)(ws + WS_H), (const pg8::bf16_t*)(ws + WS_WIN), RT, NPROJ, DM}; pg8::StaticOrder S; S.init(RT, NPROJ, G, bx);
        pg8::EpiBf16<0> E{(pg8::bf16_t*)(ws + WS_BIG), NPROJ, nullptr, 0, 0, 1.f};
        pg8::gemm_phase<pg8::EpiBf16<0>, pg8::StaticOrder, true, true>(lds, g, S, E);
    } SEAM(2);
    if (IN(3)) REPLOOP(3) { phase_gdn_prep(A, lds, tid, lane, wave, G, bx); } SEAM(3);
    if (IN(4)) REPLOOP(4) { phase_gdn_scan(A, lds, tid, lane, wave, G, bx); } SEAM(4);
    if (IN(5)) REPLOOP(5) { phase_ycat(A, lds, tid, lane, wave, G, bx); } SEAM(5);
    if (IN(6)) REPLOOP(6) {
        pg8::Gemm g{(const pg8::bf16_t*)(ws + WS_H), (const pg8::bf16_t*)(ws + WS_WOUT), RT, DM, DM}; pg8::StaticOrder S; S.init(RT, DM, G, bx);
        pg8::EpiResidual E{A.in[0], A.in[2], A.out, (float*)(ws + WS_XC), (const float*)(ws + WS_MODV) + 2 * 1024, RL};
        pg8::gemm_phase<pg8::EpiResidual, pg8::StaticOrder, true, true>(lds, g, S, E);
    } SEAM(6);
    if (IN(7)) REPLOOP(7) { phase_modulate<1, 0>(A, lds, tid, lane, wave, G, bx); } SEAM(7);
    if (IN(8)) REPLOOP(8) { phase_topk<0>(A, lds, tid, lane, wave, G, bx); } SEAM(8);
    if (IN(9)) REPLOOP(9) {
        pg8::Gemm g{(const pg8::bf16_t*)(ws + WS_G), (const pg8::bf16_t*)(ws + WS_E0), M1_0, 4096, DM}; pg8::MoeOrder S{17 * 16 * 16, G, bx, 17, 16};
        pg8::EpiMoe1 E{(pg8::bf16_t*)(ws + WS_BIG)};
        pg8::gemm_phase<pg8::EpiMoe1, pg8::MoeOrder, true, true>(lds, g, S, E);
    } SEAM(9);
    if (IN(10)) REPLOOP(10) {
        pg8::Gemm g{(const pg8::bf16_t*)(ws + WS_BIG), (const pg8::bf16_t*)(ws + WS_E0 + 128 * MiB), M1_0, DM, FFN}; pg8::MoeOrder S{17 * 16 * 4, G, bx, 17, 4};
        pg8::EpiMoe2 E{(pg8::bf16_t*)(ws + WS_G + 192 * MiB), (const float*)(ws + WS_GATEV)};
        pg8::gemm_phase<pg8::EpiMoe2, pg8::MoeOrder, true, true>(lds, g, S, E);
    } SEAM(10);
    if (IN(11)) REPLOOP(11) { phase_combine<0>(A, lds, tid, lane, wave, G, bx); } SEAM(11);
    if (IN(12)) REPLOOP(12) {
        { pg8::Gemm g{(const pg8::bf16_t*)(ws + WS_H), (const pg8::bf16_t*)(ws + WS_WQK), RT, 2048, DM}; pg8::StaticOrder S; S.init(RT, 2048, G, bx);
          pg8::EpiQK E{(pg8::bf16_t*)(ws + WS_BIG), (const float*)(ws + WS_ROPE), 0.125f * 1.4426950408889634f, RL};
          pg8::gemm_phase<pg8::EpiQK, pg8::StaticOrder, true, true>(lds, g, S, E); }
        { pg8::Gemm g{(const pg8::bf16_t*)(ws + WS_WV), (const pg8::bf16_t*)(ws + WS_H), DM, RT, DM}; pg8::StaticOrder S; S.init(DM, RT, G, bx);
          pg8::EpiBf16<0> E{(pg8::bf16_t*)(ws + WS_BIG + 132 * MiB), RT, nullptr, 0, 0, 1.f};
          pg8::gemm_phase<pg8::EpiBf16<0>, pg8::StaticOrder, true, true>(lds, g, S, E); }
    } SEAM(12);
    if (IN(13)) REPLOOP(13) { phase_attn(A, lds, tid, lane, wave, G, bx); } SEAM(13);
    if (IN(14)) REPLOOP(14) {
        pg8::Gemm g{(const pg8::bf16_t*)(ws + WS_H), (const pg8::bf16_t*)(ws + WS_WO), RL, DM, DM}; pg8::StaticOrder S; S.init(RL, DM, G, bx);
        pg8::EpiResidual E{A.out, A.out, A.out, A.out, (const float*)(ws + WS_MODV) + 5 * 6144 + 2 * 1024, RL};
        pg8::gemm_phase<pg8::EpiResidual, pg8::StaticOrder, true, true>(lds, g, S, E);
    } SEAM(14);
    if (IN(15)) REPLOOP(15) { phase_modulate<1, 1>(A, lds, tid, lane, wave, G, bx); } SEAM(15);
    if (IN(16)) REPLOOP(16) { phase_topk<1>(A, lds, tid, lane, wave, G, bx); } SEAM(16);
    if (IN(17)) REPLOOP(17) {
        pg8::Gemm g{(const pg8::bf16_t*)(ws + WS_G + 192 * MiB), (const pg8::bf16_t*)(ws + WS_G), M1_1, 4096, DM}; pg8::MoeOrder S{16 * 16 * 16, G, bx, 16, 16};
        pg8::EpiMoe1 E{(pg8::bf16_t*)(ws + WS_BIG)};
        pg8::gemm_phase<pg8::EpiMoe1, pg8::MoeOrder, true, true>(lds, g, S, E);
    } SEAM(17);
    if (IN(18)) REPLOOP(18) {
        pg8::Gemm g{(const pg8::bf16_t*)(ws + WS_BIG), (const pg8::bf16_t*)(ws + WS_G + 128 * MiB), M1_1, DM, FFN}; pg8::MoeOrder S{16 * 16 * 4, G, bx, 16, 4};
        pg8::EpiMoe2 E{(pg8::bf16_t*)(ws + WS_E0), (const float*)(ws + WS_GATEV)};
        pg8::gemm_phase<pg8::EpiMoe2, pg8::MoeOrder, true, true>(lds, g, S, E);
    } SEAM(18);
    if (IN(19)) REPLOOP(19) { phase_combine<1>(A, lds, tid, lane, wave, G, bx); }
#undef IN
#undef SEAM
}

extern "C" void kernel_launch(void* const* d_in, const int* in_sizes, int n_in, void* d_out, int out_size, void* d_ws, size_t ws_size, hipStream_t stream) {
    static int grid = 0;
    if (grid == 0) {
        if (n_in != 35 || out_size != RL * DM || ws_size < WS_END) { fprintf(stderr, "kernel_launch: unexpected problem (n_in %d, out %d, ws %zu < %zu)\n", n_in, out_size, ws_size, (size_t)WS_END); grid = -1; return; }
        int dev = 0, cus = 0, per_cu = 0;
        if (hipGetDevice(&dev) != hipSuccess || hipDeviceGetAttribute(&cus, hipDeviceAttributeMultiprocessorCount, dev) != hipSuccess) { grid = -1; return; }
        if (hipFuncSetAttribute((const void*)mega_fwd, hipFuncAttributeMaxDynamicSharedMemorySize, LDS_BYTES) != hipSuccess) { fprintf(stderr, "kernel_launch: hipFuncSetAttribute failed\n"); grid = -1; return; }
        if (hipOccupancyMaxActiveBlocksPerMultiprocessor(&per_cu, (const void*)mega_fwd, NTHR, LDS_BYTES) != hipSuccess || per_cu < 1) { fprintf(stderr, "kernel_launch: occupancy query reports %d\n", per_cu); }
        (void)hipGetLastError();
        grid = cus;
    }
    if (grid < 0) return;
    if (hipMemsetAsync((char*)d_ws + WS_CTL, 0, CTL_ZERO_BYTES, stream) != hipSuccess) return;
    Args a{};
    for (int i = 0; i < 35; ++i) a.in[i] = (const float*)d_in[i];
    a.out = (float*)d_out; a.ws = (unsigned char*)d_ws;
#if MK_SPLIT
    for (int p = 0; p < NPHASE; ++p) { a.ph_lo = p; a.ph_hi = p + 1; hipLaunchKernelGGL(mega_fwd, dim3(grid), dim3(NTHR), LDS_BYTES, stream, a); }
#else
    a.ph_lo = 0; a.ph_hi = NPHASE; a.ph_rep = 2;
    hipLaunchKernelGGL(mega_fwd, dim3(grid), dim3(NTHR), LDS_BYTES, stream, a);
#endif
}
```

```cpp
#include <hip/hip_runtime.h>
#include <cstdio>
#include <cstdint>
#ifndef MK_SPLIT
#define MK_SPLIT 0
#endif

namespace pg8 {
#define PG8_LAS __attribute__((address_space(3)))
typedef unsigned short bf16_t;
typedef short bf16x8 __attribute__((ext_vector_type(8)));
typedef float f32x4 __attribute__((ext_vector_type(4)));
typedef unsigned u32x4 __attribute__((ext_vector_type(4)));
constexpr int BM = 256, BK = 64, HALF = 128, HTB = HALF * BK * 2  , STAGE_BYTES = 8 * HTB, NXCD = 8, WGM = 8;

__host__ __device__ __forceinline__ int lds_byte(int r, int c) { const int st = (r >> 4) * 2 + (c >> 5), rr = r & 15, cc = c & 31, ob = rr * 64 + cc * 2; return st * 1024 + (ob ^ (((ob >> 9) & 1) << 5)); }
__host__ __device__ __forceinline__ void stage_rc(int b, int& R, int& C) { const int st = b / 1024, sb = b % 1024, swz = sb ^ (((sb >> 9) & 1) << 5); R = (st >> 1) * 16 + swz / 64; C = (st & 1) * 32 + (swz % 64) / 2; }
__host__ __device__ __forceinline__ int perm32(int rho) { const int n = rho >> 4, i = rho & 15; return 8 * (i >> 2) + 4 * n + (i & 3); }

struct Unit { int pm, pn; };
struct Gemm { const bf16_t* A; const bf16_t* Bt; int M, N, K; };

struct StaticOrder {
    int nM, nN, nwg, G, c;
    __host__ __device__ void init(int M, int N, int G_, int c_) { nM = M / BM; nN = N / BM; nwg = nM * nN; G = G_; c = c_; }
    __host__ __device__ bool next(int i, Unit& u) const {
        const long L = (long)i * G + c; if (L >= nwg) return false;
        int wgid = (int)L; { const int q = nwg / NXCD, r = nwg % NXCD, xcd = wgid % NXCD, off = wgid / NXCD; wgid = (xcd < r ? xcd * (q + 1) : r * (q + 1) + (xcd - r) * q) + off; }
        const int nig = WGM * nN, gid = wgid / nig, fm = gid * WGM, gsz = (nM - fm) < WGM ? (nM - fm) : WGM;
        u.pm = fm + ((wgid % nig) % gsz); u.pn = (wgid % nig) / gsz; return true;
    }
    __device__ __forceinline__ void a_ready(const Unit&) const {}
    __device__ __forceinline__ void done(const Unit&) const {}
};

__device__ __forceinline__ unsigned cvt_pk_bf16(float lo, float hi) { unsigned r; asm volatile("v_cvt_pk_bf16_f32 %0, %1, %2" : "=v"(r) : "v"(lo), "v"(hi)); return r; }
typedef float f32x2 __attribute__((ext_vector_type(2)));
__device__ __forceinline__ f32x2 gelu_pk(f32x2 v) {
    const f32x2 av = __builtin_elementwise_abs(v), d = av * 0.2316418882f + 1.0f;
    f32x2 t; t.x = __builtin_amdgcn_rcpf(d.x); t.y = __builtin_amdgcn_rcpf(d.y);
    f32x2 q = t * 0.5307027145f + (-0.7265760135f); q = q * t + 0.7107068705f; q = q * t + (-0.142248368f); q = q * t + 0.127414796f; q = q * t;
    const f32x2 s = (v * v) * (-0.72134752044f);
    f32x2 e; e.x = __builtin_amdgcn_exp2f(s.x); e.y = __builtin_amdgcn_exp2f(s.y);
    const f32x2 m = v * (q * e), r = v - m;
    f32x2 o; o.x = v.x < 0.f ? m.x : r.x; o.y = v.y < 0.f ? m.y : r.y; return o;
}

template <int ACT  > struct EpiBf16 {
    static constexpr bool PERM = true, AFTER_DRAIN = false; static_assert(ACT == 0 || ACT == 1, "EpiBf16: ACT is 0 (none) or 1 (gelu_pk)");
    bf16_t* O; int ldc; const float* bias; int split_cols; size_t split_stride; float scale0;
    __device__ __forceinline__ void operator()(const f32x4 (&acc)[2][2][4][2], const Unit& u, int wr, int wc, int fr, int fq) const {
        const int row0 = u.pm * BM + wr * 64 + fr; int colt = u.pn * BM; bf16_t* base = O;
        float sc = 1.f; if (split_cols) { const int t = colt / split_cols; base += (size_t)t * split_stride; colt -= t * split_cols; if (t == 0) sc = scale0; }
        const int col0 = colt + wc * 32 + 8 * fq, bcol0 = u.pn * BM + wc * 32 + 8 * fq;
        f32x4 bv[2][2];
#pragma unroll
        for (int bj = 0; bj < 2; ++bj)
#pragma unroll
            for (int n = 0; n < 2; ++n) bv[bj][n] = bias ? *(const f32x4*)(bias + bcol0 + bj * HALF + 4 * n) : (f32x4){0.f, 0.f, 0.f, 0.f};
#pragma unroll
        for (int ai = 0; ai < 2; ++ai)
#pragma unroll
            for (int m = 0; m < 4; ++m) { bf16_t* rowp = base + (size_t)(row0 + ai * HALF + m * 16) * ldc + col0;
#pragma unroll
                for (int bj = 0; bj < 2; ++bj) { f32x4 v0 = acc[ai][bj][m][0] + bv[bj][0], v1 = acc[ai][bj][m][1] + bv[bj][1];
                    if (ACT == 1) { f32x2 a = gelu_pk((f32x2){v0[0], v0[1]}), b = gelu_pk((f32x2){v0[2], v0[3]}), c = gelu_pk((f32x2){v1[0], v1[1]}), d = gelu_pk((f32x2){v1[2], v1[3]});
                        v0 = (f32x4){a.x, a.y, b.x, b.y}; v1 = (f32x4){c.x, c.y, d.x, d.y}; }
                    v0 = v0 * sc; v1 = v1 * sc; u32x4 w; w.x = cvt_pk_bf16(v0[0], v0[1]); w.y = cvt_pk_bf16(v0[2], v0[3]); w.z = cvt_pk_bf16(v1[0], v1[1]); w.w = cvt_pk_bf16(v1[2], v1[3]);
                    *(u32x4*)(rowp + bj * HALF) = w; } }
    }
};

__device__ __forceinline__ float silu_fast(float x) { return x * __builtin_amdgcn_rcpf(1.0f + __builtin_amdgcn_exp2f(-1.4426950408889634f * x)); }
struct EpiResidual {
    static constexpr bool PERM = false, AFTER_DRAIN = false;
    const float* base_lat; const float* base_ctx; float* out_lat; float* out_ctx; const float* gate; int RL;
    __device__ __forceinline__ void operator()(const f32x4 (&acc)[2][2][4][2], const Unit& u, int wr, int wc, int fr, int fq) const {
        const int col0 = u.pn * BM + wc * 32 + 4 * fq;
#pragma unroll
        for (int ai = 0; ai < 2; ++ai)
#pragma unroll
            for (int m = 0; m < 4; ++m) {
                const int row = u.pm * BM + ai * HALF + wr * 64 + m * 16 + fr;
                const bool lat = row < RL; const int rr = lat ? row : row - RL; const int bb = lat ? (row >> 13) : 4;
                const float* bp = (lat ? base_lat : base_ctx) + (size_t)rr * 1024 + col0; float* op = (lat ? out_lat : out_ctx) + (size_t)rr * 1024 + col0;
                const float* gp = gate + bb * 6144 + col0;
#pragma unroll
                for (int bj = 0; bj < 2; ++bj)
#pragma unroll
                    for (int n = 0; n < 2; ++n) { const int c = bj * HALF + n * 16; const f32x4 g = *(const f32x4*)(gp + c), b = *(const f32x4*)(bp + c); *(f32x4*)(op + c) = b + g * acc[ai][bj][m][n]; }
            }
    }
};
struct EpiMoe1 {
    static constexpr bool PERM = true, AFTER_DRAIN = false;
    bf16_t* O;
    __device__ __forceinline__ void operator()(const f32x4 (&acc)[2][2][4][2], const Unit& u, int wr, int wc, int fr, int fq) const {
        const int row0 = u.pm * BM + wr * 64 + fr; const int hcol0 = (u.pn & 15) * 128 + wc * 32 + 8 * fq;
#pragma unroll
        for (int ai = 0; ai < 2; ++ai)
#pragma unroll
            for (int m = 0; m < 4; ++m) { bf16_t* rowp = O + (size_t)(row0 + ai * HALF + m * 16) * 2048 + hcol0;
                const f32x4 g0 = acc[ai][0][m][0], g1 = acc[ai][0][m][1], u0 = acc[ai][1][m][0], u1 = acc[ai][1][m][1];
                u32x4 w; w.x = cvt_pk_bf16(silu_fast(g0[0]) * u0[0], silu_fast(g0[1]) * u0[1]); w.y = cvt_pk_bf16(silu_fast(g0[2]) * u0[2], silu_fast(g0[3]) * u0[3]);
                w.z = cvt_pk_bf16(silu_fast(g1[0]) * u1[0], silu_fast(g1[1]) * u1[1]); w.w = cvt_pk_bf16(silu_fast(g1[2]) * u1[2], silu_fast(g1[3]) * u1[3]);
                *(u32x4*)rowp = w; }
    }
};
struct EpiMoe2 {
    static constexpr bool PERM = true, AFTER_DRAIN = false;
    bf16_t* O; const float* gatev;
    __device__ __forceinline__ void operator()(const f32x4 (&acc)[2][2][4][2], const Unit& u, int wr, int wc, int fr, int fq) const {
        const int row0 = u.pm * BM + wr * 64 + fr; const int col0 = (u.pn & 3) * BM + wc * 32 + 8 * fq;
#pragma unroll
        for (int ai = 0; ai < 2; ++ai)
#pragma unroll
            for (int m = 0; m < 4; ++m) { const int row = row0 + ai * HALF + m * 16; const float gv = gatev[row]; bf16_t* rowp = O + (size_t)row * 1024 + col0;
#pragma unroll
                for (int bj = 0; bj < 2; ++bj) { const f32x4 v0 = acc[ai][bj][m][0] * gv, v1 = acc[ai][bj][m][1] * gv;
                    u32x4 w; w.x = cvt_pk_bf16(v0[0], v0[1]); w.y = cvt_pk_bf16(v0[2], v0[3]); w.z = cvt_pk_bf16(v1[0], v1[1]); w.w = cvt_pk_bf16(v1[2], v1[3]);
                    *(u32x4*)(rowp + bj * HALF) = w; } }
    }
};
struct EpiQK {
    static constexpr bool PERM = true, AFTER_DRAIN = false;
    bf16_t* O; const float* rope; float qscale; int RL;
    __device__ __forceinline__ void operator()(const f32x4 (&acc)[2][2][4][2], const Unit& u, int wr, int wc, int fr, int fq) const {
        const int row0 = u.pm * BM + wr * 64 + fr; const int colb = u.pn * BM + wc * 32 + 8 * fq;
#pragma unroll
        for (int ai = 0; ai < 2; ++ai)
#pragma unroll
            for (int m = 0; m < 4; ++m) { const int row = row0 + ai * HALF + m * 16; const bool lat = row < RL; const int t = row & 8191; const int pr = t >> 6, pc = t & 63;
#pragma unroll
                for (int bj = 0; bj < 2; ++bj) { const int col = colb + bj * HALF; f32x4 v0 = acc[ai][bj][m][0], v1 = acc[ai][bj][m][1];
                    if (lat) { const int half = (col >> 5) & 1, j0 = (col & 31) >> 1;
                        const float* cp = rope + (half ? 4096 + pc * 16 : pr * 16) + j0; const float* sp = cp + (half ? 1024 : 2048);
                        const f32x4 c = *(const f32x4*)cp, s = *(const f32x4*)sp;
                        f32x4 a, b;
                        a[0] = v0[0] * c[0] - v0[1] * s[0]; a[1] = v0[1] * c[0] + v0[0] * s[0]; a[2] = v0[2] * c[1] - v0[3] * s[1]; a[3] = v0[3] * c[1] + v0[2] * s[1];
                        b[0] = v1[0] * c[2] - v1[1] * s[2]; b[1] = v1[1] * c[2] + v1[0] * s[2]; b[2] = v1[2] * c[3] - v1[3] * s[3]; b[3] = v1[3] * c[3] + v1[2] * s[3];
                        v0 = a; v1 = b; }
                    const float sc = (col < 1024) ? qscale : 1.0f; v0 = v0 * sc; v1 = v1 * sc;
                    u32x4 w; w.x = cvt_pk_bf16(v0[0], v0[1]); w.y = cvt_pk_bf16(v0[2], v0[3]); w.z = cvt_pk_bf16(v1[0], v1[1]); w.w = cvt_pk_bf16(v1[2], v1[3]);
                    *(u32x4*)(O + (size_t)row * 2048 + col) = w; } }
    }
};
struct MoeOrder {
    int total, G, c, tiles_pe, ncol;
    __device__ __forceinline__ bool next(int i, Unit& u) const {
        const long L = (long)i * G + c; if (L >= total) return false;
        const int per = tiles_pe * ncol; const int e = (int)L / per, rem = (int)L % per; int pml = rem % tiles_pe, pnl = rem / tiles_pe;
        if (per == 256 && G == 256) { const int x = rem & 7, j = rem >> 3; pml = (x & 3) * 4 + (j & 3); pnl = (x >> 2) * 8 + (j >> 2); }
        int ee = e;
        if (per == 272 && G == 256) {
            const int x = c & 7, j = c >> 3, g = x & 3, ph = x >> 2, k = i * 32 + j;
            const int q4 = k / 136, r = k % 136; const int b1 = 32 + (g == 0 ? 8 : 0), b2 = b1 + 32 + (g == 1 ? 8 : 0), b3 = b2 + 32 + (g == 2 ? 8 : 0);
            const int t = (r >= b1) + (r >= b2) + (r >= b3); const int rp = r - (t == 0 ? 0 : t == 1 ? b1 : t == 2 ? b2 : b3);
            ee = 4 * q4 + t;
            if (rp < 32) { pml = g * 4 + (rp & 3); pnl = ph * 8 + (rp >> 2); } else { pml = 16; pnl = ph * 8 + (rp - 32); } }
        u.pm = ee * tiles_pe + pml; u.pn = ee * ncol + pnl; return true; }
    __device__ __forceinline__ void a_ready(const Unit&) const {}
    __device__ __forceinline__ void done(const Unit&) const {}
};
struct QkvOrder {
    int G, c, tH, tWqk, tWv;
    __device__ __forceinline__ bool next(int i, Unit& u) const {
        const int L = i * G + c; if (L >= 1584) return false;
        if (L < 1056) { u.pm = tH + (L >> 3); u.pn = tWqk + (L & 7); } else { const int q = L - 1056; u.pm = tWv + (q & 3); u.pn = tH + (q >> 2); }
        return true; }
    __device__ __forceinline__ void a_ready(const Unit&) const {}
    __device__ __forceinline__ void done(const Unit&) const {}
};
struct EpiQKV {
    static constexpr bool PERM = true, AFTER_DRAIN = false;
    EpiQK qk; EpiBf16<0> vt; int tH, tWqk, tWv;
    __device__ __forceinline__ void operator()(const f32x4 (&acc)[2][2][4][2], const Unit& u, int wr, int wc, int fr, int fq) const {
        if (u.pn >= tH) { Unit v; v.pm = u.pm - tWv; v.pn = u.pn - tH; vt(acc, v, wr, wc, fr, fq); }
        else { Unit v; v.pm = u.pm - tH; v.pn = u.pn - tWqk; qk(acc, v, wr, wc, fr, fq); }
    }
};
template <class Epi, class Sched, bool ALIGN_EPI = false, bool SP2 = false, bool GATHER = false>
__device__ __forceinline__ void gemm_phase(PG8_LAS unsigned char* lds, const Gemm g, const Sched& S, const Epi& E, const PG8_LAS unsigned short* gtab = nullptr) {
    static_assert(!GATHER || SP2, "GATHER needs the SP2 loop");
    const int tid = threadIdx.x, wid = __builtin_amdgcn_readfirstlane(tid >> 6), lane = tid & 63, wr = wid >> 2, wc = wid & 3, fr = lane & 15, fq = lane >> 4;
    const int K = g.K, nt = K / BK;
    unsigned voffA[2], voffB[2]; int gR[2]; unsigned gC2[2];
#pragma unroll
    for (int i = 0; i < 2; ++i) { int R, C; stage_rc(tid * 16 + i * 8192, R, C); const int Rb = Epi::PERM ? ((R & ~31) + perm32(R & 31)) : R;
        voffA[i] = (unsigned)(R * K + C) * 2u; voffB[i] = (unsigned)(Rb * K + C) * 2u; gR[i] = R; gC2[i] = (unsigned)C * 2u; }
    unsigned offc[2][2] = {{0u, 0u}, {0u, 0u}}, offn[2][2] = {{0u, 0u}, {0u, 0u}};
#define PG8_GOFF(dst, ui_) do { _Pragma("unroll") for (int _h = 0; _h < 2; ++_h) _Pragma("unroll") for (int _i = 0; _i < 2; ++_i) \
        dst[_h][_i] = (unsigned)gtab[(ui_) * 256 + _h * 128 + gR[_i]] * (unsigned)(K * 2) + gC2[_i]; } while (0)
#define PG8_STA(bufoff, ptr, kb, h, nx) do { if constexpr (GATHER) { _Pragma("unroll") for (int _i = 0; _i < 2; ++_i) \
        __builtin_amdgcn_global_load_lds((const unsigned*)((const char*)g.A + (kb) + ((nx) ? offn[h][_i] : offc[h][_i])), (PG8_LAS unsigned*)(lds + (bufoff) + ldsw + _i * 8192), 16, 0, 0); } \
        else { PG8_STAGE(bufoff, ptr, voffA); } } while (0)
    const size_t kstep = (size_t)(BK * 2);
    const size_t hstep = (size_t)HALF * K * 2;
    const size_t tstep = 2 * hstep;
    const unsigned ldsw = (unsigned)wid * 1024u;
    const int aoff = lds_byte(wr * 64 + fr, fq * 8), boff = lds_byte(wc * 32 + fr, fq * 8);
#define PG8_SA(b, h) (((b) * 2 + (h)) * HTB)
#define PG8_SB(b, h) ((4 + (b) * 2 + (h)) * HTB)
#define PG8_STAGE(bufoff, gbase, voff) do { _Pragma("unroll") for (int _i = 0; _i < 2; ++_i) \
        __builtin_amdgcn_global_load_lds((const unsigned*)((const char*)(gbase) + (voff)[_i]), (PG8_LAS unsigned*)(lds + (bufoff) + ldsw + _i * 8192), 16, 0, 0); } while (0)
#define PG8_LDA(dst, b, h) do { _Pragma("unroll") for (int m = 0; m < 4; ++m) _Pragma("unroll") for (int k = 0; k < 2; ++k) dst[m][k] = *(const PG8_LAS bf16x8*)(lds + PG8_SA(b, h) + aoff + m * 2048 + k * 1024); } while (0)
#define PG8_LDB(dst, b, h) do { _Pragma("unroll") for (int n = 0; n < 2; ++n) _Pragma("unroll") for (int k = 0; k < 2; ++k) dst[n][k] = *(const PG8_LAS bf16x8*)(lds + PG8_SB(b, h) + boff + n * 2048 + k * 1024); } while (0)
#define PG8_MMA(ai, bj, At, Bt) do { __builtin_amdgcn_s_setprio(1); _Pragma("unroll") for (int m = 0; m < 4; ++m) _Pragma("unroll") for (int n = 0; n < 2; ++n) _Pragma("unroll") for (int k = 0; k < 2; ++k) \
        acc[ai][bj][m][n] = __builtin_amdgcn_mfma_f32_16x16x32_bf16(Bt[n][k], At[m][k], acc[ai][bj][m][n], 0, 0, 0); __builtin_amdgcn_s_setprio(0); } while (0)
#define PG8_WAIT_V(n) asm volatile("s_waitcnt vmcnt(" #n ")" ::: "memory")
#define PG8_WAIT_L(n) asm volatile("s_waitcnt lgkmcnt(" #n ")" ::: "memory")
#define PG8_BAR __builtin_amdgcn_s_barrier()
#define PG8_SCHED __builtin_amdgcn_sched_barrier(0)
    Unit cur, nxt; int ui = 0;
    if (!S.next(0, cur)) return;
    f32x4 acc[2][2][4][2];
#pragma unroll
    for (int a = 0; a < 2; ++a)
#pragma unroll
        for (int b = 0; b < 2; ++b)
#pragma unroll
            for (int m = 0; m < 4; ++m)
#pragma unroll
                for (int n = 0; n < 2; ++n) acc[a][b][m][n] = (f32x4){0.f, 0.f, 0.f, 0.f};
    bf16x8 At[4][2], B0[2][2], B1[2][2];
    const char* cA = (const char*)g.A + (size_t)cur.pm * tstep; const char* cB = (const char*)g.Bt + (size_t)cur.pn * tstep;
    S.a_ready(cur);
    if constexpr (GATHER) PG8_GOFF(offc, 0);
    if constexpr (SP2) {
        PG8_STAGE(PG8_SB(0, 0), cB, voffB); PG8_STAGE(PG8_SB(0, 1), cB + hstep, voffB); PG8_STA(PG8_SA(0, 0), cA, (size_t)0, 0, false); PG8_STA(PG8_SA(0, 1), cA + hstep, (size_t)0, 1, false);
        if (wr == 1) PG8_BAR;
        PG8_WAIT_V(2); PG8_BAR;
        PG8_STAGE(PG8_SB(1, 0), cB + kstep, voffB); PG8_STA(PG8_SA(1, 0), cA + kstep, kstep, 0, false); PG8_STAGE(PG8_SB(1, 1), cB + hstep + kstep, voffB);
        PG8_WAIT_V(6); PG8_BAR;
    } else {
        PG8_STAGE(PG8_SB(0, 0), cB, voffB); PG8_STAGE(PG8_SA(0, 0), cA, voffA); PG8_STAGE(PG8_SB(0, 1), cB + hstep, voffB); PG8_STAGE(PG8_SA(0, 1), cA + hstep, voffA);
        if (wr == 1) PG8_BAR;
        PG8_WAIT_V(4); PG8_BAR;
        PG8_STAGE(PG8_SB(1, 0), cB + kstep, voffB); PG8_STAGE(PG8_SA(1, 0), cA + kstep, voffA); PG8_STAGE(PG8_SB(1, 1), cB + hstep + kstep, voffB);
        PG8_WAIT_V(6); PG8_BAR;
    }
    for (;;) {
        const bool has_next = S.next(ui + 1, nxt);
        if constexpr (GATHER) PG8_GOFF(offn, has_next ? ui + 1 : ui);
        const char* nA = has_next ? (const char*)g.A + (size_t)nxt.pm * tstep : cA; const char* nB = has_next ? (const char*)g.Bt + (size_t)nxt.pn * tstep : cB;
        for (int t = 0; t < nt; t += 2) {
            const bool last = (t == nt - 2);
            const char* a1 = cA + (size_t)(t + 1) * kstep;
            const char* a2 = last ? nA : cA + (size_t)(t + 2) * kstep; const char* b2 = last ? nB : cB + (size_t)(t + 2) * kstep;
            const char* a3 = a2 + kstep; const char* b3 = b2 + kstep;
            const size_t ka1 = (size_t)(t + 1) * kstep, ka2 = last ? (size_t)0 : (size_t)(t + 2) * kstep, ka3 = ka2 + kstep;
            if (last && has_next) S.a_ready(nxt);
            if constexpr (SP2) {
            PG8_LDB(B0, 0, 0); PG8_LDB(B1, 0, 1); PG8_SCHED; PG8_LDA(At, 0, 0); PG8_STA(PG8_SA(1, 1), a1 + hstep, ka1, 1, false);
            PG8_WAIT_V(8); PG8_WAIT_L(0); PG8_BAR; PG8_MMA(0, 0, At, B0); PG8_MMA(0, 1, At, B1); PG8_BAR; PG8_SCHED;
            PG8_LDA(At, 0, 1); PG8_STAGE(PG8_SB(0, 0), b2, voffB); PG8_STAGE(PG8_SB(0, 1), b2 + hstep, voffB); PG8_STA(PG8_SA(0, 0), a2, ka2, 0, last);
            PG8_WAIT_V(8); PG8_WAIT_L(0); PG8_BAR; PG8_MMA(1, 0, At, B0); PG8_MMA(1, 1, At, B1); PG8_BAR; PG8_SCHED;
            PG8_LDB(B0, 1, 0); PG8_LDB(B1, 1, 1); PG8_SCHED; PG8_LDA(At, 1, 0); PG8_STA(PG8_SA(0, 1), a2 + hstep, ka2, 1, last);
            PG8_WAIT_V(8); PG8_WAIT_L(0); PG8_BAR; PG8_MMA(0, 0, At, B0); PG8_MMA(0, 1, At, B1); PG8_BAR; PG8_SCHED;
            PG8_LDA(At, 1, 1); PG8_STAGE(PG8_SB(1, 0), b3, voffB); PG8_STAGE(PG8_SB(1, 1), b3 + hstep, voffB); PG8_STA(PG8_SA(1, 0), a3, ka3, 0, last);
            PG8_WAIT_V(8); PG8_WAIT_L(0); PG8_BAR; PG8_MMA(1, 0, At, B0); PG8_MMA(1, 1, At, B1); PG8_BAR; PG8_SCHED;
            } else {
            PG8_LDB(B0, 0, 0); PG8_SCHED; PG8_LDA(At, 0, 0); PG8_STAGE(PG8_SA(1, 1), a1 + hstep, voffA);
            PG8_WAIT_L(8); PG8_BAR; PG8_WAIT_L(0); PG8_MMA(0, 0, At, B0); PG8_BAR; PG8_SCHED;
            PG8_LDB(B1, 0, 1); PG8_STAGE(PG8_SB(0, 0), b2, voffB);
            PG8_BAR; PG8_WAIT_L(0); PG8_MMA(0, 1, At, B1); PG8_BAR;
            PG8_LDA(At, 0, 1); PG8_STAGE(PG8_SA(0, 0), a2, voffA);
            PG8_BAR; PG8_WAIT_L(0); PG8_MMA(1, 0, At, B0); PG8_BAR; PG8_SCHED;
            PG8_STAGE(PG8_SB(0, 1), b2 + hstep, voffB);
            PG8_WAIT_V(6); PG8_BAR; PG8_MMA(1, 1, At, B1); PG8_BAR;
            PG8_LDB(B0, 1, 0); PG8_SCHED; PG8_LDA(At, 1, 0); PG8_STAGE(PG8_SA(0, 1), a2 + hstep, voffA);
            PG8_WAIT_L(8); PG8_BAR; PG8_WAIT_L(0); PG8_MMA(0, 0, At, B0); PG8_BAR; PG8_SCHED;
            PG8_LDB(B1, 1, 1); PG8_STAGE(PG8_SB(1, 0), b3, voffB);
            PG8_BAR; PG8_WAIT_L(0); PG8_MMA(0, 1, At, B1); PG8_BAR;
            PG8_LDA(At, 1, 1); PG8_STAGE(PG8_SA(1, 0), a3, voffA);
            PG8_BAR; PG8_WAIT_L(0); PG8_MMA(1, 0, At, B0); PG8_BAR; PG8_SCHED;
            PG8_STAGE(PG8_SB(1, 1), b3 + hstep, voffB);
            PG8_WAIT_V(6); PG8_BAR; PG8_MMA(1, 1, At, B1); PG8_BAR;
            }
        }
        if constexpr (ALIGN_EPI) { if (wr == 0) PG8_BAR; }
        if constexpr (!Epi::AFTER_DRAIN) { E(acc, cur, wr, wc, fr, fq); S.done(cur); }
        if (!has_next) break;
#pragma unroll
        for (int a = 0; a < 2; ++a)
#pragma unroll
            for (int b = 0; b < 2; ++b)
#pragma unroll
                for (int m = 0; m < 4; ++m)
#pragma unroll
                    for (int n = 0; n < 2; ++n) acc[a][b][m][n] = (f32x4){0.f, 0.f, 0.f, 0.f};
        cur = nxt; cA = nA; cB = nB; ++ui;
        if constexpr (GATHER) { offc[0][0] = offn[0][0]; offc[0][1] = offn[0][1]; offc[1][0] = offn[1][0]; offc[1][1] = offn[1][1]; }
        if constexpr (ALIGN_EPI) { if (wr == 1) PG8_BAR; }
    }
    PG8_WAIT_V(0);
    if constexpr (!ALIGN_EPI) { if (wr == 0) PG8_BAR; }
    PG8_BAR;
    if constexpr (Epi::AFTER_DRAIN) { E.fused(acc, cur, wr, wc, fr, fq, lds, wid, lane); S.done(cur); }
#undef PG8_SA
#undef PG8_SB
#undef PG8_STAGE
#undef PG8_STA
#undef PG8_GOFF
#undef PG8_LDA
#undef PG8_LDB
#undef PG8_MMA
#undef PG8_WAIT_V
#undef PG8_WAIT_L
#undef PG8_BAR
#undef PG8_SCHED
}
}

#define GAS __attribute__((address_space(1)))
#define LAS __attribute__((address_space(3)))
#define DI __device__ __forceinline__
typedef unsigned short bf16;
typedef float f32x4 __attribute__((ext_vector_type(4)));
typedef float f32x2 __attribute__((ext_vector_type(2)));
typedef float f32x16 __attribute__((ext_vector_type(16)));
typedef short bf16x8 __attribute__((ext_vector_type(8)));
typedef unsigned u32x4 __attribute__((ext_vector_type(4)));
typedef unsigned u32x2 __attribute__((ext_vector_type(2)));
typedef __bf16 bf16x2_t __attribute__((ext_vector_type(2)));
#define LDS_WAIT() asm volatile("s_waitcnt lgkmcnt(0)" ::: "memory")
#define MFMA32(a, b, c) __builtin_amdgcn_mfma_f32_32x32x16_bf16((a), (b), (c), 0, 0, 0)
DI unsigned pk2(float lo, float hi) { f32x2 v = {lo, hi}; bf16x2_t b = __builtin_convertvector(v, bf16x2_t); return __builtin_bit_cast(unsigned, b); }
DI float bflo(unsigned w) { return __uint_as_float(w << 16); }
DI float bfhi(unsigned w) { return __uint_as_float(w & 0xffff0000u); }
DI int crow(int r, int hi) { return (r & 3) + 8 * (r >> 2) + 4 * hi; }
DI float wave_sum(float v) {
#pragma unroll
    for (int o = 1; o < 64; o <<= 1) v += __shfl_xor(v, o);
    return v;
}
DI float wave_max(float v) {
#pragma unroll
    for (int o = 1; o < 64; o <<= 1) v = fmaxf(v, __shfl_xor(v, o));
    return v;
}
DI float silu_f(float x) { return x / (1.0f + __expf(-x)); }
template <int S> DI bf16x8 pack8(const f32x16& x) {
    u32x4 p; p.x = pk2(x[8 * S], x[8 * S + 1]); p.y = pk2(x[8 * S + 2], x[8 * S + 3]); p.z = pk2(x[8 * S + 4], x[8 * S + 5]); p.w = pk2(x[8 * S + 6], x[8 * S + 7]);
    return __builtin_bit_cast(bf16x8, p);
}
DI int sw64(int row, int c8) { return row * 128 + ((c8 ^ ((row >> 1) & 7)) << 4); }
DI int sw128(int row, int c16) { return row * 256 + ((c16 ^ (row & 15)) << 4); }

#define XB_TMO      128
#define XB_XCNT(j)  (256  + 64 * (j))
#define XB_XSUB(j)  (1280 + 64 * (j))
#define XB_XGEN(j)  (2304 + 64 * (j))
#define XB_TOP      3328
#define XB_TOPGEN   3392
#define XCD_BAR_WORDS 3456
#define XB_SPIN_CAP (1u << 18)

__device__ __forceinline__ unsigned xb_ld(unsigned* p)              { return __hip_atomic_load(p, __ATOMIC_RELAXED, __HIP_MEMORY_SCOPE_AGENT); }
__device__ __forceinline__ unsigned xb_add(unsigned* p, unsigned v) { return __hip_atomic_fetch_add(p, v, __ATOMIC_RELAXED, __HIP_MEMORY_SCOPE_AGENT); }
__device__ __forceinline__ unsigned xb_xcc_id() { return (unsigned)__builtin_amdgcn_s_getreg((3 << 11) | 20) & 0xFu; }
#define XB_SPIN(cond, bar) do { unsigned _sp = 0; while (cond) { __builtin_amdgcn_s_sleep(1); \
    if ((++_sp & 255u) == 0u) { if (xb_ld(&(bar)[XB_TMO])) break; if (_sp > XB_SPIN_CAP) { atomicAdd(&(bar)[XB_TMO], 1u); break; } } } } while (0)

struct XcdBarrier {
    unsigned* bar; unsigned x;
    volatile LAS unsigned* st;
};

__device__ __forceinline__ XcdBarrier xcd_barrier_post(unsigned* bar, volatile LAS unsigned* st) {
    XcdBarrier b; b.bar = bar; b.x = xb_xcc_id(); b.st = st;
    if (threadIdx.x == 0) (void)xb_add(&bar[XB_XCNT(b.x)], 1u);
    return b;
}
__device__ __forceinline__ void xcd_barrier_complete(unsigned* bar, unsigned x, unsigned& nloc, unsigned& nx) {
    const unsigned G = gridDim.x * gridDim.y * gridDim.z;
    unsigned sum, cnt, mine, sp = 0u;
    for (;;) {
        sum = 0u; cnt = 0u; mine = 0u;
#pragma unroll
        for (unsigned j = 0; j < 16; ++j) { const unsigned c = xb_ld(&bar[XB_XCNT(j)]); sum += c; cnt += (c > 0u) ? 1u : 0u; mine = (j == x) ? c : mine; }
        if (sum == G) break;
        __builtin_amdgcn_s_sleep(1);
        if ((++sp & 255u) == 0u) { if (xb_ld(&bar[XB_TMO])) break; if (sp > XB_SPIN_CAP) { atomicAdd(&bar[XB_TMO], 1u); break; } }
    }
    nloc = mine > 0u ? mine : 1u; nx = cnt > 0u ? cnt : 1u;
}

__device__ __forceinline__ void xcd_barrier(const XcdBarrier& b) {
    asm volatile("s_waitcnt vmcnt(0)" ::: "memory");
    __syncthreads();
    if (threadIdx.x == 0) {
        unsigned* bar = b.bar;
        __builtin_amdgcn_s_waitcnt(0);
        unsigned nloc = b.st[0], nx = b.st[1];
        if (nloc == 0u) { xcd_barrier_complete(bar, b.x, nloc, nx); b.st[0] = nloc; b.st[1] = nx; }
        const unsigned old = xb_add(&bar[XB_XSUB(b.x)], 1u);
        const unsigned gen = old / nloc;
        if (old + 1u == (gen + 1u) * nloc) {
            __builtin_amdgcn_fence(__ATOMIC_RELEASE, "agent");
            asm volatile("s_waitcnt vmcnt(0)" ::: "memory");
            const unsigned og = xb_add(&bar[XB_TOP], 1u);
            const unsigned tg = og / nx;
            if (og + 1u == (tg + 1u) * nx) xb_add(&bar[XB_TOPGEN], 1u);
            else XB_SPIN(xb_ld(&bar[XB_TOPGEN]) == tg, bar);
            __builtin_amdgcn_fence(__ATOMIC_ACQUIRE, "agent");
            xb_add(&bar[XB_XGEN(b.x)], 1u);
            asm volatile("s_waitcnt vmcnt(0)" ::: "memory");
        } else {
            XB_SPIN(xb_ld(&bar[XB_XGEN(b.x)]) == gen, bar);
            __builtin_amdgcn_fence(__ATOMIC_ACQUIRE, "agent");
            asm volatile("s_waitcnt vmcnt(0)" ::: "memory");
        }
    }
    __syncthreads();
}

constexpr int NWAVES = 8, NTHR = 512;
constexpr int DM = 1024, NBATCH = 4, SEQL = 8192, CTXL = 256, RL = NBATCH * SEQL, RC = NBATCH * CTXL, RT = RL + RC;
constexpr int NPROJ = 3584, INCOLS = 3600, NEXP = 16, FFN = 2048;
constexpr int SPE0 = 17 * 256, SPE1 = 16 * 256;
constexpr int M1_0 = NEXP * SPE0, M1_1 = NEXP * SPE1;
constexpr float EPSN = 1e-6f;
constexpr float LAM_INIT = 0.35550907f;
constexpr int NCHUNK = 132;
constexpr int GBLK = 73728;

constexpr size_t MiB = 1u << 20;
constexpr size_t WS_CTL = 0, CTL_ZERO_BYTES = 1 * MiB;
constexpr size_t WS_MODV = 1 * MiB;
constexpr size_t WS_ROPE = 1 * MiB + 256 * 1024;
constexpr size_t WS_ZROW = 1 * MiB + 512 * 1024;
constexpr size_t WS_GATES = 2 * MiB;
constexpr size_t WS_AFFT = 5 * MiB;
constexpr size_t WS_INV = 8 * MiB;
constexpr size_t WS_GATEV = 11 * MiB;
constexpr size_t WS_IDX = 11 * MiB + 512 * 1024;
constexpr size_t WS_GLAST = 12 * MiB;
constexpr size_t WS_WIN = 17 * MiB, WS_WOUT = 24 * MiB, WS_WQK = 26 * MiB, WS_WV = 30 * MiB, WS_WO = 32 * MiB;
constexpr size_t WS_E0 = 36 * MiB;
constexpr size_t WS_XC = 228 * MiB;
constexpr size_t WS_H = 232 * MiB;
constexpr size_t WS_BIG = 298 * MiB;
constexpr size_t WS_G = 570 * MiB;
constexpr size_t WS_W2L1 = 898 * MiB;
constexpr size_t WS_END = 962 * MiB;
constexpr int CW_BAR = 4096, CW_Q0 = 8192, CW_Q1 = 8256, CW_Q2 = 8320, CW_Q3 = 8384;

constexpr int RING_BYTES = 131072;
constexpr int LDSX = RING_BYTES;
constexpr int LDS_BYTES = 147456;

struct Args { const float* in[35]; float* out; unsigned char* ws; int ph_lo, ph_hi, ph_rep, pad; };

template <class F> DI void tr_item(const float* W, int ldw, bf16* WT, int ldk, int k0, F rowmap, LAS float* scr, int lane) {
    float tmp_[32];
#pragma unroll
    for (int i = 0; i < 32; ++i) { const int kk = 2 * i + (lane >> 5); tmp_[i] = W[(size_t)kk * ldw + (lane & 31)]; }
#pragma unroll
    for (int i = 0; i < 32; ++i) { const int kk = 2 * i + (lane >> 5); scr[kk * 33 + (lane & 31)] = tmp_[i]; }
    LDS_WAIT(); asm volatile("" ::: "memory");
    const int c = lane & 7;
#pragma unroll
    for (int j = 0; j < 4; ++j) { const int n = (lane >> 3) + 8 * j; const LAS float* s = scr + (8 * c) * 33 + n;
        u32x4 o; o.x = pk2(s[0 * 33], s[1 * 33]); o.y = pk2(s[2 * 33], s[3 * 33]); o.z = pk2(s[4 * 33], s[5 * 33]); o.w = pk2(s[6 * 33], s[7 * 33]);
        *(u32x4*)(WT + (size_t)rowmap(n) * ldk + k0 + 8 * c) = o; }
    LDS_WAIT(); asm volatile("" ::: "memory");
}
DI void tr_load(const float* W, int ldw, float (&t)[32], int lane) {
#pragma unroll
    for (int i = 0; i < 32; ++i) { const int kk = 2 * i + (lane >> 5); t[i] = __builtin_nontemporal_load(W + (size_t)kk * ldw + (lane & 31)); }
}
DI void tr_finish(const float (&t)[32], bf16* WT, int ldk, int k0, int rbase, LAS float* scr, int lane) {
#pragma unroll
    for (int i = 0; i < 32; ++i) { const int kk = 2 * i + (lane >> 5); scr[kk * 33 + (lane & 31)] = t[i]; }
    LDS_WAIT(); asm volatile("" ::: "memory");
    const int c = lane & 7;
#pragma unroll
    for (int j = 0; j < 4; ++j) { const int n = (lane >> 3) + 8 * j; const LAS float* s = scr + (8 * c) * 33 + n;
        u32x4 o; o.x = pk2(s[0 * 33], s[1 * 33]); o.y = pk2(s[2 * 33], s[3 * 33]); o.z = pk2(s[4 * 33], s[5 * 33]); o.w = pk2(s[6 * 33], s[7 * 33]);
        *(u32x4*)(WT + (size_t)(rbase + n) * ldk + k0 + 8 * c) = o; }
    LDS_WAIT(); asm volatile("" ::: "memory");
}
struct ItemDesc { const float* src; bf16* dst; int ldw, ldk, k0, rbase; };
DI ItemDesc expert_desc(int r, const float* Wg, const float* Wu, const float* Wd, bf16* W1, bf16* W2) {
    ItemDesc d;
    if (r < 32768) { const int up = r >> 14, q = r & 16383, e = q >> 10, it = q & 1023, kb = it >> 6, nb = it & 63;
        d.src = (up ? Wu : Wg) + (size_t)e * 1024 * 2048 + (size_t)(kb * 64) * 2048 + nb * 32; d.ldw = 2048; d.dst = W1; d.ldk = 1024; d.k0 = kb * 64;
        d.rbase = e * 4096 + (nb >> 2) * 256 + up * 128 + (nb & 3) * 32;
    } else { const int q = r - 32768, e = q >> 10, it = q & 1023, kb = it >> 5, nb = it & 31;
        d.src = Wd + (size_t)e * 2048 * 1024 + (size_t)(kb * 64) * 1024 + nb * 32; d.ldw = 1024; d.dst = W2; d.ldk = 2048; d.k0 = kb * 64; d.rbase = e * 1024 + nb * 32; }
    return d;
}
struct AddMap { int base; DI int operator()(int n) const { return base + n; } };
struct PairMap { int base; DI int operator()(int n) const { return base + (n < 16 ? 2 * n : 2 * (n - 16) + 1); } };
DI void expert_item(int r, const float* Wg, const float* Wu, const float* Wd, bf16* W1, bf16* W2, LAS float* scr, int lane) {
    if (r < 32768) { const int up = r >> 14, q = r & 16383, e = q >> 10, it = q & 1023, kb = it >> 6, nb = it & 63;
        const float* src = (up ? Wu : Wg) + (size_t)e * 1024 * 2048 + (size_t)(kb * 64) * 2048 + nb * 32;
        const int rbase = e * 4096 + (nb >> 2) * 256 + up * 128 + (nb & 3) * 32;
        tr_item(src, 2048, W1, 1024, kb * 64, AddMap{rbase}, scr, lane);
    } else { const int q = r - 32768, e = q >> 10, it = q & 1023, kb = it >> 5, nb = it & 31;
        const float* src = Wd + (size_t)e * 2048 * 1024 + (size_t)(kb * 64) * 1024 + nb * 32;
        const int rbase = e * 1024 + nb * 32;
        tr_item(src, 1024, W2, 2048, kb * 64, AddMap{rbase}, scr, lane);
    }
}
DI void stage_tab16(const float* W, int ldw, LAS float* tab, int tid) {
    for (int idx = tid; idx < 16384; idx += NTHR) { const int d = idx >> 4, e = idx & 15; const int j = d >> 8, l = (d >> 2) & 63, c = d & 3;
        tab[((((j * 4 + c) * 4 + (e >> 2)) * 64 + l) << 2) + (e & 3)] = W[(size_t)d * ldw + e]; }
}
DI void row_gemv16(const f32x4 (&h)[4], const LAS float* tab, int lane, float (&sums)[16]) {
#pragma unroll
    for (int e = 0; e < 16; ++e) sums[e] = 0.f;
#pragma unroll
    for (int j = 0; j < 4; ++j)
#pragma unroll
        for (int c = 0; c < 4; ++c) { const float hv = h[j][c];
#pragma unroll
            for (int q = 0; q < 4; ++q) { const f32x4 w = *(const LAS f32x4*)(tab + ((((j * 4 + c) * 4 + q) * 64 + lane) << 2));
                sums[4 * q + 0] += hv * w[0]; sums[4 * q + 1] += hv * w[1]; sums[4 * q + 2] += hv * w[2]; sums[4 * q + 3] += hv * w[3]; }
            asm volatile("" ::: "memory"); }
}
DI int eidx16(int lane) { return ((lane >> 5) & 1) * 8 + ((lane >> 4) & 1) * 4 + ((lane >> 3) & 1) * 2 + ((lane >> 2) & 1); }
DI float reduce16(const float (&s)[16], int lane) {
    float a8[8], a4[4], a2[2];
    const bool u5 = (lane & 32) != 0, u4 = (lane & 16) != 0, u3 = (lane & 8) != 0, u2 = (lane & 4) != 0;
#pragma unroll
    for (int k = 0; k < 8; ++k) { const float keep = u5 ? s[k + 8] : s[k], send = u5 ? s[k] : s[k + 8]; a8[k] = keep + __shfl_xor(send, 32); }
#pragma unroll
    for (int k = 0; k < 4; ++k) { const float keep = u4 ? a8[k + 4] : a8[k], send = u4 ? a8[k] : a8[k + 4]; a4[k] = keep + __shfl_xor(send, 16); }
#pragma unroll
    for (int k = 0; k < 2; ++k) { const float keep = u3 ? a4[k + 2] : a4[k], send = u3 ? a4[k] : a4[k + 2]; a2[k] = keep + __shfl_xor(send, 8); }
    float r; { const float keep = u2 ? a2[1] : a2[0], send = u2 ? a2[0] : a2[1]; r = keep + __shfl_xor(send, 4); }
    r += __shfl_xor(r, 2); r += __shfl_xor(r, 1);
    return r;
}
DI float* resid_ptr(float* lat, float* ctx, int r) { return r < RL ? lat + (size_t)r * DM : ctx + (size_t)(r - RL) * DM; }
DI int row_bb(int r) { return r < RL ? (r >> 13) : 4; }
DI void modulate_row(f32x4 (&v)[4], const float* nw, const float* shift, const float* scale, int lane) {
    float ss = 0.f;
#pragma unroll
    for (int j = 0; j < 4; ++j) ss += (v[j][0] * v[j][0] + v[j][1] * v[j][1]) + (v[j][2] * v[j][2] + v[j][3] * v[j][3]);
    const float rstd = 1.0f / sqrtf(wave_sum(ss) * (1.0f / DM) + EPSN);
#pragma unroll
    for (int j = 0; j < 4; ++j) { const int d = 256 * j + 4 * lane; const f32x4 w = *(const f32x4*)(nw + d), sc = *(const f32x4*)(scale + d), sh = *(const f32x4*)(shift + d);
        v[j] = v[j] * rstd * w * (sc + 1.0f) + sh; }
}
DI void store_row_bf16(bf16* dst, const f32x4 (&v)[4], int lane) {
#pragma unroll
    for (int j = 0; j < 4; ++j) { u32x2 o; o.x = pk2(v[j][0], v[j][1]); o.y = pk2(v[j][2], v[j][3]); *(u32x2*)(dst + 256 * j + 4 * lane) = o; }
}
DI void load_row_f32(const float* src, f32x4 (&v)[4], int lane) {
#pragma unroll
    for (int j = 0; j < 4; ++j) v[j] = *(const f32x4*)(src + 256 * j + 4 * lane);
}
DI void moe_combine_row(f32x4 (&v)[4], const int* invrow, const bf16* YE, const float* gvec, int lane) {
    const int mine = invrow[lane & 15];
    f32x4 a[4];
#pragma unroll
    for (int j = 0; j < 4; ++j) a[j] = (f32x4){0.f, 0.f, 0.f, 0.f};
#pragma unroll
    for (int e = 0; e < 16; ++e) { const int s = __builtin_amdgcn_readlane(mine, e);
        if (s >= 0) { const bf16* yr = YE + (size_t)s * DM;
#pragma unroll
            for (int j = 0; j < 4; ++j) { const u32x2 w = *(const u32x2*)(yr + 256 * j + 4 * lane); a[j][0] += bflo(w.x); a[j][1] += bfhi(w.x); a[j][2] += bflo(w.y); a[j][3] += bfhi(w.y); } } }
#pragma unroll
    for (int j = 0; j < 4; ++j) { const f32x4 g = *(const f32x4*)(gvec + 256 * j + 4 * lane); v[j] = v[j] + g * a[j]; }
}

#define PH_ARGS const Args& A, LAS unsigned char* lds, int tid, int lane, int wave, int G, int bx
DI void sincos_d(double a, float& sn, float& cs) {
    const double TWO_OVER_PI = 0.63661977236758134308, PIO2 = 1.57079632679489661923;
    const double kq = (double)(long long)(a * TWO_OVER_PI + 0.5); const double y = a - kq * PIO2; const double y2 = y * y;
    const double s = y * (1.0 + y2 * (-1.0 / 6 + y2 * (1.0 / 120 + y2 * (-1.0 / 5040 + y2 * (1.0 / 362880 + y2 * (-1.0 / 39916800 + y2 * (1.0 / 6227020800.0)))))));
    const double c = 1.0 + y2 * (-0.5 + y2 * (1.0 / 24 + y2 * (-1.0 / 720 + y2 * (1.0 / 40320 + y2 * (-1.0 / 3628800 + y2 * (1.0 / 479001600.0))))));
    const int k = (int)((long long)kq & 3);
    const double ss = (k == 0) ? s : (k == 1) ? c : (k == 2) ? -s : -c;
    const double cc = (k == 0) ? c : (k == 1) ? -s : (k == 2) ? -c : s;
    sn = (float)ss; cs = (float)cc;
}

DI void phase0(PH_ARGS) {
    unsigned char* ws = A.ws;
    LAS float* sil = (LAS float*)(lds + 73728);
    for (int i = tid; i < 5120; i += NTHR) { const int bb = i >> 10, k = i & 1023; const float cv = bb < 4 ? A.in[1][bb * 1024 + k] : A.in[3][k]; sil[i] = silu_f(cv); }
    __syncthreads();
    {
        const int t = wave * G + bx;
        if (t < 768) { const int layer = t / 384, n = (t % 384) * 16 + (lane & 15), kq = lane >> 4;
            const float* W = A.in[layer ? 19 : 4] + (size_t)(kq * 256) * 6144 + n; const float* Bv = A.in[layer ? 20 : 5];
            const LAS float* sl = sil + kq * 256;
            float a0 = 0.f, a1 = 0.f, a2 = 0.f, a3 = 0.f, a4 = 0.f;
#pragma unroll 1
            for (int k0 = 0; k0 < 256; k0 += 32) { float wv[32];
#pragma unroll
                for (int q = 0; q < 32; ++q) wv[q] = W[(size_t)(k0 + q) * 6144];
#pragma unroll
                for (int q = 0; q < 32; ++q) { const float w = wv[q]; a0 += sl[k0 + q] * w; a1 += sl[1024 + k0 + q] * w; a2 += sl[2048 + k0 + q] * w; a3 += sl[3072 + k0 + q] * w; a4 += sl[4096 + k0 + q] * w; } }
            a0 += __shfl_xor(a0, 16); a0 += __shfl_xor(a0, 32); a1 += __shfl_xor(a1, 16); a1 += __shfl_xor(a1, 32); a2 += __shfl_xor(a2, 16); a2 += __shfl_xor(a2, 32);
            a3 += __shfl_xor(a3, 16); a3 += __shfl_xor(a3, 32); a4 += __shfl_xor(a4, 16); a4 += __shfl_xor(a4, 32);
            if (kq == 0) { float* mv = (float*)(ws + WS_MODV) + layer * 5 * 6144 + n; const float bv = Bv[n];
                mv[0] = a0 + bv; mv[6144] = a1 + bv; mv[2 * 6144] = a2 + bv; mv[3 * 6144] = a3 + bv; mv[4 * 6144] = a4 + bv; } }
    }
    if (bx == G - 1) {
        float* rope = (float*)(ws + WS_ROPE);
        for (int i = tid; i < 3072; i += NTHR) { const int isc = i >= 2048, ii = isc ? i - 2048 : i; const int pos = ii >> 4, j = ii & 15;
            double f = 1.0; for (int q = 0; q < j; ++q) f *= 0.56234132519034908;
            float sn, cs; sincos_d((double)pos * f, sn, cs);
            if (isc) { rope[4096 + ii] = cs; rope[5120 + ii] = sn; } else { rope[ii] = cs; rope[2048 + ii] = sn; } }
        unsigned* z = (unsigned*)(ws + WS_ZROW); for (int i = tid; i < 512; i += NTHR) z[i] = 0u;
    }
    LAS float* scr = (LAS float*)(lds + wave * 8704);
    const int gw = bx * NWAVES + wave, NGW = G * NWAVES;
    constexpr int I_IN = 16 * 112, I_OUT = 16 * 32, I_QK = 16 * 64, I_V = 16 * 32, I_O = 16 * 32;
    constexpr int NITEMS = I_IN + I_OUT + I_QK + I_V + I_O;
    for (int it = gw; it < NITEMS; it += NGW) {
        int r = it;
        if (r < I_IN) { const int kb = r / 112, nb = r % 112; tr_item(A.in[7] + (size_t)(kb * 64) * INCOLS + nb * 32, INCOLS, (bf16*)(ws + WS_WIN), 1024, kb * 64, AddMap{nb * 32}, scr, lane); continue; } r -= I_IN;
        if (r < I_OUT) { const int kb = r >> 5, nb = r & 31; tr_item(A.in[13] + (size_t)(kb * 64) * 1024 + nb * 32, 1024, (bf16*)(ws + WS_WOUT), 1024, kb * 64, AddMap{nb * 32}, scr, lane); continue; } r -= I_OUT;
        if (r < I_QK) { const int kb = r >> 6, nb = r & 63; tr_item(A.in[22] + (size_t)(kb * 64) * 3072 + nb * 32, 3072, (bf16*)(ws + WS_WQK), 1024, kb * 64, PairMap{nb * 32}, scr, lane); continue; } r -= I_QK;
        if (r < I_V) { const int kb = r >> 5, nb = r & 31; tr_item(A.in[22] + (size_t)(kb * 64) * 3072 + 2048 + nb * 32, 3072, (bf16*)(ws + WS_WV), 1024, kb * 64, AddMap{nb * 32}, scr, lane); continue; } r -= I_V;
        { const int kb = r >> 5, nb = r & 31; tr_item(A.in[28] + (size_t)(kb * 64) * 1024 + nb * 32, 1024, (bf16*)(ws + WS_WO), 1024, kb * 64, AddMap{nb * 32}, scr, lane); }
    }
}

template <int MODE, int LAYER> DI void phase_modulate(PH_ARGS) {
    unsigned char* ws = A.ws;
    LAS float* tab = (LAS float*)lds;
    if (MODE == 0) stage_tab16(A.in[7] + NPROJ, INCOLS, tab, tid); else stage_tab16(A.in[LAYER ? 30 : 15], 16, tab, tid);
    __syncthreads();
    const float* nw = A.in[MODE == 0 ? 6 : (LAYER ? 29 : 14)];
    const float* mv = (const float*)(ws + WS_MODV) + LAYER * 5 * 6144 + (MODE == 0 ? 0 : 3 * 1024);
    bf16* H = (bf16*)(ws + WS_H);
    const int NR = (MODE == 1 && LAYER == 1) ? RL : RT;
    const int stride = G * NWAVES;
    for (int r0 = bx * NWAVES + wave; r0 < NR; r0 += 2 * stride) {
        const int r1 = (r0 + stride < NR) ? r0 + stride : r0;
        const float* s0 = (MODE == 0) ? (r0 < RL ? A.in[0] + (size_t)r0 * DM : A.in[2] + (size_t)(r0 - RL) * DM) : resid_ptr(A.out, (float*)(ws + WS_XC), r0);
        const float* s1 = (MODE == 0) ? (r1 < RL ? A.in[0] + (size_t)r1 * DM : A.in[2] + (size_t)(r1 - RL) * DM) : resid_ptr(A.out, (float*)(ws + WS_XC), r1);
        const int bb0 = row_bb(r0), bb1 = row_bb(r1);
        f32x4 v0[4], v1[4]; load_row_f32(s0, v0, lane); load_row_f32(s1, v1, lane);
        modulate_row(v0, nw, mv + bb0 * 6144, mv + bb0 * 6144 + 1024, lane);
        modulate_row(v1, nw, mv + bb1 * 6144, mv + bb1 * 6144 + 1024, lane);
        store_row_bf16(H + (size_t)r0 * DM, v0, lane); store_row_bf16(H + (size_t)r1 * DM, v1, lane);
        float sa[16], sb[16];
#pragma unroll
        for (int e = 0; e < 16; ++e) { sa[e] = 0.f; sb[e] = 0.f; }
#pragma unroll
        for (int j = 0; j < 4; ++j)
#pragma unroll
            for (int c = 0; c < 4; ++c) { const float ha = v0[j][c], hb = v1[j][c];
#pragma unroll
                for (int q = 0; q < 4; ++q) { const f32x4 w = *(const LAS f32x4*)(tab + ((((j * 4 + c) * 4 + q) * 64 + lane) << 2));
                    sa[4 * q + 0] += ha * w[0]; sa[4 * q + 1] += ha * w[1]; sa[4 * q + 2] += ha * w[2]; sa[4 * q + 3] += ha * w[3];
                    sb[4 * q + 0] += hb * w[0]; sb[4 * q + 1] += hb * w[1]; sb[4 * q + 2] += hb * w[2]; sb[4 * q + 3] += hb * w[3]; }
                asm volatile("" ::: "memory"); }
        const float red0 = reduce16(sa, lane), red1 = reduce16(sb, lane); const int ee = eidx16(lane);
        if (MODE == 0) { if ((lane & 3) == 0) { ((float*)(ws + WS_GATES))[(size_t)r0 * 16 + ee] = red0; ((float*)(ws + WS_GATES))[(size_t)r1 * 16 + ee] = red1; } }
        else { const float mx0 = wave_max(red0), mx1 = wave_max(red1); const float ex0 = __expf(red0 - mx0), ex1 = __expf(red1 - mx1);
            const float den0 = wave_sum(ex0) * 0.25f, den1 = wave_sum(ex1) * 0.25f; const float a0 = ex0 / den0, a1 = ex1 / den1;
            if ((lane & 3) == 0) { float* af = (float*)(ws + WS_AFFT);
                if (r0 < RL) af[(size_t)(((r0 >> 13) * 16 + ee)) * 8192 + (r0 & 8191)] = a0; else { const int rr = r0 - RL; af[524288 + (size_t)(((rr >> 8) * 16 + ee)) * 256 + (rr & 255)] = a0; }
                if (r1 < RL) af[(size_t)(((r1 >> 13) * 16 + ee)) * 8192 + (r1 & 8191)] = a1; else { const int rr = r1 - RL; af[524288 + (size_t)(((rr >> 8) * 16 + ee)) * 256 + (rr & 255)] = a1; } } }
    }
}

DI void fnma_asm(float& acc, float a, float b) { asm("v_fma_f32 %0, -%1, %2, %0" : "+v"(acc) : "v"(a), "v"(b)); }
template <int J, int H> struct BsSeg { static constexpr int K0 = (J + 1) >> 2; static constexpr int LO = H ? (K0 > 8 ? K0 : 8) : K0; static constexpr int HI = H ? 16 : 8; static constexpr int CNT = HI > LO ? HI - LO : 0; };
template <int J, int H> DI void bs_issue(f32x4 (&buf)[8], unsigned lt_addr) {
    if constexpr (J >= 0) {
#pragma unroll
        for (int k4 = BsSeg<J, H>::LO; k4 < BsSeg<J, H>::HI; ++k4) asm volatile("ds_read_b128 %0, %1 offset:%2" : "=v"(buf[k4 & 7]) : "v"(lt_addr), "n"((J * 64 + 4 * k4) * 4));
    }
}
template <int J, int H, int NY> DI void bs_consume(const float (&t)[64], f32x4 (&buf)[8], float& a0, float& a1, float& a2, float& a3) {
    if constexpr (BsSeg<J, H>::CNT > 0) {
        asm volatile("s_waitcnt lgkmcnt(%1)" : "+v"(buf[BsSeg<J, H>::LO & 7]) : "n"(NY));
#pragma unroll
        for (int k4 = BsSeg<J, H>::LO + 1; k4 < BsSeg<J, H>::HI; ++k4) asm volatile("" : "+v"(buf[k4 & 7]));
#pragma unroll
        for (int k4 = BsSeg<J, H>::LO; k4 < BsSeg<J, H>::HI; ++k4) {
            if (4 * k4 + 0 > J) fnma_asm(a0, t[4 * k4 + 0], buf[k4 & 7][0]);
            if (4 * k4 + 1 > J) fnma_asm(a1, t[4 * k4 + 1], buf[k4 & 7][1]);
            if (4 * k4 + 2 > J) fnma_asm(a2, t[4 * k4 + 2], buf[k4 & 7][2]);
            if (4 * k4 + 3 > J) fnma_asm(a3, t[4 * k4 + 3], buf[k4 & 7][3]);
        }
    }
}
template <int J> struct BsNextCnt { static constexpr int V = BsSeg<J - 1, 1>::CNT; };
template <> struct BsNextCnt<0> { static constexpr int V = 0; };
template <int J> DI void bs_row(float (&t)[64], f32x4 (&bufA)[8], f32x4 (&bufB)[8], unsigned lt_addr, int lane) {
    float a0 = (lane == J) ? 1.0f : 0.0f, a1 = 0.f, a2 = 0.f, a3 = 0.f;
    bs_issue<J, 0>(bufB, lt_addr);
    bs_consume<J, 1, BsSeg<J, 0>::CNT>(t, bufA, a0, a1, a2, a3);
    if constexpr (J > 0) bs_issue<J - 1, 1>(bufA, lt_addr);
    bs_consume<J, 0, BsNextCnt<J>::V>(t, bufB, a0, a1, a2, a3);
    t[J] = (a0 + a1) + (a2 + a3);
    if constexpr (J > 0) bs_row<J - 1>(t, bufA, bufB, lt_addr, lane);
}
DI void backsub_all63(float (&t)[64], const LAS float* LT, int lane) {
    f32x4 bufA[8], bufB[8];
#pragma unroll
    for (int k = 0; k < 8; ++k) { bufA[k] = (f32x4){0.f, 0.f, 0.f, 0.f}; bufB[k] = (f32x4){0.f, 0.f, 0.f, 0.f}; }
    const unsigned lt_addr = (unsigned)(size_t)LT;
    bs_issue<63, 1>(bufA, lt_addr);
    bs_row<63>(t, bufA, bufB, lt_addr, lane);
}
DI void gdn_dir4(const Args& A, LAS unsigned char* lds, int lane, int dir, int wq, int b, int h, int seqsel, int cidx, int rowbase, int t0) {
    unsigned char* ws = A.ws;
    const int r32 = lane & 31, hi = lane >> 5;
    LAS unsigned char* Qn = lds; LAS unsigned char* Kn = lds + 16384;
    LAS unsigned char* DB = lds + 32768 + 49152 * dir;
    LAS float* LT = (LAS float*)DB; LAS unsigned char* TBG = DB; LAS unsigned char* TB = DB + 8192;
    LAS unsigned char* KT = DB + 16384; LAS unsigned char* VT = DB + 32768;
    LAS float* SM = (LAS float*)(lds + LDSX + 1024 + dir * 1280);
    LAS float* GC = SM; LAS float* EGC = SM + 64; LAS float* BETA = SM + 128; LAS float* BG = SM + 192; LAS float* KDEC = SM + 256;
    const int ch = (b * 4 + h) * 2 + dir;
    const int p = seqsel ? (dir ? 3 - cidx : cidx) : 4 + (dir ? 127 - cidx : cidx);
    unsigned char* blk = ws + WS_G + (size_t)(ch * NCHUNK + p) * GBLK;
    if (wq == 0) {
        const int tk = dir ? 63 - lane : lane; const float* gr = (const float*)(ws + WS_GATES) + (size_t)(rowbase + t0 + tk) * 16;
        const float av = gr[dir * 4 + h], bv = gr[8 + dir * 4 + h];
        const float xs = av + A.in[11][dir * 4 + h]; const float sp = xs > 20.f ? xs : log1pf(__expf(xs));
        const float g = -__expf(A.in[10][dir * 4 + h]) * sp; const float beta = 1.0f / (1.0f + __expf(-bv));
        float gc = g;
#pragma unroll
        for (int o = 1; o < 64; o <<= 1) { const float tv = __shfl_up(gc, o); if (lane >= o) gc += tv; }
        const float gl = __shfl(gc, 63); const float eg = __expf(gc);
        GC[lane] = gc; EGC[lane] = eg; BETA[lane] = beta; BG[lane] = beta * eg; KDEC[lane] = __expf(gl - gc);
        if (lane == 0) ((float*)(ws + WS_GLAST))[ch * NCHUNK + p] = __expf(gl);
    }
    __syncthreads();
    {
        const int ib = (wq == 1 || wq == 2) ? 1 : 0, jb = (wq >= 2) ? 1 : 0;
        const int i = 32 * ib + r32; const int ti = dir ? 63 - i : i; const float gi = GC[i], bi = BETA[i];
        f32x16 aK, aQ;
#pragma unroll
        for (int r = 0; r < 16; ++r) { aK[r] = 0.f; aQ[r] = 0.f; }
        if (jb <= ib) {
            const int j = 32 * jb + r32; const int tj = dir ? 63 - j : j;
#pragma unroll
            for (int kk = 0; kk < 8; ++kk) {
                const bf16x8 a = *(const LAS bf16x8*)(Kn + sw128(tj, 2 * kk + hi));
                const bf16x8 bK = *(const LAS bf16x8*)(Kn + sw128(ti, 2 * kk + hi));
                const bf16x8 bQ = *(const LAS bf16x8*)(Qn + sw128(ti, 2 * kk + hi));
                aK = MFMA32(a, bK, aK); aQ = MFMA32(a, bQ, aQ);
            }
        }
#pragma unroll
        for (int g4 = 0; g4 < 4; ++g4) { const f32x4 gj = *(const LAS f32x4*)(GC + 32 * jb + 8 * g4 + 4 * hi);
#pragma unroll
            for (int q = 0; q < 4; ++q) { const int r = 4 * g4 + q; const int j = 32 * jb + 8 * g4 + 4 * hi + q;
                const float dec = __expf(fminf(gi - gj[q], 0.f));
                LT[j * 64 + i] = (j < i) ? bi * aK[r] * dec : 0.f;
                aQ[r] = (j <= i) ? aQ[r] * dec : 0.f; } }
        *(bf16x8*)(blk + 32768 + ((ib * 4 + 2 * jb + 0) * 1024) + lane * 16) = pack8<0>(aQ);
        *(bf16x8*)(blk + 32768 + ((ib * 4 + 2 * jb + 1) * 1024) + lane * 16) = pack8<1>(aQ);
    }
    __syncthreads();
    if (wq == 0) {
        float t[64];
        backsub_all63(t, LT, lane);
        LDS_WAIT(); asm volatile("" ::: "memory");
#pragma unroll
        for (int c = 0; c < 8; ++c) {
            const f32x4 b0 = *(const LAS f32x4*)(BETA + 8 * c), b1 = *(const LAS f32x4*)(BETA + 8 * c + 4), g0 = *(const LAS f32x4*)(BG + 8 * c), g1 = *(const LAS f32x4*)(BG + 8 * c + 4);
            u32x4 wb, wg;
            wb.x = pk2(t[8 * c] * b0[0], t[8 * c + 1] * b0[1]); wb.y = pk2(t[8 * c + 2] * b0[2], t[8 * c + 3] * b0[3]); wb.z = pk2(t[8 * c + 4] * b1[0], t[8 * c + 5] * b1[1]); wb.w = pk2(t[8 * c + 6] * b1[2], t[8 * c + 7] * b1[3]);
            wg.x = pk2(t[8 * c] * g0[0], t[8 * c + 1] * g0[1]); wg.y = pk2(t[8 * c + 2] * g0[2], t[8 * c + 3] * g0[3]); wg.z = pk2(t[8 * c + 4] * g1[0], t[8 * c + 5] * g1[1]); wg.w = pk2(t[8 * c + 6] * g1[2], t[8 * c + 7] * g1[3]);
            *(LAS u32x4*)(TB + sw64(lane, c)) = wb; *(LAS u32x4*)(TBG + sw64(lane, c)) = wg;
        }
    } else {
#pragma unroll 1
        for (int f = wq - 1; f < 32; f += 3) {
            if (f < 16) { const int ib = f >> 3, ks = f & 7; const int i = 32 * ib + r32; const int ti = dir ? 63 - i : i; const float eg = EGC[i];
                const u32x2 lo = *(const LAS u32x2*)(Qn + sw128(ti, 2 * ks) + 8 * hi), hh = *(const LAS u32x2*)(Qn + sw128(ti, 2 * ks + 1) + 8 * hi);
                u32x4 o; o.x = pk2(bflo(lo.x) * eg, bfhi(lo.x) * eg); o.y = pk2(bflo(lo.y) * eg, bfhi(lo.y) * eg); o.z = pk2(bflo(hh.x) * eg, bfhi(hh.x) * eg); o.w = pk2(bflo(hh.y) * eg, bfhi(hh.y) * eg);
                *(u32x4*)(blk + 16384 + ((ib * 8 + ks) * 1024) + lane * 16) = o;
            } else { const int kb = (f - 16) >> 2, ks = (f - 16) & 3; const int dk = 32 * kb + r32;
                const u32x2 lo = *(const LAS u32x2*)(KT + sw64(dk, 2 * ks) + 8 * hi), hh = *(const LAS u32x2*)(KT + sw64(dk, 2 * ks + 1) + 8 * hi);
                const f32x4 d0 = *(const LAS f32x4*)(KDEC + 16 * ks + 4 * hi), d1 = *(const LAS f32x4*)(KDEC + 16 * ks + 8 + 4 * hi);
                u32x4 o; o.x = pk2(bflo(lo.x) * d0[0], bfhi(lo.x) * d0[1]); o.y = pk2(bflo(lo.y) * d0[2], bfhi(lo.y) * d0[3]); o.z = pk2(bflo(hh.x) * d1[0], bfhi(hh.x) * d1[1]); o.w = pk2(bflo(hh.y) * d1[2], bfhi(hh.y) * d1[3]);
                *(u32x4*)(blk + 40960 + ((kb * 4 + ks) * 1024) + lane * 16) = o; }
        }
    }
    __syncthreads();
#pragma unroll 1
    for (int m = 0; m < 4; ++m) { const int g = wq * 4 + m;
        f32x16 acc;
#pragma unroll
        for (int r = 0; r < 16; ++r) acc[r] = 0.f;
        if (g < 8) { const int ib = g >> 2, kb = g & 3;
#pragma unroll
            for (int js = 0; js < 4; ++js) { const bf16x8 a = *(const LAS bf16x8*)(KT + sw64(32 * kb + r32, 2 * js + hi)); const bf16x8 tg = *(const LAS bf16x8*)(TBG + sw64(32 * ib + r32, 2 * js + hi)); acc = MFMA32(a, tg, acc); }
            *(bf16x8*)(blk + ((ib * 8 + 2 * kb + 0) * 1024) + lane * 16) = pack8<0>(acc);
            *(bf16x8*)(blk + ((ib * 8 + 2 * kb + 1) * 1024) + lane * 16) = pack8<1>(acc);
        } else { const int ib = (g - 8) >> 2, dvb = (g - 8) & 3;
#pragma unroll
            for (int js = 0; js < 4; ++js) { const bf16x8 tb = *(const LAS bf16x8*)(TB + sw64(32 * ib + r32, 2 * js + hi)); const bf16x8 bv = *(const LAS bf16x8*)(VT + sw64(32 * dvb + r32, 2 * js + hi)); acc = MFMA32(tb, bv, acc); }
            unsigned char* up = blk + 57344 + (dvb * 2 + ib) * 2048 + lane * 32;
            *(bf16x8*)(up) = pack8<0>(acc); *(bf16x8*)(up + 16) = pack8<1>(acc);
        }
    }
}

DI void phase_gdn_prep(PH_ARGS) {
    unsigned char* ws = A.ws;
    const bf16* PROJ = (const bf16*)(ws + WS_BIG);
    LAS unsigned char* Qn = lds; LAS unsigned char* Kn = lds + 16384;
    LAS float* NRM = (LAS float*)(lds + LDSX + 1024 + 2560);
    const int lane_in = lane;
    for (int u = bx; u < 2112; u += G) {
        int lane = lane_in; asm volatile("" : "+v"(lane));
        int seqsel, b, cidx, h;
        if (u < 2048) { seqsel = 0; b = u >> 9; cidx = (u >> 2) & 127; h = u & 3; } else { const int q = u - 2048; seqsel = 1; b = q >> 4; cidx = (q >> 2) & 3; h = q & 3; }
        const int rowbase = seqsel ? RL + b * CTXL : b * SEQL; const int L = seqsel ? CTXL : SEQL; const int t0 = cidx * 64;
        {
            const int d = 2 * lane; float w[3][3][2];
#pragma unroll
            for (int s = 0; s < 3; ++s)
#pragma unroll
                for (int j = 0; j < 3; ++j) { const f32x2 wv = *(const f32x2*)(A.in[9] + j * 1536 + s * 512 + h * 128 + d); w[s][j][0] = wv[0]; w[s][j][1] = wv[1]; }
            unsigned raw[10][3];
#pragma unroll
            for (int rr = 0; rr < 10; ++rr) { const int t = t0 + 8 * wave - 1 + rr; const bool ok = (t >= 0) && (t < L);
#pragma unroll
                for (int s = 0; s < 3; ++s) raw[rr][s] = ok ? *(const unsigned*)(PROJ + (size_t)(rowbase + t) * NPROJ + 1536 + s * 512 + h * 128 + d) : 0u; }
            float val[8][3][2], ssq[16];
#pragma unroll
            for (int ii = 0; ii < 8; ++ii) {
#pragma unroll
                for (int s = 0; s < 3; ++s) {
                    const float x0 = w[s][0][0] * bflo(raw[ii][s]) + w[s][1][0] * bflo(raw[ii + 1][s]) + w[s][2][0] * bflo(raw[ii + 2][s]);
                    const float x1 = w[s][0][1] * bfhi(raw[ii][s]) + w[s][1][1] * bfhi(raw[ii + 1][s]) + w[s][2][1] * bfhi(raw[ii + 2][s]);
                    val[ii][s][0] = silu_f(x0); val[ii][s][1] = silu_f(x1); }
                ssq[ii] = val[ii][0][0] * val[ii][0][0] + val[ii][0][1] * val[ii][0][1]; ssq[8 + ii] = val[ii][1][0] * val[ii][1][0] + val[ii][1][1] * val[ii][1][1]; }
            { const float red = reduce16(ssq, lane); const int ee = eidx16(lane);
              const float rn = (ee < 8 ? 0.08838834764831845f : 1.0f) / sqrtf(red + EPSN);
              if ((lane & 3) == 0) NRM[wave * 16 + ee] = rn; }
            LDS_WAIT(); asm volatile("" ::: "memory");
            float nrm[16];
#pragma unroll
            for (int q4 = 0; q4 < 4; ++q4) { const f32x4 nv = *(const LAS f32x4*)(NRM + wave * 16 + 4 * q4); nrm[4 * q4] = nv[0]; nrm[4 * q4 + 1] = nv[1]; nrm[4 * q4 + 2] = nv[2]; nrm[4 * q4 + 3] = nv[3]; }
#pragma unroll
            for (int ii = 0; ii < 8; ++ii) { const int i = 8 * wave + ii; const float rq = nrm[ii], rk = nrm[8 + ii];
                const unsigned qp = pk2(val[ii][0][0] * rq, val[ii][0][1] * rq), kp = pk2(val[ii][1][0] * rk, val[ii][1][1] * rk), vp = pk2(val[ii][2][0], val[ii][2][1]);
                *(LAS unsigned*)(Qn + sw128(i, lane >> 2) + (lane & 3) * 4) = qp;
                *(LAS unsigned*)(Kn + sw128(i, lane >> 2) + (lane & 3) * 4) = kp;
#pragma unroll
                for (int dir = 0; dir < 2; ++dir) { const int pi = dir ? 63 - i : i; LAS unsigned char* KT = lds + 32768 + 49152 * dir + 16384; LAS unsigned char* VT = KT + 16384;
                    *(LAS unsigned short*)(KT + sw64(d, pi >> 3) + (pi & 7) * 2) = (unsigned short)(kp & 0xffffu);
                    *(LAS unsigned short*)(KT + sw64(d + 1, pi >> 3) + (pi & 7) * 2) = (unsigned short)(kp >> 16);
                    *(LAS unsigned short*)(VT + sw64(d, pi >> 3) + (pi & 7) * 2) = (unsigned short)(vp & 0xffffu);
                    *(LAS unsigned short*)(VT + sw64(d + 1, pi >> 3) + (pi & 7) * 2) = (unsigned short)(vp >> 16); }
            }
        }
        __syncthreads();
        gdn_dir4(A, lds, lane, wave >> 2, wave & 3, b, h, seqsel, cidx, rowbase, t0);
        __syncthreads();
    }
}

DI void expert_queue(const Args& A, LAS unsigned char* lds, int lane, int wave, unsigned* qword, const float* Wg, const float* Wu, const float* Wd, bf16* W1, bf16* W2, unsigned ibase = 0u, unsigned icount = 49152u) {
    LAS float* scr = (LAS float*)(lds + wave * 8704);
    for (;;) {
        unsigned it0 = 0u;
        if (lane == 0) it0 = __hip_atomic_fetch_add(qword, 8u, __ATOMIC_RELAXED, __HIP_MEMORY_SCOPE_AGENT);
        it0 = (unsigned)__builtin_amdgcn_readfirstlane((int)it0);
        if (it0 >= icount) break;
        it0 += ibase;
        float ta[32], tb[32];
        ItemDesc da = expert_desc((int)it0, Wg, Wu, Wd, W1, W2), db = da;
        tr_load(da.src, da.ldw, ta, lane);
#pragma unroll 1
        for (int q = 0; q < 8; q += 2) {
            db = expert_desc((int)it0 + q + 1, Wg, Wu, Wd, W1, W2); tr_load(db.src, db.ldw, tb, lane);
            tr_finish(ta, da.dst, da.ldk, da.k0, da.rbase, scr, lane);
            if (q + 2 < 8) { da = expert_desc((int)it0 + q + 2, Wg, Wu, Wd, W1, W2); tr_load(da.src, da.ldw, ta, lane); }
            tr_finish(tb, db.dst, db.ldk, db.k0, db.rbase, scr, lane);
        }
    }
}
DI void phase_gdn_scan(PH_ARGS) {
    unsigned char* ws = A.ws;
    unsigned* qword = (unsigned*)(ws + WS_CTL) + CW_Q0;
    if (bx < 128) {
    const int xcd = bx & 7, idx = bx >> 3; const int ch = xcd + 8 * (idx >> 2), v = idx & 3;
    const int dir = ch & 1, bh = ch >> 1, b = bh >> 2, h = bh & 3;
    const int r32 = lane & 31, hi = lane >> 5;
    bf16* PROJ = (bf16*)(ws + WS_BIG);
    const float* GL = (const float*)(ws + WS_GLAST) + ch * NCHUNK;
    const unsigned char* gbase = ws + WS_G + (size_t)ch * NCHUNK * GBLK;
    constexpr int SBUF = 61440;
    const int lt = tid - 64;
    u32x4 tv[9];
#pragma unroll
    for (int k = 0; k < 9; ++k) tv[k] = (u32x4){0u, 0u, 0u, 0u};
#define SCAN_ISSUE(p) do { const unsigned char* gb = gbase + (size_t)(p) * GBLK; \
        _Pragma("unroll") for (int k = 0; k < 8; ++k) tv[k] = *(const u32x4*)(gb + (lt + 448 * k) * 16); \
        if (lt < 256) tv[8] = *(const u32x4*)(gb + 57344 + v * 4096 + lt * 16); } while (0)
#define SCAN_WRITE(bufi) do { LAS unsigned char* lb = lds + (bufi) * SBUF; \
        _Pragma("unroll") for (int k = 0; k < 8; ++k) *(LAS u32x4*)(lb + (lt + 448 * k) * 16) = tv[k]; \
        if (lt < 256) *(LAS u32x4*)(lb + 57344 + lt * 16) = tv[8]; } while (0)
    if (wave > 0) { SCAN_ISSUE(0); SCAN_WRITE(0); SCAN_ISSUE(1); }
    __syncthreads();
    f32x16 S[4];
#pragma unroll
    for (int kb = 0; kb < 4; ++kb)
#pragma unroll
        for (int r = 0; r < 16; ++r) S[kb][r] = 0.f;
    for (int p = 0; p < NCHUNK; ++p) {
      if (wave > 0) { if (p + 1 < NCHUNK) SCAN_WRITE((p + 1) & 1); if (p + 2 < NCHUNK) SCAN_ISSUE(p + 2); }
      else {
        const LAS unsigned char* blk = lds + (p & 1) * SBUF + lane * 16;
        const float gl = GL[p];
        bf16x8 Sb[8];
        Sb[0] = pack8<0>(S[0]); Sb[1] = pack8<1>(S[0]); Sb[2] = pack8<0>(S[1]); Sb[3] = pack8<1>(S[1]);
        Sb[4] = pack8<0>(S[2]); Sb[5] = pack8<1>(S[2]); Sb[6] = pack8<0>(S[3]); Sb[7] = pack8<1>(S[3]);
        f32x16 P[2], O[2];
#pragma unroll
        for (int ib = 0; ib < 2; ++ib) {
#pragma unroll
            for (int r = 0; r < 16; ++r) { P[ib][r] = 0.f; O[ib][r] = 0.f; }
#pragma unroll
            for (int ks = 0; ks < 8; ++ks) { const bf16x8 wf = *(const LAS bf16x8*)(blk + (ib * 8 + ks) * 1024); P[ib] = MFMA32(wf, Sb[ks], P[ib]); }
            asm volatile("" ::: "memory");
#pragma unroll
            for (int ks = 0; ks < 8; ++ks) { const bf16x8 qf = *(const LAS bf16x8*)(blk + 16384 + (ib * 8 + ks) * 1024); O[ib] = MFMA32(qf, Sb[ks], O[ib]); }
            asm volatile("" ::: "memory");
        }
        bf16x8 Vb[4];
#pragma unroll
        for (int ib = 0; ib < 2; ++ib) {
            const LAS unsigned char* up = lds + (p & 1) * SBUF + 57344 + ib * 2048 + lane * 32;
            const u32x4 u0 = *(const LAS u32x4*)up, u1 = *(const LAS u32x4*)(up + 16);
            f32x16 vn;
            vn[0] = bflo(u0.x) - P[ib][0]; vn[1] = bfhi(u0.x) - P[ib][1]; vn[2] = bflo(u0.y) - P[ib][2]; vn[3] = bfhi(u0.y) - P[ib][3];
            vn[4] = bflo(u0.z) - P[ib][4]; vn[5] = bfhi(u0.z) - P[ib][5]; vn[6] = bflo(u0.w) - P[ib][6]; vn[7] = bfhi(u0.w) - P[ib][7];
            vn[8] = bflo(u1.x) - P[ib][8]; vn[9] = bfhi(u1.x) - P[ib][9]; vn[10] = bflo(u1.y) - P[ib][10]; vn[11] = bfhi(u1.y) - P[ib][11];
            vn[12] = bflo(u1.z) - P[ib][12]; vn[13] = bfhi(u1.z) - P[ib][13]; vn[14] = bflo(u1.w) - P[ib][14]; vn[15] = bfhi(u1.w) - P[ib][15];
            Vb[2 * ib] = pack8<0>(vn); Vb[2 * ib + 1] = pack8<1>(vn);
        }
#pragma unroll
        for (int ib = 0; ib < 2; ++ib)
#pragma unroll
            for (int kt = 0; kt < 4; ++kt) { const bf16x8 af = *(const LAS bf16x8*)(blk + 32768 + (ib * 4 + kt) * 1024); O[ib] = MFMA32(af, Vb[kt], O[ib]); }
        asm volatile("" ::: "memory");
#pragma unroll
        for (int kb = 0; kb < 4; ++kb) {
            asm volatile("" ::: "memory");
#pragma unroll
            for (int r = 0; r < 16; ++r) S[kb][r] *= gl;
#pragma unroll
            for (int kt = 0; kt < 4; ++kt) { const bf16x8 kf = *(const LAS bf16x8*)(blk + 40960 + (kb * 4 + kt) * 1024); S[kb] = MFMA32(kf, Vb[kt], S[kb]); }
        }
        int rowbase, cidx;
        if (p < 4) { cidx = dir ? 3 - p : p; rowbase = RL + b * CTXL; } else { cidx = dir ? 131 - p : p - 4; rowbase = b * SEQL; }
        int hiv = hi; asm volatile("" : "+v"(hiv));
        const long step = dir ? -(long)NPROJ : (long)NPROJ;
        bf16* ob = PROJ + (size_t)(rowbase + cidx * 64 + (dir ? 63 - 4 * hiv : 4 * hiv)) * NPROJ + 1536 + dir * 512 + h * 128 + 32 * v + r32;
#pragma unroll
        for (int ib = 0; ib < 2; ++ib)
#pragma unroll
            for (int r = 0; r < 16; ++r) { const int c = 32 * ib + (r & 3) + 8 * (r >> 2);
                ob[step * c] = (bf16)(pk2(O[ib][r], 0.f) & 0xffffu); }
      }
      __syncthreads();
    }
#undef SCAN_ISSUE
#undef SCAN_WRITE
    }
    expert_queue(A, lds, lane, wave, qword, A.in[16], A.in[17], A.in[18], (bf16*)(ws + WS_E0), (bf16*)(ws + WS_E0 + 128 * MiB));
    expert_queue(A, lds, lane, wave, (unsigned*)(ws + WS_CTL) + CW_Q3, A.in[31], A.in[32], A.in[33], (bf16*)(ws + WS_G), (bf16*)(ws + WS_W2L1), 32768u, 16384u);
}

DI void unpack8(const u32x4 w, float (&f)[8]) { f[0] = bflo(w.x); f[1] = bfhi(w.x); f[2] = bflo(w.y); f[3] = bfhi(w.y); f[4] = bflo(w.z); f[5] = bfhi(w.z); f[6] = bflo(w.w); f[7] = bfhi(w.w); }
DI void phase_ycat(PH_ARGS) {
    unsigned char* ws = A.ws;
    const bf16* PROJ = (const bf16*)(ws + WS_BIG); bf16* Y = (bf16*)(ws + WS_H);
    const int c0 = 8 * lane;
    float cw[3][8], gn[8];
#pragma unroll
    for (int j = 0; j < 3; ++j) { const f32x4 a = *(const f32x4*)(A.in[8] + j * 512 + c0), b2 = *(const f32x4*)(A.in[8] + j * 512 + c0 + 4);
        cw[j][0] = a[0]; cw[j][1] = a[1]; cw[j][2] = a[2]; cw[j][3] = a[3]; cw[j][4] = b2[0]; cw[j][5] = b2[1]; cw[j][6] = b2[2]; cw[j][7] = b2[3]; }
    { const f32x4 a = *(const f32x4*)(A.in[12] + (c0 & 127)), b2 = *(const f32x4*)(A.in[12] + (c0 & 127) + 4);
        gn[0] = a[0]; gn[1] = a[1]; gn[2] = a[2]; gn[3] = a[3]; gn[4] = b2[0]; gn[5] = b2[1]; gn[6] = b2[2]; gn[7] = b2[3]; }
    for (int r = bx * NWAVES + wave; r < RT; r += G * NWAVES) {
        const int t = r < RL ? (r & 8191) : ((r - RL) & 255); const int L = r < RL ? SEQL : CTXL;
        const bf16* pr = PROJ + (size_t)r * NPROJ;
        float pm[8], pc[8], pn[8], xa[8], gc_[8], gb[8];
        unpack8(*(const u32x4*)(pr + c0), xa); unpack8(*(const u32x4*)(pr + 1024 + c0), gc_); unpack8(*(const u32x4*)(pr + 512 + c0), gb);
#pragma unroll
        for (int q = 0; q < 8; ++q) pc[q] = gc_[q] * xa[q];
        if (t > 0) { unpack8(*(const u32x4*)(pr - NPROJ + c0), xa); unpack8(*(const u32x4*)(pr - NPROJ + 1024 + c0), gc_);
#pragma unroll
            for (int q = 0; q < 8; ++q) pm[q] = gc_[q] * xa[q]; }
        else {
#pragma unroll
            for (int q = 0; q < 8; ++q) pm[q] = 0.f; }
        if (t < L - 1) { unpack8(*(const u32x4*)(pr + NPROJ + c0), xa); unpack8(*(const u32x4*)(pr + NPROJ + 1024 + c0), gc_);
#pragma unroll
            for (int q = 0; q < 8; ++q) pn[q] = gc_[q] * xa[q]; }
        else {
#pragma unroll
            for (int q = 0; q < 8; ++q) pn[q] = 0.f; }
        u32x4 o;
        { float y[8];
#pragma unroll
            for (int q = 0; q < 8; ++q) y[q] = gb[q] * (cw[0][q] * pm[q] + cw[1][q] * pc[q] + cw[2][q] * pn[q]);
            o.x = pk2(y[0], y[1]); o.y = pk2(y[2], y[3]); o.z = pk2(y[4], y[5]); o.w = pk2(y[6], y[7]); }
        *(u32x4*)(Y + (size_t)r * DM + c0) = o;
        float of[8], ob[8], z[8];
        unpack8(*(const u32x4*)(pr + 1536 + c0), of); unpack8(*(const u32x4*)(pr + 2048 + c0), ob); unpack8(*(const u32x4*)(pr + 3072 + c0), z);
        float ss = 0.f;
#pragma unroll
        for (int q = 0; q < 8; ++q) { of[q] += ob[q]; ss += of[q] * of[q]; }
        ss += __shfl_xor(ss, 1); ss += __shfl_xor(ss, 2); ss += __shfl_xor(ss, 4); ss += __shfl_xor(ss, 8);
        const float rn = 1.0f / sqrtf(ss * (1.0f / 128.0f) + EPSN);
        { float y[8];
#pragma unroll
            for (int q = 0; q < 8; ++q) y[q] = of[q] * rn * gn[q] * silu_f(z[q]);
            o.x = pk2(y[0], y[1]); o.y = pk2(y[2], y[3]); o.z = pk2(y[4], y[5]); o.w = pk2(y[6], y[7]); }
        *(u32x4*)(Y + (size_t)r * DM + 512 + c0) = o;
    }
}

template <int LAYER> DI void phase_topk(PH_ARGS) {
    unsigned char* ws = A.ws;
    LAS unsigned* vals = (LAS unsigned*)lds; LAS unsigned* hist = (LAS unsigned*)(lds + 32768); LAS unsigned* misc = (LAS unsigned*)(lds + 34816);
    LAS unsigned* wsum = (LAS unsigned*)(lds + 35840);
    const int SPE = LAYER ? SPE1 : SPE0; const int NTASK = LAYER ? 64 : 128;
    float* gatev = (float*)(ws + WS_GATEV); int* INV = (int*)(ws + WS_INV); int* IDX = (int*)(ws + WS_IDX);
    for (int task = bx; task < NTASK; task += G) {
        const int seqsel = task >> 6, b = (task >> 4) & 3, e = task & 15;
        const int n = seqsel ? CTXL : SEQL, cap = seqsel ? 32 : 1024;
        const float* af = (const float*)(ws + WS_AFFT) + (seqsel ? 524288 + (size_t)((b * 16 + e)) * 256 : (size_t)((b * 16 + e)) * 8192);
        const int rowbase = seqsel ? RL + b * CTXL : b * SEQL;
        const int slotbase = e * SPE + (seqsel ? 4096 + b * 32 : b * 1024);
        for (int i = tid; i < n; i += NTHR) vals[i] = __float_as_uint(af[i]);
        __syncthreads();
        unsigned prefix = 0u; int remaining = cap;
#pragma unroll 1
        for (int pass = 3; pass >= 0; --pass) { const int shift = pass * 8;
            if (tid < 256) hist[tid] = 0u;
            __syncthreads();
            for (int i = tid; i < n; i += NTHR) { const unsigned vv = vals[i]; const bool match = (pass == 3) || (((vv ^ prefix) >> (shift + 8)) == 0u); if (match) __hip_atomic_fetch_add(&hist[(vv >> shift) & 255u], 1u, __ATOMIC_RELAXED, __HIP_MEMORY_SCOPE_WORKGROUP); }
            __syncthreads();
            if (wave == 0) {
                const u32x4 hv = *(const LAS u32x4*)(hist + 4 * lane); const int h0 = (int)hv.x, h1 = (int)hv.y, h2 = (int)hv.z, h3 = (int)hv.w;
                const int c = h0 + h1 + h2 + h3; int inc = c;
#pragma unroll
                for (int o = 1; o < 64; o <<= 1) { const int tv = __shfl_down(inc, o); if (lane + o < 64) inc += tv; }
                int cum = inc - c;
                if (cum < remaining && remaining <= cum + c) { int dsel;
                    if (cum + h3 >= remaining) dsel = 3; else { cum += h3; if (cum + h2 >= remaining) dsel = 2; else { cum += h2; if (cum + h1 >= remaining) dsel = 1; else { cum += h1; dsel = 0; } } }
                    misc[0] = (unsigned)(4 * lane + dsel); misc[1] = (unsigned)(remaining - cum); } }
            __syncthreads();
            prefix |= misc[0] << shift; remaining = (int)misc[1];
            __syncthreads();
        }
        const int per = seqsel ? 1 : 16; const int i0 = tid * per; const bool act = i0 < n;
        int cgt = 0, ceq = 0;
        if (act) for (int q = 0; q < per; ++q) { const unsigned vv = vals[i0 + q]; cgt += (vv > prefix); ceq += (vv == prefix); }
        unsigned pk = (unsigned)cgt | ((unsigned)ceq << 16), inc = pk;
#pragma unroll
        for (int o = 1; o < 64; o <<= 1) { const unsigned tv = __shfl_up(inc, o); if (lane >= o) inc += tv; }
        if (lane == 63) wsum[wave] = inc;
        __syncthreads();
        unsigned woff = 0u;
#pragma unroll
        for (int w = 0; w < NWAVES; ++w) { const unsigned s = wsum[w]; if (w < wave) woff += s; }
        const unsigned exc = woff + inc - pk; int gt_before = (int)(exc & 0xffffu), eq_before = (int)(exc >> 16);
        if (act) for (int q = 0; q < per; ++q) { const int i = i0 + q; const unsigned vv = vals[i]; int slot = -1;
            if (vv > prefix) { slot = gt_before + (eq_before < remaining ? eq_before : remaining); ++gt_before; }
            else if (vv == prefix) { if (eq_before < remaining) slot = gt_before + eq_before; ++eq_before; }
            INV[(size_t)(rowbase + i) * 16 + e] = slot >= 0 ? slotbase + slot : -1;
            if (slot >= 0) { IDX[slotbase + slot] = rowbase + i; gatev[slotbase + slot] = __uint_as_float(vv); } }
        if (LAYER == 0 && seqsel == 1 && b == 0) {
            if (tid < 128) { IDX[e * SPE + 4224 + tid] = 0; gatev[e * SPE + 4224 + tid] = 0.f; } }
        __syncthreads();
    }
    if (LAYER == 0) expert_queue(A, lds, lane, wave, (unsigned*)(ws + WS_CTL) + CW_Q1, A.in[31], A.in[32], A.in[33], (bf16*)(ws + WS_G), (bf16*)(ws + WS_G + 128 * MiB), 0u, 20480u);
    else expert_queue(A, lds, lane, wave, (unsigned*)(ws + WS_CTL) + CW_Q2, A.in[31], A.in[32], A.in[33], (bf16*)(ws + WS_G), (bf16*)(ws + WS_W2L1), 20480u, 12288u);
}

template <int LAYER> DI void combine_finish(const Args& A, unsigned char* ws, float* xr, f32x4 (&v)[4], int r, int bb, int lane) {
    if (LAYER == 0) {
#pragma unroll
        for (int j = 0; j < 4; ++j) *(f32x4*)(xr + 256 * j + 4 * lane) = v[j];
        const float* m1 = (const float*)(ws + WS_MODV) + 5 * 6144 + bb * 6144;
        modulate_row(v, A.in[21], m1, m1 + 1024, lane);
        store_row_bf16((bf16*)(ws + WS_H) + (size_t)r * DM, v, lane);
    } else {
        float ss = 0.f;
#pragma unroll
        for (int j = 0; j < 4; ++j) ss += (v[j][0] * v[j][0] + v[j][1] * v[j][1]) + (v[j][2] * v[j][2] + v[j][3] * v[j][3]);
        const float rstd = 1.0f / sqrtf(wave_sum(ss) * (1.0f / DM) + EPSN);
#pragma unroll
        for (int j = 0; j < 4; ++j) { const f32x4 w = *(const f32x4*)(A.in[34] + 256 * j + 4 * lane); *(f32x4*)(xr + 256 * j + 4 * lane) = v[j] * rstd * w; }
    }
}
template <int LAYER> DI void phase_combine(PH_ARGS) {
    unsigned char* ws = A.ws;
    const bf16* YE = (const bf16*)(LAYER ? ws + WS_E0 : ws + WS_G + 192 * MiB);
    const int* INV = (const int*)(ws + WS_INV);
    const float* mv = (const float*)(ws + WS_MODV) + LAYER * 5 * 6144;
    const int NR = LAYER ? RL : RT;
    const int stride = G * NWAVES;
    for (int r0 = bx * NWAVES + wave; r0 < NR; r0 += 2 * stride) {
        const bool two = (r0 + stride < NR); const int r1 = two ? r0 + stride : r0;
        float* x0 = resid_ptr(A.out, (float*)(ws + WS_XC), r0); float* x1 = resid_ptr(A.out, (float*)(ws + WS_XC), r1);
        const int bb0 = row_bb(r0), bb1 = row_bb(r1);
        f32x4 v0[4], v1[4]; load_row_f32(x0, v0, lane); load_row_f32(x1, v1, lane);
        const int i0 = INV[(size_t)r0 * 16 + (lane & 15)], i1 = INV[(size_t)r1 * 16 + (lane & 15)];
        f32x4 a0[4], a1[4];
#pragma unroll
        for (int j = 0; j < 4; ++j) { a0[j] = (f32x4){0.f, 0.f, 0.f, 0.f}; a1[j] = (f32x4){0.f, 0.f, 0.f, 0.f}; }
        unsigned long long m0 = __ballot(i0 >= 0) & 0xffffull, m1 = __ballot(i1 >= 0) & 0xffffull;
        while (m0 | m1) {
            if (m0) { const int e = __builtin_ctzll(m0); m0 &= m0 - 1; const int sl = __shfl(i0, e); const bf16* yr = YE + (size_t)sl * DM;
#pragma unroll
                for (int j = 0; j < 4; ++j) { const u32x2 w = *(const u32x2*)(yr + 256 * j + 4 * lane); a0[j][0] += bflo(w.x); a0[j][1] += bfhi(w.x); a0[j][2] += bflo(w.y); a0[j][3] += bfhi(w.y); } }
            if (m1) { const int e = __builtin_ctzll(m1); m1 &= m1 - 1; const int sl = __shfl(i1, e); const bf16* yr = YE + (size_t)sl * DM;
#pragma unroll
                for (int j = 0; j < 4; ++j) { const u32x2 w = *(const u32x2*)(yr + 256 * j + 4 * lane); a1[j][0] += bflo(w.x); a1[j][1] += bfhi(w.x); a1[j][2] += bflo(w.y); a1[j][3] += bfhi(w.y); } }
        }
#pragma unroll
        for (int j = 0; j < 4; ++j) { const f32x4 g0 = *(const f32x4*)(mv + bb0 * 6144 + 5 * 1024 + 256 * j + 4 * lane), g1 = *(const f32x4*)(mv + bb1 * 6144 + 5 * 1024 + 256 * j + 4 * lane);
            v0[j] = v0[j] + g0 * a0[j]; v1[j] = v1[j] + g1 * a1[j]; }
        combine_finish<LAYER>(A, ws, x0, v0, r0, bb0, lane);
        if (two) combine_finish<LAYER>(A, ws, x1, v1, r1, bb1, lane);
    }
}

DI float max3_asm(float a, float b, float c) { float r; asm("v_max3_f32 %0, %1, %2, %3" : "=v"(r) : "v"(a), "v"(b), "v"(c)); return r; }
DI void glds16(const void* g, LAS unsigned char* l) { __builtin_amdgcn_global_load_lds((const unsigned*)g, (LAS unsigned*)l, 16, 0, 0); }
#define AT_WAIT_BAR(N) do { asm volatile("s_waitcnt vmcnt(" #N ") lgkmcnt(0)" ::: "memory"); __builtin_amdgcn_s_barrier(); asm volatile("" ::: "memory"); } while (0)
DI void phase_attn(PH_ARGS) {
    unsigned char* ws = A.ws;
    const bf16* QK = (const bf16*)(ws + WS_BIG); const bf16* VTg = (const bf16*)(ws + WS_BIG + 132 * MiB); bf16* ATT = (bf16*)(ws + WS_H);
    const int r32 = lane & 31, hi = lane >> 5; const int isub = wave >> 2, rg = wave & 3;
    constexpr int NT = 132, KRING = 0, VRING = 49152, SLOT = 16384;
    float lam;
    { const float s1 = wave_sum(A.in[23][lane] * A.in[24][lane]), s2 = wave_sum(A.in[25][lane] * A.in[26][lane]); lam = __expf(s1) - __expf(s2) + LAM_INIT; }
    const int vcu = (G % 8 == 0) ? (bx % 8) * (G / 8) + bx / 8 : bx;
    const int krow = (r32 & ~12) | ((r32 >> 1) & 4) | ((r32 << 1) & 8);
    const unsigned ldsb = (unsigned)(size_t)lds;
    unsigned kofs[4], vofs[4];
#pragma unroll
    for (int q = 0; q < 4; ++q) { kofs[q] = (unsigned)sw64(krow, 2 * q + hi); vofs[q] = (unsigned)sw64(r32, 2 * q + hi); }
    LAS float* sublnL = (LAS float*)(lds + LDSX + 1024);
    if (tid < 128) sublnL[tid] = A.in[27][tid];
    __syncthreads();
    int b = 0, h = 0, q0 = 0;
    bf16x8 qf[4]; const bf16* srck[2]; const bf16* srcv[2];
#pragma unroll
    for (int kk = 0; kk < 4; ++kk) qf[kk] = (bf16x8){0, 0, 0, 0, 0, 0, 0, 0};
    srck[0] = srck[1] = QK; srcv[0] = srcv[1] = VTg;
    LAS unsigned char* kdst = lds + KRING + (2 * wave) * 1024; LAS unsigned char* vdst = lds + VRING + (2 * wave) * 1024;
#define KEYROW(t) (((t) < 4) ? (RL + b * CTXL + (t) * 64) : (b * SEQL + ((t) - 4) * 64))
#define DMA_K(t, slot) do { const size_t ko_ = (size_t)KEYROW(t) * 2048; glds16(srck[0] + ko_, kdst + (slot) * SLOT); glds16(srck[1] + ko_, kdst + (slot) * SLOT + 1024); } while (0)
#define DMA_V(t, slot) do { const size_t vo_ = (size_t)KEYROW(t); glds16(srcv[0] + vo_, vdst + (slot) * SLOT); glds16(srcv[1] + vo_, vdst + (slot) * SLOT + 1024); } while (0)
#define AT_SETUP(u_) do { const int bh_ = (u_) >> 6; b = bh_ >> 3; h = bh_ & 7; q0 = ((u_) & 63) * 128; \
            const int qrow_ = b * SEQL + q0 + 32 * rg + r32; \
            _Pragma("unroll") for (int kk = 0; kk < 4; ++kk) qf[kk] = *(const bf16x8*)(QK + (size_t)qrow_ * 2048 + h * 128 + isub * 64 + 16 * kk + 8 * hi); \
            int ln_ = lane; asm volatile("" : "+v"(ln_)); const int dl = ln_ >> 3, dpc = ln_ & 7; \
            _Pragma("unroll") for (int i = 0; i < 2; ++i) { const int n = 2 * wave + i; \
                const int sub = n >> 3, key = 8 * (n & 7) + dl, ck = dpc ^ ((key >> 1) & 7); srck[i] = QK + 1024 + h * 128 + sub * 64 + ck * 8 + (size_t)key * 2048; \
                const int dv = 8 * n + dl, cv = dpc ^ ((dv >> 1) & 7); srcv[i] = VTg + (size_t)(h * 128 + dv) * RT + cv * 8; } \
            DMA_K(0, 0); DMA_V(0, 0); DMA_K(1, 1); DMA_K(2, 2); } while (0)
#define AT_LBAR() do { asm volatile("s_waitcnt lgkmcnt(0)" ::: "memory"); __builtin_amdgcn_s_barrier(); asm volatile("" ::: "memory"); } while (0)
    if (vcu < 2048) AT_SETUP(vcu);
    for (int u = vcu; u < 2048; u += G) {
#define QKT(Sx0, Sx1, kslot, negm) do { const LAS unsigned char* kb_ = lds + KRING + (kslot) * SLOT; \
            _Pragma("unroll") for (int r = 0; r < 16; ++r) { Sx0[r] = (negm); Sx1[r] = (negm); } \
            _Pragma("unroll") for (int kk = 0; kk < 4; ++kk) { const bf16x8 a0 = *(const LAS bf16x8*)(kb_ + isub * 8192 + kofs[kk]), a1 = *(const LAS bf16x8*)(kb_ + isub * 8192 + kofs[kk] + 4096); \
                Sx0 = MFMA32(a0, qf[kk], Sx0); Sx1 = MFMA32(a1, qf[kk], Sx1); } } while (0)
        float m_run = 0.f, l_run = 0.f, mcA = 0.f, mcB = 0.f;
        f32x16 OT[4];
#pragma unroll
        for (int d = 0; d < 4; ++d)
#pragma unroll
            for (int r = 0; r < 16; ++r) OT[d][r] = 0.f;
        f32x16 SA0, SA1, SB0, SB1;
        bf16x8 PX[4], PY[4];
        AT_WAIT_BAR(0);
        QKT(SA0, SA1, 0, 0.f);
        DMA_V(1, 1);
        AT_WAIT_BAR(2);
        int ks_next = 1, ks_free = 0;
#define SCE(Sc0, Sc1, e) (((e) < 16) ? Sc0[(e) & 15] : Sc1[(e) & 15])
#define AT_RD(dst, addr, imm) asm volatile("ds_read_b128 %0, %1 offset:%2" : "=v"(dst) : "v"(addr), "n"(imm))
#define AT_WL(dst, n) asm volatile("s_waitcnt lgkmcnt(" #n ")" : "+v"(dst))
#define AT_STEP(Sc0, Sc1, mc, Sn0, Sn1, mn, Pp, Pn, t, DO_PV) do { \
            if ((t) + 3 < NT) DMA_K((t) + 3, ks_free); \
            if ((t) + 2 < NT) DMA_V((t) + 2, ((t) + 2) & 3); \
            mn = 0.f; \
              \
            unsigned ka_[4], va_[4]; \
            { const unsigned kb_ = ldsb + KRING + ks_next * SLOT + isub * 8192, vb_ = ldsb + VRING + (((t) - 1) & 3) * SLOT; \
              _Pragma("unroll") for (int q = 0; q < 4; ++q) { ka_[q] = kb_ + kofs[q]; va_[q] = vb_ + vofs[q]; } } \
            _Pragma("unroll") for (int r = 0; r < 16; ++r) { Sn0[r] = 0.f; Sn1[r] = 0.f; } \
            bf16x8 fr_[3]; float mxa_ = 0.f, mxb_ = 0.f; \
            AT_RD(fr_[0], ka_[0], 0); AT_RD(fr_[1], ka_[0], 4096); \
            __builtin_amdgcn_sched_barrier(0); \
            _Pragma("unroll") for (int g = 0; g < 8; ++g) { \
                if (g + 2 < 8) { if ((g + 2) & 1) AT_RD(fr_[(g + 2) % 3], ka_[(g + 2) >> 1], 4096); else AT_RD(fr_[(g + 2) % 3], ka_[(g + 2) >> 1], 0); } \
                else if (DO_PV) AT_RD(fr_[(g + 2) % 3], va_[g - 6], 0); \
                if (g + 2 < 8 || DO_PV) AT_WL(fr_[g % 3], 2); else if (g == 6) AT_WL(fr_[g % 3], 1); else AT_WL(fr_[g % 3], 0); \
                if (g & 1) Sn1 = MFMA32(fr_[g % 3], qf[g >> 1], Sn1); else Sn0 = MFMA32(fr_[g % 3], qf[g >> 1], Sn0); \
                if (g == 0) { mxa_ = max3_asm(Sc0[0], Sc0[1], Sc0[2]); mxb_ = max3_asm(Sc1[0], Sc1[1], Sc1[2]); } \
                else if (g < 7) { mxa_ = max3_asm(mxa_, Sc0[2 * g + 1], Sc0[2 * g + 2]); mxb_ = max3_asm(mxb_, Sc1[2 * g + 1], Sc1[2 * g + 2]); } \
                else { mxa_ = max3_asm(mxa_, Sc0[15], Sc1[15]); } \
                __builtin_amdgcn_sched_barrier(0); } \
            float mx = fmaxf(mxa_, mxb_); \
            { auto rr_ = __builtin_amdgcn_permlane32_swap(__float_as_uint(mx), __float_as_uint(mx), false, false); mx = fmaxf(__uint_as_float(rr_[0]), __uint_as_float(rr_[1])); }     \
            const float cand = mc + mx; \
            const bool up_ = (cand > m_run + 24.0f) || ((t) == 0 && (cand > 24.0f || cand < -24.0f)); \
            if (__any(up_ || (mc != m_run))) { const float mnew = up_ ? cand : m_run; \
                const float al = __builtin_amdgcn_exp2f(m_run - mnew); l_run *= al; \
                _Pragma("unroll") for (int d = 0; d < 4; ++d) _Pragma("unroll") for (int r = 0; r < 16; ++r) OT[d][r] *= al; \
                if (DO_PV) { _Pragma("unroll") for (int js = 0; js < 4; ++js) { u32x4 w_ = __builtin_bit_cast(u32x4, Pp[js]); \
                    w_.x = pk2(bflo(w_.x) * al, bfhi(w_.x) * al); w_.y = pk2(bflo(w_.y) * al, bfhi(w_.y) * al); w_.z = pk2(bflo(w_.z) * al, bfhi(w_.z) * al); w_.w = pk2(bflo(w_.w) * al, bfhi(w_.w) * al); \
                    Pp[js] = __builtin_bit_cast(bf16x8, w_); } } \
                const float dl = mnew - mc; \
                _Pragma("unroll") for (int r = 0; r < 16; ++r) { Sc0[r] -= dl; Sc1[r] -= dl; } \
                m_run = mnew; } \
            float ls = 0.f; u32x4 pw_[4]; \
            __builtin_amdgcn_sched_barrier(0); \
            _Pragma("unroll") for (int g = 0; g < 16; ++g) { \
                if (DO_PV) { if (g + 2 < 16) AT_RD(fr_[(g + 4) % 3], va_[(g + 2) & 3], ((g + 2) >> 2) * 4096); \
                    if (g + 2 < 16) AT_WL(fr_[(g + 2) % 3], 2); else if (g == 14) AT_WL(fr_[(g + 2) % 3], 1); else AT_WL(fr_[(g + 2) % 3], 0); \
                    OT[g >> 2] = MFMA32(fr_[(g + 2) % 3], Pp[g & 3], OT[g >> 2]); } \
                float x0_ = SCE(Sc0, Sc1, 2 * g), x1_ = SCE(Sc0, Sc1, 2 * g + 1); asm volatile("" : "+v"(x0_), "+v"(x1_)); \
                float e0_ = __builtin_amdgcn_exp2f(x0_), e1_ = __builtin_amdgcn_exp2f(x1_); \
                ls += e0_; ls += e1_; unsigned pk_ = pk2(e0_, e1_); asm volatile("" : "+v"(pk_), "+v"(ls)); pw_[g >> 2][g & 3] = pk_; \
                __builtin_amdgcn_sched_barrier(0); } \
            l_run += ls; \
            Pn[0] = __builtin_bit_cast(bf16x8, pw_[0]); Pn[1] = __builtin_bit_cast(bf16x8, pw_[1]); Pn[2] = __builtin_bit_cast(bf16x8, pw_[2]); Pn[3] = __builtin_bit_cast(bf16x8, pw_[3]); \
            if ((t) + 3 < NT) AT_WAIT_BAR(6); else AT_WAIT_BAR(0); \
            ks_free = ks_next; ks_next = (ks_next == 2) ? 0 : ks_next + 1; } while (0)
        AT_STEP(SA0, SA1, mcA, SB0, SB1, mcB, PX, PY, 0, false);
        for (int t = 1; t < NT - 1; t += 2) { AT_STEP(SB0, SB1, mcB, SA0, SA1, mcA, PY, PX, t, true); AT_STEP(SA0, SA1, mcA, SB0, SB1, mcB, PX, PY, t + 1, true); }
        AT_STEP(SB0, SB1, mcB, SA0, SA1, mcA, PY, PX, NT - 1, true);
        { const LAS unsigned char* vb_ = lds + VRING + ((NT - 1) & 3) * SLOT;
#pragma unroll
          for (int dvb = 0; dvb < 4; ++dvb)
#pragma unroll
            for (int js = 0; js < 4; ++js) { const bf16x8 av = *(const LAS bf16x8*)(vb_ + sw64(32 * dvb + r32, 2 * js + hi)); OT[dvb] = MFMA32(av, PX[js], OT[dvb]); } }
        const int bC = b, hC = h, q0C = q0;
        if (u + G < 2048) AT_SETUP(u + G);
        AT_LBAR();
#undef AT_STEP
#undef AT_RD
#undef AT_WL
#undef SCE
#undef QKT
#undef DMA_K
#undef DMA_V
#undef KEYROW
        { const float lt = l_run + __shfl_xor(l_run, 32); const float il = 1.0f / lt;
#pragma unroll
            for (int d = 0; d < 4; ++d)
#pragma unroll
                for (int r = 0; r < 16; ++r) OT[d][r] *= il; }
        LAS float* ex = (LAS float*)(lds + 65536);
        if (isub == 1) {
#pragma unroll
            for (int d = 0; d < 4; ++d)
#pragma unroll
                for (int r = 0; r < 16; ++r) ex[((rg * 4 + d) * 16 + r) * 64 + lane] = OT[d][r]; }
        AT_LBAR();
        if (isub == 0) {
            float ss = 0.f;
#pragma unroll
            for (int d = 0; d < 4; ++d)
#pragma unroll
                for (int r = 0; r < 16; ++r) { const float o = OT[d][r] - lam * ex[((rg * 4 + d) * 16 + r) * 64 + lane]; OT[d][r] = o; ss += o * o; }
            ss += __shfl_xor(ss, 32);
            const float rn = (1.0f - LAM_INIT) / sqrtf(ss * (1.0f / 128.0f) + EPSN);
            int r32e = lane & 31; asm volatile("" : "+v"(r32e));
            bf16* orow = ATT + (size_t)(bC * SEQL + q0C + 32 * rg + r32e) * DM + hC * 128;
#pragma unroll
            for (int d = 0; d < 4; ++d)
#pragma unroll
                for (int g4 = 0; g4 < 4; ++g4) { const int dv = 32 * d + 8 * g4 + 4 * hi; const f32x4 w = *(const LAS f32x4*)(sublnL + dv);
                    u32x2 o; o.x = pk2(OT[d][4 * g4] * rn * w[0], OT[d][4 * g4 + 1] * rn * w[1]); o.y = pk2(OT[d][4 * g4 + 2] * rn * w[2], OT[d][4 * g4 + 3] * rn * w[3]);
                    *(u32x2*)(orow + dv) = o; }
        }
        AT_LBAR();
    }
    asm volatile("s_waitcnt vmcnt(0)" ::: "memory");
    __syncthreads();
}
#undef AT_SETUP
#undef AT_LBAR
#undef AT_WAIT_BAR

constexpr int NPHASE = 20;
__global__ void __launch_bounds__(NTHR, 2) mega_fwd(Args A) {
    extern __shared__ __attribute__((aligned(16))) unsigned char lds_raw[];
    LAS unsigned char* lds = (LAS unsigned char*)lds_raw;
    const int tid = threadIdx.x, lane = tid & 63, wave = __builtin_amdgcn_readfirstlane(tid >> 6);
    const int G = gridDim.x, bx = blockIdx.x;
    unsigned char* ws = A.ws;
    if (tid < 64) ((LAS unsigned*)(lds + LDSX))[tid] = 0u;
    __syncthreads();
    XcdBarrier bar; bar.bar = (unsigned*)(ws + WS_CTL) + CW_BAR; bar.x = 0; bar.st = nullptr;
    if (!MK_SPLIT) bar = xcd_barrier_post((unsigned*)(ws + WS_CTL) + CW_BAR, (volatile LAS unsigned*)(lds + LDSX));
    const int lo = A.ph_lo, hi_ = A.ph_hi;
#ifdef ONLY_PHASE
#define IN(k) ((k) == ONLY_PHASE && lo <= (k) && (k) < hi_)
#else
#define IN(k) (lo <= (k) && (k) < hi_)
#endif
#if defined(REPEAT_PHASE)
#define REPLOOP(k) for (int rep_ = 0, nrep_ = ((((REPEAT_PHASE) >> (k)) & 1) ? A.ph_rep : 1); rep_ < nrep_; (++rep_ < nrep_) ? xcd_barrier(bar) : (void)0)
#else
#define REPLOOP(k)
#endif
#ifdef PROBE_PHASE
    unsigned long long tp0_ = __builtin_amdgcn_s_memrealtime(), tp1_ = 0ull;
#define SEAM(k) do { if (IN(k) && IN((k) + 1)) xcd_barrier(bar); if ((k) == PROBE_PHASE) tp1_ = __builtin_amdgcn_s_memrealtime(); if ((k) + 1 == PROBE_PHASE) tp0_ = __builtin_amdgcn_s_memrealtime(); } while (0)
#else
#define SEAM(k) do { if (IN(k) && IN((k) + 1)) xcd_barrier(bar); } while (0)
#endif

    if (IN(0)) REPLOOP(0) { phase0(A, lds, tid, lane, wave, G, bx); } SEAM(0);
    if (IN(1)) REPLOOP(1) { phase_modulate<0, 0>(A, lds, tid, lane, wave, G, bx); } SEAM(1);
    if (IN(2)) REPLOOP(2) {
        pg8::Gemm g{(const pg8::bf16_t*)(ws + WS_H), (const pg8::bf16_t*)(ws + WS_WIN), RT, NPROJ, DM}; pg8::StaticOrder S; S.init(RT, NPROJ, G, bx);
        pg8::EpiBf16<0> E{(pg8::bf16_t*)(ws + WS_BIG), NPROJ, nullptr, 0, 0, 1.f};
        pg8::gemm_phase<pg8::EpiBf16<0>, pg8::StaticOrder, true, true>(lds, g, S, E);
    } SEAM(2);
    if (IN(3)) REPLOOP(3) { phase_gdn_prep(A, lds, tid, lane, wave, G, bx); } SEAM(3);
    if (IN(4)) REPLOOP(4) { phase_gdn_scan(A, lds, tid, lane, wave, G, bx); } SEAM(4);
    if (IN(5)) REPLOOP(5) { phase_ycat(A, lds, tid, lane, wave, G, bx); } SEAM(5);
    if (IN(6)) REPLOOP(6) {
        pg8::Gemm g{(const pg8::bf16_t*)(ws + WS_H), (const pg8::bf16_t*)(ws + WS_WOUT), RT, DM, DM}; pg8::StaticOrder S; S.init(RT, DM, G, bx);
        pg8::EpiResidual E{A.in[0], A.in[2], A.out, (float*)(ws + WS_XC), (const float*)(ws + WS_MODV) + 2 * 1024, RL};
        pg8::gemm_phase<pg8::EpiResidual, pg8::StaticOrder, true, true>(lds, g, S, E);
    } SEAM(6);
    if (IN(7)) REPLOOP(7) { phase_modulate<1, 0>(A, lds, tid, lane, wave, G, bx); } SEAM(7);
    if (IN(8)) REPLOOP(8) { phase_topk<0>(A, lds, tid, lane, wave, G, bx); } SEAM(8);
    if (IN(9)) REPLOOP(9) {
        pg8::Gemm g{(const pg8::bf16_t*)(ws + WS_H), (const pg8::bf16_t*)(ws + WS_E0), M1_0, 4096, DM}; pg8::MoeOrder S{17 * 16 * 16, G, bx, 17, 16};
        pg8::EpiMoe1 E{(pg8::bf16_t*)(ws + WS_BIG)};
        LAS unsigned short* gt = (LAS unsigned short*)(lds + LDSX + 1024); const int* IDX = (const int*)(ws + WS_IDX);
        { pg8::Unit uu; for (int i = 0; S.next(i, uu); ++i) if (tid < 256) gt[i * 256 + tid] = (unsigned short)IDX[uu.pm * 256 + tid]; }
        __syncthreads();
        pg8::gemm_phase<pg8::EpiMoe1, pg8::MoeOrder, true, true, true>(lds, g, S, E, gt);
    } SEAM(9);
    if (IN(10)) REPLOOP(10) {
        pg8::Gemm g{(const pg8::bf16_t*)(ws + WS_BIG), (const pg8::bf16_t*)(ws + WS_E0 + 128 * MiB), M1_0, DM, FFN}; pg8::MoeOrder S{17 * 16 * 4, G, bx, 17, 4};
        pg8::EpiMoe2 E{(pg8::bf16_t*)(ws + WS_G + 192 * MiB), (const float*)(ws + WS_GATEV)};
        pg8::gemm_phase<pg8::EpiMoe2, pg8::MoeOrder, true, true>(lds, g, S, E);
    } SEAM(10);
    if (IN(11)) REPLOOP(11) { phase_combine<0>(A, lds, tid, lane, wave, G, bx); } SEAM(11);
    if (IN(12)) REPLOOP(12) {
        constexpr int tH = (int)(WS_H / (512 * 1024)), tWqk = (int)(WS_WQK / (512 * 1024)), tWv = (int)(WS_WV / (512 * 1024));
        static_assert(WS_H % (512 * 1024) == 0 && WS_WQK % (512 * 1024) == 0 && WS_WV % (512 * 1024) == 0 && tWqk + 8 <= tH && tWv + 4 <= tH, "operand arrays on 256-row tile boundaries, weights below H");
        pg8::Gemm g{(const pg8::bf16_t*)ws, (const pg8::bf16_t*)ws, 0, 0, DM}; pg8::QkvOrder S{G, bx, tH, tWqk, tWv};
        pg8::EpiQKV E{pg8::EpiQK{(pg8::bf16_t*)(ws + WS_BIG), (const float*)(ws + WS_ROPE), 0.125f * 1.4426950408889634f, RL},
                      pg8::EpiBf16<0>{(pg8::bf16_t*)(ws + WS_BIG + 132 * MiB), RT, nullptr, 0, 0, 1.f}, tH, tWqk, tWv};
        pg8::gemm_phase<pg8::EpiQKV, pg8::QkvOrder, true, true>(lds, g, S, E);
    } SEAM(12);
    if (IN(13)) REPLOOP(13) { phase_attn(A, lds, tid, lane, wave, G, bx); } SEAM(13);
    if (IN(14)) REPLOOP(14) {
        pg8::Gemm g{(const pg8::bf16_t*)(ws + WS_H), (const pg8::bf16_t*)(ws + WS_WO), RL, DM, DM}; pg8::StaticOrder S; S.init(RL, DM, G, bx);
        pg8::EpiResidual E{A.out, A.out, A.out, A.out, (const float*)(ws + WS_MODV) + 5 * 6144 + 2 * 1024, RL};
        pg8::gemm_phase<pg8::EpiResidual, pg8::StaticOrder, true, true>(lds, g, S, E);
    } SEAM(14);
    if (IN(15)) REPLOOP(15) { phase_modulate<1, 1>(A, lds, tid, lane, wave, G, bx); } SEAM(15);
    if (IN(16)) REPLOOP(16) { phase_topk<1>(A, lds, tid, lane, wave, G, bx); } SEAM(16);
    if (IN(17)) REPLOOP(17) {
        pg8::Gemm g{(const pg8::bf16_t*)(ws + WS_H), (const pg8::bf16_t*)(ws + WS_G), M1_1, 4096, DM}; pg8::MoeOrder S{16 * 16 * 16, G, bx, 16, 16};
        pg8::EpiMoe1 E{(pg8::bf16_t*)(ws + WS_BIG)};
        LAS unsigned short* gt = (LAS unsigned short*)(lds + LDSX + 1024); const int* IDX = (const int*)(ws + WS_IDX);
        { pg8::Unit uu; for (int i = 0; S.next(i, uu); ++i) if (tid < 256) gt[i * 256 + tid] = (unsigned short)IDX[uu.pm * 256 + tid]; }
        __syncthreads();
        pg8::gemm_phase<pg8::EpiMoe1, pg8::MoeOrder, true, true, true>(lds, g, S, E, gt);
    } SEAM(17);
    if (IN(18)) REPLOOP(18) {
        pg8::Gemm g{(const pg8::bf16_t*)(ws + WS_BIG), (const pg8::bf16_t*)(ws + WS_W2L1), M1_1, DM, FFN}; pg8::MoeOrder S{16 * 16 * 4, G, bx, 16, 4};
        pg8::EpiMoe2 E{(pg8::bf16_t*)(ws + WS_E0), (const float*)(ws + WS_GATEV)};
        pg8::gemm_phase<pg8::EpiMoe2, pg8::MoeOrder, true, true>(lds, g, S, E);
    } SEAM(18);
    if (IN(19)) REPLOOP(19) { phase_combine<1>(A, lds, tid, lane, wave, G, bx); }
#ifdef PROBE_PHASE
    if (PROBE_PHASE == 19) tp1_ = __builtin_amdgcn_s_memrealtime();
    if (bx == 0 && tid == 0) { const unsigned long long te_ = __builtin_amdgcn_s_memrealtime(), dd_ = 4ull * (tp1_ - tp0_);
        while (__builtin_amdgcn_s_memrealtime() - te_ < dd_) __builtin_amdgcn_s_sleep(32); }
#endif
#undef IN
#undef SEAM
}

extern "C" void kernel_launch(void* const* d_in, const int* in_sizes, int n_in, void* d_out, int out_size, void* d_ws, size_t ws_size, hipStream_t stream) {
    static int grid = 0;
    if (grid == 0) {
        if (n_in != 35 || out_size != RL * DM || ws_size < WS_END) { fprintf(stderr, "kernel_launch: unexpected problem (n_in %d, out %d, ws %zu < %zu)\n", n_in, out_size, ws_size, (size_t)WS_END); grid = -1; return; }
        int dev = 0, cus = 0, per_cu = 0;
        if (hipGetDevice(&dev) != hipSuccess || hipDeviceGetAttribute(&cus, hipDeviceAttributeMultiprocessorCount, dev) != hipSuccess) { grid = -1; return; }
        if (hipFuncSetAttribute((const void*)mega_fwd, hipFuncAttributeMaxDynamicSharedMemorySize, LDS_BYTES) != hipSuccess) { fprintf(stderr, "kernel_launch: hipFuncSetAttribute failed\n"); grid = -1; return; }
        if (hipOccupancyMaxActiveBlocksPerMultiprocessor(&per_cu, (const void*)mega_fwd, NTHR, LDS_BYTES) != hipSuccess || per_cu < 1) { fprintf(stderr, "kernel_launch: occupancy query reports %d\n", per_cu); }
        (void)hipGetLastError();
        grid = cus;
    }
    if (grid < 0) return;
    if (hipMemsetAsync((char*)d_ws + WS_CTL, 0, CTL_ZERO_BYTES, stream) != hipSuccess) return;
    Args a{};
    for (int i = 0; i < 35; ++i) a.in[i] = (const float*)d_in[i];
    a.out = (float*)d_out; a.ws = (unsigned char*)d_ws;
#if MK_SPLIT
    for (int p = 0; p < NPHASE; ++p) { a.ph_lo = p; a.ph_hi = p + 1; hipLaunchKernelGGL(mega_fwd, dim3(grid), dim3(NTHR), LDS_BYTES, stream, a); }
#else
    a.ph_lo = 0; a.ph_hi = NPHASE; a.ph_rep = 2;
    hipLaunchKernelGGL(mega_fwd, dim3(grid), dim3(NTHR), LDS_BYTES, stream, a);
#endif
}
```

```cpp
#include <hip/hip_runtime.h>
#include <cstdio>
#include <cstdint>
#ifndef MK_SPLIT
#define MK_SPLIT 0
#endif

namespace pg8 {
#define PG8_LAS __attribute__((address_space(3)))
typedef unsigned short bf16_t;
typedef short bf16x8 __attribute__((ext_vector_type(8)));
typedef float f32x4 __attribute__((ext_vector_type(4)));
typedef unsigned u32x4 __attribute__((ext_vector_type(4)));
constexpr int BM = 256, BK = 64, HALF = 128, HTB = HALF * BK * 2  , STAGE_BYTES = 8 * HTB, NXCD = 8, WGM = 8;

__host__ __device__ __forceinline__ int lds_byte(int r, int c) { const int st = (r >> 4) * 2 + (c >> 5), rr = r & 15, cc = c & 31, ob = rr * 64 + cc * 2; return st * 1024 + (ob ^ (((ob >> 9) & 1) << 5)); }
__host__ __device__ __forceinline__ void stage_rc(int b, int& R, int& C) { const int st = b / 1024, sb = b % 1024, swz = sb ^ (((sb >> 9) & 1) << 5); R = (st >> 1) * 16 + swz / 64; C = (st & 1) * 32 + (swz % 64) / 2; }
__host__ __device__ __forceinline__ int perm32(int rho) { const int n = rho >> 4, i = rho & 15; return 8 * (i >> 2) + 4 * n + (i & 3); }

struct Unit { int pm, pn; };
struct Gemm { const bf16_t* A; const bf16_t* Bt; int M, N, K; };

struct StaticOrder {
    int nM, nN, nwg, G, c;
    __host__ __device__ void init(int M, int N, int G_, int c_) { nM = M / BM; nN = N / BM; nwg = nM * nN; G = G_; c = c_; }
    __host__ __device__ bool next(int i, Unit& u) const {
        const long L = (long)i * G + c; if (L >= nwg) return false;
        int wgid = (int)L; { const int q = nwg / NXCD, r = nwg % NXCD, xcd = wgid % NXCD, off = wgid / NXCD; wgid = (xcd < r ? xcd * (q + 1) : r * (q + 1) + (xcd - r) * q) + off; }
        const int nig = WGM * nN, gid = wgid / nig, fm = gid * WGM, gsz = (nM - fm) < WGM ? (nM - fm) : WGM;
        u.pm = fm + ((wgid % nig) % gsz); u.pn = (wgid % nig) / gsz; return true;
    }
    __device__ __forceinline__ void a_ready(const Unit&) const {}
    __device__ __forceinline__ void done(const Unit&) const {}
};

__device__ __forceinline__ unsigned cvt_pk_bf16(float lo, float hi) { unsigned r; asm volatile("v_cvt_pk_bf16_f32 %0, %1, %2" : "=v"(r) : "v"(lo), "v"(hi)); return r; }
typedef float f32x2 __attribute__((ext_vector_type(2)));
__device__ __forceinline__ f32x2 gelu_pk(f32x2 v) {
    const f32x2 av = __builtin_elementwise_abs(v), d = av * 0.2316418882f + 1.0f;
    f32x2 t; t.x = __builtin_amdgcn_rcpf(d.x); t.y = __builtin_amdgcn_rcpf(d.y);
    f32x2 q = t * 0.5307027145f + (-0.7265760135f); q = q * t + 0.7107068705f; q = q * t + (-0.142248368f); q = q * t + 0.127414796f; q = q * t;
    const f32x2 s = (v * v) * (-0.72134752044f);
    f32x2 e; e.x = __builtin_amdgcn_exp2f(s.x); e.y = __builtin_amdgcn_exp2f(s.y);
    const f32x2 m = v * (q * e), r = v - m;
    f32x2 o; o.x = v.x < 0.f ? m.x : r.x; o.y = v.y < 0.f ? m.y : r.y; return o;
}

template <int ACT  > struct EpiBf16 {
    static constexpr bool PERM = true, AFTER_DRAIN = false; static_assert(ACT == 0 || ACT == 1, "EpiBf16: ACT is 0 (none) or 1 (gelu_pk)");
    bf16_t* O; int ldc; const float* bias; int split_cols; size_t split_stride; float scale0;
    __device__ __forceinline__ void operator()(const f32x4 (&acc)[2][2][4][2], const Unit& u, int wr, int wc, int fr, int fq) const {
        const int row0 = u.pm * BM + wr * 64 + fr; int colt = u.pn * BM; bf16_t* base = O;
        float sc = 1.f; if (split_cols) { const int t = colt / split_cols; base += (size_t)t * split_stride; colt -= t * split_cols; if (t == 0) sc = scale0; }
        const int col0 = colt + wc * 32 + 8 * fq, bcol0 = u.pn * BM + wc * 32 + 8 * fq;
        f32x4 bv[2][2];
#pragma unroll
        for (int bj = 0; bj < 2; ++bj)
#pragma unroll
            for (int n = 0; n < 2; ++n) bv[bj][n] = bias ? *(const f32x4*)(bias + bcol0 + bj * HALF + 4 * n) : (f32x4){0.f, 0.f, 0.f, 0.f};
#pragma unroll
        for (int ai = 0; ai < 2; ++ai)
#pragma unroll
            for (int m = 0; m < 4; ++m) { bf16_t* rowp = base + (size_t)(row0 + ai * HALF + m * 16) * ldc + col0;
#pragma unroll
                for (int bj = 0; bj < 2; ++bj) { f32x4 v0 = acc[ai][bj][m][0] + bv[bj][0], v1 = acc[ai][bj][m][1] + bv[bj][1];
                    if (ACT == 1) { f32x2 a = gelu_pk((f32x2){v0[0], v0[1]}), b = gelu_pk((f32x2){v0[2], v0[3]}), c = gelu_pk((f32x2){v1[0], v1[1]}), d = gelu_pk((f32x2){v1[2], v1[3]});
                        v0 = (f32x4){a.x, a.y, b.x, b.y}; v1 = (f32x4){c.x, c.y, d.x, d.y}; }
                    v0 = v0 * sc; v1 = v1 * sc; u32x4 w; w.x = cvt_pk_bf16(v0[0], v0[1]); w.y = cvt_pk_bf16(v0[2], v0[3]); w.z = cvt_pk_bf16(v1[0], v1[1]); w.w = cvt_pk_bf16(v1[2], v1[3]);
                    *(u32x4*)(rowp + bj * HALF) = w; } }
    }
};

__device__ __forceinline__ float silu_fast(float x) { return x * __builtin_amdgcn_rcpf(1.0f + __builtin_amdgcn_exp2f(-1.4426950408889634f * x)); }
struct EpiResidual {
    static constexpr bool PERM = false, AFTER_DRAIN = false;
    const float* base_lat; const float* base_ctx; float* out_lat; float* out_ctx; const float* gate; int RL;
    __device__ __forceinline__ void operator()(const f32x4 (&acc)[2][2][4][2], const Unit& u, int wr, int wc, int fr, int fq) const {
        const int col0 = u.pn * BM + wc * 32 + 4 * fq;
#pragma unroll
        for (int ai = 0; ai < 2; ++ai)
#pragma unroll
            for (int m = 0; m < 4; ++m) {
                const int row = u.pm * BM + ai * HALF + wr * 64 + m * 16 + fr;
                const bool lat = row < RL; const int rr = lat ? row : row - RL; const int bb = lat ? (row >> 13) : 4;
                const float* bp = (lat ? base_lat : base_ctx) + (size_t)rr * 1024 + col0; float* op = (lat ? out_lat : out_ctx) + (size_t)rr * 1024 + col0;
                const float* gp = gate + bb * 6144 + col0;
#pragma unroll
                for (int bj = 0; bj < 2; ++bj)
#pragma unroll
                    for (int n = 0; n < 2; ++n) { const int c = bj * HALF + n * 16; const f32x4 g = *(const f32x4*)(gp + c), b = *(const f32x4*)(bp + c); *(f32x4*)(op + c) = b + g * acc[ai][bj][m][n]; }
            }
    }
};
struct EpiMoe1 {
    static constexpr bool PERM = true, AFTER_DRAIN = false;
    bf16_t* O;
    __device__ __forceinline__ void operator()(const f32x4 (&acc)[2][2][4][2], const Unit& u, int wr, int wc, int fr, int fq) const {
        const int row0 = u.pm * BM + wr * 64 + fr; const int hcol0 = (u.pn & 15) * 128 + wc * 32 + 8 * fq;
#pragma unroll
        for (int ai = 0; ai < 2; ++ai)
#pragma unroll
            for (int m = 0; m < 4; ++m) { bf16_t* rowp = O + (size_t)(row0 + ai * HALF + m * 16) * 2048 + hcol0;
                const f32x4 g0 = acc[ai][0][m][0], g1 = acc[ai][0][m][1], u0 = acc[ai][1][m][0], u1 = acc[ai][1][m][1];
                u32x4 w; w.x = cvt_pk_bf16(silu_fast(g0[0]) * u0[0], silu_fast(g0[1]) * u0[1]); w.y = cvt_pk_bf16(silu_fast(g0[2]) * u0[2], silu_fast(g0[3]) * u0[3]);
                w.z = cvt_pk_bf16(silu_fast(g1[0]) * u1[0], silu_fast(g1[1]) * u1[1]); w.w = cvt_pk_bf16(silu_fast(g1[2]) * u1[2], silu_fast(g1[3]) * u1[3]);
                *(u32x4*)rowp = w; }
    }
};
struct EpiMoe2 {
    static constexpr bool PERM = true, AFTER_DRAIN = false;
    bf16_t* O; const float* gatev;
    __device__ __forceinline__ void operator()(const f32x4 (&acc)[2][2][4][2], const Unit& u, int wr, int wc, int fr, int fq) const {
        const int row0 = u.pm * BM + wr * 64 + fr; const int col0 = (u.pn & 3) * BM + wc * 32 + 8 * fq;
#pragma unroll
        for (int ai = 0; ai < 2; ++ai)
#pragma unroll
            for (int m = 0; m < 4; ++m) { const int row = row0 + ai * HALF + m * 16; const float gv = gatev[row]; bf16_t* rowp = O + (size_t)row * 1024 + col0;
#pragma unroll
                for (int bj = 0; bj < 2; ++bj) { const f32x4 v0 = acc[ai][bj][m][0] * gv, v1 = acc[ai][bj][m][1] * gv;
                    u32x4 w; w.x = cvt_pk_bf16(v0[0], v0[1]); w.y = cvt_pk_bf16(v0[2], v0[3]); w.z = cvt_pk_bf16(v1[0], v1[1]); w.w = cvt_pk_bf16(v1[2], v1[3]);
                    *(u32x4*)(rowp + bj * HALF) = w; } }
    }
};
struct EpiQK {
    static constexpr bool PERM = true, AFTER_DRAIN = false;
    bf16_t* O; const float* rope; float qscale; int RL;
    __device__ __forceinline__ void operator()(const f32x4 (&acc)[2][2][4][2], const Unit& u, int wr, int wc, int fr, int fq) const {
        const int row0 = u.pm * BM + wr * 64 + fr; const int colb = u.pn * BM + wc * 32 + 8 * fq;
#pragma unroll
        for (int ai = 0; ai < 2; ++ai)
#pragma unroll
            for (int m = 0; m < 4; ++m) { const int row = row0 + ai * HALF + m * 16; const bool lat = row < RL; const int t = row & 8191; const int pr = t >> 6, pc = t & 63;
#pragma unroll
                for (int bj = 0; bj < 2; ++bj) { const int col = colb + bj * HALF; f32x4 v0 = acc[ai][bj][m][0], v1 = acc[ai][bj][m][1];
                    if (lat) { const int half = (col >> 5) & 1, j0 = (col & 31) >> 1;
                        const float* cp = rope + (half ? 4096 + pc * 16 : pr * 16) + j0; const float* sp = cp + (half ? 1024 : 2048);
                        const f32x4 c = *(const f32x4*)cp, s = *(const f32x4*)sp;
                        f32x4 a, b;
                        a[0] = v0[0] * c[0] - v0[1] * s[0]; a[1] = v0[1] * c[0] + v0[0] * s[0]; a[2] = v0[2] * c[1] - v0[3] * s[1]; a[3] = v0[3] * c[1] + v0[2] * s[1];
                        b[0] = v1[0] * c[2] - v1[1] * s[2]; b[1] = v1[1] * c[2] + v1[0] * s[2]; b[2] = v1[2] * c[3] - v1[3] * s[3]; b[3] = v1[3] * c[3] + v1[2] * s[3];
                        v0 = a; v1 = b; }
                    const float sc = (col < 1024) ? qscale : 1.0f; v0 = v0 * sc; v1 = v1 * sc;
                    u32x4 w; w.x = cvt_pk_bf16(v0[0], v0[1]); w.y = cvt_pk_bf16(v0[2], v0[3]); w.z = cvt_pk_bf16(v1[0], v1[1]); w.w = cvt_pk_bf16(v1[2], v1[3]);
                    *(u32x4*)(O + (size_t)row * 2048 + col) = w; } }
    }
};
struct MoeOrder {
    int total, G, c, tiles_pe, ncol;
    __device__ __forceinline__ bool next(int i, Unit& u) const {
        const long L = (long)i * G + c; if (L >= total) return false;
        const int per = tiles_pe * ncol; const int e = (int)L / per, rem = (int)L % per; int pml = rem % tiles_pe, pnl = rem / tiles_pe;
        if (per == 256 && G == 256) { const int x = rem & 7, j = rem >> 3; pml = (x & 3) * 4 + (j & 3); pnl = (x >> 2) * 8 + (j >> 2); }
        int ee = e;
        if (per == 272 && G == 256) {
            const int x = c & 7, j = c >> 3, g = x & 3, ph = x >> 2, k = i * 32 + j;
            const int q4 = k / 136, r = k % 136; const int b1 = 32 + (g == 0 ? 8 : 0), b2 = b1 + 32 + (g == 1 ? 8 : 0), b3 = b2 + 32 + (g == 2 ? 8 : 0);
            const int t = (r >= b1) + (r >= b2) + (r >= b3); const int rp = r - (t == 0 ? 0 : t == 1 ? b1 : t == 2 ? b2 : b3);
            ee = 4 * q4 + t;
            if (rp < 32) { pml = g * 4 + (rp & 3); pnl = ph * 8 + (rp >> 2); } else { pml = 16; pnl = ph * 8 + (rp - 32); } }
        u.pm = ee * tiles_pe + pml; u.pn = ee * ncol + pnl; return true; }
    __device__ __forceinline__ void a_ready(const Unit&) const {}
    __device__ __forceinline__ void done(const Unit&) const {}
};
struct QkvOrder {
    int G, c, tH, tWqk, tWv;
    __device__ __forceinline__ bool next(int i, Unit& u) const {
        const int L = i * G + c; if (L >= 1584) return false;
        if (L < 1056) { u.pm = tH + (L >> 3); u.pn = tWqk + (L & 7); } else { const int q = L - 1056; u.pm = tWv + (q & 3); u.pn = tH + (q >> 2); }
        return true; }
    __device__ __forceinline__ void a_ready(const Unit&) const {}
    __device__ __forceinline__ void done(const Unit&) const {}
};
struct EpiQKV {
    static constexpr bool PERM = true, AFTER_DRAIN = false;
    EpiQK qk; EpiBf16<0> vt; int tH, tWqk, tWv;
    __device__ __forceinline__ void operator()(const f32x4 (&acc)[2][2][4][2], const Unit& u, int wr, int wc, int fr, int fq) const {
        if (u.pn >= tH) { Unit v; v.pm = u.pm - tWv; v.pn = u.pn - tH; vt(acc, v, wr, wc, fr, fq); }
        else { Unit v; v.pm = u.pm - tH; v.pn = u.pn - tWqk; qk(acc, v, wr, wc, fr, fq); }
    }
};
template <class Epi, class Sched, bool ALIGN_EPI = false, bool SP2 = false, bool GATHER = false>
__device__ __forceinline__ void gemm_phase(PG8_LAS unsigned char* lds, const Gemm g, const Sched& S, const Epi& E, const PG8_LAS unsigned short* gtab = nullptr) {
    static_assert(!GATHER || SP2, "GATHER needs the SP2 loop");
    const int tid = threadIdx.x, wid = __builtin_amdgcn_readfirstlane(tid >> 6), lane = tid & 63, wr = wid >> 2, wc = wid & 3, fr = lane & 15, fq = lane >> 4;
    const int K = g.K, nt = K / BK;
    unsigned voffA[2], voffB[2]; int gR[2]; unsigned gC2[2];
#pragma unroll
    for (int i = 0; i < 2; ++i) { int R, C; stage_rc(tid * 16 + i * 8192, R, C); const int Rb = Epi::PERM ? ((R & ~31) + perm32(R & 31)) : R;
        voffA[i] = (unsigned)(R * K + C) * 2u; voffB[i] = (unsigned)(Rb * K + C) * 2u; gR[i] = R; gC2[i] = (unsigned)C * 2u; }
    unsigned offc[2][2] = {{0u, 0u}, {0u, 0u}}, offn[2][2] = {{0u, 0u}, {0u, 0u}};
#define PG8_GOFF(dst, ui_) do { _Pragma("unroll") for (int _h = 0; _h < 2; ++_h) _Pragma("unroll") for (int _i = 0; _i < 2; ++_i) \
        dst[_h][_i] = (unsigned)gtab[(ui_) * 256 + _h * 128 + gR[_i]] * (unsigned)(K * 2) + gC2[_i]; } while (0)
#define PG8_STA(bufoff, ptr, kb, h, nx) do { if constexpr (GATHER) { _Pragma("unroll") for (int _i = 0; _i < 2; ++_i) \
        __builtin_amdgcn_global_load_lds((const unsigned*)((const char*)g.A + (kb) + ((nx) ? offn[h][_i] : offc[h][_i])), (PG8_LAS unsigned*)(lds + (bufoff) + ldsw + _i * 8192), 16, 0, 0); } \
        else { PG8_STAGE(bufoff, ptr, voffA); } } while (0)
    const size_t kstep = (size_t)(BK * 2);
    const size_t hstep = (size_t)HALF * K * 2;
    const size_t tstep = 2 * hstep;
    const unsigned ldsw = (unsigned)wid * 1024u;
    const int aoff = lds_byte(wr * 64 + fr, fq * 8), boff = lds_byte(wc * 32 + fr, fq * 8);
#define PG8_SA(b, h) (((b) * 2 + (h)) * HTB)
#define PG8_SB(b, h) ((4 + (b) * 2 + (h)) * HTB)
#define PG8_STAGE(bufoff, gbase, voff) do { _Pragma("unroll") for (int _i = 0; _i < 2; ++_i) \
        __builtin_amdgcn_global_load_lds((const unsigned*)((const char*)(gbase) + (voff)[_i]), (PG8_LAS unsigned*)(lds + (bufoff) + ldsw + _i * 8192), 16, 0, 0); } while (0)
#define PG8_LDA(dst, b, h) do { _Pragma("unroll") for (int m = 0; m < 4; ++m) _Pragma("unroll") for (int k = 0; k < 2; ++k) dst[m][k] = *(const PG8_LAS bf16x8*)(lds + PG8_SA(b, h) + aoff + m * 2048 + k * 1024); } while (0)
#define PG8_LDB(dst, b, h) do { _Pragma("unroll") for (int n = 0; n < 2; ++n) _Pragma("unroll") for (int k = 0; k < 2; ++k) dst[n][k] = *(const PG8_LAS bf16x8*)(lds + PG8_SB(b, h) + boff + n * 2048 + k * 1024); } while (0)
#define PG8_MMA(ai, bj, At, Bt) do { __builtin_amdgcn_s_setprio(1); _Pragma("unroll") for (int m = 0; m < 4; ++m) _Pragma("unroll") for (int n = 0; n < 2; ++n) _Pragma("unroll") for (int k = 0; k < 2; ++k) \
        acc[ai][bj][m][n] = __builtin_amdgcn_mfma_f32_16x16x32_bf16(Bt[n][k], At[m][k], acc[ai][bj][m][n], 0, 0, 0); __builtin_amdgcn_s_setprio(0); } while (0)
#define PG8_WAIT_V(n) asm volatile("s_waitcnt vmcnt(" #n ")" ::: "memory")
#define PG8_WAIT_L(n) asm volatile("s_waitcnt lgkmcnt(" #n ")" ::: "memory")
#define PG8_BAR __builtin_amdgcn_s_barrier()
#define PG8_SCHED __builtin_amdgcn_sched_barrier(0)
    Unit cur, nxt; int ui = 0;
    if (!S.next(0, cur)) return;
    f32x4 acc[2][2][4][2];
#pragma unroll
    for (int a = 0; a < 2; ++a)
#pragma unroll
        for (int b = 0; b < 2; ++b)
#pragma unroll
            for (int m = 0; m < 4; ++m)
#pragma unroll
                for (int n = 0; n < 2; ++n) acc[a][b][m][n] = (f32x4){0.f, 0.f, 0.f, 0.f};
    bf16x8 At[4][2], B0[2][2], B1[2][2];
    const char* cA = (const char*)g.A + (size_t)cur.pm * tstep; const char* cB = (const char*)g.Bt + (size_t)cur.pn * tstep;
    S.a_ready(cur);
    if constexpr (GATHER) PG8_GOFF(offc, 0);
    if constexpr (SP2) {
        PG8_STAGE(PG8_SB(0, 0), cB, voffB); PG8_STAGE(PG8_SB(0, 1), cB + hstep, voffB); PG8_STA(PG8_SA(0, 0), cA, (size_t)0, 0, false); PG8_STA(PG8_SA(0, 1), cA + hstep, (size_t)0, 1, false);
        if (wr == 1) PG8_BAR;
        PG8_WAIT_V(2); PG8_BAR;
        PG8_STAGE(PG8_SB(1, 0), cB + kstep, voffB); PG8_STA(PG8_SA(1, 0), cA + kstep, kstep, 0, false); PG8_STAGE(PG8_SB(1, 1), cB + hstep + kstep, voffB);
        PG8_WAIT_V(6); PG8_BAR;
    } else {
        PG8_STAGE(PG8_SB(0, 0), cB, voffB); PG8_STAGE(PG8_SA(0, 0), cA, voffA); PG8_STAGE(PG8_SB(0, 1), cB + hstep, voffB); PG8_STAGE(PG8_SA(0, 1), cA + hstep, voffA);
        if (wr == 1) PG8_BAR;
        PG8_WAIT_V(4); PG8_BAR;
        PG8_STAGE(PG8_SB(1, 0), cB + kstep, voffB); PG8_STAGE(PG8_SA(1, 0), cA + kstep, voffA); PG8_STAGE(PG8_SB(1, 1), cB + hstep + kstep, voffB);
        PG8_WAIT_V(6); PG8_BAR;
    }
    for (;;) {
        const bool has_next = S.next(ui + 1, nxt);
        if constexpr (GATHER) PG8_GOFF(offn, has_next ? ui + 1 : ui);
        const char* nA = has_next ? (const char*)g.A + (size_t)nxt.pm * tstep : cA; const char* nB = has_next ? (const char*)g.Bt + (size_t)nxt.pn * tstep : cB;
        for (int t = 0; t < nt; t += 2) {
            const bool last = (t == nt - 2);
            const char* a1 = cA + (size_t)(t + 1) * kstep;
            const char* a2 = last ? nA : cA + (size_t)(t + 2) * kstep; const char* b2 = last ? nB : cB + (size_t)(t + 2) * kstep;
            const char* a3 = a2 + kstep; const char* b3 = b2 + kstep;
            const size_t ka1 = (size_t)(t + 1) * kstep, ka2 = last ? (size_t)0 : (size_t)(t + 2) * kstep, ka3 = ka2 + kstep;
            if (last && has_next) S.a_ready(nxt);
            if constexpr (SP2) {
            PG8_LDB(B0, 0, 0); PG8_LDB(B1, 0, 1); PG8_SCHED; PG8_LDA(At, 0, 0); PG8_STA(PG8_SA(1, 1), a1 + hstep, ka1, 1, false);
            PG8_WAIT_V(8); PG8_WAIT_L(0); PG8_BAR; PG8_MMA(0, 0, At, B0); PG8_MMA(0, 1, At, B1); PG8_BAR; PG8_SCHED;
            PG8_LDA(At, 0, 1); PG8_STAGE(PG8_SB(0, 0), b2, voffB); PG8_STAGE(PG8_SB(0, 1), b2 + hstep, voffB); PG8_STA(PG8_SA(0, 0), a2, ka2, 0, last);
            PG8_WAIT_V(8); PG8_WAIT_L(0); PG8_BAR; PG8_MMA(1, 0, At, B0); PG8_MMA(1, 1, At, B1); PG8_BAR; PG8_SCHED;
            PG8_LDB(B0, 1, 0); PG8_LDB(B1, 1, 1); PG8_SCHED; PG8_LDA(At, 1, 0); PG8_STA(PG8_SA(0, 1), a2 + hstep, ka2, 1, last);
            PG8_WAIT_V(8); PG8_WAIT_L(0); PG8_BAR; PG8_MMA(0, 0, At, B0); PG8_MMA(0, 1, At, B1); PG8_BAR; PG8_SCHED;
            PG8_LDA(At, 1, 1); PG8_STAGE(PG8_SB(1, 0), b3, voffB); PG8_STAGE(PG8_SB(1, 1), b3 + hstep, voffB); PG8_STA(PG8_SA(1, 0), a3, ka3, 0, last);
            PG8_WAIT_V(8); PG8_WAIT_L(0); PG8_BAR; PG8_MMA(1, 0, At, B0); PG8_MMA(1, 1, At, B1); PG8_BAR; PG8_SCHED;
            } else {
            PG8_LDB(B0, 0, 0); PG8_SCHED; PG8_LDA(At, 0, 0); PG8_STAGE(PG8_SA(1, 1), a1 + hstep, voffA);
            PG8_WAIT_L(8); PG8_BAR; PG8_WAIT_L(0); PG8_MMA(0, 0, At, B0); PG8_BAR; PG8_SCHED;
            PG8_LDB(B1, 0, 1); PG8_STAGE(PG8_SB(0, 0), b2, voffB);
            PG8_BAR; PG8_WAIT_L(0); PG8_MMA(0, 1, At, B1); PG8_BAR;
            PG8_LDA(At, 0, 1); PG8_STAGE(PG8_SA(0, 0), a2, voffA);
            PG8_BAR; PG8_WAIT_L(0); PG8_MMA(1, 0, At, B0); PG8_BAR; PG8_SCHED;
            PG8_STAGE(PG8_SB(0, 1), b2 + hstep, voffB);
            PG8_WAIT_V(6); PG8_BAR; PG8_MMA(1, 1, At, B1); PG8_BAR;
            PG8_LDB(B0, 1, 0); PG8_SCHED; PG8_LDA(At, 1, 0); PG8_STAGE(PG8_SA(0, 1), a2 + hstep, voffA);
            PG8_WAIT_L(8); PG8_BAR; PG8_WAIT_L(0); PG8_MMA(0, 0, At, B0); PG8_BAR; PG8_SCHED;
            PG8_LDB(B1, 1, 1); PG8_STAGE(PG8_SB(1, 0), b3, voffB);
            PG8_BAR; PG8_WAIT_L(0); PG8_MMA(0, 1, At, B1); PG8_BAR;
            PG8_LDA(At, 1, 1); PG8_STAGE(PG8_SA(1, 0), a3, voffA);
            PG8_BAR; PG8_WAIT_L(0); PG8_MMA(1, 0, At, B0); PG8_BAR; PG8_SCHED;
            PG8_STAGE(PG8_SB(1, 1), b3 + hstep, voffB);
            PG8_WAIT_V(6); PG8_BAR; PG8_MMA(1, 1, At, B1); PG8_BAR;
            }
        }
        if constexpr (ALIGN_EPI) { if (wr == 0) PG8_BAR; }
        if constexpr (!Epi::AFTER_DRAIN) { E(acc, cur, wr, wc, fr, fq); S.done(cur); }
        if (!has_next) break;
#pragma unroll
        for (int a = 0; a < 2; ++a)
#pragma unroll
            for (int b = 0; b < 2; ++b)
#pragma unroll
                for (int m = 0; m < 4; ++m)
#pragma unroll
                    for (int n = 0; n < 2; ++n) acc[a][b][m][n] = (f32x4){0.f, 0.f, 0.f, 0.f};
        cur = nxt; cA = nA; cB = nB; ++ui;
        if constexpr (GATHER) { offc[0][0] = offn[0][0]; offc[0][1] = offn[0][1]; offc[1][0] = offn[1][0]; offc[1][1] = offn[1][1]; }
        if constexpr (ALIGN_EPI) { if (wr == 1) PG8_BAR; }
    }
    PG8_WAIT_V(0);
    if constexpr (!ALIGN_EPI) { if (wr == 0) PG8_BAR; }
    PG8_BAR;
    if constexpr (Epi::AFTER_DRAIN) { E.fused(acc, cur, wr, wc, fr, fq, lds, wid, lane); S.done(cur); }
#undef PG8_SA
#undef PG8_SB
#undef PG8_STAGE
#undef PG8_STA
#undef PG8_GOFF
#undef PG8_LDA
#undef PG8_LDB
#undef PG8_MMA
#undef PG8_WAIT_V
#undef PG8_WAIT_L
#undef PG8_BAR
#undef PG8_SCHED
}
}

#define GAS __attribute__((address_space(1)))
#define LAS __attribute__((address_space(3)))
#define DI __device__ __forceinline__
typedef unsigned short bf16;
typedef float f32x4 __attribute__((ext_vector_type(4)));
typedef float f32x2 __attribute__((ext_vector_type(2)));
typedef float f32x16 __attribute__((ext_vector_type(16)));
typedef short bf16x8 __attribute__((ext_vector_type(8)));
typedef unsigned u32x4 __attribute__((ext_vector_type(4)));
typedef unsigned u32x2 __attribute__((ext_vector_type(2)));
typedef __bf16 bf16x2_t __attribute__((ext_vector_type(2)));
#define LDS_WAIT() asm volatile("s_waitcnt lgkmcnt(0)" ::: "memory")
#define MFMA32(a, b, c) __builtin_amdgcn_mfma_f32_32x32x16_bf16((a), (b), (c), 0, 0, 0)
DI unsigned pk2(float lo, float hi) { f32x2 v = {lo, hi}; bf16x2_t b = __builtin_convertvector(v, bf16x2_t); return __builtin_bit_cast(unsigned, b); }
DI float bflo(unsigned w) { return __uint_as_float(w << 16); }
DI float bfhi(unsigned w) { return __uint_as_float(w & 0xffff0000u); }
DI int crow(int r, int hi) { return (r & 3) + 8 * (r >> 2) + 4 * hi; }
DI float wave_sum(float v) {
#pragma unroll
    for (int o = 1; o < 64; o <<= 1) v += __shfl_xor(v, o);
    return v;
}
DI float wave_max(float v) {
#pragma unroll
    for (int o = 1; o < 64; o <<= 1) v = fmaxf(v, __shfl_xor(v, o));
    return v;
}
DI float silu_f(float x) { return x / (1.0f + __expf(-x)); }
template <int S> DI bf16x8 pack8(const f32x16& x) {
    u32x4 p; p.x = pk2(x[8 * S], x[8 * S + 1]); p.y = pk2(x[8 * S + 2], x[8 * S + 3]); p.z = pk2(x[8 * S + 4], x[8 * S + 5]); p.w = pk2(x[8 * S + 6], x[8 * S + 7]);
    return __builtin_bit_cast(bf16x8, p);
}
DI int sw64(int row, int c8) { return row * 128 + ((c8 ^ ((row >> 1) & 7)) << 4); }
DI int sw128(int row, int c16) { return row * 256 + ((c16 ^ (row & 15)) << 4); }

#define XB_TMO      128
#define XB_XCNT(j)  (256  + 64 * (j))
#define XB_XSUB(j)  (1280 + 64 * (j))
#define XB_XGEN(j)  (2304 + 64 * (j))
#define XB_TOP      3328
#define XB_TOPGEN   3392
#define XCD_BAR_WORDS 3456
#define XB_SPIN_CAP (1u << 18)

__device__ __forceinline__ unsigned xb_ld(unsigned* p)              { return __hip_atomic_load(p, __ATOMIC_RELAXED, __HIP_MEMORY_SCOPE_AGENT); }
__device__ __forceinline__ unsigned xb_add(unsigned* p, unsigned v) { return __hip_atomic_fetch_add(p, v, __ATOMIC_RELAXED, __HIP_MEMORY_SCOPE_AGENT); }
__device__ __forceinline__ unsigned xb_xcc_id() { return (unsigned)__builtin_amdgcn_s_getreg((3 << 11) | 20) & 0xFu; }
#define XB_SPIN(cond, bar) do { unsigned _sp = 0; while (cond) { __builtin_amdgcn_s_sleep(1); \
    if ((++_sp & 255u) == 0u) { if (xb_ld(&(bar)[XB_TMO])) break; if (_sp > XB_SPIN_CAP) { atomicAdd(&(bar)[XB_TMO], 1u); break; } } } } while (0)

struct XcdBarrier {
    unsigned* bar; unsigned x;
    volatile LAS unsigned* st;
};

__device__ __forceinline__ XcdBarrier xcd_barrier_post(unsigned* bar, volatile LAS unsigned* st) {
    XcdBarrier b; b.bar = bar; b.x = xb_xcc_id(); b.st = st;
    if (threadIdx.x == 0) (void)xb_add(&bar[XB_XCNT(b.x)], 1u);
    return b;
}
__device__ __forceinline__ void xcd_barrier_complete(unsigned* bar, unsigned x, unsigned& nloc, unsigned& nx) {
    const unsigned G = gridDim.x * gridDim.y * gridDim.z;
    unsigned sum, cnt, mine, sp = 0u;
    for (;;) {
        sum = 0u; cnt = 0u; mine = 0u;
#pragma unroll
        for (unsigned j = 0; j < 16; ++j) { const unsigned c = xb_ld(&bar[XB_XCNT(j)]); sum += c; cnt += (c > 0u) ? 1u : 0u; mine = (j == x) ? c : mine; }
        if (sum == G) break;
        __builtin_amdgcn_s_sleep(1);
        if ((++sp & 255u) == 0u) { if (xb_ld(&bar[XB_TMO])) break; if (sp > XB_SPIN_CAP) { atomicAdd(&bar[XB_TMO], 1u); break; } }
    }
    nloc = mine > 0u ? mine : 1u; nx = cnt > 0u ? cnt : 1u;
}

__device__ __forceinline__ void xcd_barrier(const XcdBarrier& b) {
    asm volatile("s_waitcnt vmcnt(0)" ::: "memory");
    __syncthreads();
    if (threadIdx.x == 0) {
        unsigned* bar = b.bar;
        __builtin_amdgcn_s_waitcnt(0);
        unsigned nloc = b.st[0], nx = b.st[1];
        if (nloc == 0u) { xcd_barrier_complete(bar, b.x, nloc, nx); b.st[0] = nloc; b.st[1] = nx; }
        const unsigned old = xb_add(&bar[XB_XSUB(b.x)], 1u);
        const unsigned gen = old / nloc;
        if (old + 1u == (gen + 1u) * nloc) {
            __builtin_amdgcn_fence(__ATOMIC_RELEASE, "agent");
            asm volatile("s_waitcnt vmcnt(0)" ::: "memory");
            const unsigned og = xb_add(&bar[XB_TOP], 1u);
            const unsigned tg = og / nx;
            if (og + 1u == (tg + 1u) * nx) xb_add(&bar[XB_TOPGEN], 1u);
            else XB_SPIN(xb_ld(&bar[XB_TOPGEN]) == tg, bar);
            __builtin_amdgcn_fence(__ATOMIC_ACQUIRE, "agent");
            xb_add(&bar[XB_XGEN(b.x)], 1u);
            asm volatile("s_waitcnt vmcnt(0)" ::: "memory");
        } else {
            XB_SPIN(xb_ld(&bar[XB_XGEN(b.x)]) == gen, bar);
            __builtin_amdgcn_fence(__ATOMIC_ACQUIRE, "agent");
            asm volatile("s_waitcnt vmcnt(0)" ::: "memory");
        }
    }
    __syncthreads();
}

constexpr int NWAVES = 8, NTHR = 512;
constexpr int DM = 1024, NBATCH = 4, SEQL = 8192, CTXL = 256, RL = NBATCH * SEQL, RC = NBATCH * CTXL, RT = RL + RC;
constexpr int NPROJ = 3584, INCOLS = 3600, NEXP = 16, FFN = 2048;
constexpr int SPE0 = 17 * 256, SPE1 = 16 * 256;
constexpr int M1_0 = NEXP * SPE0, M1_1 = NEXP * SPE1;
constexpr float EPSN = 1e-6f;
constexpr float LAM_INIT = 0.35550907f;
constexpr int NCHUNK = 132;
constexpr int GBLK = 73728;

constexpr size_t MiB = 1u << 20;
constexpr size_t WS_CTL = 0, CTL_ZERO_BYTES = 1 * MiB;
constexpr size_t WS_MODV = 1 * MiB;
constexpr size_t WS_ROPE = 1 * MiB + 256 * 1024;
constexpr size_t WS_ZROW = 1 * MiB + 512 * 1024;
constexpr size_t WS_GATES = 2 * MiB;
constexpr size_t WS_AFFT = 5 * MiB;
constexpr size_t WS_INV = 8 * MiB;
constexpr size_t WS_GATEV = 11 * MiB;
constexpr size_t WS_IDX = 11 * MiB + 512 * 1024;
constexpr size_t WS_GLAST = 12 * MiB;
constexpr size_t WS_WIN = 17 * MiB, WS_WOUT = 24 * MiB, WS_WQK = 26 * MiB, WS_WV = 30 * MiB, WS_WO = 32 * MiB;
constexpr size_t WS_E0 = 36 * MiB;
constexpr size_t WS_XC = 228 * MiB;
constexpr size_t WS_H = 232 * MiB;
constexpr size_t WS_BIG = 298 * MiB;
constexpr size_t WS_G = 570 * MiB;
constexpr size_t WS_W2L1 = 898 * MiB;
constexpr size_t WS_END = 962 * MiB;
constexpr int CW_BAR = 4096, CW_Q0 = 8192, CW_Q1 = 8256, CW_Q2 = 8320, CW_Q3 = 8384, CW_Q4 = 8448, CW_Q5 = 8512, CW_Q6 = 8576, CW_Q7 = 8640;

constexpr int RING_BYTES = 131072;
constexpr int LDSX = RING_BYTES;
constexpr int LDS_BYTES = 147456;

constexpr int GW_P2 = 232, GW_P3 = 240, GW_P10 = 224, GW_P12 = 232;
constexpr unsigned L0_SPARE2 = 8192u, L0_SPARE = 12288u;
constexpr unsigned L1_A = 9728u, L1_B = 18944u, L1_C = 23040u;
struct Args { const float* in[35]; float* out; unsigned char* ws; int ph_lo, ph_hi, ph_rep, pad; };

template <class F> DI void tr_item(const float* W, int ldw, bf16* WT, int ldk, int k0, F rowmap, LAS float* scr, int lane) {
    float tmp_[32];
#pragma unroll
    for (int i = 0; i < 32; ++i) { const int kk = 2 * i + (lane >> 5); tmp_[i] = W[(size_t)kk * ldw + (lane & 31)]; }
#pragma unroll
    for (int i = 0; i < 32; ++i) { const int kk = 2 * i + (lane >> 5); scr[kk * 33 + (lane & 31)] = tmp_[i]; }
    LDS_WAIT(); asm volatile("" ::: "memory");
    const int c = lane & 7;
#pragma unroll
    for (int j = 0; j < 4; ++j) { const int n = (lane >> 3) + 8 * j; const LAS float* s = scr + (8 * c) * 33 + n;
        u32x4 o; o.x = pk2(s[0 * 33], s[1 * 33]); o.y = pk2(s[2 * 33], s[3 * 33]); o.z = pk2(s[4 * 33], s[5 * 33]); o.w = pk2(s[6 * 33], s[7 * 33]);
        *(u32x4*)(WT + (size_t)rowmap(n) * ldk + k0 + 8 * c) = o; }
    LDS_WAIT(); asm volatile("" ::: "memory");
}
DI void tr_load(const float* W, int ldw, float (&t)[32], int lane) {
#pragma unroll
    for (int i = 0; i < 32; ++i) { const int kk = 2 * i + (lane >> 5); t[i] = __builtin_nontemporal_load(W + (size_t)kk * ldw + (lane & 31)); }
}
DI void tr_finish(const float (&t)[32], bf16* WT, int ldk, int k0, int rbase, LAS float* scr, int lane) {
#pragma unroll
    for (int i = 0; i < 32; ++i) { const int kk = 2 * i + (lane >> 5); scr[kk * 33 + (lane & 31)] = t[i]; }
    LDS_WAIT(); asm volatile("" ::: "memory");
    const int c = lane & 7;
#pragma unroll
    for (int j = 0; j < 4; ++j) { const int n = (lane >> 3) + 8 * j; const LAS float* s = scr + (8 * c) * 33 + n;
        u32x4 o; o.x = pk2(s[0 * 33], s[1 * 33]); o.y = pk2(s[2 * 33], s[3 * 33]); o.z = pk2(s[4 * 33], s[5 * 33]); o.w = pk2(s[6 * 33], s[7 * 33]);
        *(u32x4*)(WT + (size_t)(rbase + n) * ldk + k0 + 8 * c) = o; }
    LDS_WAIT(); asm volatile("" ::: "memory");
}
struct ItemDesc { const float* src; bf16* dst; int ldw, ldk, k0, rbase; };
DI ItemDesc expert_desc(int r, const float* Wg, const float* Wu, const float* Wd, bf16* W1, bf16* W2) {
    ItemDesc d;
    if (r < 32768) { const int up = r >> 14, q = r & 16383, e = q >> 10, it = q & 1023, kb = it >> 6, nb = it & 63;
        d.src = (up ? Wu : Wg) + (size_t)e * 1024 * 2048 + (size_t)(kb * 64) * 2048 + nb * 32; d.ldw = 2048; d.dst = W1; d.ldk = 1024; d.k0 = kb * 64;
        d.rbase = e * 4096 + (nb >> 2) * 256 + up * 128 + (nb & 3) * 32;
    } else { const int q = r - 32768, e = q >> 10, it = q & 1023, kb = it >> 5, nb = it & 31;
        d.src = Wd + (size_t)e * 2048 * 1024 + (size_t)(kb * 64) * 1024 + nb * 32; d.ldw = 1024; d.dst = W2; d.ldk = 2048; d.k0 = kb * 64; d.rbase = e * 1024 + nb * 32; }
    return d;
}
struct AddMap { int base; DI int operator()(int n) const { return base + n; } };
struct PairMap { int base; DI int operator()(int n) const { return base + (n < 16 ? 2 * n : 2 * (n - 16) + 1); } };
DI void expert_item(int r, const float* Wg, const float* Wu, const float* Wd, bf16* W1, bf16* W2, LAS float* scr, int lane) {
    if (r < 32768) { const int up = r >> 14, q = r & 16383, e = q >> 10, it = q & 1023, kb = it >> 6, nb = it & 63;
        const float* src = (up ? Wu : Wg) + (size_t)e * 1024 * 2048 + (size_t)(kb * 64) * 2048 + nb * 32;
        const int rbase = e * 4096 + (nb >> 2) * 256 + up * 128 + (nb & 3) * 32;
        tr_item(src, 2048, W1, 1024, kb * 64, AddMap{rbase}, scr, lane);
    } else { const int q = r - 32768, e = q >> 10, it = q & 1023, kb = it >> 5, nb = it & 31;
        const float* src = Wd + (size_t)e * 2048 * 1024 + (size_t)(kb * 64) * 1024 + nb * 32;
        const int rbase = e * 1024 + nb * 32;
        tr_item(src, 1024, W2, 2048, kb * 64, AddMap{rbase}, scr, lane);
    }
}
DI void stage_tab16(const float* W, int ldw, LAS float* tab, int tid) {
    for (int idx = tid; idx < 16384; idx += NTHR) { const int d = idx >> 4, e = idx & 15; const int j = d >> 8, l = (d >> 2) & 63, c = d & 3;
        tab[((((j * 4 + c) * 4 + (e >> 2)) * 64 + l) << 2) + (e & 3)] = W[(size_t)d * ldw + e]; }
}
DI void row_gemv16(const f32x4 (&h)[4], const LAS float* tab, int lane, float (&sums)[16]) {
#pragma unroll
    for (int e = 0; e < 16; ++e) sums[e] = 0.f;
#pragma unroll
    for (int j = 0; j < 4; ++j)
#pragma unroll
        for (int c = 0; c < 4; ++c) { const float hv = h[j][c];
#pragma unroll
            for (int q = 0; q < 4; ++q) { const f32x4 w = *(const LAS f32x4*)(tab + ((((j * 4 + c) * 4 + q) * 64 + lane) << 2));
                sums[4 * q + 0] += hv * w[0]; sums[4 * q + 1] += hv * w[1]; sums[4 * q + 2] += hv * w[2]; sums[4 * q + 3] += hv * w[3]; }
            asm volatile("" ::: "memory"); }
}
DI int eidx16(int lane) { return ((lane >> 5) & 1) * 8 + ((lane >> 4) & 1) * 4 + ((lane >> 3) & 1) * 2 + ((lane >> 2) & 1); }
DI float reduce16(const float (&s)[16], int lane) {
    float a8[8], a4[4], a2[2];
    const bool u5 = (lane & 32) != 0, u4 = (lane & 16) != 0, u3 = (lane & 8) != 0, u2 = (lane & 4) != 0;
#pragma unroll
    for (int k = 0; k < 8; ++k) { const float keep = u5 ? s[k + 8] : s[k], send = u5 ? s[k] : s[k + 8]; a8[k] = keep + __shfl_xor(send, 32); }
#pragma unroll
    for (int k = 0; k < 4; ++k) { const float keep = u4 ? a8[k + 4] : a8[k], send = u4 ? a8[k] : a8[k + 4]; a4[k] = keep + __shfl_xor(send, 16); }
#pragma unroll
    for (int k = 0; k < 2; ++k) { const float keep = u3 ? a4[k + 2] : a4[k], send = u3 ? a4[k] : a4[k + 2]; a2[k] = keep + __shfl_xor(send, 8); }
    float r; { const float keep = u2 ? a2[1] : a2[0], send = u2 ? a2[0] : a2[1]; r = keep + __shfl_xor(send, 4); }
    r += __shfl_xor(r, 2); r += __shfl_xor(r, 1);
    return r;
}
DI float* resid_ptr(float* lat, float* ctx, int r) { return r < RL ? lat + (size_t)r * DM : ctx + (size_t)(r - RL) * DM; }
DI int row_bb(int r) { return r < RL ? (r >> 13) : 4; }
DI void modulate_row(f32x4 (&v)[4], const float* nw, const float* shift, const float* scale, int lane) {
    float ss = 0.f;
#pragma unroll
    for (int j = 0; j < 4; ++j) ss += (v[j][0] * v[j][0] + v[j][1] * v[j][1]) + (v[j][2] * v[j][2] + v[j][3] * v[j][3]);
    const float rstd = 1.0f / sqrtf(wave_sum(ss) * (1.0f / DM) + EPSN);
#pragma unroll
    for (int j = 0; j < 4; ++j) { const int d = 256 * j + 4 * lane; const f32x4 w = *(const f32x4*)(nw + d), sc = *(const f32x4*)(scale + d), sh = *(const f32x4*)(shift + d);
        v[j] = v[j] * rstd * w * (sc + 1.0f) + sh; }
}
DI void store_row_bf16(bf16* dst, const f32x4 (&v)[4], int lane) {
#pragma unroll
    for (int j = 0; j < 4; ++j) { u32x2 o; o.x = pk2(v[j][0], v[j][1]); o.y = pk2(v[j][2], v[j][3]); *(u32x2*)(dst + 256 * j + 4 * lane) = o; }
}
DI void load_row_f32(const float* src, f32x4 (&v)[4], int lane) {
#pragma unroll
    for (int j = 0; j < 4; ++j) v[j] = *(const f32x4*)(src + 256 * j + 4 * lane);
}
DI void moe_combine_row(f32x4 (&v)[4], const int* invrow, const bf16* YE, const float* gvec, int lane) {
    const int mine = invrow[lane & 15];
    f32x4 a[4];
#pragma unroll
    for (int j = 0; j < 4; ++j) a[j] = (f32x4){0.f, 0.f, 0.f, 0.f};
#pragma unroll
    for (int e = 0; e < 16; ++e) { const int s = __builtin_amdgcn_readlane(mine, e);
        if (s >= 0) { const bf16* yr = YE + (size_t)s * DM;
#pragma unroll
            for (int j = 0; j < 4; ++j) { const u32x2 w = *(const u32x2*)(yr + 256 * j + 4 * lane); a[j][0] += bflo(w.x); a[j][1] += bfhi(w.x); a[j][2] += bflo(w.y); a[j][3] += bfhi(w.y); } } }
#pragma unroll
    for (int j = 0; j < 4; ++j) { const f32x4 g = *(const f32x4*)(gvec + 256 * j + 4 * lane); v[j] = v[j] + g * a[j]; }
}

#define PH_ARGS const Args& A, LAS unsigned char* lds, int tid, int lane, int wave, int G, int bx
DI void sincos_d(double a, float& sn, float& cs) {
    const double TWO_OVER_PI = 0.63661977236758134308, PIO2 = 1.57079632679489661923;
    const double kq = (double)(long long)(a * TWO_OVER_PI + 0.5); const double y = a - kq * PIO2; const double y2 = y * y;
    const double s = y * (1.0 + y2 * (-1.0 / 6 + y2 * (1.0 / 120 + y2 * (-1.0 / 5040 + y2 * (1.0 / 362880 + y2 * (-1.0 / 39916800 + y2 * (1.0 / 6227020800.0)))))));
    const double c = 1.0 + y2 * (-0.5 + y2 * (1.0 / 24 + y2 * (-1.0 / 720 + y2 * (1.0 / 40320 + y2 * (-1.0 / 3628800 + y2 * (1.0 / 479001600.0))))));
    const int k = (int)((long long)kq & 3);
    const double ss = (k == 0) ? s : (k == 1) ? c : (k == 2) ? -s : -c;
    const double cc = (k == 0) ? c : (k == 1) ? -s : (k == 2) ? -c : s;
    sn = (float)ss; cs = (float)cc;
}

DI void phase0(PH_ARGS) {
    unsigned char* ws = A.ws;
    LAS float* sil = (LAS float*)(lds + 73728);
    for (int i = tid; i < 5120; i += NTHR) { const int bb = i >> 10, k = i & 1023; const float cv = bb < 4 ? A.in[1][bb * 1024 + k] : A.in[3][k]; sil[i] = silu_f(cv); }
    __syncthreads();
    {
        const int t = wave * G + bx;
        if (t < 768) { const int layer = t / 384, n = (t % 384) * 16 + (lane & 15), kq = lane >> 4;
            const float* W = A.in[layer ? 19 : 4] + (size_t)(kq * 256) * 6144 + n; const float* Bv = A.in[layer ? 20 : 5];
            const LAS float* sl = sil + kq * 256;
            float a0 = 0.f, a1 = 0.f, a2 = 0.f, a3 = 0.f, a4 = 0.f;
#pragma unroll 1
            for (int k0 = 0; k0 < 256; k0 += 32) { float wv[32];
#pragma unroll
                for (int q = 0; q < 32; ++q) wv[q] = W[(size_t)(k0 + q) * 6144];
#pragma unroll
                for (int q = 0; q < 32; ++q) { const float w = wv[q]; a0 += sl[k0 + q] * w; a1 += sl[1024 + k0 + q] * w; a2 += sl[2048 + k0 + q] * w; a3 += sl[3072 + k0 + q] * w; a4 += sl[4096 + k0 + q] * w; } }
            a0 += __shfl_xor(a0, 16); a0 += __shfl_xor(a0, 32); a1 += __shfl_xor(a1, 16); a1 += __shfl_xor(a1, 32); a2 += __shfl_xor(a2, 16); a2 += __shfl_xor(a2, 32);
            a3 += __shfl_xor(a3, 16); a3 += __shfl_xor(a3, 32); a4 += __shfl_xor(a4, 16); a4 += __shfl_xor(a4, 32);
            if (kq == 0) { float* mv = (float*)(ws + WS_MODV) + layer * 5 * 6144 + n; const float bv = Bv[n];
                mv[0] = a0 + bv; mv[6144] = a1 + bv; mv[2 * 6144] = a2 + bv; mv[3 * 6144] = a3 + bv; mv[4 * 6144] = a4 + bv; } }
    }
    if (bx == G - 1) {
        float* rope = (float*)(ws + WS_ROPE);
        for (int i = tid; i < 3072; i += NTHR) { const int isc = i >= 2048, ii = isc ? i - 2048 : i; const int pos = ii >> 4, j = ii & 15;
            double f = 1.0; for (int q = 0; q < j; ++q) f *= 0.56234132519034908;
            float sn, cs; sincos_d((double)pos * f, sn, cs);
            if (isc) { rope[4096 + ii] = cs; rope[5120 + ii] = sn; } else { rope[ii] = cs; rope[2048 + ii] = sn; } }
        unsigned* z = (unsigned*)(ws + WS_ZROW); for (int i = tid; i < 512; i += NTHR) z[i] = 0u;
    }
    LAS float* scr = (LAS float*)(lds + wave * 8704);
    const int gw = bx * NWAVES + wave, NGW = G * NWAVES;
    constexpr int I_IN = 16 * 112, I_OUT = 16 * 32, I_QK = 16 * 64, I_V = 16 * 32, I_O = 16 * 32;
    constexpr int NITEMS = I_IN + I_OUT + I_QK + I_V + I_O;
    for (int it = gw; it < NITEMS; it += NGW) {
        int r = it;
        if (r < I_IN) { const int kb = r / 112, nb = r % 112; tr_item(A.in[7] + (size_t)(kb * 64) * INCOLS + nb * 32, INCOLS, (bf16*)(ws + WS_WIN), 1024, kb * 64, AddMap{nb * 32}, scr, lane); continue; } r -= I_IN;
        if (r < I_OUT) { const int kb = r >> 5, nb = r & 31; tr_item(A.in[13] + (size_t)(kb * 64) * 1024 + nb * 32, 1024, (bf16*)(ws + WS_WOUT), 1024, kb * 64, AddMap{nb * 32}, scr, lane); continue; } r -= I_OUT;
        if (r < I_QK) { const int kb = r >> 6, nb = r & 63; tr_item(A.in[22] + (size_t)(kb * 64) * 3072 + nb * 32, 3072, (bf16*)(ws + WS_WQK), 1024, kb * 64, PairMap{nb * 32}, scr, lane); continue; } r -= I_QK;
        if (r < I_V) { const int kb = r >> 5, nb = r & 31; tr_item(A.in[22] + (size_t)(kb * 64) * 3072 + 2048 + nb * 32, 3072, (bf16*)(ws + WS_WV), 1024, kb * 64, AddMap{nb * 32}, scr, lane); continue; } r -= I_V;
        { const int kb = r >> 5, nb = r & 31; tr_item(A.in[28] + (size_t)(kb * 64) * 1024 + nb * 32, 1024, (bf16*)(ws + WS_WO), 1024, kb * 64, AddMap{nb * 32}, scr, lane); }
    }
}

template <int MODE, int LAYER> DI void phase_modulate(PH_ARGS) {
    unsigned char* ws = A.ws;
    LAS float* tab = (LAS float*)lds;
    if (MODE == 0) stage_tab16(A.in[7] + NPROJ, INCOLS, tab, tid); else stage_tab16(A.in[LAYER ? 30 : 15], 16, tab, tid);
    __syncthreads();
    const float* nw = A.in[MODE == 0 ? 6 : (LAYER ? 29 : 14)];
    const float* mv = (const float*)(ws + WS_MODV) + LAYER * 5 * 6144 + (MODE == 0 ? 0 : 3 * 1024);
    bf16* H = (bf16*)(ws + WS_H);
    const int NR = (MODE == 1 && LAYER == 1) ? RL : RT;
    const int stride = G * NWAVES;
    for (int r0 = bx * NWAVES + wave; r0 < NR; r0 += 2 * stride) {
        const int r1 = (r0 + stride < NR) ? r0 + stride : r0;
        const float* s0 = (MODE == 0) ? (r0 < RL ? A.in[0] + (size_t)r0 * DM : A.in[2] + (size_t)(r0 - RL) * DM) : resid_ptr(A.out, (float*)(ws + WS_XC), r0);
        const float* s1 = (MODE == 0) ? (r1 < RL ? A.in[0] + (size_t)r1 * DM : A.in[2] + (size_t)(r1 - RL) * DM) : resid_ptr(A.out, (float*)(ws + WS_XC), r1);
        const int bb0 = row_bb(r0), bb1 = row_bb(r1);
        f32x4 v0[4], v1[4]; load_row_f32(s0, v0, lane); load_row_f32(s1, v1, lane);
        modulate_row(v0, nw, mv + bb0 * 6144, mv + bb0 * 6144 + 1024, lane);
        modulate_row(v1, nw, mv + bb1 * 6144, mv + bb1 * 6144 + 1024, lane);
        store_row_bf16(H + (size_t)r0 * DM, v0, lane); store_row_bf16(H + (size_t)r1 * DM, v1, lane);
        float sa[16], sb[16];
#pragma unroll
        for (int e = 0; e < 16; ++e) { sa[e] = 0.f; sb[e] = 0.f; }
#pragma unroll
        for (int j = 0; j < 4; ++j)
#pragma unroll
            for (int c = 0; c < 4; ++c) { const float ha = v0[j][c], hb = v1[j][c];
#pragma unroll
                for (int q = 0; q < 4; ++q) { const f32x4 w = *(const LAS f32x4*)(tab + ((((j * 4 + c) * 4 + q) * 64 + lane) << 2));
                    sa[4 * q + 0] += ha * w[0]; sa[4 * q + 1] += ha * w[1]; sa[4 * q + 2] += ha * w[2]; sa[4 * q + 3] += ha * w[3];
                    sb[4 * q + 0] += hb * w[0]; sb[4 * q + 1] += hb * w[1]; sb[4 * q + 2] += hb * w[2]; sb[4 * q + 3] += hb * w[3]; }
                asm volatile("" ::: "memory"); }
        const float red0 = reduce16(sa, lane), red1 = reduce16(sb, lane); const int ee = eidx16(lane);
        if (MODE == 0) { if ((lane & 3) == 0) { ((float*)(ws + WS_GATES))[(size_t)r0 * 16 + ee] = red0; ((float*)(ws + WS_GATES))[(size_t)r1 * 16 + ee] = red1; } }
        else { const float mx0 = wave_max(red0), mx1 = wave_max(red1); const float ex0 = __expf(red0 - mx0), ex1 = __expf(red1 - mx1);
            const float den0 = wave_sum(ex0) * 0.25f, den1 = wave_sum(ex1) * 0.25f; const float a0 = ex0 / den0, a1 = ex1 / den1;
            if ((lane & 3) == 0) { float* af = (float*)(ws + WS_AFFT);
                if (r0 < RL) af[(size_t)(((r0 >> 13) * 16 + ee)) * 8192 + (r0 & 8191)] = a0; else { const int rr = r0 - RL; af[524288 + (size_t)(((rr >> 8) * 16 + ee)) * 256 + (rr & 255)] = a0; }
                if (r1 < RL) af[(size_t)(((r1 >> 13) * 16 + ee)) * 8192 + (r1 & 8191)] = a1; else { const int rr = r1 - RL; af[524288 + (size_t)(((rr >> 8) * 16 + ee)) * 256 + (rr & 255)] = a1; } } }
    }
}

DI void fnma_asm(float& acc, float a, float b) { asm("v_fma_f32 %0, -%1, %2, %0" : "+v"(acc) : "v"(a), "v"(b)); }
template <int J, int H> struct BsSeg { static constexpr int K0 = (J + 1) >> 2; static constexpr int LO = H ? (K0 > 8 ? K0 : 8) : K0; static constexpr int HI = H ? 16 : 8; static constexpr int CNT = HI > LO ? HI - LO : 0; };
template <int J, int H> DI void bs_issue(f32x4 (&buf)[8], unsigned lt_addr) {
    if constexpr (J >= 0) {
#pragma unroll
        for (int k4 = BsSeg<J, H>::LO; k4 < BsSeg<J, H>::HI; ++k4) asm volatile("ds_read_b128 %0, %1 offset:%2" : "=v"(buf[k4 & 7]) : "v"(lt_addr), "n"((J * 64 + 4 * k4) * 4));
    }
}
template <int J, int H, int NY> DI void bs_consume(const float (&t)[64], f32x4 (&buf)[8], float& a0, float& a1, float& a2, float& a3) {
    if constexpr (BsSeg<J, H>::CNT > 0) {
        asm volatile("s_waitcnt lgkmcnt(%1)" : "+v"(buf[BsSeg<J, H>::LO & 7]) : "n"(NY));
#pragma unroll
        for (int k4 = BsSeg<J, H>::LO + 1; k4 < BsSeg<J, H>::HI; ++k4) asm volatile("" : "+v"(buf[k4 & 7]));
#pragma unroll
        for (int k4 = BsSeg<J, H>::LO; k4 < BsSeg<J, H>::HI; ++k4) {
            if (4 * k4 + 0 > J) fnma_asm(a0, t[4 * k4 + 0], buf[k4 & 7][0]);
            if (4 * k4 + 1 > J) fnma_asm(a1, t[4 * k4 + 1], buf[k4 & 7][1]);
            if (4 * k4 + 2 > J) fnma_asm(a2, t[4 * k4 + 2], buf[k4 & 7][2]);
            if (4 * k4 + 3 > J) fnma_asm(a3, t[4 * k4 + 3], buf[k4 & 7][3]);
        }
    }
}
template <int J> struct BsNextCnt { static constexpr int V = BsSeg<J - 1, 1>::CNT; };
template <> struct BsNextCnt<0> { static constexpr int V = 0; };
template <int J> DI void bs_row(float (&t)[64], f32x4 (&bufA)[8], f32x4 (&bufB)[8], unsigned lt_addr, int lane) {
    float a0 = (lane == J) ? 1.0f : 0.0f, a1 = 0.f, a2 = 0.f, a3 = 0.f;
    bs_issue<J, 0>(bufB, lt_addr);
    bs_consume<J, 1, BsSeg<J, 0>::CNT>(t, bufA, a0, a1, a2, a3);
    if constexpr (J > 0) bs_issue<J - 1, 1>(bufA, lt_addr);
    bs_consume<J, 0, BsNextCnt<J>::V>(t, bufB, a0, a1, a2, a3);
    t[J] = (a0 + a1) + (a2 + a3);
    if constexpr (J > 0) bs_row<J - 1>(t, bufA, bufB, lt_addr, lane);
}
DI void backsub_all63(float (&t)[64], const LAS float* LT, int lane) {
    f32x4 bufA[8], bufB[8];
#pragma unroll
    for (int k = 0; k < 8; ++k) { bufA[k] = (f32x4){0.f, 0.f, 0.f, 0.f}; bufB[k] = (f32x4){0.f, 0.f, 0.f, 0.f}; }
    const unsigned lt_addr = (unsigned)(size_t)LT;
    bs_issue<63, 1>(bufA, lt_addr);
    bs_row<63>(t, bufA, bufB, lt_addr, lane);
}
DI void gdn_dir4(const Args& A, LAS unsigned char* lds, int lane, int dir, int wq, int b, int h, int seqsel, int cidx, int rowbase, int t0) {
    unsigned char* ws = A.ws;
    const int r32 = lane & 31, hi = lane >> 5;
    LAS unsigned char* Qn = lds; LAS unsigned char* Kn = lds + 16384;
    LAS unsigned char* DB = lds + 32768 + 49152 * dir;
    LAS float* LT = (LAS float*)DB; LAS unsigned char* TBG = DB; LAS unsigned char* TB = DB + 8192;
    LAS unsigned char* KT = DB + 16384; LAS unsigned char* VT = DB + 32768;
    LAS float* SM = (LAS float*)(lds + LDSX + 1024 + dir * 1280);
    LAS float* GC = SM; LAS float* EGC = SM + 64; LAS float* BETA = SM + 128; LAS float* BG = SM + 192; LAS float* KDEC = SM + 256;
    const int ch = (b * 4 + h) * 2 + dir;
    const int p = seqsel ? (dir ? 3 - cidx : cidx) : 4 + (dir ? 127 - cidx : cidx);
    unsigned char* blk = ws + WS_G + (size_t)(ch * NCHUNK + p) * GBLK;
    if (wq == 0) {
        const int tk = dir ? 63 - lane : lane; const float* gr = (const float*)(ws + WS_GATES) + (size_t)(rowbase + t0 + tk) * 16;
        const float av = gr[dir * 4 + h], bv = gr[8 + dir * 4 + h];
        const float xs = av + A.in[11][dir * 4 + h]; const float sp = xs > 20.f ? xs : log1pf(__expf(xs));
        const float g = -__expf(A.in[10][dir * 4 + h]) * sp; const float beta = 1.0f / (1.0f + __expf(-bv));
        float gc = g;
#pragma unroll
        for (int o = 1; o < 64; o <<= 1) { const float tv = __shfl_up(gc, o); if (lane >= o) gc += tv; }
        const float gl = __shfl(gc, 63); const float eg = __expf(gc);
        GC[lane] = gc; EGC[lane] = eg; BETA[lane] = beta; BG[lane] = beta * eg; KDEC[lane] = __expf(gl - gc);
        if (lane == 0) ((float*)(ws + WS_GLAST))[ch * NCHUNK + p] = __expf(gl);
    }
    __syncthreads();
    {
        const int ib = (wq == 1 || wq == 2) ? 1 : 0, jb = (wq >= 2) ? 1 : 0;
        const int i = 32 * ib + r32; const int ti = dir ? 63 - i : i; const float gi = GC[i], bi = BETA[i];
        f32x16 aK, aQ;
#pragma unroll
        for (int r = 0; r < 16; ++r) { aK[r] = 0.f; aQ[r] = 0.f; }
        if (jb <= ib) {
            const int j = 32 * jb + r32; const int tj = dir ? 63 - j : j;
#pragma unroll
            for (int kk = 0; kk < 8; ++kk) {
                const bf16x8 a = *(const LAS bf16x8*)(Kn + sw128(tj, 2 * kk + hi));
                const bf16x8 bK = *(const LAS bf16x8*)(Kn + sw128(ti, 2 * kk + hi));
                const bf16x8 bQ = *(const LAS bf16x8*)(Qn + sw128(ti, 2 * kk + hi));
                aK = MFMA32(a, bK, aK); aQ = MFMA32(a, bQ, aQ);
            }
        }
#pragma unroll
        for (int g4 = 0; g4 < 4; ++g4) { const f32x4 gj = *(const LAS f32x4*)(GC + 32 * jb + 8 * g4 + 4 * hi);
#pragma unroll
            for (int q = 0; q < 4; ++q) { const int r = 4 * g4 + q; const int j = 32 * jb + 8 * g4 + 4 * hi + q;
                const float dec = __expf(fminf(gi - gj[q], 0.f));
                LT[j * 64 + i] = (j < i) ? bi * aK[r] * dec : 0.f;
                aQ[r] = (j <= i) ? aQ[r] * dec : 0.f; } }
        *(bf16x8*)(blk + 32768 + ((ib * 4 + 2 * jb + 0) * 1024) + lane * 16) = pack8<0>(aQ);
        *(bf16x8*)(blk + 32768 + ((ib * 4 + 2 * jb + 1) * 1024) + lane * 16) = pack8<1>(aQ);
    }
    __syncthreads();
    if (wq == 0) {
        float t[64];
        backsub_all63(t, LT, lane);
        LDS_WAIT(); asm volatile("" ::: "memory");
#pragma unroll
        for (int c = 0; c < 8; ++c) {
            const f32x4 b0 = *(const LAS f32x4*)(BETA + 8 * c), b1 = *(const LAS f32x4*)(BETA + 8 * c + 4), g0 = *(const LAS f32x4*)(BG + 8 * c), g1 = *(const LAS f32x4*)(BG + 8 * c + 4);
            u32x4 wb, wg;
            wb.x = pk2(t[8 * c] * b0[0], t[8 * c + 1] * b0[1]); wb.y = pk2(t[8 * c + 2] * b0[2], t[8 * c + 3] * b0[3]); wb.z = pk2(t[8 * c + 4] * b1[0], t[8 * c + 5] * b1[1]); wb.w = pk2(t[8 * c + 6] * b1[2], t[8 * c + 7] * b1[3]);
            wg.x = pk2(t[8 * c] * g0[0], t[8 * c + 1] * g0[1]); wg.y = pk2(t[8 * c + 2] * g0[2], t[8 * c + 3] * g0[3]); wg.z = pk2(t[8 * c + 4] * g1[0], t[8 * c + 5] * g1[1]); wg.w = pk2(t[8 * c + 6] * g1[2], t[8 * c + 7] * g1[3]);
            *(LAS u32x4*)(TB + sw64(lane, c)) = wb; *(LAS u32x4*)(TBG + sw64(lane, c)) = wg;
        }
    } else {
#pragma unroll 1
        for (int f = wq - 1; f < 32; f += 3) {
            if (f < 16) { const int ib = f >> 3, ks = f & 7; const int i = 32 * ib + r32; const int ti = dir ? 63 - i : i; const float eg = EGC[i];
                const u32x2 lo = *(const LAS u32x2*)(Qn + sw128(ti, 2 * ks) + 8 * hi), hh = *(const LAS u32x2*)(Qn + sw128(ti, 2 * ks + 1) + 8 * hi);
                u32x4 o; o.x = pk2(bflo(lo.x) * eg, bfhi(lo.x) * eg); o.y = pk2(bflo(lo.y) * eg, bfhi(lo.y) * eg); o.z = pk2(bflo(hh.x) * eg, bfhi(hh.x) * eg); o.w = pk2(bflo(hh.y) * eg, bfhi(hh.y) * eg);
                *(u32x4*)(blk + 16384 + ((ib * 8 + ks) * 1024) + lane * 16) = o;
            } else { const int kb = (f - 16) >> 2, ks = (f - 16) & 3; const int dk = 32 * kb + r32;
                const u32x2 lo = *(const LAS u32x2*)(KT + sw64(dk, 2 * ks) + 8 * hi), hh = *(const LAS u32x2*)(KT + sw64(dk, 2 * ks + 1) + 8 * hi);
                const f32x4 d0 = *(const LAS f32x4*)(KDEC + 16 * ks + 4 * hi), d1 = *(const LAS f32x4*)(KDEC + 16 * ks + 8 + 4 * hi);
                u32x4 o; o.x = pk2(bflo(lo.x) * d0[0], bfhi(lo.x) * d0[1]); o.y = pk2(bflo(lo.y) * d0[2], bfhi(lo.y) * d0[3]); o.z = pk2(bflo(hh.x) * d1[0], bfhi(hh.x) * d1[1]); o.w = pk2(bflo(hh.y) * d1[2], bfhi(hh.y) * d1[3]);
                *(u32x4*)(blk + 40960 + ((kb * 4 + ks) * 1024) + lane * 16) = o; }
        }
    }
    __syncthreads();
#pragma unroll 1
    for (int m = 0; m < 4; ++m) { const int g = wq * 4 + m;
        f32x16 acc;
#pragma unroll
        for (int r = 0; r < 16; ++r) acc[r] = 0.f;
        if (g < 8) { const int ib = g >> 2, kb = g & 3;
#pragma unroll
            for (int js = 0; js < 4; ++js) { const bf16x8 a = *(const LAS bf16x8*)(KT + sw64(32 * kb + r32, 2 * js + hi)); const bf16x8 tg = *(const LAS bf16x8*)(TBG + sw64(32 * ib + r32, 2 * js + hi)); acc = MFMA32(a, tg, acc); }
            *(bf16x8*)(blk + ((ib * 8 + 2 * kb + 0) * 1024) + lane * 16) = pack8<0>(acc);
            *(bf16x8*)(blk + ((ib * 8 + 2 * kb + 1) * 1024) + lane * 16) = pack8<1>(acc);
        } else { const int ib = (g - 8) >> 2, dvb = (g - 8) & 3;
#pragma unroll
            for (int js = 0; js < 4; ++js) { const bf16x8 tb = *(const LAS bf16x8*)(TB + sw64(32 * ib + r32, 2 * js + hi)); const bf16x8 bv = *(const LAS bf16x8*)(VT + sw64(32 * dvb + r32, 2 * js + hi)); acc = MFMA32(tb, bv, acc); }
            unsigned char* up = blk + 57344 + (dvb * 2 + ib) * 2048 + lane * 32;
            *(bf16x8*)(up) = pack8<0>(acc); *(bf16x8*)(up + 16) = pack8<1>(acc);
        }
    }
}

DI void phase_gdn_prep(PH_ARGS) {
    unsigned char* ws = A.ws;
    const bf16* PROJ = (const bf16*)(ws + WS_BIG);
    LAS unsigned char* Qn = lds; LAS unsigned char* Kn = lds + 16384;
    LAS float* NRM = (LAS float*)(lds + LDSX + 1024 + 2560);
    const int lane_in = lane;
    for (int u = bx; u < 2112; u += G) {
        int lane = lane_in; asm volatile("" : "+v"(lane));
        int seqsel, b, cidx, h;
        if (u < 2048) { seqsel = 0; b = u >> 9; cidx = (u >> 2) & 127; h = u & 3; } else { const int q = u - 2048; seqsel = 1; b = q >> 4; cidx = (q >> 2) & 3; h = q & 3; }
        const int rowbase = seqsel ? RL + b * CTXL : b * SEQL; const int L = seqsel ? CTXL : SEQL; const int t0 = cidx * 64;
        {
            const int d = 2 * lane; float w[3][3][2];
#pragma unroll
            for (int s = 0; s < 3; ++s)
#pragma unroll
                for (int j = 0; j < 3; ++j) { const f32x2 wv = *(const f32x2*)(A.in[9] + j * 1536 + s * 512 + h * 128 + d); w[s][j][0] = wv[0]; w[s][j][1] = wv[1]; }
            unsigned raw[10][3];
#pragma unroll
            for (int rr = 0; rr < 10; ++rr) { const int t = t0 + 8 * wave - 1 + rr; const bool ok = (t >= 0) && (t < L);
#pragma unroll
                for (int s = 0; s < 3; ++s) raw[rr][s] = ok ? *(const unsigned*)(PROJ + (size_t)(rowbase + t) * NPROJ + 1536 + s * 512 + h * 128 + d) : 0u; }
            float val[8][3][2], ssq[16];
#pragma unroll
            for (int ii = 0; ii < 8; ++ii) {
#pragma unroll
                for (int s = 0; s < 3; ++s) {
                    const float x0 = w[s][0][0] * bflo(raw[ii][s]) + w[s][1][0] * bflo(raw[ii + 1][s]) + w[s][2][0] * bflo(raw[ii + 2][s]);
                    const float x1 = w[s][0][1] * bfhi(raw[ii][s]) + w[s][1][1] * bfhi(raw[ii + 1][s]) + w[s][2][1] * bfhi(raw[ii + 2][s]);
                    val[ii][s][0] = silu_f(x0); val[ii][s][1] = silu_f(x1); }
                ssq[ii] = val[ii][0][0] * val[ii][0][0] + val[ii][0][1] * val[ii][0][1]; ssq[8 + ii] = val[ii][1][0] * val[ii][1][0] + val[ii][1][1] * val[ii][1][1]; }
            { const float red = reduce16(ssq, lane); const int ee = eidx16(lane);
              const float rn = (ee < 8 ? 0.08838834764831845f : 1.0f) / sqrtf(red + EPSN);
              if ((lane & 3) == 0) NRM[wave * 16 + ee] = rn; }
            LDS_WAIT(); asm volatile("" ::: "memory");
            float nrm[16];
#pragma unroll
            for (int q4 = 0; q4 < 4; ++q4) { const f32x4 nv = *(const LAS f32x4*)(NRM + wave * 16 + 4 * q4); nrm[4 * q4] = nv[0]; nrm[4 * q4 + 1] = nv[1]; nrm[4 * q4 + 2] = nv[2]; nrm[4 * q4 + 3] = nv[3]; }
#pragma unroll
            for (int ii = 0; ii < 8; ++ii) { const int i = 8 * wave + ii; const float rq = nrm[ii], rk = nrm[8 + ii];
                const unsigned qp = pk2(val[ii][0][0] * rq, val[ii][0][1] * rq), kp = pk2(val[ii][1][0] * rk, val[ii][1][1] * rk), vp = pk2(val[ii][2][0], val[ii][2][1]);
                *(LAS unsigned*)(Qn + sw128(i, lane >> 2) + (lane & 3) * 4) = qp;
                *(LAS unsigned*)(Kn + sw128(i, lane >> 2) + (lane & 3) * 4) = kp;
#pragma unroll
                for (int dir = 0; dir < 2; ++dir) { const int pi = dir ? 63 - i : i; LAS unsigned char* KT = lds + 32768 + 49152 * dir + 16384; LAS unsigned char* VT = KT + 16384;
                    *(LAS unsigned short*)(KT + sw64(d, pi >> 3) + (pi & 7) * 2) = (unsigned short)(kp & 0xffffu);
                    *(LAS unsigned short*)(KT + sw64(d + 1, pi >> 3) + (pi & 7) * 2) = (unsigned short)(kp >> 16);
                    *(LAS unsigned short*)(VT + sw64(d, pi >> 3) + (pi & 7) * 2) = (unsigned short)(vp & 0xffffu);
                    *(LAS unsigned short*)(VT + sw64(d + 1, pi >> 3) + (pi & 7) * 2) = (unsigned short)(vp >> 16); }
            }
        }
        __syncthreads();
        gdn_dir4(A, lds, lane, wave >> 2, wave & 3, b, h, seqsel, cidx, rowbase, t0);
        __syncthreads();
    }
}

DI void expert_queue(const Args& A, LAS unsigned char* lds, int lane, int wave, unsigned* qword, const float* Wg, const float* Wu, const float* Wd, bf16* W1, bf16* W2, unsigned ibase = 0u, unsigned icount = 49152u) {
    LAS float* scr = (LAS float*)(lds + wave * 8704);
    for (;;) {
        unsigned it0 = 0u;
        if (lane == 0) it0 = __hip_atomic_fetch_add(qword, 8u, __ATOMIC_RELAXED, __HIP_MEMORY_SCOPE_AGENT);
        it0 = (unsigned)__builtin_amdgcn_readfirstlane((int)it0);
        if (it0 >= icount) break;
        it0 += ibase;
        float ta[32], tb[32];
        ItemDesc da = expert_desc((int)it0, Wg, Wu, Wd, W1, W2), db = da;
        tr_load(da.src, da.ldw, ta, lane);
#pragma unroll 1
        for (int q = 0; q < 8; q += 2) {
            db = expert_desc((int)it0 + q + 1, Wg, Wu, Wd, W1, W2); tr_load(db.src, db.ldw, tb, lane);
            tr_finish(ta, da.dst, da.ldk, da.k0, da.rbase, scr, lane);
            if (q + 2 < 8) { da = expert_desc((int)it0 + q + 2, Wg, Wu, Wd, W1, W2); tr_load(da.src, da.ldw, ta, lane); }
            tr_finish(tb, db.dst, db.ldk, db.k0, db.rbase, scr, lane);
        }
    }
}
DI void phase_gdn_scan(PH_ARGS) {
    unsigned char* ws = A.ws;
    unsigned* qword = (unsigned*)(ws + WS_CTL) + CW_Q0;
    if (bx < 128) {
    const int xcd = bx & 7, idx = bx >> 3; const int ch = xcd + 8 * (idx >> 2), v = idx & 3;
    const int dir = ch & 1, bh = ch >> 1, b = bh >> 2, h = bh & 3;
    const int r32 = lane & 31, hi = lane >> 5;
    bf16* PROJ = (bf16*)(ws + WS_BIG);
    const float* GL = (const float*)(ws + WS_GLAST) + ch * NCHUNK;
    const unsigned char* gbase = ws + WS_G + (size_t)ch * NCHUNK * GBLK;
    constexpr int SBUF = 61440;
    const int lt = tid - 64;
    u32x4 tv[9];
#pragma unroll
    for (int k = 0; k < 9; ++k) tv[k] = (u32x4){0u, 0u, 0u, 0u};
#define SCAN_ISSUE(p) do { const unsigned char* gb = gbase + (size_t)(p) * GBLK; \
        _Pragma("unroll") for (int k = 0; k < 8; ++k) tv[k] = *(const u32x4*)(gb + (lt + 448 * k) * 16); \
        if (lt < 256) tv[8] = *(const u32x4*)(gb + 57344 + v * 4096 + lt * 16); } while (0)
#define SCAN_WRITE(bufi) do { LAS unsigned char* lb = lds + (bufi) * SBUF; \
        _Pragma("unroll") for (int k = 0; k < 8; ++k) *(LAS u32x4*)(lb + (lt + 448 * k) * 16) = tv[k]; \
        if (lt < 256) *(LAS u32x4*)(lb + 57344 + lt * 16) = tv[8]; } while (0)
    if (wave > 0) { SCAN_ISSUE(0); SCAN_WRITE(0); SCAN_ISSUE(1); }
    __syncthreads();
    f32x16 S[4];
#pragma unroll
    for (int kb = 0; kb < 4; ++kb)
#pragma unroll
        for (int r = 0; r < 16; ++r) S[kb][r] = 0.f;
    for (int p = 0; p < NCHUNK; ++p) {
      if (wave > 0) { if (p + 1 < NCHUNK) SCAN_WRITE((p + 1) & 1); if (p + 2 < NCHUNK) SCAN_ISSUE(p + 2); }
      else {
        const LAS unsigned char* blk = lds + (p & 1) * SBUF + lane * 16;
        const float gl = GL[p];
        bf16x8 Sb[8];
        Sb[0] = pack8<0>(S[0]); Sb[1] = pack8<1>(S[0]); Sb[2] = pack8<0>(S[1]); Sb[3] = pack8<1>(S[1]);
        Sb[4] = pack8<0>(S[2]); Sb[5] = pack8<1>(S[2]); Sb[6] = pack8<0>(S[3]); Sb[7] = pack8<1>(S[3]);
        f32x16 P[2], O[2];
#pragma unroll
        for (int ib = 0; ib < 2; ++ib) {
#pragma unroll
            for (int r = 0; r < 16; ++r) { P[ib][r] = 0.f; O[ib][r] = 0.f; }
#pragma unroll
            for (int ks = 0; ks < 8; ++ks) { const bf16x8 wf = *(const LAS bf16x8*)(blk + (ib * 8 + ks) * 1024); P[ib] = MFMA32(wf, Sb[ks], P[ib]); }
            asm volatile("" ::: "memory");
#pragma unroll
            for (int ks = 0; ks < 8; ++ks) { const bf16x8 qf = *(const LAS bf16x8*)(blk + 16384 + (ib * 8 + ks) * 1024); O[ib] = MFMA32(qf, Sb[ks], O[ib]); }
            asm volatile("" ::: "memory");
        }
        bf16x8 Vb[4];
#pragma unroll
        for (int ib = 0; ib < 2; ++ib) {
            const LAS unsigned char* up = lds + (p & 1) * SBUF + 57344 + ib * 2048 + lane * 32;
            const u32x4 u0 = *(const LAS u32x4*)up, u1 = *(const LAS u32x4*)(up + 16);
            f32x16 vn;
            vn[0] = bflo(u0.x) - P[ib][0]; vn[1] = bfhi(u0.x) - P[ib][1]; vn[2] = bflo(u0.y) - P[ib][2]; vn[3] = bfhi(u0.y) - P[ib][3];
            vn[4] = bflo(u0.z) - P[ib][4]; vn[5] = bfhi(u0.z) - P[ib][5]; vn[6] = bflo(u0.w) - P[ib][6]; vn[7] = bfhi(u0.w) - P[ib][7];
            vn[8] = bflo(u1.x) - P[ib][8]; vn[9] = bfhi(u1.x) - P[ib][9]; vn[10] = bflo(u1.y) - P[ib][10]; vn[11] = bfhi(u1.y) - P[ib][11];
            vn[12] = bflo(u1.z) - P[ib][12]; vn[13] = bfhi(u1.z) - P[ib][13]; vn[14] = bflo(u1.w) - P[ib][14]; vn[15] = bfhi(u1.w) - P[ib][15];
            Vb[2 * ib] = pack8<0>(vn); Vb[2 * ib + 1] = pack8<1>(vn);
        }
#pragma unroll
        for (int ib = 0; ib < 2; ++ib)
#pragma unroll
            for (int kt = 0; kt < 4; ++kt) { const bf16x8 af = *(const LAS bf16x8*)(blk + 32768 + (ib * 4 + kt) * 1024); O[ib] = MFMA32(af, Vb[kt], O[ib]); }
        asm volatile("" ::: "memory");
#pragma unroll
        for (int kb = 0; kb < 4; ++kb) {
            asm volatile("" ::: "memory");
#pragma unroll
            for (int r = 0; r < 16; ++r) S[kb][r] *= gl;
#pragma unroll
            for (int kt = 0; kt < 4; ++kt) { const bf16x8 kf = *(const LAS bf16x8*)(blk + 40960 + (kb * 4 + kt) * 1024); S[kb] = MFMA32(kf, Vb[kt], S[kb]); }
        }
        int rowbase, cidx;
        if (p < 4) { cidx = dir ? 3 - p : p; rowbase = RL + b * CTXL; } else { cidx = dir ? 131 - p : p - 4; rowbase = b * SEQL; }
        int hiv = hi; asm volatile("" : "+v"(hiv));
        const long step = dir ? -(long)NPROJ : (long)NPROJ;
        bf16* ob = PROJ + (size_t)(rowbase + cidx * 64 + (dir ? 63 - 4 * hiv : 4 * hiv)) * NPROJ + 1536 + dir * 512 + h * 128 + 32 * v + r32;
#pragma unroll
        for (int ib = 0; ib < 2; ++ib)
#pragma unroll
            for (int r = 0; r < 16; ++r) { const int c = 32 * ib + (r & 3) + 8 * (r >> 2);
                ob[step * c] = (bf16)(pk2(O[ib][r], 0.f) & 0xffffu); }
      }
      __syncthreads();
    }
#undef SCAN_ISSUE
#undef SCAN_WRITE
    }
    { const unsigned i0 = (G == 256) ? L0_SPARE : 0u; expert_queue(A, lds, lane, wave, qword, A.in[16], A.in[17], A.in[18], (bf16*)(ws + WS_E0), (bf16*)(ws + WS_E0 + 128 * MiB), i0, 49152u - i0); }
    expert_queue(A, lds, lane, wave, (unsigned*)(ws + WS_CTL) + CW_Q3, A.in[31], A.in[32], A.in[33], (bf16*)(ws + WS_G), (bf16*)(ws + WS_W2L1), 32768u, 16384u);
}

DI void unpack8(const u32x4 w, float (&f)[8]) { f[0] = bflo(w.x); f[1] = bfhi(w.x); f[2] = bflo(w.y); f[3] = bfhi(w.y); f[4] = bflo(w.z); f[5] = bfhi(w.z); f[6] = bflo(w.w); f[7] = bfhi(w.w); }
DI void phase_ycat(PH_ARGS) {
    unsigned char* ws = A.ws;
    const bf16* PROJ = (const bf16*)(ws + WS_BIG); bf16* Y = (bf16*)(ws + WS_H);
    const int c0 = 8 * lane;
    float cw[3][8], gn[8];
#pragma unroll
    for (int j = 0; j < 3; ++j) { const f32x4 a = *(const f32x4*)(A.in[8] + j * 512 + c0), b2 = *(const f32x4*)(A.in[8] + j * 512 + c0 + 4);
        cw[j][0] = a[0]; cw[j][1] = a[1]; cw[j][2] = a[2]; cw[j][3] = a[3]; cw[j][4] = b2[0]; cw[j][5] = b2[1]; cw[j][6] = b2[2]; cw[j][7] = b2[3]; }
    { const f32x4 a = *(const f32x4*)(A.in[12] + (c0 & 127)), b2 = *(const f32x4*)(A.in[12] + (c0 & 127) + 4);
        gn[0] = a[0]; gn[1] = a[1]; gn[2] = a[2]; gn[3] = a[3]; gn[4] = b2[0]; gn[5] = b2[1]; gn[6] = b2[2]; gn[7] = b2[3]; }
    for (int r = bx * NWAVES + wave; r < RT; r += G * NWAVES) {
        const int t = r < RL ? (r & 8191) : ((r - RL) & 255); const int L = r < RL ? SEQL : CTXL;
        const bf16* pr = PROJ + (size_t)r * NPROJ;
        float pm[8], pc[8], pn[8], xa[8], gc_[8], gb[8];
        unpack8(*(const u32x4*)(pr + c0), xa); unpack8(*(const u32x4*)(pr + 1024 + c0), gc_); unpack8(*(const u32x4*)(pr + 512 + c0), gb);
#pragma unroll
        for (int q = 0; q < 8; ++q) pc[q] = gc_[q] * xa[q];
        if (t > 0) { unpack8(*(const u32x4*)(pr - NPROJ + c0), xa); unpack8(*(const u32x4*)(pr - NPROJ + 1024 + c0), gc_);
#pragma unroll
            for (int q = 0; q < 8; ++q) pm[q] = gc_[q] * xa[q]; }
        else {
#pragma unroll
            for (int q = 0; q < 8; ++q) pm[q] = 0.f; }
        if (t < L - 1) { unpack8(*(const u32x4*)(pr + NPROJ + c0), xa); unpack8(*(const u32x4*)(pr + NPROJ + 1024 + c0), gc_);
#pragma unroll
            for (int q = 0; q < 8; ++q) pn[q] = gc_[q] * xa[q]; }
        else {
#pragma unroll
            for (int q = 0; q < 8; ++q) pn[q] = 0.f; }
        u32x4 o;
        { float y[8];
#pragma unroll
            for (int q = 0; q < 8; ++q) y[q] = gb[q] * (cw[0][q] * pm[q] + cw[1][q] * pc[q] + cw[2][q] * pn[q]);
            o.x = pk2(y[0], y[1]); o.y = pk2(y[2], y[3]); o.z = pk2(y[4], y[5]); o.w = pk2(y[6], y[7]); }
        *(u32x4*)(Y + (size_t)r * DM + c0) = o;
        float of[8], ob[8], z[8];
        unpack8(*(const u32x4*)(pr + 1536 + c0), of); unpack8(*(const u32x4*)(pr + 2048 + c0), ob); unpack8(*(const u32x4*)(pr + 3072 + c0), z);
        float ss = 0.f;
#pragma unroll
        for (int q = 0; q < 8; ++q) { of[q] += ob[q]; ss += of[q] * of[q]; }
        ss += __shfl_xor(ss, 1); ss += __shfl_xor(ss, 2); ss += __shfl_xor(ss, 4); ss += __shfl_xor(ss, 8);
        const float rn = 1.0f / sqrtf(ss * (1.0f / 128.0f) + EPSN);
        { float y[8];
#pragma unroll
            for (int q = 0; q < 8; ++q) y[q] = of[q] * rn * gn[q] * silu_f(z[q]);
            o.x = pk2(y[0], y[1]); o.y = pk2(y[2], y[3]); o.z = pk2(y[4], y[5]); o.w = pk2(y[6], y[7]); }
        *(u32x4*)(Y + (size_t)r * DM + 512 + c0) = o;
    }
}

template <int LAYER> DI void phase_topk(PH_ARGS) {
    unsigned char* ws = A.ws;
    LAS unsigned* vals = (LAS unsigned*)lds; LAS unsigned* hist = (LAS unsigned*)(lds + 32768); LAS unsigned* misc = (LAS unsigned*)(lds + 34816);
    LAS unsigned* wsum = (LAS unsigned*)(lds + 35840);
    const int SPE = LAYER ? SPE1 : SPE0; const int NTASK = LAYER ? 64 : 128;
    float* gatev = (float*)(ws + WS_GATEV); int* INV = (int*)(ws + WS_INV); int* IDX = (int*)(ws + WS_IDX);
    for (int task = bx; task < NTASK; task += G) {
        const int seqsel = task >> 6, b = (task >> 4) & 3, e = task & 15;
        const int n = seqsel ? CTXL : SEQL, cap = seqsel ? 32 : 1024;
        const float* af = (const float*)(ws + WS_AFFT) + (seqsel ? 524288 + (size_t)((b * 16 + e)) * 256 : (size_t)((b * 16 + e)) * 8192);
        const int rowbase = seqsel ? RL + b * CTXL : b * SEQL;
        const int slotbase = e * SPE + (seqsel ? 4096 + b * 32 : b * 1024);
        for (int i = tid; i < n; i += NTHR) vals[i] = __float_as_uint(af[i]);
        __syncthreads();
        unsigned prefix = 0u; int remaining = cap;
#pragma unroll 1
        for (int pass = 3; pass >= 0; --pass) { const int shift = pass * 8;
            if (tid < 256) hist[tid] = 0u;
            __syncthreads();
            for (int i = tid; i < n; i += NTHR) { const unsigned vv = vals[i]; const bool match = (pass == 3) || (((vv ^ prefix) >> (shift + 8)) == 0u); if (match) __hip_atomic_fetch_add(&hist[(vv >> shift) & 255u], 1u, __ATOMIC_RELAXED, __HIP_MEMORY_SCOPE_WORKGROUP); }
            __syncthreads();
            if (wave == 0) {
                const u32x4 hv = *(const LAS u32x4*)(hist + 4 * lane); const int h0 = (int)hv.x, h1 = (int)hv.y, h2 = (int)hv.z, h3 = (int)hv.w;
                const int c = h0 + h1 + h2 + h3; int inc = c;
#pragma unroll
                for (int o = 1; o < 64; o <<= 1) { const int tv = __shfl_down(inc, o); if (lane + o < 64) inc += tv; }
                int cum = inc - c;
                if (cum < remaining && remaining <= cum + c) { int dsel;
                    if (cum + h3 >= remaining) dsel = 3; else { cum += h3; if (cum + h2 >= remaining) dsel = 2; else { cum += h2; if (cum + h1 >= remaining) dsel = 1; else { cum += h1; dsel = 0; } } }
                    misc[0] = (unsigned)(4 * lane + dsel); misc[1] = (unsigned)(remaining - cum); } }
            __syncthreads();
            prefix |= misc[0] << shift; remaining = (int)misc[1];
            __syncthreads();
        }
        const int per = seqsel ? 1 : 16; const int i0 = tid * per; const bool act = i0 < n;
        int cgt = 0, ceq = 0;
        if (act) for (int q = 0; q < per; ++q) { const unsigned vv = vals[i0 + q]; cgt += (vv > prefix); ceq += (vv == prefix); }
        unsigned pk = (unsigned)cgt | ((unsigned)ceq << 16), inc = pk;
#pragma unroll
        for (int o = 1; o < 64; o <<= 1) { const unsigned tv = __shfl_up(inc, o); if (lane >= o) inc += tv; }
        if (lane == 63) wsum[wave] = inc;
        __syncthreads();
        unsigned woff = 0u;
#pragma unroll
        for (int w = 0; w < NWAVES; ++w) { const unsigned s = wsum[w]; if (w < wave) woff += s; }
        const unsigned exc = woff + inc - pk; int gt_before = (int)(exc & 0xffffu), eq_before = (int)(exc >> 16);
        if (act) for (int q = 0; q < per; ++q) { const int i = i0 + q; const unsigned vv = vals[i]; int slot = -1;
            if (vv > prefix) { slot = gt_before + (eq_before < remaining ? eq_before : remaining); ++gt_before; }
            else if (vv == prefix) { if (eq_before < remaining) slot = gt_before + eq_before; ++eq_before; }
            INV[(size_t)(rowbase + i) * 16 + e] = slot >= 0 ? slotbase + slot : -1;
            if (slot >= 0) { IDX[slotbase + slot] = rowbase + i; gatev[slotbase + slot] = __uint_as_float(vv); } }
        if (LAYER == 0 && seqsel == 1 && b == 0) {
            if (tid < 128) { IDX[e * SPE + 4224 + tid] = 0; gatev[e * SPE + 4224 + tid] = 0.f; } }
        __syncthreads();
    }
    if (LAYER == 0) expert_queue(A, lds, lane, wave, (unsigned*)(ws + WS_CTL) + CW_Q1, A.in[31], A.in[32], A.in[33], (bf16*)(ws + WS_G), (bf16*)(ws + WS_W2L1), 0u, (G == 256) ? L1_A : 20480u);
    else expert_queue(A, lds, lane, wave, (unsigned*)(ws + WS_CTL) + CW_Q2, A.in[31], A.in[32], A.in[33], (bf16*)(ws + WS_G), (bf16*)(ws + WS_W2L1), (G == 256) ? L1_C : 20480u, 32768u - ((G == 256) ? L1_C : 20480u));
}

template <int LAYER> DI void combine_finish(const Args& A, unsigned char* ws, float* xr, f32x4 (&v)[4], int r, int bb, int lane) {
    if (LAYER == 0) {
#pragma unroll
        for (int j = 0; j < 4; ++j) *(f32x4*)(xr + 256 * j + 4 * lane) = v[j];
        const float* m1 = (const float*)(ws + WS_MODV) + 5 * 6144 + bb * 6144;
        modulate_row(v, A.in[21], m1, m1 + 1024, lane);
        store_row_bf16((bf16*)(ws + WS_H) + (size_t)r * DM, v, lane);
    } else {
        float ss = 0.f;
#pragma unroll
        for (int j = 0; j < 4; ++j) ss += (v[j][0] * v[j][0] + v[j][1] * v[j][1]) + (v[j][2] * v[j][2] + v[j][3] * v[j][3]);
        const float rstd = 1.0f / sqrtf(wave_sum(ss) * (1.0f / DM) + EPSN);
#pragma unroll
        for (int j = 0; j < 4; ++j) { const f32x4 w = *(const f32x4*)(A.in[34] + 256 * j + 4 * lane); *(f32x4*)(xr + 256 * j + 4 * lane) = v[j] * rstd * w; }
    }
}
template <int LAYER> DI void phase_combine(PH_ARGS) {
    unsigned char* ws = A.ws;
    const bf16* YE = (const bf16*)(LAYER ? ws + WS_E0 : ws + WS_G + 192 * MiB);
    const int* INV = (const int*)(ws + WS_INV);
    const float* mv = (const float*)(ws + WS_MODV) + LAYER * 5 * 6144;
    const int NR = LAYER ? RL : RT;
    const int stride = G * NWAVES;
    for (int r0 = bx * NWAVES + wave; r0 < NR; r0 += 2 * stride) {
        const bool two = (r0 + stride < NR); const int r1 = two ? r0 + stride : r0;
        float* x0 = resid_ptr(A.out, (float*)(ws + WS_XC), r0); float* x1 = resid_ptr(A.out, (float*)(ws + WS_XC), r1);
        const int bb0 = row_bb(r0), bb1 = row_bb(r1);
        f32x4 v0[4], v1[4]; load_row_f32(x0, v0, lane); load_row_f32(x1, v1, lane);
        const int i0 = INV[(size_t)r0 * 16 + (lane & 15)], i1 = INV[(size_t)r1 * 16 + (lane & 15)];
        f32x4 a0[4], a1[4];
#pragma unroll
        for (int j = 0; j < 4; ++j) { a0[j] = (f32x4){0.f, 0.f, 0.f, 0.f}; a1[j] = (f32x4){0.f, 0.f, 0.f, 0.f}; }
        unsigned long long m0 = __ballot(i0 >= 0) & 0xffffull, m1 = __ballot(i1 >= 0) & 0xffffull;
        while (m0 | m1) {
            if (m0) { const int e = __builtin_ctzll(m0); m0 &= m0 - 1; const int sl = __shfl(i0, e); const bf16* yr = YE + (size_t)sl * DM;
#pragma unroll
                for (int j = 0; j < 4; ++j) { const u32x2 w = *(const u32x2*)(yr + 256 * j + 4 * lane); a0[j][0] += bflo(w.x); a0[j][1] += bfhi(w.x); a0[j][2] += bflo(w.y); a0[j][3] += bfhi(w.y); } }
            if (m1) { const int e = __builtin_ctzll(m1); m1 &= m1 - 1; const int sl = __shfl(i1, e); const bf16* yr = YE + (size_t)sl * DM;
#pragma unroll
                for (int j = 0; j < 4; ++j) { const u32x2 w = *(const u32x2*)(yr + 256 * j + 4 * lane); a1[j][0] += bflo(w.x); a1[j][1] += bfhi(w.x); a1[j][2] += bflo(w.y); a1[j][3] += bfhi(w.y); } }
        }
#pragma unroll
        for (int j = 0; j < 4; ++j) { const f32x4 g0 = *(const f32x4*)(mv + bb0 * 6144 + 5 * 1024 + 256 * j + 4 * lane), g1 = *(const f32x4*)(mv + bb1 * 6144 + 5 * 1024 + 256 * j + 4 * lane);
            v0[j] = v0[j] + g0 * a0[j]; v1[j] = v1[j] + g1 * a1[j]; }
        combine_finish<LAYER>(A, ws, x0, v0, r0, bb0, lane);
        if (two) combine_finish<LAYER>(A, ws, x1, v1, r1, bb1, lane);
    }
}

DI float max3_asm(float a, float b, float c) { float r; asm("v_max3_f32 %0, %1, %2, %3" : "=v"(r) : "v"(a), "v"(b), "v"(c)); return r; }
DI void glds16(const void* g, LAS unsigned char* l) { __builtin_amdgcn_global_load_lds((const unsigned*)g, (LAS unsigned*)l, 16, 0, 0); }
#define AT_WAIT_BAR(N) do { asm volatile("s_waitcnt vmcnt(" #N ") lgkmcnt(0)" ::: "memory"); __builtin_amdgcn_s_barrier(); asm volatile("" ::: "memory"); } while (0)
DI void phase_attn(PH_ARGS) {
    unsigned char* ws = A.ws;
    const bf16* QK = (const bf16*)(ws + WS_BIG); const bf16* VTg = (const bf16*)(ws + WS_BIG + 132 * MiB); bf16* ATT = (bf16*)(ws + WS_H);
    const int r32 = lane & 31, hi = lane >> 5; const int isub = wave >> 2, rg = wave & 3;
    constexpr int NT = 132, KRING = 0, VRING = 49152, SLOT = 16384;
    float lam;
    { const float s1 = wave_sum(A.in[23][lane] * A.in[24][lane]), s2 = wave_sum(A.in[25][lane] * A.in[26][lane]); lam = __expf(s1) - __expf(s2) + LAM_INIT; }
    const int vcu = (G % 8 == 0) ? (bx % 8) * (G / 8) + bx / 8 : bx;
    const int krow = (r32 & ~12) | ((r32 >> 1) & 4) | ((r32 << 1) & 8);
    const unsigned ldsb = (unsigned)(size_t)lds;
    unsigned kofs[4], vofs[4];
#pragma unroll
    for (int q = 0; q < 4; ++q) { kofs[q] = (unsigned)sw64(krow, 2 * q + hi); vofs[q] = (unsigned)sw64(r32, 2 * q + hi); }
    LAS float* sublnL = (LAS float*)(lds + LDSX + 1024);
    if (tid < 128) sublnL[tid] = A.in[27][tid];
    __syncthreads();
    int b = 0, h = 0, q0 = 0;
    bf16x8 qf[4]; const bf16* srck[2]; const bf16* srcv[2];
#pragma unroll
    for (int kk = 0; kk < 4; ++kk) qf[kk] = (bf16x8){0, 0, 0, 0, 0, 0, 0, 0};
    srck[0] = srck[1] = QK; srcv[0] = srcv[1] = VTg;
    LAS unsigned char* kdst = lds + KRING + (2 * wave) * 1024; LAS unsigned char* vdst = lds + VRING + (2 * wave) * 1024;
#define KEYROW(t) (((t) < 4) ? (RL + b * CTXL + (t) * 64) : (b * SEQL + ((t) - 4) * 64))
#define DMA_K(t, slot) do { const size_t ko_ = (size_t)KEYROW(t) * 2048; glds16(srck[0] + ko_, kdst + (slot) * SLOT); glds16(srck[1] + ko_, kdst + (slot) * SLOT + 1024); } while (0)
#define DMA_V(t, slot) do { const size_t vo_ = (size_t)KEYROW(t); glds16(srcv[0] + vo_, vdst + (slot) * SLOT); glds16(srcv[1] + vo_, vdst + (slot) * SLOT + 1024); } while (0)
#define AT_SETUP(u_) do { const int bh_ = (u_) >> 6; b = bh_ >> 3; h = bh_ & 7; q0 = ((u_) & 63) * 128; \
            const int qrow_ = b * SEQL + q0 + 32 * rg + r32; \
            _Pragma("unroll") for (int kk = 0; kk < 4; ++kk) qf[kk] = *(const bf16x8*)(QK + (size_t)qrow_ * 2048 + h * 128 + isub * 64 + 16 * kk + 8 * hi); \
            int ln_ = lane; asm volatile("" : "+v"(ln_)); const int dl = ln_ >> 3, dpc = ln_ & 7; \
            _Pragma("unroll") for (int i = 0; i < 2; ++i) { const int n = 2 * wave + i; \
                const int sub = n >> 3, key = 8 * (n & 7) + dl, ck = dpc ^ ((key >> 1) & 7); srck[i] = QK + 1024 + h * 128 + sub * 64 + ck * 8 + (size_t)key * 2048; \
                const int dv = 8 * n + dl, cv = dpc ^ ((dv >> 1) & 7); srcv[i] = VTg + (size_t)(h * 128 + dv) * RT + cv * 8; } \
            DMA_K(0, 0); DMA_V(0, 0); DMA_K(1, 1); DMA_K(2, 2); } while (0)
#define AT_LBAR() do { asm volatile("s_waitcnt lgkmcnt(0)" ::: "memory"); __builtin_amdgcn_s_barrier(); asm volatile("" ::: "memory"); } while (0)
    if (vcu < 2048) AT_SETUP(vcu);
    for (int u = vcu; u < 2048; u += G) {
#define QKT(Sx0, Sx1, kslot, negm) do { const LAS unsigned char* kb_ = lds + KRING + (kslot) * SLOT; \
            _Pragma("unroll") for (int r = 0; r < 16; ++r) { Sx0[r] = (negm); Sx1[r] = (negm); } \
            _Pragma("unroll") for (int kk = 0; kk < 4; ++kk) { const bf16x8 a0 = *(const LAS bf16x8*)(kb_ + isub * 8192 + kofs[kk]), a1 = *(const LAS bf16x8*)(kb_ + isub * 8192 + kofs[kk] + 4096); \
                Sx0 = MFMA32(a0, qf[kk], Sx0); Sx1 = MFMA32(a1, qf[kk], Sx1); } } while (0)
        float m_run = 0.f, l_run = 0.f, mcA = 0.f, mcB = 0.f;
        f32x16 OT[4];
#pragma unroll
        for (int d = 0; d < 4; ++d)
#pragma unroll
            for (int r = 0; r < 16; ++r) OT[d][r] = 0.f;
        f32x16 SA0, SA1, SB0, SB1;
        bf16x8 PX[4], PY[4];
        AT_WAIT_BAR(0);
        QKT(SA0, SA1, 0, 0.f);
        DMA_V(1, 1);
        AT_WAIT_BAR(2);
        int ks_next = 1, ks_free = 0;
#define SCE(Sc0, Sc1, e) (((e) < 16) ? Sc0[(e) & 15] : Sc1[(e) & 15])
#define AT_RD(dst, addr, imm) asm volatile("ds_read_b128 %0, %1 offset:%2" : "=v"(dst) : "v"(addr), "n"(imm))
#define AT_WL(dst, n) asm volatile("s_waitcnt lgkmcnt(" #n ")" : "+v"(dst))
#define AT_STEP(Sc0, Sc1, mc, Sn0, Sn1, mn, Pp, Pn, t, DO_PV) do { \
            if ((t) + 3 < NT) DMA_K((t) + 3, ks_free); \
            if ((t) + 2 < NT) DMA_V((t) + 2, ((t) + 2) & 3); \
            mn = 0.f; \
              \
            unsigned ka_[4], va_[4]; \
            { const unsigned kb_ = ldsb + KRING + ks_next * SLOT + isub * 8192, vb_ = ldsb + VRING + (((t) - 1) & 3) * SLOT; \
              _Pragma("unroll") for (int q = 0; q < 4; ++q) { ka_[q] = kb_ + kofs[q]; va_[q] = vb_ + vofs[q]; } } \
            _Pragma("unroll") for (int r = 0; r < 16; ++r) { Sn0[r] = 0.f; Sn1[r] = 0.f; } \
            bf16x8 fr_[3]; float mxa_ = 0.f, mxb_ = 0.f; \
            AT_RD(fr_[0], ka_[0], 0); AT_RD(fr_[1], ka_[0], 4096); \
            __builtin_amdgcn_sched_barrier(0); \
            _Pragma("unroll") for (int g = 0; g < 8; ++g) { \
                if (g + 2 < 8) { if ((g + 2) & 1) AT_RD(fr_[(g + 2) % 3], ka_[(g + 2) >> 1], 4096); else AT_RD(fr_[(g + 2) % 3], ka_[(g + 2) >> 1], 0); } \
                else if (DO_PV) AT_RD(fr_[(g + 2) % 3], va_[g - 6], 0); \
                if (g + 2 < 8 || DO_PV) AT_WL(fr_[g % 3], 2); else if (g == 6) AT_WL(fr_[g % 3], 1); else AT_WL(fr_[g % 3], 0); \
                if (g & 1) Sn1 = MFMA32(fr_[g % 3], qf[g >> 1], Sn1); else Sn0 = MFMA32(fr_[g % 3], qf[g >> 1], Sn0); \
                if (g == 0) { mxa_ = max3_asm(Sc0[0], Sc0[1], Sc0[2]); mxb_ = max3_asm(Sc1[0], Sc1[1], Sc1[2]); } \
                else if (g < 7) { mxa_ = max3_asm(mxa_, Sc0[2 * g + 1], Sc0[2 * g + 2]); mxb_ = max3_asm(mxb_, Sc1[2 * g + 1], Sc1[2 * g + 2]); } \
                else { mxa_ = max3_asm(mxa_, Sc0[15], Sc1[15]); } \
                __builtin_amdgcn_sched_barrier(0); } \
            float mx = fmaxf(mxa_, mxb_); \
            { auto rr_ = __builtin_amdgcn_permlane32_swap(__float_as_uint(mx), __float_as_uint(mx), false, false); mx = fmaxf(__uint_as_float(rr_[0]), __uint_as_float(rr_[1])); }     \
            const float cand = mc + mx; \
            const bool up_ = (cand > m_run + 24.0f) || ((t) == 0 && (cand > 24.0f || cand < -24.0f)); \
            if (__any(up_ || (mc != m_run))) { const float mnew = up_ ? cand : m_run; \
                const float al = __builtin_amdgcn_exp2f(m_run - mnew); l_run *= al; \
                _Pragma("unroll") for (int d = 0; d < 4; ++d) _Pragma("unroll") for (int r = 0; r < 16; ++r) OT[d][r] *= al; \
                if (DO_PV) { _Pragma("unroll") for (int js = 0; js < 4; ++js) { u32x4 w_ = __builtin_bit_cast(u32x4, Pp[js]); \
                    w_.x = pk2(bflo(w_.x) * al, bfhi(w_.x) * al); w_.y = pk2(bflo(w_.y) * al, bfhi(w_.y) * al); w_.z = pk2(bflo(w_.z) * al, bfhi(w_.z) * al); w_.w = pk2(bflo(w_.w) * al, bfhi(w_.w) * al); \
                    Pp[js] = __builtin_bit_cast(bf16x8, w_); } } \
                const float dl = mnew - mc; \
                _Pragma("unroll") for (int r = 0; r < 16; ++r) { Sc0[r] -= dl; Sc1[r] -= dl; } \
                m_run = mnew; } \
            float ls = 0.f; u32x4 pw_[4]; \
            __builtin_amdgcn_sched_barrier(0); \
            _Pragma("unroll") for (int g = 0; g < 16; ++g) { \
                if (DO_PV) { if (g + 2 < 16) AT_RD(fr_[(g + 4) % 3], va_[(g + 2) & 3], ((g + 2) >> 2) * 4096); \
                    if (g + 2 < 16) AT_WL(fr_[(g + 2) % 3], 2); else if (g == 14) AT_WL(fr_[(g + 2) % 3], 1); else AT_WL(fr_[(g + 2) % 3], 0); \
                    OT[g >> 2] = MFMA32(fr_[(g + 2) % 3], Pp[g & 3], OT[g >> 2]); } \
                float x0_ = SCE(Sc0, Sc1, 2 * g), x1_ = SCE(Sc0, Sc1, 2 * g + 1); asm volatile("" : "+v"(x0_), "+v"(x1_)); \
                float e0_ = __builtin_amdgcn_exp2f(x0_), e1_ = __builtin_amdgcn_exp2f(x1_); \
                ls += e0_; ls += e1_; unsigned pk_ = pk2(e0_, e1_); asm volatile("" : "+v"(pk_), "+v"(ls)); pw_[g >> 2][g & 3] = pk_; \
                __builtin_amdgcn_sched_barrier(0); } \
            l_run += ls; \
            Pn[0] = __builtin_bit_cast(bf16x8, pw_[0]); Pn[1] = __builtin_bit_cast(bf16x8, pw_[1]); Pn[2] = __builtin_bit_cast(bf16x8, pw_[2]); Pn[3] = __builtin_bit_cast(bf16x8, pw_[3]); \
            if ((t) + 3 < NT) AT_WAIT_BAR(6); else AT_WAIT_BAR(0); \
            ks_free = ks_next; ks_next = (ks_next == 2) ? 0 : ks_next + 1; } while (0)
        AT_STEP(SA0, SA1, mcA, SB0, SB1, mcB, PX, PY, 0, false);
        for (int t = 1; t < NT - 1; t += 2) { AT_STEP(SB0, SB1, mcB, SA0, SA1, mcA, PY, PX, t, true); AT_STEP(SA0, SA1, mcA, SB0, SB1, mcB, PX, PY, t + 1, true); }
        AT_STEP(SB0, SB1, mcB, SA0, SA1, mcA, PY, PX, NT - 1, true);
        { const LAS unsigned char* vb_ = lds + VRING + ((NT - 1) & 3) * SLOT;
#pragma unroll
          for (int dvb = 0; dvb < 4; ++dvb)
#pragma unroll
            for (int js = 0; js < 4; ++js) { const bf16x8 av = *(const LAS bf16x8*)(vb_ + sw64(32 * dvb + r32, 2 * js + hi)); OT[dvb] = MFMA32(av, PX[js], OT[dvb]); } }
        const int bC = b, hC = h, q0C = q0;
        if (u + G < 2048) AT_SETUP(u + G);
        AT_LBAR();
#undef AT_STEP
#undef AT_RD
#undef AT_WL
#undef SCE
#undef QKT
#undef DMA_K
#undef DMA_V
#undef KEYROW
        { const float lt = l_run + __shfl_xor(l_run, 32); const float il = 1.0f / lt;
#pragma unroll
            for (int d = 0; d < 4; ++d)
#pragma unroll
                for (int r = 0; r < 16; ++r) OT[d][r] *= il; }
        LAS float* ex = (LAS float*)(lds + 65536);
        if (isub == 1) {
#pragma unroll
            for (int d = 0; d < 4; ++d)
#pragma unroll
                for (int r = 0; r < 16; ++r) ex[((rg * 4 + d) * 16 + r) * 64 + lane] = OT[d][r]; }
        AT_LBAR();
        if (isub == 0) {
            float ss = 0.f;
#pragma unroll
            for (int d = 0; d < 4; ++d)
#pragma unroll
                for (int r = 0; r < 16; ++r) { const float o = OT[d][r] - lam * ex[((rg * 4 + d) * 16 + r) * 64 + lane]; OT[d][r] = o; ss += o * o; }
            ss += __shfl_xor(ss, 32);
            const float rn = (1.0f - LAM_INIT) / sqrtf(ss * (1.0f / 128.0f) + EPSN);
            int r32e = lane & 31; asm volatile("" : "+v"(r32e));
            bf16* orow = ATT + (size_t)(bC * SEQL + q0C + 32 * rg + r32e) * DM + hC * 128;
#pragma unroll
            for (int d = 0; d < 4; ++d)
#pragma unroll
                for (int g4 = 0; g4 < 4; ++g4) { const int dv = 32 * d + 8 * g4 + 4 * hi; const f32x4 w = *(const LAS f32x4*)(sublnL + dv);
                    u32x2 o; o.x = pk2(OT[d][4 * g4] * rn * w[0], OT[d][4 * g4 + 1] * rn * w[1]); o.y = pk2(OT[d][4 * g4 + 2] * rn * w[2], OT[d][4 * g4 + 3] * rn * w[3]);
                    *(u32x2*)(orow + dv) = o; }
        }
        AT_LBAR();
    }
    asm volatile("s_waitcnt vmcnt(0)" ::: "memory");
    __syncthreads();
}
#undef AT_SETUP
#undef AT_LBAR
#undef AT_WAIT_BAR

constexpr int NPHASE = 20;
__global__ void __launch_bounds__(NTHR, 2) mega_fwd(Args A) {
    extern __shared__ __attribute__((aligned(16))) unsigned char lds_raw[];
    LAS unsigned char* lds = (LAS unsigned char*)lds_raw;
    const int tid = threadIdx.x, lane = tid & 63, wave = __builtin_amdgcn_readfirstlane(tid >> 6);
    const int G = gridDim.x, bx = blockIdx.x;
    unsigned char* ws = A.ws;
    if (tid < 64) ((LAS unsigned*)(lds + LDSX))[tid] = 0u;
    __syncthreads();
    XcdBarrier bar; bar.bar = (unsigned*)(ws + WS_CTL) + CW_BAR; bar.x = 0; bar.st = nullptr;
    if (!MK_SPLIT) bar = xcd_barrier_post((unsigned*)(ws + WS_CTL) + CW_BAR, (volatile LAS unsigned*)(lds + LDSX));
    const int lo = A.ph_lo, hi_ = A.ph_hi;
#ifdef ONLY_PHASE
#define IN(k) ((k) == ONLY_PHASE && lo <= (k) && (k) < hi_)
#else
#define IN(k) (lo <= (k) && (k) < hi_)
#endif
#if defined(REPEAT_PHASE)
#define REPLOOP(k) for (int rep_ = 0, nrep_ = ((((REPEAT_PHASE) >> (k)) & 1) ? A.ph_rep : 1); rep_ < nrep_; (++rep_ < nrep_) ? xcd_barrier(bar) : (void)0)
#else
#define REPLOOP(k)
#endif
#ifdef PROBE_PHASE
    unsigned long long tp0_ = __builtin_amdgcn_s_memrealtime(), tp1_ = 0ull;
#define SEAM(k) do { if (IN(k) && IN((k) + 1)) xcd_barrier(bar); if ((k) == PROBE_PHASE) tp1_ = __builtin_amdgcn_s_memrealtime(); if ((k) + 1 == PROBE_PHASE) tp0_ = __builtin_amdgcn_s_memrealtime(); } while (0)
#else
#define SEAM(k) do { if (IN(k) && IN((k) + 1)) xcd_barrier(bar); } while (0)
#endif

    if (IN(0)) REPLOOP(0) { phase0(A, lds, tid, lane, wave, G, bx); } SEAM(0);
    if (IN(1)) REPLOOP(1) { phase_modulate<0, 0>(A, lds, tid, lane, wave, G, bx); } SEAM(1);
    if (IN(2)) REPLOOP(2) {
        const int gw = (G == 256) ? GW_P2 : G;
        if (bx < gw) {
        pg8::Gemm g{(const pg8::bf16_t*)(ws + WS_H), (const pg8::bf16_t*)(ws + WS_WIN), RT, NPROJ, DM}; pg8::StaticOrder S; S.init(RT, NPROJ, gw, bx);
        pg8::EpiBf16<0> E{(pg8::bf16_t*)(ws + WS_BIG), NPROJ, nullptr, 0, 0, 1.f};
        pg8::gemm_phase<pg8::EpiBf16<0>, pg8::StaticOrder, true, true>(lds, g, S, E);
        } else expert_queue(A, lds, lane, wave, (unsigned*)(ws + WS_CTL) + CW_Q6, A.in[16], A.in[17], A.in[18], (bf16*)(ws + WS_E0), (bf16*)(ws + WS_E0 + 128 * MiB), 0u, L0_SPARE2);
    } SEAM(2);
    if (IN(3)) REPLOOP(3) { const int gw = (G == 256) ? GW_P3 : G;
        if (bx < gw) phase_gdn_prep(A, lds, tid, lane, wave, gw, bx);
        else expert_queue(A, lds, lane, wave, (unsigned*)(ws + WS_CTL) + CW_Q7, A.in[16], A.in[17], A.in[18], (bf16*)(ws + WS_E0), (bf16*)(ws + WS_E0 + 128 * MiB), L0_SPARE2, L0_SPARE - L0_SPARE2);
    } SEAM(3);
    if (IN(4)) REPLOOP(4) { phase_gdn_scan(A, lds, tid, lane, wave, G, bx); } SEAM(4);
    if (IN(5)) REPLOOP(5) { phase_ycat(A, lds, tid, lane, wave, G, bx); } SEAM(5);
    if (IN(6)) REPLOOP(6) {
        pg8::Gemm g{(const pg8::bf16_t*)(ws + WS_H), (const pg8::bf16_t*)(ws + WS_WOUT), RT, DM, DM}; pg8::StaticOrder S; S.init(RT, DM, G, bx);
        pg8::EpiResidual E{A.in[0], A.in[2], A.out, (float*)(ws + WS_XC), (const float*)(ws + WS_MODV) + 2 * 1024, RL};
        pg8::gemm_phase<pg8::EpiResidual, pg8::StaticOrder, true, true>(lds, g, S, E);
    } SEAM(6);
    if (IN(7)) REPLOOP(7) { phase_modulate<1, 0>(A, lds, tid, lane, wave, G, bx); } SEAM(7);
    if (IN(8)) REPLOOP(8) { phase_topk<0>(A, lds, tid, lane, wave, G, bx); } SEAM(8);
    if (IN(9)) REPLOOP(9) {
        pg8::Gemm g{(const pg8::bf16_t*)(ws + WS_H), (const pg8::bf16_t*)(ws + WS_E0), M1_0, 4096, DM}; pg8::MoeOrder S{17 * 16 * 16, G, bx, 17, 16};
        pg8::EpiMoe1 E{(pg8::bf16_t*)(ws + WS_BIG)};
        LAS unsigned short* gt = (LAS unsigned short*)(lds + LDSX + 1024); const int* IDX = (const int*)(ws + WS_IDX);
        { pg8::Unit uu; for (int i = 0; S.next(i, uu); ++i) if (tid < 256) gt[i * 256 + tid] = (unsigned short)IDX[uu.pm * 256 + tid]; }
        __syncthreads();
        pg8::gemm_phase<pg8::EpiMoe1, pg8::MoeOrder, true, true, true>(lds, g, S, E, gt);
    } SEAM(9);
    if (IN(10)) REPLOOP(10) {
        const int gw = (G == 256) ? GW_P10 : G;
        if (bx < gw) {
        pg8::Gemm g{(const pg8::bf16_t*)(ws + WS_BIG), (const pg8::bf16_t*)(ws + WS_E0 + 128 * MiB), M1_0, DM, FFN}; pg8::MoeOrder S{17 * 16 * 4, gw, bx, 17, 4};
        pg8::EpiMoe2 E{(pg8::bf16_t*)(ws + WS_G + 192 * MiB), (const float*)(ws + WS_GATEV)};
        pg8::gemm_phase<pg8::EpiMoe2, pg8::MoeOrder, true, true>(lds, g, S, E);
        } else expert_queue(A, lds, lane, wave, (unsigned*)(ws + WS_CTL) + CW_Q4, A.in[31], A.in[32], A.in[33], (bf16*)(ws + WS_G), (bf16*)(ws + WS_W2L1), L1_A, L1_B - L1_A);
    } SEAM(10);
    if (IN(11)) REPLOOP(11) { phase_combine<0>(A, lds, tid, lane, wave, G, bx); } SEAM(11);
    if (IN(12)) REPLOOP(12) {
        constexpr int tH = (int)(WS_H / (512 * 1024)), tWqk = (int)(WS_WQK / (512 * 1024)), tWv = (int)(WS_WV / (512 * 1024));
        static_assert(WS_H % (512 * 1024) == 0 && WS_WQK % (512 * 1024) == 0 && WS_WV % (512 * 1024) == 0 && tWqk + 8 <= tH && tWv + 4 <= tH, "operand arrays on 256-row tile boundaries, weights below H");
        const int gw = (G == 256) ? GW_P12 : G;
        if (bx < gw) {
        pg8::Gemm g{(const pg8::bf16_t*)ws, (const pg8::bf16_t*)ws, 0, 0, DM}; pg8::QkvOrder S{gw, bx, tH, tWqk, tWv};
        pg8::EpiQKV E{pg8::EpiQK{(pg8::bf16_t*)(ws + WS_BIG), (const float*)(ws + WS_ROPE), 0.125f * 1.4426950408889634f, RL},
                      pg8::EpiBf16<0>{(pg8::bf16_t*)(ws + WS_BIG + 132 * MiB), RT, nullptr, 0, 0, 1.f}, tH, tWqk, tWv};
        pg8::gemm_phase<pg8::EpiQKV, pg8::QkvOrder, true, true>(lds, g, S, E);
        } else expert_queue(A, lds, lane, wave, (unsigned*)(ws + WS_CTL) + CW_Q5, A.in[31], A.in[32], A.in[33], (bf16*)(ws + WS_G), (bf16*)(ws + WS_W2L1), L1_B, L1_C - L1_B);
    } SEAM(12);
    if (IN(13)) REPLOOP(13) { phase_attn(A, lds, tid, lane, wave, G, bx); } SEAM(13);
    if (IN(14)) REPLOOP(14) {
        pg8::Gemm g{(const pg8::bf16_t*)(ws + WS_H), (const pg8::bf16_t*)(ws + WS_WO), RL, DM, DM}; pg8::StaticOrder S; S.init(RL, DM, G, bx);
        pg8::EpiResidual E{A.out, A.out, A.out, A.out, (const float*)(ws + WS_MODV) + 5 * 6144 + 2 * 1024, RL};
        pg8::gemm_phase<pg8::EpiResidual, pg8::StaticOrder, true, true>(lds, g, S, E);
    } SEAM(14);
    if (IN(15)) REPLOOP(15) { phase_modulate<1, 1>(A, lds, tid, lane, wave, G, bx); } SEAM(15);
    if (IN(16)) REPLOOP(16) { phase_topk<1>(A, lds, tid, lane, wave, G, bx); } SEAM(16);
    if (IN(17)) REPLOOP(17) {
        pg8::Gemm g{(const pg8::bf16_t*)(ws + WS_H), (const pg8::bf16_t*)(ws + WS_G), M1_1, 4096, DM}; pg8::MoeOrder S{16 * 16 * 16, G, bx, 16, 16};
        pg8::EpiMoe1 E{(pg8::bf16_t*)(ws + WS_BIG)};
        LAS unsigned short* gt = (LAS unsigned short*)(lds + LDSX + 1024); const int* IDX = (const int*)(ws + WS_IDX);
        { pg8::Unit uu; for (int i = 0; S.next(i, uu); ++i) if (tid < 256) gt[i * 256 + tid] = (unsigned short)IDX[uu.pm * 256 + tid]; }
        __syncthreads();
        pg8::gemm_phase<pg8::EpiMoe1, pg8::MoeOrder, true, true, true>(lds, g, S, E, gt);
    } SEAM(17);
    if (IN(18)) REPLOOP(18) {
        pg8::Gemm g{(const pg8::bf16_t*)(ws + WS_BIG), (const pg8::bf16_t*)(ws + WS_W2L1), M1_1, DM, FFN}; pg8::MoeOrder S{16 * 16 * 4, G, bx, 16, 4};
        pg8::EpiMoe2 E{(pg8::bf16_t*)(ws + WS_E0), (const float*)(ws + WS_GATEV)};
        pg8::gemm_phase<pg8::EpiMoe2, pg8::MoeOrder, true, true>(lds, g, S, E);
    } SEAM(18);
    if (IN(19)) REPLOOP(19) { phase_combine<1>(A, lds, tid, lane, wave, G, bx); }
#ifdef PROBE_PHASE
    if (PROBE_PHASE == 19) tp1_ = __builtin_amdgcn_s_memrealtime();
    if (bx == 0 && tid == 0) { const unsigned long long te_ = __builtin_amdgcn_s_memrealtime(), dd_ = 4ull * (tp1_ - tp0_);
        while (__builtin_amdgcn_s_memrealtime() - te_ < dd_) __builtin_amdgcn_s_sleep(32); }
#endif
#undef IN
#undef SEAM
}

extern "C" void kernel_launch(void* const* d_in, const int* in_sizes, int n_in, void* d_out, int out_size, void* d_ws, size_t ws_size, hipStream_t stream) {
    static int grid = 0;
    if (grid == 0) {
        if (n_in != 35 || out_size != RL * DM || ws_size < WS_END) { fprintf(stderr, "kernel_launch: unexpected problem (n_in %d, out %d, ws %zu < %zu)\n", n_in, out_size, ws_size, (size_t)WS_END); grid = -1; return; }
        int dev = 0, cus = 0, per_cu = 0;
        if (hipGetDevice(&dev) != hipSuccess || hipDeviceGetAttribute(&cus, hipDeviceAttributeMultiprocessorCount, dev) != hipSuccess) { grid = -1; return; }
        if (hipFuncSetAttribute((const void*)mega_fwd, hipFuncAttributeMaxDynamicSharedMemorySize, LDS_BYTES) != hipSuccess) { fprintf(stderr, "kernel_launch: hipFuncSetAttribute failed\n"); grid = -1; return; }
        if (hipOccupancyMaxActiveBlocksPerMultiprocessor(&per_cu, (const void*)mega_fwd, NTHR, LDS_BYTES) != hipSuccess || per_cu < 1) { fprintf(stderr, "kernel_launch: occupancy query reports %d\n", per_cu); }
        (void)hipGetLastError();
        grid = cus;
    }
    if (grid < 0) return;
    if (hipMemsetAsync((char*)d_ws + WS_CTL, 0, CTL_ZERO_BYTES, stream) != hipSuccess) return;
    Args a{};
    for (int i = 0; i < 35; ++i) a.in[i] = (const float*)d_in[i];
    a.out = (float*)d_out; a.ws = (unsigned char*)d_ws;
#if MK_SPLIT
    for (int p = 0; p < NPHASE; ++p) { a.ph_lo = p; a.ph_hi = p + 1; hipLaunchKernelGGL(mega_fwd, dim3(grid), dim3(NTHR), LDS_BYTES, stream, a); }
#else
    a.ph_lo = 0; a.ph_hi = NPHASE; a.ph_rep = 2;
    hipLaunchKernelGGL(mega_fwd, dim3(grid), dim3(NTHR), LDS_BYTES, stream, a);
#endif
}
```
